# Optimizing an MI355X kernel written in HIP

```python
import math
import jax, jax.numpy as jnp
from jax import lax
import numpy as np

D_MODEL = 2048
BATCH = 2
SEQ = 4096
DEPTH = 4

N_MEM = 256
D_FF = 5632
RMS_EPS = 1e-5

WINDOW = 128
HEAD_DIM = 64
N_Q_HEADS = 16
N_KV_HEADS = 4
GQA_REP = N_Q_HEADS // N_KV_HEADS
Q_WIDTH = N_Q_HEADS * HEAD_DIM
KV_WIDTH = N_KV_HEADS * HEAD_DIM

SSM_WIDTH = 1024
SSM_GROUP = 16
SSM_GROUPS = SSM_WIDTH // SSM_GROUP
SSM_STATE = 64
DT_MIN = 1e-3
DT_MAX = 1e-1

MEM_HEADS = 4
MEM_HEAD_DIM = 256
MEM_WIDTH = MEM_HEADS * MEM_HEAD_DIM

N_BRANCHES = 3
IN_SPLITS = (Q_WIDTH, KV_WIDTH, KV_WIDTH, SSM_WIDTH, MEM_WIDTH, N_BRANCHES * D_MODEL)
IN_WIDTH = sum(IN_SPLITS)
NEG_INF = -1e30

kernel_name = "macaron_hybrid_swa_s5_memory_gated"


def rms_norm(x, w):
    xf = x.astype(jnp.float32)
    y = xf * lax.rsqrt(jnp.mean(xf * xf, axis=-1, keepdims=True) + RMS_EPS)
    return (y * w.astype(jnp.float32)).astype(x.dtype)


def swiglu(x, w_in, w_out):
    g, u = jnp.split(x @ w_in, 2, axis=-1)
    return (jax.nn.silu(g) * u) @ w_out


def sliding_window_attention(q, k, v, sinks):
    B, L = q.shape[0], q.shape[1]
    W = WINDOW
    nb = L // W
    qb = q.reshape(B, nb, W, N_KV_HEADS, GQA_REP, HEAD_DIM)
    kb = k.reshape(B, nb, W, N_KV_HEADS, HEAD_DIM)
    vb = v.reshape(B, nb, W, N_KV_HEADS, HEAD_DIM)
    pad = jnp.zeros_like(kb[:, :1])
    kk = jnp.concatenate([jnp.concatenate([pad, kb[:, :-1]], axis=1), kb], axis=2)
    vv = jnp.concatenate([jnp.concatenate([pad, vb[:, :-1]], axis=1), vb], axis=2)
    scale = HEAD_DIM ** -0.5
    s = jnp.einsum('bnqgrd,bnkgd->bngrqk', qb, kk).astype(jnp.float32) * scale
    qi = jnp.arange(W)[:, None]
    kj = jnp.arange(2 * W)[None, :] - W
    rel = qi - kj
    local = (rel >= 0) & (rel < W)
    blk = jnp.arange(nb)[:, None, None]
    valid = local[None] & ((blk * W + kj[None]) >= 0)
    s = jnp.where(valid[None, :, None, None], s, NEG_INF)
    sink = jnp.broadcast_to(
        sinks.astype(jnp.float32).reshape(N_KV_HEADS, GQA_REP)[None, None, :, :, None, None],
        s.shape[:-1] + (1,))
    p = jax.nn.softmax(jnp.concatenate([s, sink], axis=-1), axis=-1)[..., :-1]
    o = jnp.einsum('bngrqk,bnkgd->bnqgrd', p.astype(v.dtype), vv)
    return o.reshape(B, L, Q_WIDTH)


def memory_cross_attention(q, mem_k, mem_v):
    s = jnp.einsum('blhd,bmhd->bhlm', q, mem_k).astype(jnp.float32) * (MEM_HEAD_DIM ** -0.5)
    p = jax.nn.softmax(s, axis=-1)
    o = jnp.einsum('bhlm,bmhd->blhd', p.astype(mem_v.dtype), mem_v)
    return o.reshape(q.shape[0], q.shape[1], MEM_WIDTH)


def s5_ssm(u, lam_re, lam_im, log_dt, b_re, b_im, c_re, c_im, d_skip):
    Bsz, L = u.shape[0], u.shape[1]
    uf = u.astype(jnp.float32).reshape(Bsz, L, SSM_GROUPS, SSM_GROUP)
    lr = jnp.minimum(lam_re.astype(jnp.float32), -1e-4)
    li = lam_im.astype(jnp.float32)
    dt = jnp.exp(log_dt.astype(jnp.float32))[:, None]
    mag = jnp.exp(lr * dt)
    ar = mag * jnp.cos(li * dt)
    ai = mag * jnp.sin(li * dt)
    nr, ni = ar - 1.0, ai
    den = lr * lr + li * li
    kr = (nr * lr + ni * li) / den
    ki = (ni * lr - nr * li) / den
    br, bi = b_re.astype(jnp.float32), b_im.astype(jnp.float32)
    bbr = kr[..., None] * br - ki[..., None] * bi
    bbi = kr[..., None] * bi + ki[..., None] * br
    xr = jnp.einsum('blgc,gpc->blgp', uf, bbr)
    xi = jnp.einsum('blgc,gpc->blgp', uf, bbi)
    a_r = jnp.broadcast_to(ar, xr.shape)
    a_i = jnp.broadcast_to(ai, xi.shape)

    def combine(e1, e2):
        a1r, a1i, b1r, b1i = e1
        a2r, a2i, b2r, b2i = e2
        return (a1r * a2r - a1i * a2i,
                a1r * a2i + a1i * a2r,
                a2r * b1r - a2i * b1i + b2r,
                a2r * b1i + a2i * b1r + b2i)

    _, _, sr, si = lax.associative_scan(combine, (a_r, a_i, xr, xi), axis=1)
    y = (jnp.einsum('blgp,gcp->blgc', sr, c_re.astype(jnp.float32))
         - jnp.einsum('blgp,gcp->blgc', si, c_im.astype(jnp.float32)))
    y = y + d_skip.astype(jnp.float32).reshape(SSM_GROUPS, SSM_GROUP) * uf
    return y.reshape(Bsz, L, SSM_WIDTH).astype(u.dtype)


def setup_inputs(seed: int = 0) -> dict:
    key = jax.random.key(seed)
    ks = iter(jax.random.split(key, 40))

    def nrm(shape, scale):
        return jax.random.normal(next(ks), shape, jnp.float32) * scale

    def gain(shape):
        return 1.0 + nrm(shape, 0.02)

    Lr, G, P, CH = DEPTH, SSM_GROUPS, SSM_STATE, SSM_GROUP
    lam_re = -0.5 + nrm((Lr, G, P), 0.01)
    lam_im = math.pi * jnp.arange(P, dtype=jnp.float32)[None, None, :] + nrm((Lr, G, P), 0.01)
    log_dt = jax.random.uniform(next(ks), (Lr, G), jnp.float32,
                                math.log(DT_MIN), math.log(DT_MAX))
    return {
        "x": nrm((BATCH, SEQ, D_MODEL), 1.0),
        "mem": nrm((BATCH, N_MEM, D_MODEL), 1.0),
        "ffn1_norm": gain((Lr, D_MODEL)),
        "ffn1_w_in": nrm((Lr, D_MODEL, 2 * D_FF), D_MODEL ** -0.5),
        "ffn1_w_out": nrm((Lr, D_FF, D_MODEL), D_FF ** -0.5),
        "mix_norm": gain((Lr, D_MODEL)),
        "mem_norm": gain((Lr, D_MODEL)),
        "w_in": nrm((Lr, D_MODEL, IN_WIDTH), D_MODEL ** -0.5),
        "sinks": nrm((Lr, N_Q_HEADS), 0.5),
        "w_mem_kv": nrm((Lr, D_MODEL, 2 * MEM_WIDTH), D_MODEL ** -0.5),
        "lam_re": lam_re,
        "lam_im": lam_im,
        "log_dt": log_dt,
        "b_re": nrm((Lr, G, P, CH), (2 * CH) ** -0.5),
        "b_im": nrm((Lr, G, P, CH), (2 * CH) ** -0.5),
        "c_re": nrm((Lr, G, CH, P), (2 * P) ** -0.5),
        "c_im": nrm((Lr, G, CH, P), (2 * P) ** -0.5),
        "d_skip": nrm((Lr, SSM_WIDTH), 1.0),
        "w_ssm_glu": nrm((Lr, SSM_WIDTH, 2 * D_MODEL), SSM_WIDTH ** -0.5),
        "w_swa_up": nrm((Lr, Q_WIDTH, D_MODEL), Q_WIDTH ** -0.5),
        "w_mem_up": nrm((Lr, MEM_WIDTH, D_MODEL), MEM_WIDTH ** -0.5),
        "w_out": nrm((Lr, D_MODEL, D_MODEL), D_MODEL ** -0.5),
        "ffn2_norm": gain((Lr, D_MODEL)),
        "ffn2_w_in": nrm((Lr, D_MODEL, 2 * D_FF), D_MODEL ** -0.5),
        "ffn2_w_out": nrm((Lr, D_FF, D_MODEL), D_FF ** -0.5),
        "final_norm": gain((D_MODEL,)),
    }


def reference(x, mem, ffn1_norm, ffn1_w_in, ffn1_w_out, mix_norm, mem_norm, w_in, sinks,
              w_mem_kv, lam_re, lam_im, log_dt, b_re, b_im, c_re, c_im, d_skip, w_ssm_glu,
              w_swa_up, w_mem_up, w_out, ffn2_norm, ffn2_w_in, ffn2_w_out, final_norm):
    B, L = x.shape[0], x.shape[1]
    M = mem.shape[1]
    split_points = list(np.cumsum(IN_SPLITS)[:-1])
    h = x
    for l in range(DEPTH):
        h = h + 0.5 * swiglu(rms_norm(h, ffn1_norm[l]), ffn1_w_in[l], ffn1_w_out[l])

        u = rms_norm(h, mix_norm[l])
        q, k, v, s_in, mq, gates = jnp.split(u @ w_in[l], split_points, axis=-1)

        y_swa = sliding_window_attention(
            q.reshape(B, L, N_Q_HEADS, HEAD_DIM),
            k.reshape(B, L, N_KV_HEADS, HEAD_DIM),
            v.reshape(B, L, N_KV_HEADS, HEAD_DIM),
            sinks[l]) @ w_swa_up[l]

        y_s = s5_ssm(s_in, lam_re[l], lam_im[l], log_dt[l], b_re[l], b_im[l],
                     c_re[l], c_im[l], d_skip[l])
        ga, gb = jnp.split(y_s @ w_ssm_glu[l], 2, axis=-1)
        y_ssm = ga * jax.nn.sigmoid(gb)

        mk, mv = jnp.split(rms_norm(mem, mem_norm[l]) @ w_mem_kv[l], 2, axis=-1)
        y_mem = memory_cross_attention(
            mq.reshape(B, L, MEM_HEADS, MEM_HEAD_DIM),
            mk.reshape(B, M, MEM_HEADS, MEM_HEAD_DIM),
            mv.reshape(B, M, MEM_HEADS, MEM_HEAD_DIM)) @ w_mem_up[l]

        g = jax.nn.sigmoid(gates.reshape(B, L, N_BRANCHES, D_MODEL))
        merged = g[:, :, 0] * y_swa + g[:, :, 1] * y_ssm + g[:, :, 2] * y_mem
        h = h + merged @ w_out[l]

        h = h + 0.5 * swiglu(rms_norm(h, ffn2_norm[l]), ffn2_w_in[l], ffn2_w_out[l])
    return rms_norm(h, final_norm)
```

```cpp
#include <hip/hip_runtime.h>
#include <cstdio>
#include <cstdint>

#ifndef EN_PRO
#define EN_PRO 1
#endif
#ifndef EN_NORM
#define EN_NORM 1
#endif
#ifndef EN_G1
#define EN_G1 1
#endif
#ifndef EN_G3
#define EN_G3 1
#endif
#ifndef EN_M1
#define EN_M1 1
#endif
#ifndef EN_M2
#define EN_M2 1
#endif
#ifndef EN_G4
#define EN_G4 1
#endif
#ifndef EN_GR
#define EN_GR 1
#endif
#ifndef ONE_LAUNCH
#define ONE_LAUNCH 1
#endif

namespace pg8 {
#define PG8_LAS __attribute__((address_space(3)))
typedef unsigned short bf16_t;
typedef short bf16x8 __attribute__((ext_vector_type(8)));
typedef float f32x4 __attribute__((ext_vector_type(4)));
typedef unsigned u32x4 __attribute__((ext_vector_type(4)));
constexpr int BM = 256, BK = 64, HALF = 128, HTB = HALF * BK * 2  , STAGE_BYTES = 8 * HTB, NXCD = 8, WGM = 8;

__host__ __device__ __forceinline__ int lds_byte(int r, int c) { const int st = (r >> 4) * 2 + (c >> 5), rr = r & 15, cc = c & 31, ob = rr * 64 + cc * 2; return st * 1024 + (ob ^ (((ob >> 9) & 1) << 5)); }
__host__ __device__ __forceinline__ void stage_rc(int b, int& R, int& C) { const int st = b / 1024, sb = b % 1024, swz = sb ^ (((sb >> 9) & 1) << 5); R = (st >> 1) * 16 + swz / 64; C = (st & 1) * 32 + (swz % 64) / 2; }
__host__ __device__ __forceinline__ int perm32(int rho) { const int n = rho >> 4, i = rho & 15; return 8 * (i >> 2) + 4 * n + (i & 3); }


struct Unit { int pm, pn, kind; };

__device__ __forceinline__ unsigned cvt_pk_bf16(float lo, float hi) { unsigned r; asm volatile("v_cvt_pk_bf16_f32 %0, %1, %2" : "=v"(r) : "v"(lo), "v"(hi)); return r; }
__device__ __forceinline__ float bf_lo(unsigned u) { return __uint_as_float(u << 16); }
__device__ __forceinline__ float bf_hi(unsigned u) { return __uint_as_float(u & 0xffff0000u); }
__device__ __forceinline__ float sigmoidf_fast(float x) { return __builtin_amdgcn_rcpf(1.0f + __builtin_amdgcn_exp2f(-1.4426950408889634f * x)); }

__device__ __forceinline__ void tile_of(int L, int nM, int nN, int& pm, int& pn) {
    const int nwg = nM * nN; int wgid = L; { const int q = nwg / NXCD, r = nwg % NXCD, xcd = wgid % NXCD, off = wgid / NXCD; wgid = (xcd < r ? xcd * (q + 1) : r * (q + 1) + (xcd - r) * q) + off; }
    const int nig = WGM * nN, gid = wgid / nig, fm = gid * WGM, gsz = (nM - fm) < WGM ? (nM - fm) : WGM;
    pm = fm + ((wgid % nig) % gsz); pn = (wgid % nig) / gsz;
}

struct SchedTiles {
    const char* A; const char* Bt; size_t tstep; int nM, nN, G, c;
    __device__ __forceinline__ bool next(int i, Unit& u) const { const int L = i * G + c; if (L >= nM * nN) return false; tile_of(L, nM, nN, u.pm, u.pn); u.kind = 0; return true; }
    __device__ __forceinline__ void operands(const Unit& u, const char*& a, const char*& b) const { a = A + (size_t)u.pm * tstep; b = Bt + (size_t)u.pn * tstep; }
    __device__ __forceinline__ void a_ready(const Unit&) const {}
    __device__ __forceinline__ void done(const Unit&) const {}
};
struct SchedProj {
    const char* A; const char* Bt; const char* A2; const char* Bt2; size_t tstep; int nM, nN, G, c;
    __device__ __forceinline__ bool next(int i, Unit& u) const { const int L = i * G + c, nwg = nM * nN; if (L < nwg) { tile_of(L, nM, nN, u.pm, u.pn); u.kind = 0; return true; }
        if (L < nwg + 16) { const int j = L - nwg; u.pm = j & 1; u.pn = j >> 1; u.kind = 1; return true; } return false; }
    __device__ __forceinline__ void operands(const Unit& u, const char*& a, const char*& b) const { a = (u.kind ? A2 : A) + (size_t)u.pm * tstep; b = (u.kind ? Bt2 : Bt) + (size_t)u.pn * tstep; }
    __device__ __forceinline__ void a_ready(const Unit&) const {}
    __device__ __forceinline__ void done(const Unit&) const {}
};
struct SchedMix {
    const char* Aswa; const char* Amem; const char* Ays; const char* Bswa; const char* Bmem; const char* Bglu; size_t tstep; int nM, nN, G, c;
    __device__ __forceinline__ bool next(int i, Unit& u) const { const int L = (i >> 2) * G + c; if (L >= nM * nN) return false; tile_of(L, nM, nN, u.pm, u.pn); u.kind = i & 3; return true; }
    __device__ __forceinline__ void operands(const Unit& u, const char*& a, const char*& b) const {
        if (u.kind == 0) { a = Aswa + (size_t)u.pm * tstep; b = Bswa + (size_t)u.pn * tstep; }
        else if (u.kind == 1) { a = Amem + (size_t)u.pm * tstep; b = Bmem + (size_t)u.pn * tstep; }
        else { a = Ays + (size_t)u.pm * tstep; b = Bglu + (size_t)(2 * u.pn + (u.kind - 2)) * tstep; } }
    __device__ __forceinline__ void a_ready(const Unit&) const {}
    __device__ __forceinline__ void done(const Unit&) const {}
};

struct EpiSwiGLU {
    static constexpr bool PERM = true, AFTER_DRAIN = false;
    bf16_t* O; int ldo;
    __device__ __forceinline__ void operator()(const f32x4 (&acc)[2][2][4][2], const Unit& u, int wr, int wc, int fr, int fq) const {
        const int row0 = u.pm * BM + wr * 64 + fr, col0 = u.pn * HALF + wc * 32 + 8 * fq;
#pragma unroll
        for (int ai = 0; ai < 2; ++ai)
#pragma unroll
            for (int m = 0; m < 4; ++m) { bf16_t* rowp = O + (size_t)(row0 + ai * HALF + m * 16) * ldo + col0; float o[8];
#pragma unroll
                for (int n = 0; n < 2; ++n)
#pragma unroll
                    for (int e = 0; e < 4; ++e) { const float g = acc[ai][0][m][n][e], uu = acc[ai][1][m][n][e]; o[4 * n + e] = g * sigmoidf_fast(g) * uu; }
                u32x4 w; w.x = cvt_pk_bf16(o[0], o[1]); w.y = cvt_pk_bf16(o[2], o[3]); w.z = cvt_pk_bf16(o[4], o[5]); w.w = cvt_pk_bf16(o[6], o[7]);
                *(u32x4*)rowp = w; }
    }
};
struct EpiResid {
    static constexpr bool PERM = false, AFTER_DRAIN = false;
    const float* Hin; float* Hout; float alpha; int ldc;
    __device__ __forceinline__ void operator()(const f32x4 (&acc)[2][2][4][2], const Unit& u, int wr, int wc, int fr, int fq) const {
        const int row0 = u.pm * BM + wr * 64 + fr, col0 = u.pn * BM + wc * 32 + 4 * fq;
#pragma unroll
        for (int ai = 0; ai < 2; ++ai)
#pragma unroll
            for (int m = 0; m < 4; ++m) { const size_t off = (size_t)(row0 + ai * HALF + m * 16) * ldc + col0;
#pragma unroll
                for (int bj = 0; bj < 2; ++bj)
#pragma unroll
                    for (int n = 0; n < 2; ++n) { const f32x4 b = *(const f32x4*)(Hin + off + bj * HALF + n * 16); *(f32x4*)(Hout + off + bj * HALF + n * 16) = b + acc[ai][bj][m][n] * alpha; } }
    }
};
struct EpiProj {
    static constexpr bool PERM = true, AFTER_DRAIN = false;
    bf16_t* P; int ldp; int sig_from; bf16_t* KV; int ldk;
    __device__ __forceinline__ void operator()(const f32x4 (&acc)[2][2][4][2], const Unit& u, int wr, int wc, int fr, int fq) const {
        const int row0 = u.pm * BM + wr * 64 + fr, col0 = u.pn * BM + wc * 32 + 8 * fq;
        bf16_t* base = u.kind ? KV : P; const int ld = u.kind ? ldk : ldp; const bool sig = (u.kind == 0) && (u.pn >= sig_from);
#pragma unroll
        for (int ai = 0; ai < 2; ++ai)
#pragma unroll
            for (int m = 0; m < 4; ++m) { bf16_t* rowp = base + (size_t)(row0 + ai * HALF + m * 16) * ld + col0;
#pragma unroll
                for (int bj = 0; bj < 2; ++bj) { f32x4 v0 = acc[ai][bj][m][0], v1 = acc[ai][bj][m][1];
                    if (sig) {
#pragma unroll
                        for (int e = 0; e < 4; ++e) { v0[e] = sigmoidf_fast(v0[e]); v1[e] = sigmoidf_fast(v1[e]); } }
                    u32x4 w; w.x = cvt_pk_bf16(v0[0], v0[1]); w.y = cvt_pk_bf16(v0[2], v0[3]); w.z = cvt_pk_bf16(v1[0], v1[1]); w.w = cvt_pk_bf16(v1[2], v1[3]);
                    *(u32x4*)(rowp + bj * HALF) = w; } }
    }
};
struct EpiMix {
    static constexpr bool PERM = true, AFTER_DRAIN = false;
    float* T32; bf16_t* MG; const bf16_t* Gt; int ldg;
    __device__ __forceinline__ void operator()(const f32x4 (&acc)[2][2][4][2], const Unit& u, int wr, int wc, int fr, int fq) const {
        const int row0 = u.pm * BM + wr * 64 + fr, cw = wc * 32 + 8 * fq;
        if (u.kind < 2) {
            const int gsel = u.kind == 0 ? 0 : 4096;
#pragma unroll
            for (int ai = 0; ai < 2; ++ai)
#pragma unroll
                for (int m = 0; m < 4; ++m) { const size_t row = (size_t)(row0 + ai * HALF + m * 16);
#pragma unroll
                    for (int bj = 0; bj < 2; ++bj) { const int col = u.pn * BM + bj * HALF + cw;
                        const u32x4 gw = *(const u32x4*)(Gt + row * ldg + gsel + col);
                        f32x4 g0 = {bf_lo(gw.x), bf_hi(gw.x), bf_lo(gw.y), bf_hi(gw.y)}, g1 = {bf_lo(gw.z), bf_hi(gw.z), bf_lo(gw.w), bf_hi(gw.w)};
                        f32x4 t0 = acc[ai][bj][m][0] * g0, t1 = acc[ai][bj][m][1] * g1; float* tp = T32 + row * 2048 + col;
                        if (u.kind == 1) { t0 += *(const f32x4*)tp; t1 += *(const f32x4*)(tp + 4); }
                        *(f32x4*)tp = t0; *(f32x4*)(tp + 4) = t1; } }
        } else {
            const int col = u.pn * BM + (u.kind - 2) * HALF + cw;
#pragma unroll
            for (int ai = 0; ai < 2; ++ai)
#pragma unroll
                for (int m = 0; m < 4; ++m) { const size_t row = (size_t)(row0 + ai * HALF + m * 16);
                    const u32x4 gw = *(const u32x4*)(Gt + row * ldg + 2048 + col);
                    const float gg[8] = {bf_lo(gw.x), bf_hi(gw.x), bf_lo(gw.y), bf_hi(gw.y), bf_lo(gw.z), bf_hi(gw.z), bf_lo(gw.w), bf_hi(gw.w)};
                    const float* tp = T32 + row * 2048 + col; const f32x4 t0 = *(const f32x4*)tp, t1 = *(const f32x4*)(tp + 4); float o[8];
#pragma unroll
                    for (int n = 0; n < 2; ++n)
#pragma unroll
                        for (int e = 0; e < 4; ++e) { const float ga = acc[ai][0][m][n][e], gb = acc[ai][1][m][n][e]; o[4 * n + e] = (n ? t1[e] : t0[e]) + gg[4 * n + e] * ga * sigmoidf_fast(gb); }
                    u32x4 w; w.x = cvt_pk_bf16(o[0], o[1]); w.y = cvt_pk_bf16(o[2], o[3]); w.z = cvt_pk_bf16(o[4], o[5]); w.w = cvt_pk_bf16(o[6], o[7]);
                    *(u32x4*)(MG + row * 2048 + col) = w; }
        }
    }
};

template <class Epi, class Sched, bool ALIGN_EPI = false, bool SP2 = false>
__device__ __forceinline__ void gemm_phase(PG8_LAS unsigned char* lds, const int K, const Sched& S, const Epi& E) {
    int tid_ = threadIdx.x; asm volatile("" : "+v"(tid_));
    const int tid = tid_, wid = __builtin_amdgcn_readfirstlane(tid >> 6), lane = tid & 63, wr = wid >> 2, wc = wid & 3, fr = lane & 15, fq = lane >> 4;
    const int nt = K / BK;
    unsigned voffA[2], voffB[2];
#pragma unroll
    for (int i = 0; i < 2; ++i) { int R, C; stage_rc(tid * 16 + i * 8192, R, C); const int Rb = Epi::PERM ? ((R & ~31) + perm32(R & 31)) : R;
        voffA[i] = (unsigned)(R * K + C) * 2u; voffB[i] = (unsigned)(Rb * K + C) * 2u; }
    const size_t kstep = (size_t)(BK * 2);
    const size_t hstep = (size_t)HALF * K * 2;
    const unsigned ldsw = (unsigned)wid * 1024u;
    const int aoff = lds_byte(wr * 64 + fr, fq * 8), boff = lds_byte(wc * 32 + fr, fq * 8);
#define PG8_SA(b, h) (((b) * 2 + (h)) * HTB)
#define PG8_SB(b, h) ((4 + (b) * 2 + (h)) * HTB)
#define PG8_STAGE(bufoff, gbase, voff) do { _Pragma("unroll") for (int _i = 0; _i < 2; ++_i) \
        __builtin_amdgcn_global_load_lds((const unsigned*)((const char*)(gbase) + (voff)[_i]), (PG8_LAS unsigned*)(lds + (bufoff) + ldsw + _i * 8192), 16, 0, 0); } while (0)
#define PG8_LDA(dst, b, h) do { _Pragma("unroll") for (int m = 0; m < 4; ++m) _Pragma("unroll") for (int k = 0; k < 2; ++k) dst[m][k] = *(const PG8_LAS bf16x8*)(lds + PG8_SA(b, h) + aoff + m * 2048 + k * 1024); } while (0)
#define PG8_LDB(dst, b, h) do { _Pragma("unroll") for (int n = 0; n < 2; ++n) _Pragma("unroll") for (int k = 0; k < 2; ++k) dst[n][k] = *(const PG8_LAS bf16x8*)(lds + PG8_SB(b, h) + boff + n * 2048 + k * 1024); } while (0)
#define PG8_MMA(ai, bj, At, Bt) do { __builtin_amdgcn_s_setprio(1); _Pragma("unroll") for (int m = 0; m < 4; ++m) _Pragma("unroll") for (int n = 0; n < 2; ++n) _Pragma("unroll") for (int k = 0; k < 2; ++k) \
        acc[ai][bj][m][n] = __builtin_amdgcn_mfma_f32_16x16x32_bf16(Bt[n][k], At[m][k], acc[ai][bj][m][n], 0, 0, 0); __builtin_amdgcn_s_setprio(0); } while (0)
#define PG8_WAIT_V(n) asm volatile("s_waitcnt vmcnt(" #n ")" ::: "memory")
#define PG8_WAIT_L(n) asm volatile("s_waitcnt lgkmcnt(" #n ")" ::: "memory")
#define PG8_BAR __builtin_amdgcn_s_barrier()
#define PG8_SCHED __builtin_amdgcn_sched_barrier(0)
    Unit cur, nxt; int ui = 0;
    if (!S.next(0, cur)) return;
    f32x4 acc[2][2][4][2];
#pragma unroll
    for (int a = 0; a < 2; ++a)
#pragma unroll
        for (int b = 0; b < 2; ++b)
#pragma unroll
            for (int m = 0; m < 4; ++m)
#pragma unroll
                for (int n = 0; n < 2; ++n) acc[a][b][m][n] = (f32x4){0.f, 0.f, 0.f, 0.f};
    bf16x8 At[4][2], B0[2][2], B1[2][2];
    const char* cA; const char* cB; S.operands(cur, cA, cB);
    S.a_ready(cur);
    if constexpr (SP2) {
        PG8_STAGE(PG8_SB(0, 0), cB, voffB); PG8_STAGE(PG8_SB(0, 1), cB + hstep, voffB); PG8_STAGE(PG8_SA(0, 0), cA, voffA); PG8_STAGE(PG8_SA(0, 1), cA + hstep, voffA);
        if (wr == 1) PG8_BAR;
        PG8_WAIT_V(2); PG8_BAR;
        PG8_STAGE(PG8_SB(1, 0), cB + kstep, voffB); PG8_STAGE(PG8_SA(1, 0), cA + kstep, voffA); PG8_STAGE(PG8_SB(1, 1), cB + hstep + kstep, voffB);
        PG8_WAIT_V(6); PG8_BAR;
    } else {
        PG8_STAGE(PG8_SB(0, 0), cB, voffB); PG8_STAGE(PG8_SA(0, 0), cA, voffA); PG8_STAGE(PG8_SB(0, 1), cB + hstep, voffB); PG8_STAGE(PG8_SA(0, 1), cA + hstep, voffA);
        if (wr == 1) PG8_BAR;
        PG8_WAIT_V(4); PG8_BAR;
        PG8_STAGE(PG8_SB(1, 0), cB + kstep, voffB); PG8_STAGE(PG8_SA(1, 0), cA + kstep, voffA); PG8_STAGE(PG8_SB(1, 1), cB + hstep + kstep, voffB);
        PG8_WAIT_V(6); PG8_BAR;
    }
    for (;;) {
        const bool has_next = S.next(ui + 1, nxt);
        const char* nA = cA; const char* nB = cB; if (has_next) S.operands(nxt, nA, nB);
        for (int t = 0; t < nt; t += 2) {
            const bool last = (t == nt - 2);
            const char* a1 = cA + (size_t)(t + 1) * kstep;
            const char* a2 = last ? nA : cA + (size_t)(t + 2) * kstep; const char* b2 = last ? nB : cB + (size_t)(t + 2) * kstep;
            const char* a3 = a2 + kstep; const char* b3 = b2 + kstep;
            if (last && has_next) S.a_ready(nxt);
            if constexpr (SP2) {
            PG8_LDB(B0, 0, 0); PG8_LDB(B1, 0, 1); PG8_SCHED; PG8_LDA(At, 0, 0); PG8_STAGE(PG8_SA(1, 1), a1 + hstep, voffA);
            PG8_WAIT_V(8); PG8_WAIT_L(0); PG8_BAR; PG8_MMA(0, 0, At, B0); PG8_MMA(0, 1, At, B1); PG8_BAR; PG8_SCHED;
            PG8_LDA(At, 0, 1); PG8_STAGE(PG8_SB(0, 0), b2, voffB); PG8_STAGE(PG8_SB(0, 1), b2 + hstep, voffB); PG8_STAGE(PG8_SA(0, 0), a2, voffA);
            PG8_WAIT_V(8); PG8_WAIT_L(0); PG8_BAR; PG8_MMA(1, 0, At, B0); PG8_MMA(1, 1, At, B1); PG8_BAR; PG8_SCHED;
            PG8_LDB(B0, 1, 0); PG8_LDB(B1, 1, 1); PG8_SCHED; PG8_LDA(At, 1, 0); PG8_STAGE(PG8_SA(0, 1), a2 + hstep, voffA);
            PG8_WAIT_V(8); PG8_WAIT_L(0); PG8_BAR; PG8_MMA(0, 0, At, B0); PG8_MMA(0, 1, At, B1); PG8_BAR; PG8_SCHED;
            PG8_LDA(At, 1, 1); PG8_STAGE(PG8_SB(1, 0), b3, voffB); PG8_STAGE(PG8_SB(1, 1), b3 + hstep, voffB); PG8_STAGE(PG8_SA(1, 0), a3, voffA);
            PG8_WAIT_V(8); PG8_WAIT_L(0); PG8_BAR; PG8_MMA(1, 0, At, B0); PG8_MMA(1, 1, At, B1); PG8_BAR; PG8_SCHED;
            } else {
            PG8_LDB(B0, 0, 0); PG8_SCHED; PG8_LDA(At, 0, 0); PG8_STAGE(PG8_SA(1, 1), a1 + hstep, voffA);
            PG8_WAIT_L(8); PG8_BAR; PG8_WAIT_L(0); PG8_MMA(0, 0, At, B0); PG8_BAR; PG8_SCHED;
            PG8_LDB(B1, 0, 1); PG8_STAGE(PG8_SB(0, 0), b2, voffB);
            PG8_BAR; PG8_WAIT_L(0); PG8_MMA(0, 1, At, B1); PG8_BAR;
            PG8_LDA(At, 0, 1); PG8_STAGE(PG8_SA(0, 0), a2, voffA);
            PG8_BAR; PG8_WAIT_L(0); PG8_MMA(1, 0, At, B0); PG8_BAR; PG8_SCHED;
            PG8_STAGE(PG8_SB(0, 1), b2 + hstep, voffB);
            PG8_WAIT_V(6); PG8_BAR; PG8_MMA(1, 1, At, B1); PG8_BAR;
            PG8_LDB(B0, 1, 0); PG8_SCHED; PG8_LDA(At, 1, 0); PG8_STAGE(PG8_SA(0, 1), a2 + hstep, voffA);
            PG8_WAIT_L(8); PG8_BAR; PG8_WAIT_L(0); PG8_MMA(0, 0, At, B0); PG8_BAR; PG8_SCHED;
            PG8_LDB(B1, 1, 1); PG8_STAGE(PG8_SB(1, 0), b3, voffB);
            PG8_BAR; PG8_WAIT_L(0); PG8_MMA(0, 1, At, B1); PG8_BAR;
            PG8_LDA(At, 1, 1); PG8_STAGE(PG8_SA(1, 0), a3, voffA);
            PG8_BAR; PG8_WAIT_L(0); PG8_MMA(1, 0, At, B0); PG8_BAR; PG8_SCHED;
            PG8_STAGE(PG8_SB(1, 1), b3 + hstep, voffB);
            PG8_WAIT_V(6); PG8_BAR; PG8_MMA(1, 1, At, B1); PG8_BAR;
            }
        }
        if constexpr (ALIGN_EPI) { if (wr == 0) PG8_BAR; }
        if constexpr (!Epi::AFTER_DRAIN) { E(acc, cur, wr, wc, fr, fq); S.done(cur); }
        if (!has_next) break;
#pragma unroll
        for (int a = 0; a < 2; ++a)
#pragma unroll
            for (int b = 0; b < 2; ++b)
#pragma unroll
                for (int m = 0; m < 4; ++m)
#pragma unroll
                    for (int n = 0; n < 2; ++n) acc[a][b][m][n] = (f32x4){0.f, 0.f, 0.f, 0.f};
        cur = nxt; cA = nA; cB = nB; ++ui;
        if constexpr (ALIGN_EPI) { if (wr == 1) PG8_BAR; }
    }
    PG8_WAIT_V(0);
    if constexpr (!ALIGN_EPI) { if (wr == 0) PG8_BAR; }
    PG8_BAR;
    if constexpr (Epi::AFTER_DRAIN) { E.fused(acc, cur, wr, wc, fr, fq, lds, wid, lane); S.done(cur); }
#undef PG8_SA
#undef PG8_SB
#undef PG8_STAGE
#undef PG8_LDA
#undef PG8_LDB
#undef PG8_MMA
#undef PG8_WAIT_V
#undef PG8_WAIT_L
#undef PG8_BAR
#undef PG8_SCHED
}
}

constexpr int BATCH = 2, SEQ = 4096, DM = 2048, DEPTH = 4, NMEM = 256, DFF = 5632;
constexpr int T = BATCH * SEQ;
constexpr int INW = 9728, COL_Q = 0, COL_K = 1024, COL_V = 1280, COL_S = 1536, COL_MQ = 2560, COL_G = 3584;
constexpr float RMS_EPS = 1e-5f, LOG2E = 1.4426950408889634f;
constexpr int NWAVES = 8;
enum { I_X = 0, I_MEM, I_F1N, I_F1WI, I_F1WO, I_MIXN, I_MEMN, I_WIN, I_SINK, I_WMKV, I_LRE, I_LIM, I_LDT, I_BRE, I_BIM, I_CRE, I_CIM, I_DSK, I_WGLU, I_WSWA, I_WMEMUP, I_WOUT, I_F2N, I_F2WI, I_F2WO, I_FINN, N_IN };

constexpr size_t MiB = 1u << 20;
constexpr size_t WS_CTL = 0, CTL_ZERO_BYTES = 1 * MiB;
constexpr size_t WS_W = 2 * MiB, W_LAYER = 202 * MiB;
constexpr size_t WO_1IN = 0, WO_1OUT = 44 * MiB, WO_IN = 66 * MiB, WO_MKV = 104 * MiB, WO_SWA = 112 * MiB, WO_MEM = 116 * MiB, WO_GLU = 120 * MiB, WO_OUT = 128 * MiB, WO_2IN = 136 * MiB, WO_2OUT = 180 * MiB;
constexpr size_t WS_MEMN = WS_W + DEPTH * W_LAYER;
constexpr size_t WS_H = WS_MEMN + 8 * MiB;
constexpr size_t WS_XN = WS_H + 64 * MiB;
constexpr size_t WS_HID = WS_XN + 32 * MiB;
constexpr size_t WS_PROJ = WS_HID + 88 * MiB;
constexpr size_t WS_MKV = WS_PROJ + 152 * MiB;
constexpr size_t WS_OSWA = WS_MKV + 2 * MiB, WS_YS = WS_OSWA + 16 * MiB, WS_OMEM = WS_YS + 16 * MiB;
constexpr size_t WS_T32 = WS_OMEM + 16 * MiB;
constexpr size_t WS_MG = WS_T32 + 64 * MiB;
constexpr size_t WS_SEND = WS_MG + 32 * MiB;
constexpr size_t WS_END = WS_SEND + 4 * MiB;
constexpr int CW_BAR = 4096;

constexpr int RING_OFF = 0, RING_BYTES = 131072;
constexpr int LDSCTL_OFF = RING_BYTES, MISC_OFF = LDSCTL_OFF + 320;
constexpr int LDS_BYTES = 147456;

#define GAS __attribute__((address_space(1)))
#define LAS __attribute__((address_space(3)))
typedef unsigned short bf16;
typedef unsigned v4u __attribute__((ext_vector_type(4)));
typedef unsigned v2u __attribute__((ext_vector_type(2)));
typedef float f32x4 __attribute__((ext_vector_type(4)));
typedef float f32x2 __attribute__((ext_vector_type(2)));
typedef GAS unsigned gu32;
using pg8::cvt_pk_bf16; using pg8::bf_lo; using pg8::bf_hi;

#define XB_TMO      128
#define XB_XCNT(j)  (256  + 64 * (j))
#define XB_XSUB(j)  (1280 + 64 * (j))
#define XB_XGEN(j)  (2304 + 64 * (j))
#define XB_TOP      3328
#define XB_TOPGEN   3392
#define XCD_BAR_WORDS 3456
#define XB_SPIN_CAP (1u << 18)

__device__ __forceinline__ unsigned xb_ld(unsigned* p)              { return __hip_atomic_load(p, __ATOMIC_RELAXED, __HIP_MEMORY_SCOPE_AGENT); }
__device__ __forceinline__ unsigned xb_add(unsigned* p, unsigned v) { return __hip_atomic_fetch_add(p, v, __ATOMIC_RELAXED, __HIP_MEMORY_SCOPE_AGENT); }
__device__ __forceinline__ unsigned xb_xcc_id() { return (unsigned)__builtin_amdgcn_s_getreg((3 << 11) | 20) & 0xFu; }
#define XB_SPIN(cond, bar) do { unsigned _sp = 0; while (cond) { __builtin_amdgcn_s_sleep(1); \
    if ((++_sp & 255u) == 0u) { if (xb_ld(&(bar)[XB_TMO])) break; if (_sp > XB_SPIN_CAP) { atomicAdd(&(bar)[XB_TMO], 1u); break; } } } } while (0)

struct XcdBarrier {
    unsigned* bar; unsigned x;
    volatile LAS unsigned* st;
};

__device__ __forceinline__ XcdBarrier xcd_barrier_post(unsigned* bar, volatile LAS unsigned* st) {
    XcdBarrier b; b.bar = bar; b.x = xb_xcc_id(); b.st = st;
    if (threadIdx.x == 0) (void)xb_add(&bar[XB_XCNT(b.x)], 1u);
    return b;
}
__device__ __forceinline__ void xcd_barrier_complete(unsigned* bar, unsigned x, unsigned& nloc, unsigned& nx) {
    const unsigned G = gridDim.x * gridDim.y * gridDim.z;
    unsigned sum, cnt, mine, sp = 0u;
    for (;;) {
        sum = 0u; cnt = 0u; mine = 0u;
#pragma unroll
        for (unsigned j = 0; j < 16; ++j) { const unsigned c = xb_ld(&bar[XB_XCNT(j)]); sum += c; cnt += (c > 0u) ? 1u : 0u; mine = (j == x) ? c : mine; }
        if (sum == G) break;
        __builtin_amdgcn_s_sleep(1);
        if ((++sp & 255u) == 0u) { if (xb_ld(&bar[XB_TMO])) break; if (sp > XB_SPIN_CAP) { atomicAdd(&bar[XB_TMO], 1u); break; } }
    }
    nloc = mine > 0u ? mine : 1u; nx = cnt > 0u ? cnt : 1u;
}

__device__ __forceinline__ void xcd_barrier(const XcdBarrier& b) {
    asm volatile("s_waitcnt vmcnt(0)" ::: "memory");
    __syncthreads();
    if (threadIdx.x == 0) {
        unsigned* bar = b.bar;
        __builtin_amdgcn_s_waitcnt(0);
        unsigned nloc = b.st[0], nx = b.st[1];
        if (nloc == 0u) { xcd_barrier_complete(bar, b.x, nloc, nx); b.st[0] = nloc; b.st[1] = nx; }
        const unsigned old = xb_add(&bar[XB_XSUB(b.x)], 1u);
        const unsigned gen = old / nloc;
        if (old + 1u == (gen + 1u) * nloc) {
            __builtin_amdgcn_fence(__ATOMIC_RELEASE, "agent");
            asm volatile("s_waitcnt vmcnt(0)" ::: "memory");
            const unsigned og = xb_add(&bar[XB_TOP], 1u);
            const unsigned tg = og / nx;
            if (og + 1u == (tg + 1u) * nx) xb_add(&bar[XB_TOPGEN], 1u);
            else XB_SPIN(xb_ld(&bar[XB_TOPGEN]) == tg, bar);
            __builtin_amdgcn_fence(__ATOMIC_ACQUIRE, "agent");
            xb_add(&bar[XB_XGEN(b.x)], 1u);
            asm volatile("s_waitcnt vmcnt(0)" ::: "memory");
        } else {
            XB_SPIN(xb_ld(&bar[XB_XGEN(b.x)]) == gen, bar);
            __builtin_amdgcn_fence(__ATOMIC_ACQUIRE, "agent");
            asm volatile("s_waitcnt vmcnt(0)" ::: "memory");
        }
    }
    __syncthreads();
}

struct Frame {
    LAS unsigned char* lds;
    int tid, lane, wave, G;
    unsigned char* ws;
};
__device__ __forceinline__ float wave_sum(float v) {
#pragma unroll
    for (int o = 1; o < 64; o <<= 1) v += __shfl_xor(v, o);
    return v;
}
__device__ __forceinline__ bf16* wsb(const Frame& F, size_t off) { return (bf16*)(F.ws + off); }

__device__ __forceinline__ void conv_block(const float* __restrict__ W, int K, int N, bf16* __restrict__ Wt, int kb, int nb, int pairNh, float scale, int lane) {
    const int k0 = kb * 64, n = nb * 64 + lane;
    const float* src = W + (size_t)k0 * N + n;
    float v[64];
#pragma unroll
    for (int i = 0; i < 64; ++i) v[i] = src[(size_t)i * N];
    int row = n;
    if (pairNh) { const int j = n < pairNh ? n : n - pairNh; row = (j >> 7) * 256 + (j & 127) + (n < pairNh ? 0 : 128); }
    v4u* dst = (v4u*)(Wt + (size_t)row * K + k0);
#pragma unroll
    for (int q = 0; q < 8; ++q) { v4u o; o.x = cvt_pk_bf16(v[8 * q] * scale, v[8 * q + 1] * scale); o.y = cvt_pk_bf16(v[8 * q + 2] * scale, v[8 * q + 3] * scale);
        o.z = cvt_pk_bf16(v[8 * q + 4] * scale, v[8 * q + 5] * scale); o.w = cvt_pk_bf16(v[8 * q + 6] * scale, v[8 * q + 7] * scale); dst[q] = o; }
}
constexpr int CI_1IN = (DM / 64) * (2 * DFF / 64), CI_1OUT = (DFF / 64) * (DM / 64), CI_IN = (DM / 64) * (INW / 64), CI_MKV = (DM / 64) * (2048 / 64), CI_GLU = (1024 / 64) * (4096 / 64),
              CI_SWA = (1024 / 64) * (DM / 64), CI_MEM = CI_SWA, CI_OUT = (DM / 64) * (DM / 64), CI_LAYER = 2 * CI_1IN + 2 * CI_1OUT + CI_IN + CI_MKV + CI_GLU + CI_SWA + CI_MEM + CI_OUT;
struct ProIn { const float *f1wi, *f2wi, *f1wo, *f2wo, *win, *wmkv, *wglu, *wswa, *wmem, *wout, *mem, *memn; };
__device__ __forceinline__ void prologue(Frame& F, const ProIn& I) {
    const int gw = blockIdx.x * NWAVES + F.wave, NGW = F.G * NWAVES, lane = F.lane;
    for (int it = gw; it < DEPTH * CI_LAYER; it += NGW) {
        const int l = it / CI_LAYER; int r = it % CI_LAYER; unsigned char* wl = F.ws + WS_W + (size_t)l * W_LAYER;
        const float* src; bf16* dst; int K, N, pairNh = 0;
        if (r < CI_1IN) { src = I.f1wi + (size_t)l * DM * 2 * DFF; dst = (bf16*)(wl + WO_1IN); K = DM; N = 2 * DFF; pairNh = DFF; }
        else if ((r -= CI_1IN) < CI_1IN) { src = I.f2wi + (size_t)l * DM * 2 * DFF; dst = (bf16*)(wl + WO_2IN); K = DM; N = 2 * DFF; pairNh = DFF; }
        else if ((r -= CI_1IN) < CI_1OUT) { src = I.f1wo + (size_t)l * DFF * DM; dst = (bf16*)(wl + WO_1OUT); K = DFF; N = DM; }
        else if ((r -= CI_1OUT) < CI_1OUT) { src = I.f2wo + (size_t)l * DFF * DM; dst = (bf16*)(wl + WO_2OUT); K = DFF; N = DM; }
        else if ((r -= CI_1OUT) < CI_IN) { src = I.win + (size_t)l * DM * INW; dst = (bf16*)(wl + WO_IN); K = DM; N = INW; }
        else if ((r -= CI_IN) < CI_MKV) { src = I.wmkv + (size_t)l * DM * 2048; dst = (bf16*)(wl + WO_MKV); K = DM; N = 2048; }
        else if ((r -= CI_MKV) < CI_GLU) { src = I.wglu + (size_t)l * 1024 * 4096; dst = (bf16*)(wl + WO_GLU); K = 1024; N = 4096; pairNh = 2048; }
        else if ((r -= CI_GLU) < CI_SWA) { src = I.wswa + (size_t)l * 1024 * DM; dst = (bf16*)(wl + WO_SWA); K = 1024; N = DM; }
        else if ((r -= CI_SWA) < CI_MEM) { src = I.wmem + (size_t)l * 1024 * DM; dst = (bf16*)(wl + WO_MEM); K = 1024; N = DM; }
        else { r -= CI_MEM; src = I.wout + (size_t)l * DM * DM; dst = (bf16*)(wl + WO_OUT); K = DM; N = DM; }
        const int nblk = N / 64, kb = r / nblk, nb = r % nblk, n0 = nb * 64;
        float sc = 1.f; if (N == INW) sc = n0 < COL_K ? 0.125f * LOG2E : ((n0 >= COL_MQ && n0 < COL_G) ? 0.0625f * LOG2E : 1.f);
        conv_block(src, K, N, dst, kb, nb, pairNh, sc, lane);
    }
    for (int it = gw; it < DEPTH * 512; it += NGW) {
        const int l = it / 512, row = it % 512;
        const f32x4* xr = (const f32x4*)(I.mem + (size_t)row * DM) + lane; const f32x4* gr = (const f32x4*)(I.memn + (size_t)l * DM) + lane;
        f32x4 v[8]; float s = 0.f;
#pragma unroll
        for (int j = 0; j < 8; ++j) { v[j] = xr[64 * j]; s += (v[j].x * v[j].x + v[j].y * v[j].y) + (v[j].z * v[j].z + v[j].w * v[j].w); }
        const float rstd = 1.0f / sqrtf(wave_sum(s) * (1.f / DM) + RMS_EPS);
        v2u* o8 = (v2u*)(wsb(F, WS_MEMN) + ((size_t)l * 512 + row) * DM) + lane;
#pragma unroll
        for (int j = 0; j < 8; ++j) { const f32x4 g = gr[64 * j]; v2u o; o.x = cvt_pk_bf16(v[j].x * rstd * g.x, v[j].y * rstd * g.y); o.y = cvt_pk_bf16(v[j].z * rstd * g.z, v[j].w * rstd * g.w); o8[64 * j] = o; }
    }
}
template <bool OUTF32>
__device__ __forceinline__ void norm_phase(Frame& F, const float* hin, const float* gain, void* outp) {
    const int gw = blockIdx.x * NWAVES + F.wave, NGW = F.G * NWAVES, lane = F.lane;
    f32x4 g[8];
#pragma unroll
    for (int j = 0; j < 8; ++j) g[j] = ((const f32x4*)gain)[lane + 64 * j];
    for (int m = gw; m < T; m += NGW) {
        const f32x4* xr = (const f32x4*)(hin + (size_t)m * DM) + lane;
        f32x4 v[8]; float s = 0.f;
#pragma unroll
        for (int j = 0; j < 8; ++j) { v[j] = xr[64 * j]; s += (v[j].x * v[j].x + v[j].y * v[j].y) + (v[j].z * v[j].z + v[j].w * v[j].w); }
        const float rstd = 1.0f / sqrtf(wave_sum(s) * (1.f / DM) + RMS_EPS);
        if (OUTF32) { f32x4* o = (f32x4*)((float*)outp + (size_t)m * DM) + lane;
#pragma unroll
            for (int j = 0; j < 8; ++j) o[64 * j] = v[j] * rstd * g[j];
        } else { v2u* o8 = (v2u*)((bf16*)outp + (size_t)m * DM) + lane;
#pragma unroll
            for (int j = 0; j < 8; ++j) { v2u o; o.x = cvt_pk_bf16(v[j].x * rstd * g[j].x, v[j].y * rstd * g[j].y); o.y = cvt_pk_bf16(v[j].z * rstd * g[j].z, v[j].w * rstd * g[j].w); o8[64 * j] = o; } }
    }
}
__device__ __forceinline__ void unpack8(const v4u w, float* f) { f[0] = bf_lo(w.x); f[1] = bf_hi(w.x); f[2] = bf_lo(w.y); f[3] = bf_hi(w.y); f[4] = bf_lo(w.z); f[5] = bf_hi(w.z); f[6] = bf_lo(w.w); f[7] = bf_hi(w.w); }

__device__ __forceinline__ void swa_naive(Frame& F, const float* sinks) {
    const bf16* P = wsb(F, WS_PROJ); bf16* O = wsb(F, WS_OSWA);
    for (int idx = blockIdx.x * 512 + F.tid; idx < T * 16; idx += F.G * 512) {
        const int hq = idx / T, m = idx % T, b = m / SEQ, t = m % SEQ, g = hq >> 2;
        float q[64];
        { const v4u* qp = (const v4u*)(P + (size_t)m * INW + COL_Q + hq * 64);
#pragma unroll
          for (int j = 0; j < 8; ++j) unpack8(qp[j], q + 8 * j); }
        float mrun = sinks[hq] * LOG2E, lrun = 1.f, o[64];
#pragma unroll
        for (int j = 0; j < 64; ++j) o[j] = 0.f;
        const int k0 = t >= 127 ? t - 127 : 0;
        for (int kp = k0; kp <= t; ++kp) {
            const bf16* kr = P + (size_t)(b * SEQ + kp) * INW + COL_K + g * 64; const bf16* vr = kr + (COL_V - COL_K);
            float s0 = 0.f, s1 = 0.f;
#pragma unroll
            for (int j = 0; j < 8; ++j) { float kf[8]; unpack8(((const v4u*)kr)[j], kf);
#pragma unroll
                for (int e = 0; e < 8; e += 2) { s0 += q[8 * j + e] * kf[e]; s1 += q[8 * j + e + 1] * kf[e + 1]; } }
            const float s = s0 + s1, mnew = fmaxf(mrun, s), corr = __builtin_amdgcn_exp2f(mrun - mnew), p = __builtin_amdgcn_exp2f(s - mnew);
            lrun = lrun * corr + p; mrun = mnew;
#pragma unroll
            for (int j = 0; j < 8; ++j) { float vf[8]; unpack8(((const v4u*)vr)[j], vf);
#pragma unroll
                for (int e = 0; e < 8; ++e) o[8 * j + e] = o[8 * j + e] * corr + p * vf[e]; }
        }
        const float inv = 1.0f / lrun; v4u* op = (v4u*)(O + (size_t)m * 1024 + hq * 64);
#pragma unroll
        for (int j = 0; j < 8; ++j) { v4u w; w.x = cvt_pk_bf16(o[8 * j] * inv, o[8 * j + 1] * inv); w.y = cvt_pk_bf16(o[8 * j + 2] * inv, o[8 * j + 3] * inv);
            w.z = cvt_pk_bf16(o[8 * j + 4] * inv, o[8 * j + 5] * inv); w.w = cvt_pk_bf16(o[8 * j + 6] * inv, o[8 * j + 7] * inv); op[j] = w; }
    }
}
__device__ __forceinline__ void memattn_naive(Frame& F) {
    const bf16* P = wsb(F, WS_PROJ); const bf16* KV = wsb(F, WS_MKV); bf16* O = wsb(F, WS_OMEM);
    LAS float* qs = (LAS float*)F.lds;
    LAS float* ss = qs + 32 * 260;
    const int tid = F.tid, ti = tid >> 4, kg = tid & 15;
    for (int unit = blockIdx.x; unit < 1024; unit += F.G) {
        const int b = unit >> 9, hd = (unit >> 7) & 3, tb = unit & 127, m0 = b * SEQ + tb * 32;
        { const v4u* src = (const v4u*)(P + (size_t)(m0 + ti) * INW + COL_MQ + hd * 256 + kg * 16); float f[16]; unpack8(src[0], f); unpack8(src[1], f + 8);
#pragma unroll
          for (int e = 0; e < 16; ++e) qs[ti * 260 + kg * 16 + e] = f[e]; }
        __syncthreads();
        float sc[16];
#pragma unroll 1
        for (int i = 0; i < 16; ++i) { const int key = kg + 16 * i; const v4u* kr = (const v4u*)(KV + (size_t)(b * NMEM + key) * 2048 + hd * 256);
            float a0 = 0.f, a1 = 0.f;
#pragma unroll 8
            for (int d8 = 0; d8 < 32; ++d8) { float kf[8]; unpack8(kr[d8], kf); const LAS f32x4* qp = (const LAS f32x4*)(qs + ti * 260 + d8 * 8); const f32x4 qa = qp[0], qb = qp[1];
                a0 += qa.x * kf[0] + qa.y * kf[1] + qa.z * kf[2] + qa.w * kf[3]; a1 += qb.x * kf[4] + qb.y * kf[5] + qb.z * kf[6] + qb.w * kf[7]; }
            ss[ti * 257 + key] = a0 + a1; }
        __syncthreads();
        float mx = -3.0e38f;
#pragma unroll
        for (int i = 0; i < 16; ++i) { sc[i] = ss[ti * 257 + kg + 16 * i]; mx = fmaxf(mx, sc[i]); }
#pragma unroll
        for (int o = 1; o < 16; o <<= 1) mx = fmaxf(mx, __shfl_xor(mx, o));
        float sum = 0.f;
#pragma unroll
        for (int i = 0; i < 16; ++i) { sc[i] = __builtin_amdgcn_exp2f(sc[i] - mx); sum += sc[i]; }
#pragma unroll
        for (int o = 1; o < 16; o <<= 1) sum += __shfl_xor(sum, o);
        const float inv = 1.0f / sum;
#pragma unroll
        for (int i = 0; i < 16; ++i) ss[ti * 257 + kg + 16 * i] = sc[i] * inv;
        __syncthreads();
        float o[16];
#pragma unroll
        for (int e = 0; e < 16; ++e) o[e] = 0.f;
#pragma unroll 4
        for (int key = 0; key < NMEM; ++key) { const float p = ss[ti * 257 + key]; const v4u* vr = (const v4u*)(KV + (size_t)(b * NMEM + key) * 2048 + 1024 + hd * 256 + kg * 16);
            float vf[16]; unpack8(vr[0], vf); unpack8(vr[1], vf + 8);
#pragma unroll
            for (int e = 0; e < 16; ++e) o[e] += p * vf[e]; }
        v4u* op = (v4u*)(O + (size_t)(m0 + ti) * 1024 + hd * 256 + kg * 16);
        v4u w; w.x = cvt_pk_bf16(o[0], o[1]); w.y = cvt_pk_bf16(o[2], o[3]); w.z = cvt_pk_bf16(o[4], o[5]); w.w = cvt_pk_bf16(o[6], o[7]); op[0] = w;
        w.x = cvt_pk_bf16(o[8], o[9]); w.y = cvt_pk_bf16(o[10], o[11]); w.z = cvt_pk_bf16(o[12], o[13]); w.w = cvt_pk_bf16(o[14], o[15]); op[1] = w;
        __syncthreads();
    }
}
__device__ __forceinline__ void sincos_red(double x, float& s, float& c) {
    const double k = __builtin_rint(x * 0.63661977236758134308); const double r = (x - k * 1.57079632679489655800) - k * 6.123233995736766036e-17; const double r2 = r * r;
    double sp = -7.6471637318198164759e-13; sp = sp * r2 + 1.6059043836821614599e-10; sp = sp * r2 - 2.5052108385441718775e-8; sp = sp * r2 + 2.7557319223985890653e-6; sp = sp * r2 - 1.9841269841269841270e-4; sp = sp * r2 + 8.3333333333333333333e-3; sp = sp * r2 - 1.6666666666666666667e-1;
    const double sr = r + r * r2 * sp;
    double cp = -1.1470745597729724714e-11; cp = cp * r2 + 2.0876756987868098979e-9; cp = cp * r2 - 2.7557319223985890653e-7; cp = cp * r2 + 2.4801587301587301587e-5; cp = cp * r2 - 1.3888888888888888889e-3; cp = cp * r2 + 4.1666666666666666667e-2; cp = cp * r2 - 0.5;
    const double cr = 1.0 + r2 * cp;
    const int q = ((int)k) & 3;
    const double ss = (q & 1) ? cr : sr, cc = (q & 1) ? sr : cr;
    s = (float)((q & 2) ? -ss : ss); c = (float)(((q == 1) || (q == 2)) ? -cc : cc);
}
struct SsmState { float ar, ai, a64r, a64i; float bbr[16], bbi[16]; };
struct SsmIn { const float *lre, *lim, *ldt, *bre, *bim, *cre, *cim, *dsk; };
__device__ __forceinline__ void ssm_params(const SsmIn& I, int g, int p, SsmState& S) {
    const int gp = g * 64 + p;
    const float lr = fminf(I.lre[gp], -1e-4f), li = I.lim[gp], dt = expf(I.ldt[g]);
    const float mag = expf(lr * dt); float sn, cs; const double th = (double)li * (double)dt; sincos_red(th, sn, cs);
    S.ar = mag * cs; S.ai = mag * sn;
    const float mag64 = expf(lr * dt * 64.f); sincos_red(th * 64.0, sn, cs); S.a64r = mag64 * cs; S.a64i = mag64 * sn;
    const float nr = S.ar - 1.f, ni = S.ai, den = lr * lr + li * li, kr = (nr * lr + ni * li) / den, ki = (ni * lr - nr * li) / den;
    const float* br = I.bre + (size_t)gp * 16; const float* bi = I.bim + (size_t)gp * 16;
#pragma unroll
    for (int c = 0; c < 16; ++c) { S.bbr[c] = kr * br[c] - ki * bi[c]; S.bbi[c] = kr * bi[c] + ki * br[c]; }
}
__device__ __forceinline__ void ssm_step(const SsmState& S, const bf16* up, float& sr, float& si) {
    const v4u* u4 = (const v4u*)up; float uf[16]; unpack8(u4[0], uf); unpack8(u4[1], uf + 8);
    float xr = 0.f, xi = 0.f;
#pragma unroll
    for (int c = 0; c < 16; ++c) { xr += S.bbr[c] * uf[c]; xi += S.bbi[c] * uf[c]; }
    const float nr = S.ar * sr - S.ai * si + xr, ni = S.ar * si + S.ai * sr + xi; sr = nr; si = ni;
}
__device__ __forceinline__ void ssm_local(Frame& F, const SsmIn& I) {
    const bf16* P = wsb(F, WS_PROJ); f32x2* SE = (f32x2*)(F.ws + WS_SEND);
    const int gw = blockIdx.x * NWAVES + F.wave, NGW = F.G * NWAVES, p = F.lane;
    for (int u = gw; u < 2 * 64 * 64; u += NGW) {
        const int g = u & 63, ch = (u >> 6) & 63, b = u >> 12;
        SsmState S; ssm_params(I, g, p, S);
        float sr = 0.f, si = 0.f; const bf16* up = P + (size_t)(b * SEQ + ch * 64) * INW + COL_S + g * 16;
#pragma unroll 4
        for (int j = 0; j < 64; ++j) ssm_step(S, up + (size_t)j * INW, sr, si);
        SE[((size_t)(b * 64 + ch) * 64 + g) * 64 + p] = (f32x2){sr, si};
    }
}
__device__ __forceinline__ void ssm_replay(Frame& F, const SsmIn& I) {
    const bf16* P = wsb(F, WS_PROJ); const f32x2* SE = (const f32x2*)(F.ws + WS_SEND); bf16* Y = wsb(F, WS_YS);
    LAS f32x2* Cs = (LAS f32x2*)F.lds;
    LAS float* Ds = (LAS float*)(F.lds + 16 * 65 * 8);
    LAS f32x2* Sw = (LAS f32x2*)(F.lds + 16384) + F.wave * (16 * 65);
    const int p = F.lane, jj = F.lane >> 2, cq = F.lane & 3;
    for (int unit = blockIdx.x; unit < 1024; unit += F.G) {
        const int oct = unit & 7, g = (unit >> 3) & 63, b = unit >> 9, ch = oct * 8 + F.wave;
        for (int e = F.tid; e < 1024; e += 512) { const int c = e >> 6, pp = e & 63; const size_t gi = ((size_t)g * 16 + c) * 64 + pp; Cs[c * 65 + pp] = (f32x2){I.cre[gi], I.cim[gi]}; }
        if (F.tid < 16) Ds[F.tid] = I.dsk[g * 16 + F.tid];
        __syncthreads();
        SsmState S; ssm_params(I, g, p, S);
        float sr = 0.f, si = 0.f;
        for (int j = 0; j < ch; ++j) { const f32x2 e = SE[((size_t)(b * 64 + j) * 64 + g) * 64 + p]; const float nr = S.a64r * sr - S.a64i * si + e.x, ni = S.a64r * si + S.a64i * sr + e.y; sr = nr; si = ni; }
        const size_t tok0 = (size_t)b * SEQ + ch * 64;
#pragma unroll 1
        for (int sub = 0; sub < 4; ++sub) {
#pragma unroll 4
            for (int j = 0; j < 16; ++j) { ssm_step(S, P + (tok0 + sub * 16 + j) * INW + COL_S + g * 16, sr, si); Sw[j * 65 + p] = (f32x2){sr, si}; }
            asm volatile("s_waitcnt lgkmcnt(0)" ::: "memory");
            float acc[4] = {0.f, 0.f, 0.f, 0.f};
#pragma unroll 4
            for (int pp = 0; pp < 64; ++pp) { const f32x2 sv = Sw[jj * 65 + pp];
#pragma unroll
                for (int ci = 0; ci < 4; ++ci) { const f32x2 cv = Cs[(cq * 4 + ci) * 65 + pp]; acc[ci] += cv.x * sv.x - cv.y * sv.y; } }
            const size_t tok = tok0 + sub * 16 + jj; const v2u uw = *(const v2u*)(P + tok * INW + COL_S + g * 16 + cq * 4);
            const float u0 = bf_lo(uw.x), u1 = bf_hi(uw.x), u2 = bf_lo(uw.y), u3 = bf_hi(uw.y);
            v2u o; o.x = cvt_pk_bf16(acc[0] + Ds[cq * 4] * u0, acc[1] + Ds[cq * 4 + 1] * u1); o.y = cvt_pk_bf16(acc[2] + Ds[cq * 4 + 2] * u2, acc[3] + Ds[cq * 4 + 3] * u3);
            *(v2u*)(Y + tok * 1024 + g * 16 + cq * 4) = o;
            asm volatile("s_waitcnt lgkmcnt(0)" ::: "memory");
        }
        __syncthreads();
    }
}

constexpr int PH_PRO = 0, PH_SB0 = 1, PH_PER_SB = 6, N_SB = 3 * DEPTH, PH_FINAL = PH_SB0 + N_SB * PH_PER_SB, N_PH = PH_FINAL + 1;
struct Args { const float* in[N_IN]; float* out; unsigned char* ws; int ph_lo, ph_hi; };
static_assert(sizeof(Args) == N_IN * 8 + 8 + 8 + 8, "Args has no padding");

typedef __attribute__((address_space(4))) const Args* KArgs;
__device__ __forceinline__ KArgs kargs() { KArgs p = (KArgs)__builtin_amdgcn_kernarg_segment_ptr(); asm volatile("" : "+s"(p)); return p; }
#define AIN(i) (kargs()->in[i])
__global__ void __launch_bounds__(NWAVES * 64, 2) fwd(Args args_unused) {
    extern __shared__ __attribute__((aligned(16))) unsigned char lds[];
    Frame F;
    F.lds = (LAS unsigned char*)lds;
    F.tid = threadIdx.x; F.lane = F.tid & 63; F.wave = __builtin_amdgcn_readfirstlane(F.tid >> 6); F.G = gridDim.x;
    F.ws = kargs()->ws;
    const int lo = kargs()->ph_lo, hi = kargs()->ph_hi;
    volatile LAS unsigned* MISC = (volatile LAS unsigned*)(F.lds + MISC_OFF);
    for (int u = F.tid; u < (LDS_BYTES - LDSCTL_OFF) / 4; u += NWAVES * 64) ((LAS unsigned*)(F.lds + LDSCTL_OFF))[u] = 0u;
    __syncthreads();
    unsigned* barw = (unsigned*)(F.ws + WS_CTL) + CW_BAR;
    XcdBarrier bar; bar.bar = barw; bar.x = 0; bar.st = nullptr;
    if (hi - lo > 1) bar = xcd_barrier_post(barw, MISC + 8);
#define IN(p) (lo <= (p) && (p) < hi)
#define FRESH() do { int t_ = threadIdx.x; asm volatile("" : "+v"(t_)); F.tid = t_; F.lane = t_ & 63; F.wave = __builtin_amdgcn_readfirstlane(t_ >> 6); unsigned char* w_ = kargs()->ws; F.ws = w_; } while (0)
#define SEAM(p, q) do { if (IN(p) && (q) < hi) xcd_barrier(bar); } while (0)

    if (IN(PH_PRO) && EN_PRO) { FRESH(); const ProIn I{AIN(I_F1WI), AIN(I_F2WI), AIN(I_F1WO), AIN(I_F2WO), AIN(I_WIN), AIN(I_WMKV), AIN(I_WGLU), AIN(I_WSWA), AIN(I_WMEMUP), AIN(I_WOUT), AIN(I_MEM), AIN(I_MEMN)}; prologue(F, I); }
    SEAM(PH_PRO, PH_SB0);

    for (int sb = 0; sb < N_SB; ++sb) {
        const int l = sb / 3, ty = sb % 3, pb = PH_SB0 + sb * PH_PER_SB;
        if (pb + PH_PER_SB <= lo || pb >= hi) continue;
#define HIN() ((sb == 0) ? AIN(I_X) : (const float*)(F.ws + WS_H))
#define WL() (F.ws + WS_W + (size_t)l * W_LAYER)
        if (IN(pb) && EN_NORM) { FRESH(); const float* gain = (ty == 0 ? AIN(I_F1N) : ty == 1 ? AIN(I_MIXN) : AIN(I_F2N)) + (size_t)l * DM; norm_phase<false>(F, HIN(), gain, F.ws + WS_XN); }
        SEAM(pb, pb + 1);
        if (ty != 1) {
            if (IN(pb + 1) && EN_G1) { FRESH();
                pg8::SchedTiles S{(const char*)(F.ws + WS_XN), (const char*)(WL() + (ty == 0 ? WO_1IN : WO_2IN)), (size_t)256 * DM * 2, T / 256, 2 * DFF / 256, F.G, (int)blockIdx.x};
                pg8::EpiSwiGLU E{wsb(F, WS_HID), DFF};
                pg8::gemm_phase<pg8::EpiSwiGLU, pg8::SchedTiles, true, true>(F.lds + RING_OFF, DM, S, E);
            }
            SEAM(pb + 1, pb + 5);
        } else {
            if (IN(pb + 1) && EN_G3) { FRESH();
                pg8::SchedProj S{(const char*)(F.ws + WS_XN), (const char*)(WL() + WO_IN), (const char*)(F.ws + WS_MEMN + (size_t)l * 512 * DM * 2), (const char*)(WL() + WO_MKV), (size_t)256 * DM * 2, T / 256, INW / 256, F.G, (int)blockIdx.x};
                pg8::EpiProj E{wsb(F, WS_PROJ), INW, COL_G / 256, wsb(F, WS_MKV), 2048};
                pg8::gemm_phase<pg8::EpiProj, pg8::SchedProj, true, true>(F.lds + RING_OFF, DM, S, E);
            }
            SEAM(pb + 1, pb + 2);
            if (IN(pb + 2) && EN_M1) { FRESH(); swa_naive(F, AIN(I_SINK) + l * 16); memattn_naive(F);
                const SsmIn I{AIN(I_LRE) + l * 4096, AIN(I_LIM) + l * 4096, AIN(I_LDT) + l * 64, AIN(I_BRE) + l * 65536, AIN(I_BIM) + l * 65536, AIN(I_CRE) + l * 65536, AIN(I_CIM) + l * 65536, AIN(I_DSK) + l * 1024}; ssm_local(F, I); }
            SEAM(pb + 2, pb + 3);
            if (IN(pb + 3) && EN_M2) { FRESH(); const SsmIn I{AIN(I_LRE) + l * 4096, AIN(I_LIM) + l * 4096, AIN(I_LDT) + l * 64, AIN(I_BRE) + l * 65536, AIN(I_BIM) + l * 65536, AIN(I_CRE) + l * 65536, AIN(I_CIM) + l * 65536, AIN(I_DSK) + l * 1024}; ssm_replay(F, I); }
            SEAM(pb + 3, pb + 4);
            if (IN(pb + 4) && EN_G4) { FRESH();
                pg8::SchedMix S{(const char*)(F.ws + WS_OSWA), (const char*)(F.ws + WS_OMEM), (const char*)(F.ws + WS_YS), (const char*)(WL() + WO_SWA), (const char*)(WL() + WO_MEM), (const char*)(WL() + WO_GLU), (size_t)256 * 1024 * 2, T / 256, DM / 256, F.G, (int)blockIdx.x};
                pg8::EpiMix E{(float*)(F.ws + WS_T32), wsb(F, WS_MG), wsb(F, WS_PROJ) + COL_G, INW};
                pg8::gemm_phase<pg8::EpiMix, pg8::SchedMix, true, true>(F.lds + RING_OFF, 1024, S, E);
            }
            SEAM(pb + 4, pb + 5);
        }
        if (IN(pb + 5) && EN_GR) { FRESH();
            const int K = (ty == 1) ? DM : DFF;
            pg8::SchedTiles S{(const char*)(F.ws + (ty == 1 ? WS_MG : WS_HID)), (const char*)(WL() + (ty == 0 ? WO_1OUT : ty == 1 ? WO_OUT : WO_2OUT)), (size_t)256 * K * 2, T / 256, DM / 256, F.G, (int)blockIdx.x};
            pg8::EpiResid E{HIN(), (float*)(F.ws + WS_H), ty == 1 ? 1.0f : 0.5f, DM};
            pg8::gemm_phase<pg8::EpiResid, pg8::SchedTiles, true, true>(F.lds + RING_OFF, K, S, E);
        }
        SEAM(pb + 5, pb + 6);
    }
    if (IN(PH_FINAL)) { FRESH(); norm_phase<true>(F, (const float*)(F.ws + WS_H), AIN(I_FINN), kargs()->out); }
#undef IN
#undef SEAM
}

static bool phase_valid(int p) {
    if (p == PH_PRO || p == PH_FINAL) return true;
    const int sb = (p - PH_SB0) / PH_PER_SB, k = (p - PH_SB0) % PH_PER_SB;
    return (sb % 3 == 1) || k == 0 || k == 1 || k == 5;
}
extern "C" void kernel_launch(void* const* d_in, const int* in_sizes, int n_in, void* d_out, int out_size, void* d_ws, size_t ws_size, hipStream_t stream) {
    static int grid = 0;
    if (grid == 0) {
        if (n_in != N_IN || in_sizes[0] != T * DM || out_size != T * DM || ws_size < WS_END) { fprintf(stderr, "kernel_launch: unexpected shapes: n_in %d in0 %d out %d ws %zu (need %zu); nothing launched\n", n_in, n_in > 0 ? in_sizes[0] : -1, out_size, ws_size, (size_t)WS_END); grid = -1; return; }
        int dev = 0, cus = 0, per_cu = 0;
        if (hipGetDevice(&dev) != hipSuccess || hipDeviceGetAttribute(&cus, hipDeviceAttributeMultiprocessorCount, dev) != hipSuccess) { fprintf(stderr, "kernel_launch: device query failed\n"); grid = -1; return; }
        if (hipFuncSetAttribute((const void*)fwd, hipFuncAttributeMaxDynamicSharedMemorySize, LDS_BYTES) != hipSuccess) { fprintf(stderr, "kernel_launch: hipFuncSetAttribute failed\n"); grid = -1; return; }
        if (hipOccupancyMaxActiveBlocksPerMultiprocessor(&per_cu, (const void*)fwd, NWAVES * 64, LDS_BYTES) != hipSuccess || per_cu < 1) fprintf(stderr, "kernel_launch: note: occupancy query reports %d workgroups per CU\n", per_cu);
        (void)hipGetLastError();
        grid = cus;
    }
    if (grid < 0) return;
    if (hipMemsetAsync((char*)d_ws + WS_CTL, 0, CTL_ZERO_BYTES, stream) != hipSuccess) { fprintf(stderr, "kernel_launch: memset failed\n"); return; }
    Args a{};
    for (int i = 0; i < N_IN; ++i) a.in[i] = (const float*)d_in[i];
    a.out = (float*)d_out; a.ws = (unsigned char*)d_ws;
#if ONE_LAUNCH
    a.ph_lo = 0; a.ph_hi = N_PH;
    hipLaunchKernelGGL(fwd, dim3(grid), dim3(NWAVES * 64), LDS_BYTES, stream, a);
#else
    for (int p = 0; p < N_PH; ++p) { if (!phase_valid(p)) continue; a.ph_lo = p; a.ph_hi = p + 1; hipLaunchKernelGGL(fwd, dim3(grid), dim3(NWAVES * 64), LDS_BYTES, stream, a); }
#endif
    const hipError_t le = hipPeekAtLastError();
    if (le != hipSuccess) fprintf(stderr, "kernel_launch: launch failed: %s\n", hipGetErrorName(le));
}
```

```cpp
#include <hip/hip_runtime.h>
#include <cstdio>
#include <cstdint>

#ifndef EN_PRO
#define EN_PRO 1
#endif
#ifndef EN_NORM
#define EN_NORM 1
#endif
#ifndef EN_G1
#define EN_G1 1
#endif
#ifndef EN_G3
#define EN_G3 1
#endif
#ifndef EN_M1
#define EN_M1 1
#endif
#ifndef EN_M2
#define EN_M2 1
#endif
#ifndef EN_G4
#define EN_G4 1
#endif
#ifndef EN_GR
#define EN_GR 1
#endif
#ifndef REP_M
#define REP_M 1
#endif
#ifndef ONE_LAUNCH
#define ONE_LAUNCH 1
#endif

namespace pg8 {
#define PG8_LAS __attribute__((address_space(3)))
typedef unsigned short bf16_t;
typedef short bf16x8 __attribute__((ext_vector_type(8)));
typedef float f32x4 __attribute__((ext_vector_type(4)));
typedef unsigned u32x4 __attribute__((ext_vector_type(4)));
constexpr int BM = 256, BK = 64, HALF = 128, HTB = HALF * BK * 2  , STAGE_BYTES = 8 * HTB, NXCD = 8, WGM = 8;

__host__ __device__ __forceinline__ int lds_byte(int r, int c) { const int st = (r >> 4) * 2 + (c >> 5), rr = r & 15, cc = c & 31, ob = rr * 64 + cc * 2; return st * 1024 + (ob ^ (((ob >> 9) & 1) << 5)); }
__host__ __device__ __forceinline__ void stage_rc(int b, int& R, int& C) { const int st = b / 1024, sb = b % 1024, swz = sb ^ (((sb >> 9) & 1) << 5); R = (st >> 1) * 16 + swz / 64; C = (st & 1) * 32 + (swz % 64) / 2; }
__host__ __device__ __forceinline__ int perm32(int rho) { const int n = rho >> 4, i = rho & 15; return 8 * (i >> 2) + 4 * n + (i & 3); }


struct Unit { int pm, pn, kind; };

__device__ __forceinline__ unsigned cvt_pk_bf16(float lo, float hi) { unsigned r; asm volatile("v_cvt_pk_bf16_f32 %0, %1, %2" : "=v"(r) : "v"(lo), "v"(hi)); return r; }
__device__ __forceinline__ float bf_lo(unsigned u) { return __uint_as_float(u << 16); }
__device__ __forceinline__ float bf_hi(unsigned u) { return __uint_as_float(u & 0xffff0000u); }
__device__ __forceinline__ float sigmoidf_fast(float x) { return __builtin_amdgcn_rcpf(1.0f + __builtin_amdgcn_exp2f(-1.4426950408889634f * x)); }

__device__ __forceinline__ void tile_of(int L, int nM, int nN, int& pm, int& pn) {
    const int nwg = nM * nN; int wgid = L; { const int q = nwg / NXCD, r = nwg % NXCD, xcd = wgid % NXCD, off = wgid / NXCD; wgid = (xcd < r ? xcd * (q + 1) : r * (q + 1) + (xcd - r) * q) + off; }
    const int nig = WGM * nN, gid = wgid / nig, fm = gid * WGM, gsz = (nM - fm) < WGM ? (nM - fm) : WGM;
    pm = fm + ((wgid % nig) % gsz); pn = (wgid % nig) / gsz;
}

struct SchedTiles {
    const char* A; const char* Bt; size_t tstep; int nM, nN, G, c;
    __device__ __forceinline__ bool next(int i, Unit& u) const { const int L = i * G + c; if (L >= nM * nN) return false; tile_of(L, nM, nN, u.pm, u.pn); u.kind = 0; return true; }
    __device__ __forceinline__ void operands(const Unit& u, const char*& a, const char*& b) const { a = A + (size_t)u.pm * tstep; b = Bt + (size_t)u.pn * tstep; }
    __device__ __forceinline__ void a_ready(const Unit&) const {}
    __device__ __forceinline__ void done(const Unit&) const {}
};
struct SchedProj {
    const char* A; const char* Bt; const char* A2; const char* Bt2; size_t tstep; int nM, nN, G, c;
    __device__ __forceinline__ bool next(int i, Unit& u) const { const int L = i * G + c, nwg = nM * nN; if (L < nwg) { tile_of(L, nM, nN, u.pm, u.pn); u.kind = 0; return true; }
        if (L < nwg + 16) { const int j = L - nwg; u.pm = j & 1; u.pn = j >> 1; u.kind = 1; return true; } return false; }
    __device__ __forceinline__ void operands(const Unit& u, const char*& a, const char*& b) const { a = (u.kind ? A2 : A) + (size_t)u.pm * tstep; b = (u.kind ? Bt2 : Bt) + (size_t)u.pn * tstep; }
    __device__ __forceinline__ void a_ready(const Unit&) const {}
    __device__ __forceinline__ void done(const Unit&) const {}
};
struct SchedMix {
    const char* Aswa; const char* Amem; const char* Ays; const char* Bswa; const char* Bmem; const char* Bglu; size_t tstep; int nM, nN, G, c;
    __device__ __forceinline__ bool next(int i, Unit& u) const { const int L = (i >> 2) * G + c; if (L >= nM * nN) return false; tile_of(L, nM, nN, u.pm, u.pn); u.kind = i & 3; return true; }
    __device__ __forceinline__ void operands(const Unit& u, const char*& a, const char*& b) const {
        if (u.kind == 0) { a = Aswa + (size_t)u.pm * tstep; b = Bswa + (size_t)u.pn * tstep; }
        else if (u.kind == 1) { a = Amem + (size_t)u.pm * tstep; b = Bmem + (size_t)u.pn * tstep; }
        else { a = Ays + (size_t)u.pm * tstep; b = Bglu + (size_t)(2 * u.pn + (u.kind - 2)) * tstep; } }
    __device__ __forceinline__ void a_ready(const Unit&) const {}
    __device__ __forceinline__ void done(const Unit&) const {}
};

struct EpiSwiGLU {
    static constexpr bool PERM = true, AFTER_DRAIN = false;
    bf16_t* O; int ldo;
    __device__ __forceinline__ void operator()(const f32x4 (&acc)[2][2][4][2], const Unit& u, int wr, int wc, int fr, int fq) const {
        const int row0 = u.pm * BM + wr * 64 + fr, col0 = u.pn * HALF + wc * 32 + 8 * fq;
#pragma unroll
        for (int ai = 0; ai < 2; ++ai)
#pragma unroll
            for (int m = 0; m < 4; ++m) { bf16_t* rowp = O + (size_t)(row0 + ai * HALF + m * 16) * ldo + col0; float o[8];
#pragma unroll
                for (int n = 0; n < 2; ++n)
#pragma unroll
                    for (int e = 0; e < 4; ++e) { const float g = acc[ai][0][m][n][e], uu = acc[ai][1][m][n][e]; o[4 * n + e] = g * sigmoidf_fast(g) * uu; }
                u32x4 w; w.x = cvt_pk_bf16(o[0], o[1]); w.y = cvt_pk_bf16(o[2], o[3]); w.z = cvt_pk_bf16(o[4], o[5]); w.w = cvt_pk_bf16(o[6], o[7]);
                *(u32x4*)rowp = w; }
    }
};
struct EpiResid {
    static constexpr bool PERM = false, AFTER_DRAIN = false;
    const float* Hin; float* Hout; float alpha; int ldc;
    __device__ __forceinline__ void operator()(const f32x4 (&acc)[2][2][4][2], const Unit& u, int wr, int wc, int fr, int fq) const {
        const int row0 = u.pm * BM + wr * 64 + fr, col0 = u.pn * BM + wc * 32 + 4 * fq;
#pragma unroll
        for (int ai = 0; ai < 2; ++ai)
#pragma unroll
            for (int m = 0; m < 4; ++m) { const size_t off = (size_t)(row0 + ai * HALF + m * 16) * ldc + col0;
#pragma unroll
                for (int bj = 0; bj < 2; ++bj)
#pragma unroll
                    for (int n = 0; n < 2; ++n) { const f32x4 b = *(const f32x4*)(Hin + off + bj * HALF + n * 16); *(f32x4*)(Hout + off + bj * HALF + n * 16) = b + acc[ai][bj][m][n] * alpha; } }
    }
};
struct EpiProj {
    static constexpr bool PERM = true, AFTER_DRAIN = false;
    bf16_t* P; int ldp; int sig_from; bf16_t* KV; int ldk;
    __device__ __forceinline__ void operator()(const f32x4 (&acc)[2][2][4][2], const Unit& u, int wr, int wc, int fr, int fq) const {
        const int row0 = u.pm * BM + wr * 64 + fr, col0 = u.pn * BM + wc * 32 + 8 * fq;
        bf16_t* base = u.kind ? KV : P; const int ld = u.kind ? ldk : ldp; const bool sig = (u.kind == 0) && (u.pn >= sig_from);
#pragma unroll
        for (int ai = 0; ai < 2; ++ai)
#pragma unroll
            for (int m = 0; m < 4; ++m) { bf16_t* rowp = base + (size_t)(row0 + ai * HALF + m * 16) * ld + col0;
#pragma unroll
                for (int bj = 0; bj < 2; ++bj) { f32x4 v0 = acc[ai][bj][m][0], v1 = acc[ai][bj][m][1];
                    if (sig) {
#pragma unroll
                        for (int e = 0; e < 4; ++e) { v0[e] = sigmoidf_fast(v0[e]); v1[e] = sigmoidf_fast(v1[e]); } }
                    u32x4 w; w.x = cvt_pk_bf16(v0[0], v0[1]); w.y = cvt_pk_bf16(v0[2], v0[3]); w.z = cvt_pk_bf16(v1[0], v1[1]); w.w = cvt_pk_bf16(v1[2], v1[3]);
                    *(u32x4*)(rowp + bj * HALF) = w; } }
    }
};
struct EpiMix {
    static constexpr bool PERM = true, AFTER_DRAIN = false;
    float* T32; bf16_t* MG; const bf16_t* Gt; int ldg;
    __device__ __forceinline__ void operator()(const f32x4 (&acc)[2][2][4][2], const Unit& u, int wr, int wc, int fr, int fq) const {
        const int row0 = u.pm * BM + wr * 64 + fr, cw = wc * 32 + 8 * fq;
        if (u.kind < 2) {
            const int gsel = u.kind == 0 ? 0 : 4096;
#pragma unroll
            for (int ai = 0; ai < 2; ++ai)
#pragma unroll
                for (int m = 0; m < 4; ++m) { const size_t row = (size_t)(row0 + ai * HALF + m * 16);
#pragma unroll
                    for (int bj = 0; bj < 2; ++bj) { const int col = u.pn * BM + bj * HALF + cw;
                        const u32x4 gw = *(const u32x4*)(Gt + row * ldg + gsel + col);
                        f32x4 g0 = {bf_lo(gw.x), bf_hi(gw.x), bf_lo(gw.y), bf_hi(gw.y)}, g1 = {bf_lo(gw.z), bf_hi(gw.z), bf_lo(gw.w), bf_hi(gw.w)};
                        f32x4 t0 = acc[ai][bj][m][0] * g0, t1 = acc[ai][bj][m][1] * g1; float* tp = T32 + row * 2048 + col;
                        if (u.kind == 1) { t0 += *(const f32x4*)tp; t1 += *(const f32x4*)(tp + 4); }
                        *(f32x4*)tp = t0; *(f32x4*)(tp + 4) = t1; } }
        } else {
            const int col = u.pn * BM + (u.kind - 2) * HALF + cw;
#pragma unroll
            for (int ai = 0; ai < 2; ++ai)
#pragma unroll
                for (int m = 0; m < 4; ++m) { const size_t row = (size_t)(row0 + ai * HALF + m * 16);
                    const u32x4 gw = *(const u32x4*)(Gt + row * ldg + 2048 + col);
                    const float gg[8] = {bf_lo(gw.x), bf_hi(gw.x), bf_lo(gw.y), bf_hi(gw.y), bf_lo(gw.z), bf_hi(gw.z), bf_lo(gw.w), bf_hi(gw.w)};
                    const float* tp = T32 + row * 2048 + col; const f32x4 t0 = *(const f32x4*)tp, t1 = *(const f32x4*)(tp + 4); float o[8];
#pragma unroll
                    for (int n = 0; n < 2; ++n)
#pragma unroll
                        for (int e = 0; e < 4; ++e) { const float ga = acc[ai][0][m][n][e], gb = acc[ai][1][m][n][e]; o[4 * n + e] = (n ? t1[e] : t0[e]) + gg[4 * n + e] * ga * sigmoidf_fast(gb); }
                    u32x4 w; w.x = cvt_pk_bf16(o[0], o[1]); w.y = cvt_pk_bf16(o[2], o[3]); w.z = cvt_pk_bf16(o[4], o[5]); w.w = cvt_pk_bf16(o[6], o[7]);
                    *(u32x4*)(MG + row * 2048 + col) = w; }
        }
    }
};

template <class Epi, class Sched, bool ALIGN_EPI = false, bool SP2 = false>
__device__ __forceinline__ void gemm_phase(PG8_LAS unsigned char* lds, const int K, const Sched& S, const Epi& E) {
    int tid_ = threadIdx.x; asm volatile("" : "+v"(tid_));
    const int tid = tid_, wid = __builtin_amdgcn_readfirstlane(tid >> 6), lane = tid & 63, wr = wid >> 2, wc = wid & 3, fr = lane & 15, fq = lane >> 4;
    const int nt = K / BK;
    unsigned voffA[2], voffB[2];
#pragma unroll
    for (int i = 0; i < 2; ++i) { int R, C; stage_rc(tid * 16 + i * 8192, R, C); const int Rb = Epi::PERM ? ((R & ~31) + perm32(R & 31)) : R;
        voffA[i] = (unsigned)(R * K + C) * 2u; voffB[i] = (unsigned)(Rb * K + C) * 2u; }
    const size_t kstep = (size_t)(BK * 2);
    const size_t hstep = (size_t)HALF * K * 2;
    const unsigned ldsw = (unsigned)wid * 1024u;
    const int aoff = lds_byte(wr * 64 + fr, fq * 8), boff = lds_byte(wc * 32 + fr, fq * 8);
#define PG8_SA(b, h) (((b) * 2 + (h)) * HTB)
#define PG8_SB(b, h) ((4 + (b) * 2 + (h)) * HTB)
#define PG8_STAGE(bufoff, gbase, voff) do { _Pragma("unroll") for (int _i = 0; _i < 2; ++_i) \
        __builtin_amdgcn_global_load_lds((const unsigned*)((const char*)(gbase) + (voff)[_i]), (PG8_LAS unsigned*)(lds + (bufoff) + ldsw + _i * 8192), 16, 0, 0); } while (0)
#define PG8_LDA(dst, b, h) do { _Pragma("unroll") for (int m = 0; m < 4; ++m) _Pragma("unroll") for (int k = 0; k < 2; ++k) dst[m][k] = *(const PG8_LAS bf16x8*)(lds + PG8_SA(b, h) + aoff + m * 2048 + k * 1024); } while (0)
#define PG8_LDB(dst, b, h) do { _Pragma("unroll") for (int n = 0; n < 2; ++n) _Pragma("unroll") for (int k = 0; k < 2; ++k) dst[n][k] = *(const PG8_LAS bf16x8*)(lds + PG8_SB(b, h) + boff + n * 2048 + k * 1024); } while (0)
#define PG8_MMA(ai, bj, At, Bt) do { __builtin_amdgcn_s_setprio(1); _Pragma("unroll") for (int m = 0; m < 4; ++m) _Pragma("unroll") for (int n = 0; n < 2; ++n) _Pragma("unroll") for (int k = 0; k < 2; ++k) \
        acc[ai][bj][m][n] = __builtin_amdgcn_mfma_f32_16x16x32_bf16(Bt[n][k], At[m][k], acc[ai][bj][m][n], 0, 0, 0); __builtin_amdgcn_s_setprio(0); } while (0)
#define PG8_WAIT_V(n) asm volatile("s_waitcnt vmcnt(" #n ")" ::: "memory")
#define PG8_WAIT_L(n) asm volatile("s_waitcnt lgkmcnt(" #n ")" ::: "memory")
#define PG8_BAR __builtin_amdgcn_s_barrier()
#define PG8_SCHED __builtin_amdgcn_sched_barrier(0)
    Unit cur, nxt; int ui = 0;
    if (!S.next(0, cur)) return;
    f32x4 acc[2][2][4][2];
#pragma unroll
    for (int a = 0; a < 2; ++a)
#pragma unroll
        for (int b = 0; b < 2; ++b)
#pragma unroll
            for (int m = 0; m < 4; ++m)
#pragma unroll
                for (int n = 0; n < 2; ++n) acc[a][b][m][n] = (f32x4){0.f, 0.f, 0.f, 0.f};
    bf16x8 At[4][2], B0[2][2], B1[2][2];
    const char* cA; const char* cB; S.operands(cur, cA, cB);
    S.a_ready(cur);
    if constexpr (SP2) {
        PG8_STAGE(PG8_SB(0, 0), cB, voffB); PG8_STAGE(PG8_SB(0, 1), cB + hstep, voffB); PG8_STAGE(PG8_SA(0, 0), cA, voffA); PG8_STAGE(PG8_SA(0, 1), cA + hstep, voffA);
        if (wr == 1) PG8_BAR;
        PG8_WAIT_V(2); PG8_BAR;
        PG8_STAGE(PG8_SB(1, 0), cB + kstep, voffB); PG8_STAGE(PG8_SA(1, 0), cA + kstep, voffA); PG8_STAGE(PG8_SB(1, 1), cB + hstep + kstep, voffB);
        PG8_WAIT_V(6); PG8_BAR;
    } else {
        PG8_STAGE(PG8_SB(0, 0), cB, voffB); PG8_STAGE(PG8_SA(0, 0), cA, voffA); PG8_STAGE(PG8_SB(0, 1), cB + hstep, voffB); PG8_STAGE(PG8_SA(0, 1), cA + hstep, voffA);
        if (wr == 1) PG8_BAR;
        PG8_WAIT_V(4); PG8_BAR;
        PG8_STAGE(PG8_SB(1, 0), cB + kstep, voffB); PG8_STAGE(PG8_SA(1, 0), cA + kstep, voffA); PG8_STAGE(PG8_SB(1, 1), cB + hstep + kstep, voffB);
        PG8_WAIT_V(6); PG8_BAR;
    }
    for (;;) {
        const bool has_next = S.next(ui + 1, nxt);
        const char* nA = cA; const char* nB = cB; if (has_next) S.operands(nxt, nA, nB);
        for (int t = 0; t < nt; t += 2) {
            const bool last = (t == nt - 2);
            const char* a1 = cA + (size_t)(t + 1) * kstep;
            const char* a2 = last ? nA : cA + (size_t)(t + 2) * kstep; const char* b2 = last ? nB : cB + (size_t)(t + 2) * kstep;
            const char* a3 = a2 + kstep; const char* b3 = b2 + kstep;
            if (last && has_next) S.a_ready(nxt);
            if constexpr (SP2) {
            PG8_LDB(B0, 0, 0); PG8_LDB(B1, 0, 1); PG8_SCHED; PG8_LDA(At, 0, 0); PG8_STAGE(PG8_SA(1, 1), a1 + hstep, voffA);
            PG8_WAIT_V(8); PG8_WAIT_L(0); PG8_BAR; PG8_MMA(0, 0, At, B0); PG8_MMA(0, 1, At, B1); PG8_BAR; PG8_SCHED;
            PG8_LDA(At, 0, 1); PG8_STAGE(PG8_SB(0, 0), b2, voffB); PG8_STAGE(PG8_SB(0, 1), b2 + hstep, voffB); PG8_STAGE(PG8_SA(0, 0), a2, voffA);
            PG8_WAIT_V(8); PG8_WAIT_L(0); PG8_BAR; PG8_MMA(1, 0, At, B0); PG8_MMA(1, 1, At, B1); PG8_BAR; PG8_SCHED;
            PG8_LDB(B0, 1, 0); PG8_LDB(B1, 1, 1); PG8_SCHED; PG8_LDA(At, 1, 0); PG8_STAGE(PG8_SA(0, 1), a2 + hstep, voffA);
            PG8_WAIT_V(8); PG8_WAIT_L(0); PG8_BAR; PG8_MMA(0, 0, At, B0); PG8_MMA(0, 1, At, B1); PG8_BAR; PG8_SCHED;
            PG8_LDA(At, 1, 1); PG8_STAGE(PG8_SB(1, 0), b3, voffB); PG8_STAGE(PG8_SB(1, 1), b3 + hstep, voffB); PG8_STAGE(PG8_SA(1, 0), a3, voffA);
            PG8_WAIT_V(8); PG8_WAIT_L(0); PG8_BAR; PG8_MMA(1, 0, At, B0); PG8_MMA(1, 1, At, B1); PG8_BAR; PG8_SCHED;
            } else {
            PG8_LDB(B0, 0, 0); PG8_SCHED; PG8_LDA(At, 0, 0); PG8_STAGE(PG8_SA(1, 1), a1 + hstep, voffA);
            PG8_WAIT_L(8); PG8_BAR; PG8_WAIT_L(0); PG8_MMA(0, 0, At, B0); PG8_BAR; PG8_SCHED;
            PG8_LDB(B1, 0, 1); PG8_STAGE(PG8_SB(0, 0), b2, voffB);
            PG8_BAR; PG8_WAIT_L(0); PG8_MMA(0, 1, At, B1); PG8_BAR;
            PG8_LDA(At, 0, 1); PG8_STAGE(PG8_SA(0, 0), a2, voffA);
            PG8_BAR; PG8_WAIT_L(0); PG8_MMA(1, 0, At, B0); PG8_BAR; PG8_SCHED;
            PG8_STAGE(PG8_SB(0, 1), b2 + hstep, voffB);
            PG8_WAIT_V(6); PG8_BAR; PG8_MMA(1, 1, At, B1); PG8_BAR;
            PG8_LDB(B0, 1, 0); PG8_SCHED; PG8_LDA(At, 1, 0); PG8_STAGE(PG8_SA(0, 1), a2 + hstep, voffA);
            PG8_WAIT_L(8); PG8_BAR; PG8_WAIT_L(0); PG8_MMA(0, 0, At, B0); PG8_BAR; PG8_SCHED;
            PG8_LDB(B1, 1, 1); PG8_STAGE(PG8_SB(1, 0), b3, voffB);
            PG8_BAR; PG8_WAIT_L(0); PG8_MMA(0, 1, At, B1); PG8_BAR;
            PG8_LDA(At, 1, 1); PG8_STAGE(PG8_SA(1, 0), a3, voffA);
            PG8_BAR; PG8_WAIT_L(0); PG8_MMA(1, 0, At, B0); PG8_BAR; PG8_SCHED;
            PG8_STAGE(PG8_SB(1, 1), b3 + hstep, voffB);
            PG8_WAIT_V(6); PG8_BAR; PG8_MMA(1, 1, At, B1); PG8_BAR;
            }
        }
        if constexpr (ALIGN_EPI) { if (wr == 0) PG8_BAR; }
        if constexpr (!Epi::AFTER_DRAIN) { E(acc, cur, wr, wc, fr, fq); S.done(cur); }
        if (!has_next) break;
#pragma unroll
        for (int a = 0; a < 2; ++a)
#pragma unroll
            for (int b = 0; b < 2; ++b)
#pragma unroll
                for (int m = 0; m < 4; ++m)
#pragma unroll
                    for (int n = 0; n < 2; ++n) acc[a][b][m][n] = (f32x4){0.f, 0.f, 0.f, 0.f};
        cur = nxt; cA = nA; cB = nB; ++ui;
        if constexpr (ALIGN_EPI) { if (wr == 1) PG8_BAR; }
    }
    PG8_WAIT_V(0);
    if constexpr (!ALIGN_EPI) { if (wr == 0) PG8_BAR; }
    PG8_BAR;
    if constexpr (Epi::AFTER_DRAIN) { E.fused(acc, cur, wr, wc, fr, fq, lds, wid, lane); S.done(cur); }
#undef PG8_SA
#undef PG8_SB
#undef PG8_STAGE
#undef PG8_LDA
#undef PG8_LDB
#undef PG8_MMA
#undef PG8_WAIT_V
#undef PG8_WAIT_L
#undef PG8_BAR
#undef PG8_SCHED
}
}

constexpr int BATCH = 2, SEQ = 4096, DM = 2048, DEPTH = 4, NMEM = 256, DFF = 5632;
constexpr int T = BATCH * SEQ;
constexpr int INW = 9728, COL_Q = 0, COL_K = 1024, COL_V = 1280, COL_S = 1536, COL_MQ = 2560, COL_G = 3584;
constexpr float RMS_EPS = 1e-5f, LOG2E = 1.4426950408889634f;
constexpr int NWAVES = 8;
enum { I_X = 0, I_MEM, I_F1N, I_F1WI, I_F1WO, I_MIXN, I_MEMN, I_WIN, I_SINK, I_WMKV, I_LRE, I_LIM, I_LDT, I_BRE, I_BIM, I_CRE, I_CIM, I_DSK, I_WGLU, I_WSWA, I_WMEMUP, I_WOUT, I_F2N, I_F2WI, I_F2WO, I_FINN, N_IN };

constexpr size_t MiB = 1u << 20;
constexpr size_t WS_CTL = 0, CTL_ZERO_BYTES = 1 * MiB;
constexpr size_t WS_W = 2 * MiB, W_LAYER = 202 * MiB;
constexpr size_t WO_1IN = 0, WO_1OUT = 44 * MiB, WO_IN = 66 * MiB, WO_MKV = 104 * MiB, WO_SWA = 112 * MiB, WO_MEM = 116 * MiB, WO_GLU = 120 * MiB, WO_OUT = 128 * MiB, WO_2IN = 136 * MiB, WO_2OUT = 180 * MiB;
constexpr size_t WS_MEMN = WS_W + DEPTH * W_LAYER;
constexpr size_t WS_H = WS_MEMN + 8 * MiB;
constexpr size_t WS_XN = WS_H + 64 * MiB;
constexpr size_t WS_HID = WS_XN + 32 * MiB;
constexpr size_t WS_PROJ = WS_HID + 88 * MiB;
constexpr size_t WS_MKV = WS_PROJ + 152 * MiB;
constexpr size_t WS_OSWA = WS_MKV + 2 * MiB, WS_YS = WS_OSWA + 16 * MiB, WS_OMEM = WS_YS + 16 * MiB;
constexpr size_t WS_T32 = WS_OMEM + 16 * MiB;
constexpr size_t WS_MG = WS_T32 + 64 * MiB;
constexpr size_t WS_SEND = WS_MG + 32 * MiB;
constexpr size_t WS_END = WS_SEND + 4 * MiB;
constexpr int CW_BAR = 4096;

constexpr int RING_OFF = 0, RING_BYTES = 131072;
constexpr int LDSCTL_OFF = RING_BYTES, MISC_OFF = LDSCTL_OFF + 320;
constexpr int LDS_BYTES = 147456;

#define GAS __attribute__((address_space(1)))
#define LAS __attribute__((address_space(3)))
typedef unsigned short bf16;
typedef unsigned v4u __attribute__((ext_vector_type(4)));
typedef unsigned v2u __attribute__((ext_vector_type(2)));
typedef float f32x4 __attribute__((ext_vector_type(4)));
typedef float f32x2 __attribute__((ext_vector_type(2)));
typedef GAS unsigned gu32;
using pg8::cvt_pk_bf16; using pg8::bf_lo; using pg8::bf_hi;

#define XB_TMO      128
#define XB_XCNT(j)  (256  + 64 * (j))
#define XB_XSUB(j)  (1280 + 64 * (j))
#define XB_XGEN(j)  (2304 + 64 * (j))
#define XB_TOP      3328
#define XB_TOPGEN   3392
#define XCD_BAR_WORDS 3456
#define XB_SPIN_CAP (1u << 18)

__device__ __forceinline__ unsigned xb_ld(unsigned* p)              { return __hip_atomic_load(p, __ATOMIC_RELAXED, __HIP_MEMORY_SCOPE_AGENT); }
__device__ __forceinline__ unsigned xb_add(unsigned* p, unsigned v) { return __hip_atomic_fetch_add(p, v, __ATOMIC_RELAXED, __HIP_MEMORY_SCOPE_AGENT); }
__device__ __forceinline__ unsigned xb_xcc_id() { return (unsigned)__builtin_amdgcn_s_getreg((3 << 11) | 20) & 0xFu; }
#define XB_SPIN(cond, bar) do { unsigned _sp = 0; while (cond) { __builtin_amdgcn_s_sleep(1); \
    if ((++_sp & 255u) == 0u) { if (xb_ld(&(bar)[XB_TMO])) break; if (_sp > XB_SPIN_CAP) { atomicAdd(&(bar)[XB_TMO], 1u); break; } } } } while (0)

struct XcdBarrier {
    unsigned* bar; unsigned x;
    volatile LAS unsigned* st;
};

__device__ __forceinline__ XcdBarrier xcd_barrier_post(unsigned* bar, volatile LAS unsigned* st) {
    XcdBarrier b; b.bar = bar; b.x = xb_xcc_id(); b.st = st;
    if (threadIdx.x == 0) (void)xb_add(&bar[XB_XCNT(b.x)], 1u);
    return b;
}
__device__ __forceinline__ void xcd_barrier_complete(unsigned* bar, unsigned x, unsigned& nloc, unsigned& nx) {
    const unsigned G = gridDim.x * gridDim.y * gridDim.z;
    unsigned sum, cnt, mine, sp = 0u;
    for (;;) {
        sum = 0u; cnt = 0u; mine = 0u;
#pragma unroll
        for (unsigned j = 0; j < 16; ++j) { const unsigned c = xb_ld(&bar[XB_XCNT(j)]); sum += c; cnt += (c > 0u) ? 1u : 0u; mine = (j == x) ? c : mine; }
        if (sum == G) break;
        __builtin_amdgcn_s_sleep(1);
        if ((++sp & 255u) == 0u) { if (xb_ld(&bar[XB_TMO])) break; if (sp > XB_SPIN_CAP) { atomicAdd(&bar[XB_TMO], 1u); break; } }
    }
    nloc = mine > 0u ? mine : 1u; nx = cnt > 0u ? cnt : 1u;
}

__device__ __forceinline__ void xcd_barrier(const XcdBarrier& b) {
    asm volatile("s_waitcnt vmcnt(0)" ::: "memory");
    __syncthreads();
    if (threadIdx.x == 0) {
        unsigned* bar = b.bar;
        __builtin_amdgcn_s_waitcnt(0);
        unsigned nloc = b.st[0], nx = b.st[1];
        if (nloc == 0u) { xcd_barrier_complete(bar, b.x, nloc, nx); b.st[0] = nloc; b.st[1] = nx; }
        const unsigned old = xb_add(&bar[XB_XSUB(b.x)], 1u);
        const unsigned gen = old / nloc;
        if (old + 1u == (gen + 1u) * nloc) {
            __builtin_amdgcn_fence(__ATOMIC_RELEASE, "agent");
            asm volatile("s_waitcnt vmcnt(0)" ::: "memory");
            const unsigned og = xb_add(&bar[XB_TOP], 1u);
            const unsigned tg = og / nx;
            if (og + 1u == (tg + 1u) * nx) xb_add(&bar[XB_TOPGEN], 1u);
            else XB_SPIN(xb_ld(&bar[XB_TOPGEN]) == tg, bar);
            __builtin_amdgcn_fence(__ATOMIC_ACQUIRE, "agent");
            xb_add(&bar[XB_XGEN(b.x)], 1u);
            asm volatile("s_waitcnt vmcnt(0)" ::: "memory");
        } else {
            XB_SPIN(xb_ld(&bar[XB_XGEN(b.x)]) == gen, bar);
            __builtin_amdgcn_fence(__ATOMIC_ACQUIRE, "agent");
            asm volatile("s_waitcnt vmcnt(0)" ::: "memory");
        }
    }
    __syncthreads();
}

struct Frame {
    LAS unsigned char* lds;
    int tid, lane, wave, G;
    unsigned char* ws;
};
__device__ __forceinline__ float wave_sum(float v) {
#pragma unroll
    for (int o = 1; o < 64; o <<= 1) v += __shfl_xor(v, o);
    return v;
}
__device__ __forceinline__ bf16* wsb(const Frame& F, size_t off) { return (bf16*)(F.ws + off); }

__device__ __forceinline__ void conv_block(const float* __restrict__ W, int K, int N, bf16* __restrict__ Wt, int kb, int nb, int pairNh, float scale, int lane) {
    const int k0 = kb * 64, n = nb * 64 + lane;
    const float* src = W + (size_t)k0 * N + n;
    float v[64];
#pragma unroll
    for (int i = 0; i < 64; ++i) v[i] = src[(size_t)i * N];
    int row = n;
    if (pairNh) { const int j = n < pairNh ? n : n - pairNh; row = (j >> 7) * 256 + (j & 127) + (n < pairNh ? 0 : 128); }
    v4u* dst = (v4u*)(Wt + (size_t)row * K + k0);
#pragma unroll
    for (int q = 0; q < 8; ++q) { v4u o; o.x = cvt_pk_bf16(v[8 * q] * scale, v[8 * q + 1] * scale); o.y = cvt_pk_bf16(v[8 * q + 2] * scale, v[8 * q + 3] * scale);
        o.z = cvt_pk_bf16(v[8 * q + 4] * scale, v[8 * q + 5] * scale); o.w = cvt_pk_bf16(v[8 * q + 6] * scale, v[8 * q + 7] * scale); dst[q] = o; }
}
constexpr int CI_1IN = (DM / 64) * (2 * DFF / 64), CI_1OUT = (DFF / 64) * (DM / 64), CI_IN = (DM / 64) * (INW / 64), CI_MKV = (DM / 64) * (2048 / 64), CI_GLU = (1024 / 64) * (4096 / 64),
              CI_SWA = (1024 / 64) * (DM / 64), CI_MEM = CI_SWA, CI_OUT = (DM / 64) * (DM / 64), CI_LAYER = 2 * CI_1IN + 2 * CI_1OUT + CI_IN + CI_MKV + CI_GLU + CI_SWA + CI_MEM + CI_OUT;
struct ProIn { const float *f1wi, *f2wi, *f1wo, *f2wo, *win, *wmkv, *wglu, *wswa, *wmem, *wout, *mem, *memn; };
__device__ __forceinline__ void prologue(Frame& F, const ProIn& I) {
    const int gw = blockIdx.x * NWAVES + F.wave, NGW = F.G * NWAVES, lane = F.lane;
    for (int it = gw; it < DEPTH * CI_LAYER; it += NGW) {
        const int l = it / CI_LAYER; int r = it % CI_LAYER; unsigned char* wl = F.ws + WS_W + (size_t)l * W_LAYER;
        const float* src; bf16* dst; int K, N, pairNh = 0;
        if (r < CI_1IN) { src = I.f1wi + (size_t)l * DM * 2 * DFF; dst = (bf16*)(wl + WO_1IN); K = DM; N = 2 * DFF; pairNh = DFF; }
        else if ((r -= CI_1IN) < CI_1IN) { src = I.f2wi + (size_t)l * DM * 2 * DFF; dst = (bf16*)(wl + WO_2IN); K = DM; N = 2 * DFF; pairNh = DFF; }
        else if ((r -= CI_1IN) < CI_1OUT) { src = I.f1wo + (size_t)l * DFF * DM; dst = (bf16*)(wl + WO_1OUT); K = DFF; N = DM; }
        else if ((r -= CI_1OUT) < CI_1OUT) { src = I.f2wo + (size_t)l * DFF * DM; dst = (bf16*)(wl + WO_2OUT); K = DFF; N = DM; }
        else if ((r -= CI_1OUT) < CI_IN) { src = I.win + (size_t)l * DM * INW; dst = (bf16*)(wl + WO_IN); K = DM; N = INW; }
        else if ((r -= CI_IN) < CI_MKV) { src = I.wmkv + (size_t)l * DM * 2048; dst = (bf16*)(wl + WO_MKV); K = DM; N = 2048; }
        else if ((r -= CI_MKV) < CI_GLU) { src = I.wglu + (size_t)l * 1024 * 4096; dst = (bf16*)(wl + WO_GLU); K = 1024; N = 4096; pairNh = 2048; }
        else if ((r -= CI_GLU) < CI_SWA) { src = I.wswa + (size_t)l * 1024 * DM; dst = (bf16*)(wl + WO_SWA); K = 1024; N = DM; }
        else if ((r -= CI_SWA) < CI_MEM) { src = I.wmem + (size_t)l * 1024 * DM; dst = (bf16*)(wl + WO_MEM); K = 1024; N = DM; }
        else { r -= CI_MEM; src = I.wout + (size_t)l * DM * DM; dst = (bf16*)(wl + WO_OUT); K = DM; N = DM; }
        const int nblk = N / 64, kb = r / nblk, nb = r % nblk, n0 = nb * 64;
        float sc = 1.f; if (N == INW) sc = n0 < COL_K ? 0.125f * LOG2E : ((n0 >= COL_MQ && n0 < COL_G) ? 0.0625f * LOG2E : 1.f);
        conv_block(src, K, N, dst, kb, nb, pairNh, sc, lane);
    }
    for (int it = gw; it < DEPTH * 512; it += NGW) {
        const int l = it / 512, row = it % 512;
        const f32x4* xr = (const f32x4*)(I.mem + (size_t)row * DM) + lane; const f32x4* gr = (const f32x4*)(I.memn + (size_t)l * DM) + lane;
        f32x4 v[8]; float s = 0.f;
#pragma unroll
        for (int j = 0; j < 8; ++j) { v[j] = xr[64 * j]; s += (v[j].x * v[j].x + v[j].y * v[j].y) + (v[j].z * v[j].z + v[j].w * v[j].w); }
        const float rstd = 1.0f / sqrtf(wave_sum(s) * (1.f / DM) + RMS_EPS);
        v2u* o8 = (v2u*)(wsb(F, WS_MEMN) + ((size_t)l * 512 + row) * DM) + lane;
#pragma unroll
        for (int j = 0; j < 8; ++j) { const f32x4 g = gr[64 * j]; v2u o; o.x = cvt_pk_bf16(v[j].x * rstd * g.x, v[j].y * rstd * g.y); o.y = cvt_pk_bf16(v[j].z * rstd * g.z, v[j].w * rstd * g.w); o8[64 * j] = o; }
    }
}
template <bool OUTF32>
__device__ __forceinline__ void norm_phase(Frame& F, const float* hin, const float* gain, void* outp) {
    const int gw = blockIdx.x * NWAVES + F.wave, NGW = F.G * NWAVES, lane = F.lane;
    f32x4 g[8];
#pragma unroll
    for (int j = 0; j < 8; ++j) g[j] = ((const f32x4*)gain)[lane + 64 * j];
    for (int m = gw; m < T; m += NGW) {
        const f32x4* xr = (const f32x4*)(hin + (size_t)m * DM) + lane;
        f32x4 v[8]; float s = 0.f;
#pragma unroll
        for (int j = 0; j < 8; ++j) { v[j] = xr[64 * j]; s += (v[j].x * v[j].x + v[j].y * v[j].y) + (v[j].z * v[j].z + v[j].w * v[j].w); }
        const float rstd = 1.0f / sqrtf(wave_sum(s) * (1.f / DM) + RMS_EPS);
        if (OUTF32) { f32x4* o = (f32x4*)((float*)outp + (size_t)m * DM) + lane;
#pragma unroll
            for (int j = 0; j < 8; ++j) o[64 * j] = v[j] * rstd * g[j];
        } else { v2u* o8 = (v2u*)((bf16*)outp + (size_t)m * DM) + lane;
#pragma unroll
            for (int j = 0; j < 8; ++j) { v2u o; o.x = cvt_pk_bf16(v[j].x * rstd * g[j].x, v[j].y * rstd * g[j].y); o.y = cvt_pk_bf16(v[j].z * rstd * g[j].z, v[j].w * rstd * g[j].w); o8[64 * j] = o; } }
    }
}
__device__ __forceinline__ void unpack8(const v4u w, float* f) { f[0] = bf_lo(w.x); f[1] = bf_hi(w.x); f[2] = bf_lo(w.y); f[3] = bf_hi(w.y); f[4] = bf_lo(w.z); f[5] = bf_hi(w.z); f[6] = bf_lo(w.w); f[7] = bf_hi(w.w); }

__device__ __forceinline__ void swa_naive(Frame& F, const float* sinks) {
    const bf16* P = wsb(F, WS_PROJ); bf16* O = wsb(F, WS_OSWA);
    for (int idx = blockIdx.x * 512 + F.tid; idx < T * 16; idx += F.G * 512) {
        const int hq = idx / T, m = idx % T, b = m / SEQ, t = m % SEQ, g = hq >> 2;
        float q[64];
        { const v4u* qp = (const v4u*)(P + (size_t)m * INW + COL_Q + hq * 64);
#pragma unroll
          for (int j = 0; j < 8; ++j) unpack8(qp[j], q + 8 * j); }
        float mrun = sinks[hq] * LOG2E, lrun = 1.f, o[64];
#pragma unroll
        for (int j = 0; j < 64; ++j) o[j] = 0.f;
        const int k0 = t >= 127 ? t - 127 : 0;
        for (int kp = k0; kp <= t; ++kp) {
            const bf16* kr = P + (size_t)(b * SEQ + kp) * INW + COL_K + g * 64; const bf16* vr = kr + (COL_V - COL_K);
            float s0 = 0.f, s1 = 0.f;
#pragma unroll
            for (int j = 0; j < 8; ++j) { float kf[8]; unpack8(((const v4u*)kr)[j], kf);
#pragma unroll
                for (int e = 0; e < 8; e += 2) { s0 += q[8 * j + e] * kf[e]; s1 += q[8 * j + e + 1] * kf[e + 1]; } }
            const float s = s0 + s1, mnew = fmaxf(mrun, s), corr = __builtin_amdgcn_exp2f(mrun - mnew), p = __builtin_amdgcn_exp2f(s - mnew);
            lrun = lrun * corr + p; mrun = mnew;
#pragma unroll
            for (int j = 0; j < 8; ++j) { float vf[8]; unpack8(((const v4u*)vr)[j], vf);
#pragma unroll
                for (int e = 0; e < 8; ++e) o[8 * j + e] = o[8 * j + e] * corr + p * vf[e]; }
        }
        const float inv = 1.0f / lrun; v4u* op = (v4u*)(O + (size_t)m * 1024 + hq * 64);
#pragma unroll
        for (int j = 0; j < 8; ++j) { v4u w; w.x = cvt_pk_bf16(o[8 * j] * inv, o[8 * j + 1] * inv); w.y = cvt_pk_bf16(o[8 * j + 2] * inv, o[8 * j + 3] * inv);
            w.z = cvt_pk_bf16(o[8 * j + 4] * inv, o[8 * j + 5] * inv); w.w = cvt_pk_bf16(o[8 * j + 6] * inv, o[8 * j + 7] * inv); op[j] = w; }
    }
}
__device__ __forceinline__ void memattn_naive(Frame& F) {
    const bf16* P = wsb(F, WS_PROJ); const bf16* KV = wsb(F, WS_MKV); bf16* O = wsb(F, WS_OMEM);
    LAS float* qs = (LAS float*)F.lds;
    LAS float* ss = qs + 32 * 260;
    const int tid = F.tid, ti = tid >> 4, kg = tid & 15;
    for (int unit = blockIdx.x; unit < 1024; unit += F.G) {
        const int b = unit >> 9, hd = (unit >> 7) & 3, tb = unit & 127, m0 = b * SEQ + tb * 32;
        { const v4u* src = (const v4u*)(P + (size_t)(m0 + ti) * INW + COL_MQ + hd * 256 + kg * 16); float f[16]; unpack8(src[0], f); unpack8(src[1], f + 8);
#pragma unroll
          for (int e = 0; e < 16; ++e) qs[ti * 260 + kg * 16 + e] = f[e]; }
        __syncthreads();
        float sc[16];
#pragma unroll 1
        for (int i = 0; i < 16; ++i) { const int key = kg + 16 * i; const v4u* kr = (const v4u*)(KV + (size_t)(b * NMEM + key) * 2048 + hd * 256);
            float a0 = 0.f, a1 = 0.f;
#pragma unroll 8
            for (int d8 = 0; d8 < 32; ++d8) { float kf[8]; unpack8(kr[d8], kf); const LAS f32x4* qp = (const LAS f32x4*)(qs + ti * 260 + d8 * 8); const f32x4 qa = qp[0], qb = qp[1];
                a0 += qa.x * kf[0] + qa.y * kf[1] + qa.z * kf[2] + qa.w * kf[3]; a1 += qb.x * kf[4] + qb.y * kf[5] + qb.z * kf[6] + qb.w * kf[7]; }
            ss[ti * 257 + key] = a0 + a1; }
        __syncthreads();
        float mx = -3.0e38f;
#pragma unroll
        for (int i = 0; i < 16; ++i) { sc[i] = ss[ti * 257 + kg + 16 * i]; mx = fmaxf(mx, sc[i]); }
#pragma unroll
        for (int o = 1; o < 16; o <<= 1) mx = fmaxf(mx, __shfl_xor(mx, o));
        float sum = 0.f;
#pragma unroll
        for (int i = 0; i < 16; ++i) { sc[i] = __builtin_amdgcn_exp2f(sc[i] - mx); sum += sc[i]; }
#pragma unroll
        for (int o = 1; o < 16; o <<= 1) sum += __shfl_xor(sum, o);
        const float inv = 1.0f / sum;
#pragma unroll
        for (int i = 0; i < 16; ++i) ss[ti * 257 + kg + 16 * i] = sc[i] * inv;
        __syncthreads();
        float o[16];
#pragma unroll
        for (int e = 0; e < 16; ++e) o[e] = 0.f;
#pragma unroll 4
        for (int key = 0; key < NMEM; ++key) { const float p = ss[ti * 257 + key]; const v4u* vr = (const v4u*)(KV + (size_t)(b * NMEM + key) * 2048 + 1024 + hd * 256 + kg * 16);
            float vf[16]; unpack8(vr[0], vf); unpack8(vr[1], vf + 8);
#pragma unroll
            for (int e = 0; e < 16; ++e) o[e] += p * vf[e]; }
        v4u* op = (v4u*)(O + (size_t)(m0 + ti) * 1024 + hd * 256 + kg * 16);
        v4u w; w.x = cvt_pk_bf16(o[0], o[1]); w.y = cvt_pk_bf16(o[2], o[3]); w.z = cvt_pk_bf16(o[4], o[5]); w.w = cvt_pk_bf16(o[6], o[7]); op[0] = w;
        w.x = cvt_pk_bf16(o[8], o[9]); w.y = cvt_pk_bf16(o[10], o[11]); w.z = cvt_pk_bf16(o[12], o[13]); w.w = cvt_pk_bf16(o[14], o[15]); op[1] = w;
        __syncthreads();
    }
}
__device__ __forceinline__ void sincos_red(double x, float& s, float& c) {
    const double k = __builtin_rint(x * 0.63661977236758134308); const double r = (x - k * 1.57079632679489655800) - k * 6.123233995736766036e-17; const double r2 = r * r;
    double sp = -7.6471637318198164759e-13; sp = sp * r2 + 1.6059043836821614599e-10; sp = sp * r2 - 2.5052108385441718775e-8; sp = sp * r2 + 2.7557319223985890653e-6; sp = sp * r2 - 1.9841269841269841270e-4; sp = sp * r2 + 8.3333333333333333333e-3; sp = sp * r2 - 1.6666666666666666667e-1;
    const double sr = r + r * r2 * sp;
    double cp = -1.1470745597729724714e-11; cp = cp * r2 + 2.0876756987868098979e-9; cp = cp * r2 - 2.7557319223985890653e-7; cp = cp * r2 + 2.4801587301587301587e-5; cp = cp * r2 - 1.3888888888888888889e-3; cp = cp * r2 + 4.1666666666666666667e-2; cp = cp * r2 - 0.5;
    const double cr = 1.0 + r2 * cp;
    const int q = ((int)k) & 3;
    const double ss = (q & 1) ? cr : sr, cc = (q & 1) ? sr : cr;
    s = (float)((q & 2) ? -ss : ss); c = (float)(((q == 1) || (q == 2)) ? -cc : cc);
}
struct SsmState { float ar, ai, a64r, a64i; float bbr[16], bbi[16]; };
struct SsmIn { const float *lre, *lim, *ldt, *bre, *bim, *cre, *cim, *dsk; };
__device__ __forceinline__ void ssm_params(const SsmIn& I, int g, int p, SsmState& S) {
    const int gp = g * 64 + p;
    const float lr = fminf(I.lre[gp], -1e-4f), li = I.lim[gp], dt = expf(I.ldt[g]);
    const float mag = expf(lr * dt); float sn, cs; const double th = (double)li * (double)dt; sincos_red(th, sn, cs);
    S.ar = mag * cs; S.ai = mag * sn;
    const float mag64 = expf(lr * dt * 64.f); sincos_red(th * 64.0, sn, cs); S.a64r = mag64 * cs; S.a64i = mag64 * sn;
    const float nr = S.ar - 1.f, ni = S.ai, den = lr * lr + li * li, kr = (nr * lr + ni * li) / den, ki = (ni * lr - nr * li) / den;
    const float* br = I.bre + (size_t)gp * 16; const float* bi = I.bim + (size_t)gp * 16;
#pragma unroll
    for (int c = 0; c < 16; ++c) { S.bbr[c] = kr * br[c] - ki * bi[c]; S.bbi[c] = kr * bi[c] + ki * br[c]; }
}
__device__ __forceinline__ void ssm_step(const SsmState& S, const bf16* up, float& sr, float& si) {
    const v4u* u4 = (const v4u*)up; float uf[16]; unpack8(u4[0], uf); unpack8(u4[1], uf + 8);
    float xr = 0.f, xi = 0.f;
#pragma unroll
    for (int c = 0; c < 16; ++c) { xr += S.bbr[c] * uf[c]; xi += S.bbi[c] * uf[c]; }
    const float nr = S.ar * sr - S.ai * si + xr, ni = S.ar * si + S.ai * sr + xi; sr = nr; si = ni;
}
__device__ __forceinline__ void ssm_local(Frame& F, const SsmIn& I) {
    const bf16* P = wsb(F, WS_PROJ); f32x2* SE = (f32x2*)(F.ws + WS_SEND);
    const int gw = blockIdx.x * NWAVES + F.wave, NGW = F.G * NWAVES, p = F.lane;
    for (int u = gw; u < 2 * 64 * 64; u += NGW) {
        const int g = u & 63, ch = (u >> 6) & 63, b = u >> 12;
        SsmState S; ssm_params(I, g, p, S);
        float sr = 0.f, si = 0.f; const bf16* up = P + (size_t)(b * SEQ + ch * 64) * INW + COL_S + g * 16;
#pragma unroll 4
        for (int j = 0; j < 64; ++j) ssm_step(S, up + (size_t)j * INW, sr, si);
        SE[((size_t)(b * 64 + ch) * 64 + g) * 64 + p] = (f32x2){sr, si};
    }
}
__device__ __forceinline__ void ssm_replay(Frame& F, const SsmIn& I) {
    const bf16* P = wsb(F, WS_PROJ); const f32x2* SE = (const f32x2*)(F.ws + WS_SEND); bf16* Y = wsb(F, WS_YS);
    LAS f32x2* Cs = (LAS f32x2*)F.lds;
    LAS float* Ds = (LAS float*)(F.lds + 16 * 65 * 8);
    LAS f32x2* Sw = (LAS f32x2*)(F.lds + 16384) + F.wave * (16 * 65);
    const int p = F.lane, jj = F.lane >> 2, cq = F.lane & 3;
    for (int unit = blockIdx.x; unit < 1024; unit += F.G) {
        const int oct = unit & 7, g = (unit >> 3) & 63, b = unit >> 9, ch = oct * 8 + F.wave;
        for (int e = F.tid; e < 1024; e += 512) { const int c = e >> 6, pp = e & 63; const size_t gi = ((size_t)g * 16 + c) * 64 + pp; Cs[c * 65 + pp] = (f32x2){I.cre[gi], I.cim[gi]}; }
        if (F.tid < 16) Ds[F.tid] = I.dsk[g * 16 + F.tid];
        __syncthreads();
        SsmState S; ssm_params(I, g, p, S);
        float sr = 0.f, si = 0.f;
        for (int j = 0; j < ch; ++j) { const f32x2 e = SE[((size_t)(b * 64 + j) * 64 + g) * 64 + p]; const float nr = S.a64r * sr - S.a64i * si + e.x, ni = S.a64r * si + S.a64i * sr + e.y; sr = nr; si = ni; }
        const size_t tok0 = (size_t)b * SEQ + ch * 64;
#pragma unroll 1
        for (int sub = 0; sub < 4; ++sub) {
#pragma unroll 4
            for (int j = 0; j < 16; ++j) { ssm_step(S, P + (tok0 + sub * 16 + j) * INW + COL_S + g * 16, sr, si); Sw[j * 65 + p] = (f32x2){sr, si}; }
            asm volatile("s_waitcnt lgkmcnt(0)" ::: "memory");
            float acc[4] = {0.f, 0.f, 0.f, 0.f};
#pragma unroll 4
            for (int pp = 0; pp < 64; ++pp) { const f32x2 sv = Sw[jj * 65 + pp];
#pragma unroll
                for (int ci = 0; ci < 4; ++ci) { const f32x2 cv = Cs[(cq * 4 + ci) * 65 + pp]; acc[ci] += cv.x * sv.x - cv.y * sv.y; } }
            const size_t tok = tok0 + sub * 16 + jj; const v2u uw = *(const v2u*)(P + tok * INW + COL_S + g * 16 + cq * 4);
            const float u0 = bf_lo(uw.x), u1 = bf_hi(uw.x), u2 = bf_lo(uw.y), u3 = bf_hi(uw.y);
            v2u o; o.x = cvt_pk_bf16(acc[0] + Ds[cq * 4] * u0, acc[1] + Ds[cq * 4 + 1] * u1); o.y = cvt_pk_bf16(acc[2] + Ds[cq * 4 + 2] * u2, acc[3] + Ds[cq * 4 + 3] * u3);
            *(v2u*)(Y + tok * 1024 + g * 16 + cq * 4) = o;
            asm volatile("s_waitcnt lgkmcnt(0)" ::: "memory");
        }
        __syncthreads();
    }
}

typedef short bf16x8 __attribute__((ext_vector_type(8)));
typedef short s16x4 __attribute__((ext_vector_type(4)));
typedef float f32x16 __attribute__((ext_vector_type(16)));
__device__ __forceinline__ s16x4 lds_tr16(const LAS unsigned char* p) { return __builtin_bit_cast(s16x4, __builtin_amdgcn_ds_read_tr16_b64_v4i16((LAS s16x4*)p)); }
__device__ __forceinline__ bf16x8 cat8(s16x4 lo, s16x4 hi) { return (bf16x8){lo[0], lo[1], lo[2], lo[3], hi[0], hi[1], hi[2], hi[3]}; }
__device__ __forceinline__ bf16x8 pack8(float a0, float a1, float a2, float a3, float a4, float a5, float a6, float a7) {
    v4u w; w.x = cvt_pk_bf16(a0, a1); w.y = cvt_pk_bf16(a2, a3); w.z = cvt_pk_bf16(a4, a5); w.w = cvt_pk_bf16(a6, a7); return __builtin_bit_cast(bf16x8, w); }

__device__ __forceinline__ void swa_mfma(Frame& F, const float* sinks) {
    const bf16* P = wsb(F, WS_PROJ); bf16* O = wsb(F, WS_OSWA);
    LAS unsigned char* Kl = F.lds;
    LAS unsigned char* Vl = F.lds + 36864;
    const int tid = F.tid, lane = F.lane, w = F.wave, r = w >> 1, qh = w & 1, l31 = lane & 31, h = lane >> 5;
    for (int unit = blockIdx.x; unit < 256; unit += F.G) {
        const int n = unit & 31, g = (unit >> 5) & 3, b = unit >> 7;
#pragma unroll
        for (int i = 0; i < 4; ++i) { const int c = tid + 512 * i, key = c >> 3, part = c & 7, pos = (n - 1) * 128 + key;
            v4u kv = {0u, 0u, 0u, 0u}, vv = {0u, 0u, 0u, 0u};
            if (pos >= 0) { const bf16* src = P + (size_t)(b * SEQ + pos) * INW + COL_K + g * 64 + part * 8; kv = *(const v4u*)src; vv = *(const v4u*)(src + (COL_V - COL_K)); }
            *(LAS v4u*)(Kl + key * 144 + part * 16) = kv;
            *(LAS v4u*)(Vl + (part >> 2) * 16384 + key * 64 + (part & 3) * 16) = vv; }
        __syncthreads();
        const int hq = g * 4 + r; const float sink2 = sinks[hq] * LOG2E;
#pragma unroll 1
        for (int qt = 0; qt < 2; ++qt) {
            const int a = qh * 2 + qt, qi = a * 32 + l31; const size_t m = (size_t)b * SEQ + n * 128 + qi;
            bf16x8 qf[4];
#pragma unroll
            for (int ds = 0; ds < 4; ++ds) qf[ds] = *(const bf16x8*)(P + m * INW + COL_Q + hq * 64 + ds * 16 + h * 8);
            f32x16 s[5];
#pragma unroll
            for (int k5 = 0; k5 < 5; ++k5) { f32x16 acc;
#pragma unroll
                for (int e = 0; e < 16; ++e) acc[e] = 0.f;
#pragma unroll
                for (int ds = 0; ds < 4; ++ds) { const bf16x8 kf = *(const LAS bf16x8*)(Kl + (32 * (a + k5) + l31) * 144 + ds * 32 + h * 16); acc = __builtin_amdgcn_mfma_f32_32x32x16_bf16(kf, qf[ds], acc, 0, 0, 0); }
                s[k5] = acc; }
            float mx = sink2;
#pragma unroll
            for (int k5 = 0; k5 < 5; ++k5)
#pragma unroll
                for (int e = 0; e < 16; ++e) { const int kl = 32 * (a + k5) + (e & 3) + 8 * (e >> 2) + 4 * h; const bool ok = (kl > qi) && (kl <= qi + 128) && (n > 0 || kl >= 128);
                    const float v = ok ? s[k5][e] : -1.0e30f; s[k5][e] = v; mx = fmaxf(mx, v); }
            mx = fmaxf(mx, __shfl_xor(mx, 32));
            float sum = 0.f;
#pragma unroll
            for (int k5 = 0; k5 < 5; ++k5)
#pragma unroll
                for (int e = 0; e < 16; ++e) { const float p = __builtin_amdgcn_exp2f(s[k5][e] - mx); s[k5][e] = p; sum += p; }
            sum += __shfl_xor(sum, 32); sum += __builtin_amdgcn_exp2f(sink2 - mx);
            f32x16 o[2];
#pragma unroll
            for (int e = 0; e < 16; ++e) { o[0][e] = 0.f; o[1][e] = 0.f; }
#pragma unroll
            for (int k5 = 0; k5 < 5; ++k5)
#pragma unroll
                for (int s2 = 0; s2 < 2; ++s2) { const bf16x8 pf = pack8(s[k5][8 * s2], s[k5][8 * s2 + 1], s[k5][8 * s2 + 2], s[k5][8 * s2 + 3], s[k5][8 * s2 + 4], s[k5][8 * s2 + 5], s[k5][8 * s2 + 6], s[k5][8 * s2 + 7]);
                    const int base0 = 32 * (a + k5) + 16 * s2 + 4 * h;
#pragma unroll
                    for (int db = 0; db < 2; ++db) { const LAS unsigned char* vp = Vl + db * 16384 + (base0 + ((lane & 15) >> 2)) * 64 + (16 * ((lane >> 4) & 1) + 4 * (lane & 3)) * 2;
                        const bf16x8 vf = cat8(lds_tr16(vp), lds_tr16(vp + 8 * 64)); o[db] = __builtin_amdgcn_mfma_f32_32x32x16_bf16(vf, pf, o[db], 0, 0, 0); } }
            const float inv = 1.0f / sum;
#pragma unroll
            for (int db = 0; db < 2; ++db)
#pragma unroll
                for (int g4 = 0; g4 < 4; ++g4) { v2u wv; wv.x = cvt_pk_bf16(o[db][4 * g4] * inv, o[db][4 * g4 + 1] * inv); wv.y = cvt_pk_bf16(o[db][4 * g4 + 2] * inv, o[db][4 * g4 + 3] * inv);
                    *(v2u*)(O + m * 1024 + hq * 64 + db * 32 + 8 * g4 + 4 * h) = wv; }
        }
        __syncthreads();
    }
}
__device__ __forceinline__ void memattn_mfma(Frame& F) {
    const bf16* P = wsb(F, WS_PROJ); const bf16* KV = wsb(F, WS_MKV); bf16* O = wsb(F, WS_OMEM);
    constexpr int RS = 544, SLOT = 64 * RS;
    const int tid = F.tid, lane = F.lane, w = F.wave, l15 = lane & 15, kq = lane >> 4;
    for (int unit = blockIdx.x; unit < 256; unit += F.G) {
        const int tb = unit & 31, hd = (unit >> 5) & 3, b = unit >> 7; const size_t m = (size_t)b * SEQ + tb * 128 + w * 16 + l15;
        bf16x8 qf[8];
#pragma unroll
        for (int ds = 0; ds < 8; ++ds) qf[ds] = *(const bf16x8*)(P + m * INW + COL_MQ + hd * 256 + ds * 32 + kq * 8);
        v4u st[4];
#define MA_LOAD(t) do { _Pragma("unroll") for (int i_ = 0; i_ < 4; ++i_) { const int c_ = tid + 512 * i_, row_ = c_ >> 5, part_ = c_ & 31; \
            st[i_] = *(const v4u*)(KV + (size_t)(b * NMEM + 64 * ((t) & 3) + row_) * 2048 + ((t) >> 2) * 1024 + hd * 256 + part_ * 8); } } while (0)
#define MA_STORE(buf) do { _Pragma("unroll") for (int i_ = 0; i_ < 4; ++i_) { const int c_ = tid + 512 * i_, row_ = c_ >> 5, part_ = c_ & 31; *(LAS v4u*)((buf) + row_ * RS + part_ * 16) = st[i_]; } } while (0)
        MA_LOAD(0); MA_STORE(F.lds); __syncthreads();
        f32x4 s[16]; f32x4 o[16]; float inv = 0.f;
#pragma unroll
        for (int t = 0; t < 8; ++t) {
            if (t < 7) MA_LOAD(t + 1);
            const LAS unsigned char* cur = F.lds + (t & 1) * SLOT;
            if (t < 4) {
#pragma unroll
                for (int k4 = 0; k4 < 4; ++k4) { f32x4 acc = {0.f, 0.f, 0.f, 0.f};
#pragma unroll
                    for (int ds = 0; ds < 8; ++ds) { const bf16x8 kf = *(const LAS bf16x8*)(cur + (16 * k4 + l15) * RS + ds * 64 + kq * 16); acc = __builtin_amdgcn_mfma_f32_16x16x32_bf16(kf, qf[ds], acc, 0, 0, 0); }
                    s[4 * t + k4] = acc; }
                if (t == 3) {
                    float mx = -3.0e38f;
#pragma unroll
                    for (int i = 0; i < 16; ++i) mx = fmaxf(mx, fmaxf(fmaxf(s[i][0], s[i][1]), fmaxf(s[i][2], s[i][3])));
                    mx = fmaxf(mx, __shfl_xor(mx, 16)); mx = fmaxf(mx, __shfl_xor(mx, 32));
                    float sum = 0.f;
#pragma unroll
                    for (int i = 0; i < 16; ++i)
#pragma unroll
                        for (int e = 0; e < 4; ++e) { const float p = __builtin_amdgcn_exp2f(s[i][e] - mx); s[i][e] = p; sum += p; }
                    sum += __shfl_xor(sum, 16); sum += __shfl_xor(sum, 32); inv = 1.0f / sum;
#pragma unroll
                    for (int i = 0; i < 16; ++i) o[i] = (f32x4){0.f, 0.f, 0.f, 0.f};
                }
            } else {
                const int tv = t - 4;
#pragma unroll
                for (int s2 = 0; s2 < 2; ++s2) { const f32x4 p0 = s[4 * tv + 2 * s2], p1 = s[4 * tv + 2 * s2 + 1]; const bf16x8 pf = pack8(p0[0], p0[1], p0[2], p0[3], p1[0], p1[1], p1[2], p1[3]);
#pragma unroll
                    for (int db = 0; db < 16; ++db) { const LAS unsigned char* vp = cur + (32 * s2 + 4 * kq + (l15 >> 2)) * RS + (16 * db + 4 * (lane & 3)) * 2;
                        const bf16x8 vf = cat8(lds_tr16(vp), lds_tr16(vp + 16 * RS)); o[db] = __builtin_amdgcn_mfma_f32_16x16x32_bf16(vf, pf, o[db], 0, 0, 0); } }
            }
            if (t < 7) MA_STORE(F.lds + ((t + 1) & 1) * SLOT);
            __syncthreads();
        }
#undef MA_LOAD
#undef MA_STORE
#pragma unroll
        for (int db = 0; db < 16; ++db) { v2u wv; wv.x = cvt_pk_bf16(o[db][0] * inv, o[db][1] * inv); wv.y = cvt_pk_bf16(o[db][2] * inv, o[db][3] * inv); *(v2u*)(O + m * 1024 + hd * 256 + 16 * db + 4 * kq) = wv; }
    }
}

constexpr int PH_PRO = 0, PH_SB0 = 1, PH_PER_SB = 6, N_SB = 3 * DEPTH, PH_FINAL = PH_SB0 + N_SB * PH_PER_SB, N_PH = PH_FINAL + 1;
struct Args { const float* in[N_IN]; float* out; unsigned char* ws; int ph_lo, ph_hi; };
static_assert(sizeof(Args) == N_IN * 8 + 8 + 8 + 8, "Args has no padding");

typedef __attribute__((address_space(4))) const Args* KArgs;
__device__ __forceinline__ KArgs kargs() { KArgs p = (KArgs)__builtin_amdgcn_kernarg_segment_ptr(); asm volatile("" : "+s"(p)); return p; }
#define AIN(i) (kargs()->in[i])
__global__ void __launch_bounds__(NWAVES * 64, 2) fwd(Args args_unused) {
    extern __shared__ __attribute__((aligned(16))) unsigned char lds[];
    Frame F;
    F.lds = (LAS unsigned char*)lds;
    F.tid = threadIdx.x; F.lane = F.tid & 63; F.wave = __builtin_amdgcn_readfirstlane(F.tid >> 6); F.G = gridDim.x;
    F.ws = kargs()->ws;
    const int lo = kargs()->ph_lo, hi = kargs()->ph_hi;
    volatile LAS unsigned* MISC = (volatile LAS unsigned*)(F.lds + MISC_OFF);
    for (int u = F.tid; u < (LDS_BYTES - LDSCTL_OFF) / 4; u += NWAVES * 64) ((LAS unsigned*)(F.lds + LDSCTL_OFF))[u] = 0u;
    __syncthreads();
    unsigned* barw = (unsigned*)(F.ws + WS_CTL) + CW_BAR;
    XcdBarrier bar; bar.bar = barw; bar.x = 0; bar.st = nullptr;
    if (hi - lo > 1) bar = xcd_barrier_post(barw, MISC + 8);
#define IN(p) (lo <= (p) && (p) < hi)
#define FRESH() do { int t_ = threadIdx.x; asm volatile("" : "+v"(t_)); F.tid = t_; F.lane = t_ & 63; F.wave = __builtin_amdgcn_readfirstlane(t_ >> 6); unsigned char* w_ = kargs()->ws; F.ws = w_; } while (0)
#define SEAM(p, q) do { if (IN(p) && (q) < hi) xcd_barrier(bar); } while (0)

    if (IN(PH_PRO) && EN_PRO) { FRESH(); const ProIn I{AIN(I_F1WI), AIN(I_F2WI), AIN(I_F1WO), AIN(I_F2WO), AIN(I_WIN), AIN(I_WMKV), AIN(I_WGLU), AIN(I_WSWA), AIN(I_WMEMUP), AIN(I_WOUT), AIN(I_MEM), AIN(I_MEMN)}; prologue(F, I); }
    SEAM(PH_PRO, PH_SB0);

    for (int sb = 0; sb < N_SB; ++sb) {
        const int l = sb / 3, ty = sb % 3, pb = PH_SB0 + sb * PH_PER_SB;
        if (pb + PH_PER_SB <= lo || pb >= hi) continue;
#define HIN() ((sb == 0) ? AIN(I_X) : (const float*)(F.ws + WS_H))
#define WL() (F.ws + WS_W + (size_t)l * W_LAYER)
        if (IN(pb) && EN_NORM) { FRESH(); const float* gain = (ty == 0 ? AIN(I_F1N) : ty == 1 ? AIN(I_MIXN) : AIN(I_F2N)) + (size_t)l * DM; norm_phase<false>(F, HIN(), gain, F.ws + WS_XN); }
        SEAM(pb, pb + 1);
        if (ty != 1) {
            if (IN(pb + 1) && EN_G1) { FRESH();
                pg8::SchedTiles S{(const char*)(F.ws + WS_XN), (const char*)(WL() + (ty == 0 ? WO_1IN : WO_2IN)), (size_t)256 * DM * 2, T / 256, 2 * DFF / 256, F.G, (int)blockIdx.x};
                pg8::EpiSwiGLU E{wsb(F, WS_HID), DFF};
                pg8::gemm_phase<pg8::EpiSwiGLU, pg8::SchedTiles, true, true>(F.lds + RING_OFF, DM, S, E);
            }
            SEAM(pb + 1, pb + 5);
        } else {
            if (IN(pb + 1) && EN_G3) { FRESH();
                pg8::SchedProj S{(const char*)(F.ws + WS_XN), (const char*)(WL() + WO_IN), (const char*)(F.ws + WS_MEMN + (size_t)l * 512 * DM * 2), (const char*)(WL() + WO_MKV), (size_t)256 * DM * 2, T / 256, INW / 256, F.G, (int)blockIdx.x};
                pg8::EpiProj E{wsb(F, WS_PROJ), INW, COL_G / 256, wsb(F, WS_MKV), 2048};
                pg8::gemm_phase<pg8::EpiProj, pg8::SchedProj, true, true>(F.lds + RING_OFF, DM, S, E);
            }
            SEAM(pb + 1, pb + 2);
            if (IN(pb + 2) && EN_M1) for (int rep_ = 0; rep_ < REP_M; ++rep_) { FRESH(); swa_mfma(F, AIN(I_SINK) + l * 16); memattn_mfma(F);
                const SsmIn I{AIN(I_LRE) + l * 4096, AIN(I_LIM) + l * 4096, AIN(I_LDT) + l * 64, AIN(I_BRE) + l * 65536, AIN(I_BIM) + l * 65536, AIN(I_CRE) + l * 65536, AIN(I_CIM) + l * 65536, AIN(I_DSK) + l * 1024}; ssm_local(F, I); }
            SEAM(pb + 2, pb + 3);
            if (IN(pb + 3) && EN_M2) for (int rep_ = 0; rep_ < REP_M; ++rep_) { FRESH(); const SsmIn I{AIN(I_LRE) + l * 4096, AIN(I_LIM) + l * 4096, AIN(I_LDT) + l * 64, AIN(I_BRE) + l * 65536, AIN(I_BIM) + l * 65536, AIN(I_CRE) + l * 65536, AIN(I_CIM) + l * 65536, AIN(I_DSK) + l * 1024}; ssm_replay(F, I); }
            SEAM(pb + 3, pb + 4);
            if (IN(pb + 4) && EN_G4) { FRESH();
                pg8::SchedMix S{(const char*)(F.ws + WS_OSWA), (const char*)(F.ws + WS_OMEM), (const char*)(F.ws + WS_YS), (const char*)(WL() + WO_SWA), (const char*)(WL() + WO_MEM), (const char*)(WL() + WO_GLU), (size_t)256 * 1024 * 2, T / 256, DM / 256, F.G, (int)blockIdx.x};
                pg8::EpiMix E{(float*)(F.ws + WS_T32), wsb(F, WS_MG), wsb(F, WS_PROJ) + COL_G, INW};
                pg8::gemm_phase<pg8::EpiMix, pg8::SchedMix, true, true>(F.lds + RING_OFF, 1024, S, E);
            }
            SEAM(pb + 4, pb + 5);
        }
        if (IN(pb + 5) && EN_GR) { FRESH();
            const int K = (ty == 1) ? DM : DFF;
            pg8::SchedTiles S{(const char*)(F.ws + (ty == 1 ? WS_MG : WS_HID)), (const char*)(WL() + (ty == 0 ? WO_1OUT : ty == 1 ? WO_OUT : WO_2OUT)), (size_t)256 * K * 2, T / 256, DM / 256, F.G, (int)blockIdx.x};
            pg8::EpiResid E{HIN(), (float*)(F.ws + WS_H), ty == 1 ? 1.0f : 0.5f, DM};
            pg8::gemm_phase<pg8::EpiResid, pg8::SchedTiles, true, true>(F.lds + RING_OFF, K, S, E);
        }
        SEAM(pb + 5, pb + 6);
    }
    if (IN(PH_FINAL)) { FRESH(); norm_phase<true>(F, (const float*)(F.ws + WS_H), AIN(I_FINN), kargs()->out); }
#undef IN
#undef SEAM
}

static bool phase_valid(int p) {
    if (p == PH_PRO || p == PH_FINAL) return true;
    const int sb = (p - PH_SB0) / PH_PER_SB, k = (p - PH_SB0) % PH_PER_SB;
    return (sb % 3 == 1) || k == 0 || k == 1 || k == 5;
}
extern "C" void kernel_launch(void* const* d_in, const int* in_sizes, int n_in, void* d_out, int out_size, void* d_ws, size_t ws_size, hipStream_t stream) {
    static int grid = 0;
    if (grid == 0) {
        if (n_in != N_IN || in_sizes[0] != T * DM || out_size != T * DM || ws_size < WS_END) { fprintf(stderr, "kernel_launch: unexpected shapes: n_in %d in0 %d out %d ws %zu (need %zu); nothing launched\n", n_in, n_in > 0 ? in_sizes[0] : -1, out_size, ws_size, (size_t)WS_END); grid = -1; return; }
        int dev = 0, cus = 0, per_cu = 0;
        if (hipGetDevice(&dev) != hipSuccess || hipDeviceGetAttribute(&cus, hipDeviceAttributeMultiprocessorCount, dev) != hipSuccess) { fprintf(stderr, "kernel_launch: device query failed\n"); grid = -1; return; }
        if (hipFuncSetAttribute((const void*)fwd, hipFuncAttributeMaxDynamicSharedMemorySize, LDS_BYTES) != hipSuccess) { fprintf(stderr, "kernel_launch: hipFuncSetAttribute failed\n"); grid = -1; return; }
        if (hipOccupancyMaxActiveBlocksPerMultiprocessor(&per_cu, (const void*)fwd, NWAVES * 64, LDS_BYTES) != hipSuccess || per_cu < 1) fprintf(stderr, "kernel_launch: note: occupancy query reports %d workgroups per CU\n", per_cu);
        (void)hipGetLastError();
        grid = cus;
    }
    if (grid < 0) return;
    if (hipMemsetAsync((char*)d_ws + WS_CTL, 0, CTL_ZERO_BYTES, stream) != hipSuccess) { fprintf(stderr, "kernel_launch: memset failed\n"); return; }
    Args a{};
    for (int i = 0; i < N_IN; ++i) a.in[i] = (const float*)d_in[i];
    a.out = (float*)d_out; a.ws = (unsigned char*)d_ws;
#if ONE_LAUNCH
    a.ph_lo = 0; a.ph_hi = N_PH;
    hipLaunchKernelGGL(fwd, dim3(grid), dim3(NWAVES * 64), LDS_BYTES, stream, a);
#else
    for (int p = 0; p < N_PH; ++p) { if (!phase_valid(p)) continue; a.ph_lo = p; a.ph_hi = p + 1; hipLaunchKernelGGL(fwd, dim3(grid), dim3(NWAVES * 64), LDS_BYTES, stream, a); }
#endif
    const hipError_t le = hipPeekAtLastError();
    if (le != hipSuccess) fprintf(stderr, "kernel_launch: launch failed: %s\n", hipGetErrorName(le));
}
```

```cpp
#include <hip/hip_runtime.h>
#include <cstdio>
#include <cstdint>

#ifndef EN_PRO
#define EN_PRO 1
#endif
#ifndef EN_NORM
#define EN_NORM 1
#endif
#ifndef EN_G1
#define EN_G1 1
#endif
#ifndef EN_G3
#define EN_G3 1
#endif
#ifndef EN_M1
#define EN_M1 1
#endif
#ifndef EN_M2
#define EN_M2 1
#endif
#ifndef EN_G4
#define EN_G4 1
#endif
#ifndef EN_GR
#define EN_GR 1
#endif
#ifndef REP_M
#define REP_M 1
#endif
#ifndef ONE_LAUNCH
#define ONE_LAUNCH 1
#endif

namespace pg8 {
#define PG8_LAS __attribute__((address_space(3)))
typedef unsigned short bf16_t;
typedef short bf16x8 __attribute__((ext_vector_type(8)));
typedef float f32x4 __attribute__((ext_vector_type(4)));
typedef unsigned u32x4 __attribute__((ext_vector_type(4)));
constexpr int BM = 256, BK = 64, HALF = 128, HTB = HALF * BK * 2  , STAGE_BYTES = 8 * HTB, NXCD = 8, WGM = 8;

__host__ __device__ __forceinline__ int lds_byte(int r, int c) { const int st = (r >> 4) * 2 + (c >> 5), rr = r & 15, cc = c & 31, ob = rr * 64 + cc * 2; return st * 1024 + (ob ^ (((ob >> 9) & 1) << 5)); }
__host__ __device__ __forceinline__ void stage_rc(int b, int& R, int& C) { const int st = b / 1024, sb = b % 1024, swz = sb ^ (((sb >> 9) & 1) << 5); R = (st >> 1) * 16 + swz / 64; C = (st & 1) * 32 + (swz % 64) / 2; }
__host__ __device__ __forceinline__ int perm32(int rho) { const int n = rho >> 4, i = rho & 15; return 8 * (i >> 2) + 4 * n + (i & 3); }


struct Unit { int pm, pn, kind; };

__device__ __forceinline__ unsigned cvt_pk_bf16(float lo, float hi) { unsigned r; asm volatile("v_cvt_pk_bf16_f32 %0, %1, %2" : "=v"(r) : "v"(lo), "v"(hi)); return r; }
__device__ __forceinline__ float bf_lo(unsigned u) { return __uint_as_float(u << 16); }
__device__ __forceinline__ float bf_hi(unsigned u) { return __uint_as_float(u & 0xffff0000u); }
__device__ __forceinline__ float sigmoidf_fast(float x) { return __builtin_amdgcn_rcpf(1.0f + __builtin_amdgcn_exp2f(-1.4426950408889634f * x)); }

__device__ __forceinline__ void tile_of(int L, int nM, int nN, int& pm, int& pn) {
    const int nwg = nM * nN; int wgid = L; { const int q = nwg / NXCD, r = nwg % NXCD, xcd = wgid % NXCD, off = wgid / NXCD; wgid = (xcd < r ? xcd * (q + 1) : r * (q + 1) + (xcd - r) * q) + off; }
    const int nig = WGM * nN, gid = wgid / nig, fm = gid * WGM, gsz = (nM - fm) < WGM ? (nM - fm) : WGM;
    pm = fm + ((wgid % nig) % gsz); pn = (wgid % nig) / gsz;
}

struct SchedTiles {
    const char* A; const char* Bt; size_t tstep; int nM, nN, G, c;
    __device__ __forceinline__ bool next(int i, Unit& u) const { const int L = i * G + c; if (L >= nM * nN) return false; tile_of(L, nM, nN, u.pm, u.pn); u.kind = 0; return true; }
    __device__ __forceinline__ void operands(const Unit& u, const char*& a, const char*& b) const { a = A + (size_t)u.pm * tstep; b = Bt + (size_t)u.pn * tstep; }
    __device__ __forceinline__ void a_ready(const Unit&) const {}
    __device__ __forceinline__ void done(const Unit&) const {}
};
struct SchedProj {
    const char* A; const char* Bt; const char* A2; const char* Bt2; size_t tstep; int nM, nN, G, c;
    __device__ __forceinline__ bool next(int i, Unit& u) const { const int L = i * G + c, nwg = nM * nN; if (L < nwg) { tile_of(L, nM, nN, u.pm, u.pn); u.kind = 0; return true; }
        if (L < nwg + 16) { const int j = L - nwg; u.pm = j & 1; u.pn = j >> 1; u.kind = 1; return true; } return false; }
    __device__ __forceinline__ void operands(const Unit& u, const char*& a, const char*& b) const { a = (u.kind ? A2 : A) + (size_t)u.pm * tstep; b = (u.kind ? Bt2 : Bt) + (size_t)u.pn * tstep; }
    __device__ __forceinline__ void a_ready(const Unit&) const {}
    __device__ __forceinline__ void done(const Unit&) const {}
};
struct SchedMix {
    const char* Aswa; const char* Amem; const char* Ays; const char* Bswa; const char* Bmem; const char* Bglu; size_t tstep; int nM, nN, G, c;
    __device__ __forceinline__ bool next(int i, Unit& u) const { const int L = (i >> 2) * G + c; if (L >= nM * nN) return false; tile_of(L, nM, nN, u.pm, u.pn); u.kind = i & 3; return true; }
    __device__ __forceinline__ void operands(const Unit& u, const char*& a, const char*& b) const {
        if (u.kind == 0) { a = Aswa + (size_t)u.pm * tstep; b = Bswa + (size_t)u.pn * tstep; }
        else if (u.kind == 1) { a = Amem + (size_t)u.pm * tstep; b = Bmem + (size_t)u.pn * tstep; }
        else { a = Ays + (size_t)u.pm * tstep; b = Bglu + (size_t)(2 * u.pn + (u.kind - 2)) * tstep; } }
    __device__ __forceinline__ void a_ready(const Unit&) const {}
    __device__ __forceinline__ void done(const Unit&) const {}
};

struct EpiSwiGLU {
    static constexpr bool PERM = true, AFTER_DRAIN = false;
    bf16_t* O; int ldo;
    __device__ __forceinline__ void operator()(const f32x4 (&acc)[2][2][4][2], const Unit& u, int wr, int wc, int fr, int fq) const {
        const int row0 = u.pm * BM + wr * 64 + fr, col0 = u.pn * HALF + wc * 32 + 8 * fq;
#pragma unroll
        for (int ai = 0; ai < 2; ++ai)
#pragma unroll
            for (int m = 0; m < 4; ++m) { bf16_t* rowp = O + (size_t)(row0 + ai * HALF + m * 16) * ldo + col0; float o[8];
#pragma unroll
                for (int n = 0; n < 2; ++n)
#pragma unroll
                    for (int e = 0; e < 4; ++e) { const float g = acc[ai][0][m][n][e], uu = acc[ai][1][m][n][e]; o[4 * n + e] = g * sigmoidf_fast(g) * uu; }
                u32x4 w; w.x = cvt_pk_bf16(o[0], o[1]); w.y = cvt_pk_bf16(o[2], o[3]); w.z = cvt_pk_bf16(o[4], o[5]); w.w = cvt_pk_bf16(o[6], o[7]);
                *(u32x4*)rowp = w; }
    }
};
struct EpiResid {
    static constexpr bool PERM = false, AFTER_DRAIN = false;
    const float* Hin; float* Hout; float alpha; int ldc;
    __device__ __forceinline__ void operator()(const f32x4 (&acc)[2][2][4][2], const Unit& u, int wr, int wc, int fr, int fq) const {
        const int row0 = u.pm * BM + wr * 64 + fr, col0 = u.pn * BM + wc * 32 + 4 * fq;
#pragma unroll
        for (int ai = 0; ai < 2; ++ai)
#pragma unroll
            for (int m = 0; m < 4; ++m) { const size_t off = (size_t)(row0 + ai * HALF + m * 16) * ldc + col0;
#pragma unroll
                for (int bj = 0; bj < 2; ++bj)
#pragma unroll
                    for (int n = 0; n < 2; ++n) { const f32x4 b = *(const f32x4*)(Hin + off + bj * HALF + n * 16); *(f32x4*)(Hout + off + bj * HALF + n * 16) = b + acc[ai][bj][m][n] * alpha; } }
    }
};
struct EpiProj {
    static constexpr bool PERM = true, AFTER_DRAIN = false;
    bf16_t* P; int ldp; int sig_from; bf16_t* KV; int ldk;
    __device__ __forceinline__ void operator()(const f32x4 (&acc)[2][2][4][2], const Unit& u, int wr, int wc, int fr, int fq) const {
        const int row0 = u.pm * BM + wr * 64 + fr, col0 = u.pn * BM + wc * 32 + 8 * fq;
        bf16_t* base = u.kind ? KV : P; const int ld = u.kind ? ldk : ldp; const bool sig = (u.kind == 0) && (u.pn >= sig_from);
#pragma unroll
        for (int ai = 0; ai < 2; ++ai)
#pragma unroll
            for (int m = 0; m < 4; ++m) { bf16_t* rowp = base + (size_t)(row0 + ai * HALF + m * 16) * ld + col0;
#pragma unroll
                for (int bj = 0; bj < 2; ++bj) { f32x4 v0 = acc[ai][bj][m][0], v1 = acc[ai][bj][m][1];
                    if (sig) {
#pragma unroll
                        for (int e = 0; e < 4; ++e) { v0[e] = sigmoidf_fast(v0[e]); v1[e] = sigmoidf_fast(v1[e]); } }
                    u32x4 w; w.x = cvt_pk_bf16(v0[0], v0[1]); w.y = cvt_pk_bf16(v0[2], v0[3]); w.z = cvt_pk_bf16(v1[0], v1[1]); w.w = cvt_pk_bf16(v1[2], v1[3]);
                    *(u32x4*)(rowp + bj * HALF) = w; } }
    }
};
struct EpiMix {
    static constexpr bool PERM = true, AFTER_DRAIN = false;
    float* T32; bf16_t* MG; const bf16_t* Gt; int ldg;
    __device__ __forceinline__ void operator()(const f32x4 (&acc)[2][2][4][2], const Unit& u, int wr, int wc, int fr, int fq) const {
        const int row0 = u.pm * BM + wr * 64 + fr, cw = wc * 32 + 8 * fq;
        if (u.kind < 2) {
            const int gsel = u.kind == 0 ? 0 : 4096;
#pragma unroll
            for (int ai = 0; ai < 2; ++ai)
#pragma unroll
                for (int m = 0; m < 4; ++m) { const size_t row = (size_t)(row0 + ai * HALF + m * 16);
#pragma unroll
                    for (int bj = 0; bj < 2; ++bj) { const int col = u.pn * BM + bj * HALF + cw;
                        const u32x4 gw = *(const u32x4*)(Gt + row * ldg + gsel + col);
                        f32x4 g0 = {bf_lo(gw.x), bf_hi(gw.x), bf_lo(gw.y), bf_hi(gw.y)}, g1 = {bf_lo(gw.z), bf_hi(gw.z), bf_lo(gw.w), bf_hi(gw.w)};
                        f32x4 t0 = acc[ai][bj][m][0] * g0, t1 = acc[ai][bj][m][1] * g1; float* tp = T32 + row * 2048 + col;
                        if (u.kind == 1) { t0 += *(const f32x4*)tp; t1 += *(const f32x4*)(tp + 4); }
                        *(f32x4*)tp = t0; *(f32x4*)(tp + 4) = t1; } }
        } else {
            const int col = u.pn * BM + (u.kind - 2) * HALF + cw;
#pragma unroll
            for (int ai = 0; ai < 2; ++ai)
#pragma unroll
                for (int m = 0; m < 4; ++m) { const size_t row = (size_t)(row0 + ai * HALF + m * 16);
                    const u32x4 gw = *(const u32x4*)(Gt + row * ldg + 2048 + col);
                    const float gg[8] = {bf_lo(gw.x), bf_hi(gw.x), bf_lo(gw.y), bf_hi(gw.y), bf_lo(gw.z), bf_hi(gw.z), bf_lo(gw.w), bf_hi(gw.w)};
                    const float* tp = T32 + row * 2048 + col; const f32x4 t0 = *(const f32x4*)tp, t1 = *(const f32x4*)(tp + 4); float o[8];
#pragma unroll
                    for (int n = 0; n < 2; ++n)
#pragma unroll
                        for (int e = 0; e < 4; ++e) { const float ga = acc[ai][0][m][n][e], gb = acc[ai][1][m][n][e]; o[4 * n + e] = (n ? t1[e] : t0[e]) + gg[4 * n + e] * ga * sigmoidf_fast(gb); }
                    u32x4 w; w.x = cvt_pk_bf16(o[0], o[1]); w.y = cvt_pk_bf16(o[2], o[3]); w.z = cvt_pk_bf16(o[4], o[5]); w.w = cvt_pk_bf16(o[6], o[7]);
                    *(u32x4*)(MG + row * 2048 + col) = w; }
        }
    }
};

template <class Epi, class Sched, bool ALIGN_EPI = false, bool SP2 = false>
__device__ __forceinline__ void gemm_phase(PG8_LAS unsigned char* lds, const int K, const Sched& S, const Epi& E) {
    int tid_ = threadIdx.x; asm volatile("" : "+v"(tid_));
    const int tid = tid_, wid = __builtin_amdgcn_readfirstlane(tid >> 6), lane = tid & 63, wr = wid >> 2, wc = wid & 3, fr = lane & 15, fq = lane >> 4;
    const int nt = K / BK;
    unsigned voffA[2], voffB[2];
#pragma unroll
    for (int i = 0; i < 2; ++i) { int R, C; stage_rc(tid * 16 + i * 8192, R, C); const int Rb = Epi::PERM ? ((R & ~31) + perm32(R & 31)) : R;
        voffA[i] = (unsigned)(R * K + C) * 2u; voffB[i] = (unsigned)(Rb * K + C) * 2u; }
    const size_t kstep = (size_t)(BK * 2);
    const size_t hstep = (size_t)HALF * K * 2;
    const unsigned ldsw = (unsigned)wid * 1024u;
    const int aoff = lds_byte(wr * 64 + fr, fq * 8), boff = lds_byte(wc * 32 + fr, fq * 8);
#define PG8_SA(b, h) (((b) * 2 + (h)) * HTB)
#define PG8_SB(b, h) ((4 + (b) * 2 + (h)) * HTB)
#define PG8_STAGE(bufoff, gbase, voff) do { _Pragma("unroll") for (int _i = 0; _i < 2; ++_i) \
        __builtin_amdgcn_global_load_lds((const unsigned*)((const char*)(gbase) + (voff)[_i]), (PG8_LAS unsigned*)(lds + (bufoff) + ldsw + _i * 8192), 16, 0, 0); } while (0)
#define PG8_LDA(dst, b, h) do { _Pragma("unroll") for (int m = 0; m < 4; ++m) _Pragma("unroll") for (int k = 0; k < 2; ++k) dst[m][k] = *(const PG8_LAS bf16x8*)(lds + PG8_SA(b, h) + aoff + m * 2048 + k * 1024); } while (0)
#define PG8_LDB(dst, b, h) do { _Pragma("unroll") for (int n = 0; n < 2; ++n) _Pragma("unroll") for (int k = 0; k < 2; ++k) dst[n][k] = *(const PG8_LAS bf16x8*)(lds + PG8_SB(b, h) + boff + n * 2048 + k * 1024); } while (0)
#define PG8_MMA(ai, bj, At, Bt) do { __builtin_amdgcn_s_setprio(1); _Pragma("unroll") for (int m = 0; m < 4; ++m) _Pragma("unroll") for (int n = 0; n < 2; ++n) _Pragma("unroll") for (int k = 0; k < 2; ++k) \
        acc[ai][bj][m][n] = __builtin_amdgcn_mfma_f32_16x16x32_bf16(Bt[n][k], At[m][k], acc[ai][bj][m][n], 0, 0, 0); __builtin_amdgcn_s_setprio(0); } while (0)
#define PG8_WAIT_V(n) asm volatile("s_waitcnt vmcnt(" #n ")" ::: "memory")
#define PG8_WAIT_L(n) asm volatile("s_waitcnt lgkmcnt(" #n ")" ::: "memory")
#define PG8_BAR __builtin_amdgcn_s_barrier()
#define PG8_SCHED __builtin_amdgcn_sched_barrier(0)
    Unit cur, nxt; int ui = 0;
    if (!S.next(0, cur)) return;
    f32x4 acc[2][2][4][2];
#pragma unroll
    for (int a = 0; a < 2; ++a)
#pragma unroll
        for (int b = 0; b < 2; ++b)
#pragma unroll
            for (int m = 0; m < 4; ++m)
#pragma unroll
                for (int n = 0; n < 2; ++n) acc[a][b][m][n] = (f32x4){0.f, 0.f, 0.f, 0.f};
    bf16x8 At[4][2], B0[2][2], B1[2][2];
    const char* cA; const char* cB; S.operands(cur, cA, cB);
    S.a_ready(cur);
    if constexpr (SP2) {
        PG8_STAGE(PG8_SB(0, 0), cB, voffB); PG8_STAGE(PG8_SB(0, 1), cB + hstep, voffB); PG8_STAGE(PG8_SA(0, 0), cA, voffA); PG8_STAGE(PG8_SA(0, 1), cA + hstep, voffA);
        if (wr == 1) PG8_BAR;
        PG8_WAIT_V(2); PG8_BAR;
        PG8_STAGE(PG8_SB(1, 0), cB + kstep, voffB); PG8_STAGE(PG8_SA(1, 0), cA + kstep, voffA); PG8_STAGE(PG8_SB(1, 1), cB + hstep + kstep, voffB);
        PG8_WAIT_V(6); PG8_BAR;
    } else {
        PG8_STAGE(PG8_SB(0, 0), cB, voffB); PG8_STAGE(PG8_SA(0, 0), cA, voffA); PG8_STAGE(PG8_SB(0, 1), cB + hstep, voffB); PG8_STAGE(PG8_SA(0, 1), cA + hstep, voffA);
        if (wr == 1) PG8_BAR;
        PG8_WAIT_V(4); PG8_BAR;
        PG8_STAGE(PG8_SB(1, 0), cB + kstep, voffB); PG8_STAGE(PG8_SA(1, 0), cA + kstep, voffA); PG8_STAGE(PG8_SB(1, 1), cB + hstep + kstep, voffB);
        PG8_WAIT_V(6); PG8_BAR;
    }
    for (;;) {
        const bool has_next = S.next(ui + 1, nxt);
        const char* nA = cA; const char* nB = cB; if (has_next) S.operands(nxt, nA, nB);
        for (int t = 0; t < nt; t += 2) {
            const bool last = (t == nt - 2);
            const char* a1 = cA + (size_t)(t + 1) * kstep;
            const char* a2 = last ? nA : cA + (size_t)(t + 2) * kstep; const char* b2 = last ? nB : cB + (size_t)(t + 2) * kstep;
            const char* a3 = a2 + kstep; const char* b3 = b2 + kstep;
            if (last && has_next) S.a_ready(nxt);
            if constexpr (SP2) {
            PG8_LDB(B0, 0, 0); PG8_LDB(B1, 0, 1); PG8_SCHED; PG8_LDA(At, 0, 0); PG8_STAGE(PG8_SA(1, 1), a1 + hstep, voffA);
            PG8_WAIT_V(8); PG8_WAIT_L(0); PG8_BAR; PG8_MMA(0, 0, At, B0); PG8_MMA(0, 1, At, B1); PG8_BAR; PG8_SCHED;
            PG8_LDA(At, 0, 1); PG8_STAGE(PG8_SB(0, 0), b2, voffB); PG8_STAGE(PG8_SB(0, 1), b2 + hstep, voffB); PG8_STAGE(PG8_SA(0, 0), a2, voffA);
            PG8_WAIT_V(8); PG8_WAIT_L(0); PG8_BAR; PG8_MMA(1, 0, At, B0); PG8_MMA(1, 1, At, B1); PG8_BAR; PG8_SCHED;
            PG8_LDB(B0, 1, 0); PG8_LDB(B1, 1, 1); PG8_SCHED; PG8_LDA(At, 1, 0); PG8_STAGE(PG8_SA(0, 1), a2 + hstep, voffA);
            PG8_WAIT_V(8); PG8_WAIT_L(0); PG8_BAR; PG8_MMA(0, 0, At, B0); PG8_MMA(0, 1, At, B1); PG8_BAR; PG8_SCHED;
            PG8_LDA(At, 1, 1); PG8_STAGE(PG8_SB(1, 0), b3, voffB); PG8_STAGE(PG8_SB(1, 1), b3 + hstep, voffB); PG8_STAGE(PG8_SA(1, 0), a3, voffA);
            PG8_WAIT_V(8); PG8_WAIT_L(0); PG8_BAR; PG8_MMA(1, 0, At, B0); PG8_MMA(1, 1, At, B1); PG8_BAR; PG8_SCHED;
            } else {
            PG8_LDB(B0, 0, 0); PG8_SCHED; PG8_LDA(At, 0, 0); PG8_STAGE(PG8_SA(1, 1), a1 + hstep, voffA);
            PG8_WAIT_L(8); PG8_BAR; PG8_WAIT_L(0); PG8_MMA(0, 0, At, B0); PG8_BAR; PG8_SCHED;
            PG8_LDB(B1, 0, 1); PG8_STAGE(PG8_SB(0, 0), b2, voffB);
            PG8_BAR; PG8_WAIT_L(0); PG8_MMA(0, 1, At, B1); PG8_BAR;
            PG8_LDA(At, 0, 1); PG8_STAGE(PG8_SA(0, 0), a2, voffA);
            PG8_BAR; PG8_WAIT_L(0); PG8_MMA(1, 0, At, B0); PG8_BAR; PG8_SCHED;
            PG8_STAGE(PG8_SB(0, 1), b2 + hstep, voffB);
            PG8_WAIT_V(6); PG8_BAR; PG8_MMA(1, 1, At, B1); PG8_BAR;
            PG8_LDB(B0, 1, 0); PG8_SCHED; PG8_LDA(At, 1, 0); PG8_STAGE(PG8_SA(0, 1), a2 + hstep, voffA);
            PG8_WAIT_L(8); PG8_BAR; PG8_WAIT_L(0); PG8_MMA(0, 0, At, B0); PG8_BAR; PG8_SCHED;
            PG8_LDB(B1, 1, 1); PG8_STAGE(PG8_SB(1, 0), b3, voffB);
            PG8_BAR; PG8_WAIT_L(0); PG8_MMA(0, 1, At, B1); PG8_BAR;
            PG8_LDA(At, 1, 1); PG8_STAGE(PG8_SA(1, 0), a3, voffA);
            PG8_BAR; PG8_WAIT_L(0); PG8_MMA(1, 0, At, B0); PG8_BAR; PG8_SCHED;
            PG8_STAGE(PG8_SB(1, 1), b3 + hstep, voffB);
            PG8_WAIT_V(6); PG8_BAR; PG8_MMA(1, 1, At, B1); PG8_BAR;
            }
        }
        if constexpr (ALIGN_EPI) { if (wr == 0) PG8_BAR; }
        if constexpr (!Epi::AFTER_DRAIN) { E(acc, cur, wr, wc, fr, fq); S.done(cur); }
        if (!has_next) break;
#pragma unroll
        for (int a = 0; a < 2; ++a)
#pragma unroll
            for (int b = 0; b < 2; ++b)
#pragma unroll
                for (int m = 0; m < 4; ++m)
#pragma unroll
                    for (int n = 0; n < 2; ++n) acc[a][b][m][n] = (f32x4){0.f, 0.f, 0.f, 0.f};
        cur = nxt; cA = nA; cB = nB; ++ui;
        if constexpr (ALIGN_EPI) { if (wr == 1) PG8_BAR; }
    }
    PG8_WAIT_V(0);
    if constexpr (!ALIGN_EPI) { if (wr == 0) PG8_BAR; }
    PG8_BAR;
    if constexpr (Epi::AFTER_DRAIN) { E.fused(acc, cur, wr, wc, fr, fq, lds, wid, lane); S.done(cur); }
#undef PG8_SA
#undef PG8_SB
#undef PG8_STAGE
#undef PG8_LDA
#undef PG8_LDB
#undef PG8_MMA
#undef PG8_WAIT_V
#undef PG8_WAIT_L
#undef PG8_BAR
#undef PG8_SCHED
}
}

constexpr int BATCH = 2, SEQ = 4096, DM = 2048, DEPTH = 4, NMEM = 256, DFF = 5632;
constexpr int T = BATCH * SEQ;
constexpr int INW = 9728, COL_Q = 0, COL_K = 1024, COL_V = 1280, COL_S = 1536, COL_MQ = 2560, COL_G = 3584;
constexpr float RMS_EPS = 1e-5f, LOG2E = 1.4426950408889634f;
constexpr int NWAVES = 8;
enum { I_X = 0, I_MEM, I_F1N, I_F1WI, I_F1WO, I_MIXN, I_MEMN, I_WIN, I_SINK, I_WMKV, I_LRE, I_LIM, I_LDT, I_BRE, I_BIM, I_CRE, I_CIM, I_DSK, I_WGLU, I_WSWA, I_WMEMUP, I_WOUT, I_F2N, I_F2WI, I_F2WO, I_FINN, N_IN };

constexpr size_t MiB = 1u << 20;
constexpr size_t WS_CTL = 0, CTL_ZERO_BYTES = 1 * MiB;
constexpr size_t WS_W = 2 * MiB, W_LAYER = 202 * MiB;
constexpr size_t WO_1IN = 0, WO_1OUT = 44 * MiB, WO_IN = 66 * MiB, WO_MKV = 104 * MiB, WO_SWA = 112 * MiB, WO_MEM = 116 * MiB, WO_GLU = 120 * MiB, WO_OUT = 128 * MiB, WO_2IN = 136 * MiB, WO_2OUT = 180 * MiB;
constexpr size_t WS_MEMN = WS_W + DEPTH * W_LAYER;
constexpr size_t WS_H = WS_MEMN + 8 * MiB;
constexpr size_t WS_XN = WS_H + 64 * MiB;
constexpr size_t WS_HID = WS_XN + 32 * MiB;
constexpr size_t WS_PROJ = WS_HID + 88 * MiB;
constexpr size_t WS_MKV = WS_PROJ + 152 * MiB;
constexpr size_t WS_OSWA = WS_MKV + 2 * MiB, WS_YS = WS_OSWA + 16 * MiB, WS_OMEM = WS_YS + 16 * MiB;
constexpr size_t WS_T32 = WS_OMEM + 16 * MiB;
constexpr size_t WS_MG = WS_T32 + 64 * MiB;
constexpr size_t WS_SEND = WS_MG + 32 * MiB;
constexpr size_t LB_BYTES = 65 * 512;
constexpr size_t WS_LB = WS_SEND + 4 * MiB;
constexpr size_t WS_WINT = WS_LB + 9 * MiB;
constexpr size_t WS_WOUTT = WS_WINT + 64 * MiB;
constexpr size_t WS_SST = WS_WOUTT + 64 * MiB;
constexpr size_t WS_END = WS_SST + 2 * MiB;
static_assert(DEPTH * 64 * LB_BYTES <= 9 * MiB, "lag tables fit");
constexpr int CW_BAR = 4096;

constexpr int RING_OFF = 0, RING_BYTES = 131072;
constexpr int LDSCTL_OFF = RING_BYTES, MISC_OFF = LDSCTL_OFF + 320;
constexpr int LDS_BYTES = 147456;

#define GAS __attribute__((address_space(1)))
#define LAS __attribute__((address_space(3)))
typedef unsigned short bf16;
typedef unsigned v4u __attribute__((ext_vector_type(4)));
typedef unsigned v2u __attribute__((ext_vector_type(2)));
typedef float f32x4 __attribute__((ext_vector_type(4)));
typedef float f32x2 __attribute__((ext_vector_type(2)));
typedef GAS unsigned gu32;
using pg8::cvt_pk_bf16; using pg8::bf_lo; using pg8::bf_hi;

#define XB_TMO      128
#define XB_XCNT(j)  (256  + 64 * (j))
#define XB_XSUB(j)  (1280 + 64 * (j))
#define XB_XGEN(j)  (2304 + 64 * (j))
#define XB_TOP      3328
#define XB_TOPGEN   3392
#define XCD_BAR_WORDS 3456
#define XB_SPIN_CAP (1u << 18)

__device__ __forceinline__ unsigned xb_ld(unsigned* p)              { return __hip_atomic_load(p, __ATOMIC_RELAXED, __HIP_MEMORY_SCOPE_AGENT); }
__device__ __forceinline__ unsigned xb_add(unsigned* p, unsigned v) { return __hip_atomic_fetch_add(p, v, __ATOMIC_RELAXED, __HIP_MEMORY_SCOPE_AGENT); }
__device__ __forceinline__ unsigned xb_xcc_id() { return (unsigned)__builtin_amdgcn_s_getreg((3 << 11) | 20) & 0xFu; }
#define XB_SPIN(cond, bar) do { unsigned _sp = 0; while (cond) { __builtin_amdgcn_s_sleep(1); \
    if ((++_sp & 255u) == 0u) { if (xb_ld(&(bar)[XB_TMO])) break; if (_sp > XB_SPIN_CAP) { atomicAdd(&(bar)[XB_TMO], 1u); break; } } } } while (0)

struct XcdBarrier {
    unsigned* bar; unsigned x;
    volatile LAS unsigned* st;
};

__device__ __forceinline__ XcdBarrier xcd_barrier_post(unsigned* bar, volatile LAS unsigned* st) {
    XcdBarrier b; b.bar = bar; b.x = xb_xcc_id(); b.st = st;
    if (threadIdx.x == 0) (void)xb_add(&bar[XB_XCNT(b.x)], 1u);
    return b;
}
__device__ __forceinline__ void xcd_barrier_complete(unsigned* bar, unsigned x, unsigned& nloc, unsigned& nx) {
    const unsigned G = gridDim.x * gridDim.y * gridDim.z;
    unsigned sum, cnt, mine, sp = 0u;
    for (;;) {
        sum = 0u; cnt = 0u; mine = 0u;
#pragma unroll
        for (unsigned j = 0; j < 16; ++j) { const unsigned c = xb_ld(&bar[XB_XCNT(j)]); sum += c; cnt += (c > 0u) ? 1u : 0u; mine = (j == x) ? c : mine; }
        if (sum == G) break;
        __builtin_amdgcn_s_sleep(1);
        if ((++sp & 255u) == 0u) { if (xb_ld(&bar[XB_TMO])) break; if (sp > XB_SPIN_CAP) { atomicAdd(&bar[XB_TMO], 1u); break; } }
    }
    nloc = mine > 0u ? mine : 1u; nx = cnt > 0u ? cnt : 1u;
}

__device__ __forceinline__ void xcd_barrier(const XcdBarrier& b) {
    asm volatile("s_waitcnt vmcnt(0)" ::: "memory");
    __syncthreads();
    if (threadIdx.x == 0) {
        unsigned* bar = b.bar;
        __builtin_amdgcn_s_waitcnt(0);
        unsigned nloc = b.st[0], nx = b.st[1];
        if (nloc == 0u) { xcd_barrier_complete(bar, b.x, nloc, nx); b.st[0] = nloc; b.st[1] = nx; }
        const unsigned old = xb_add(&bar[XB_XSUB(b.x)], 1u);
        const unsigned gen = old / nloc;
        if (old + 1u == (gen + 1u) * nloc) {
            __builtin_amdgcn_fence(__ATOMIC_RELEASE, "agent");
            asm volatile("s_waitcnt vmcnt(0)" ::: "memory");
            const unsigned og = xb_add(&bar[XB_TOP], 1u);
            const unsigned tg = og / nx;
            if (og + 1u == (tg + 1u) * nx) xb_add(&bar[XB_TOPGEN], 1u);
            else XB_SPIN(xb_ld(&bar[XB_TOPGEN]) == tg, bar);
            __builtin_amdgcn_fence(__ATOMIC_ACQUIRE, "agent");
            xb_add(&bar[XB_XGEN(b.x)], 1u);
            asm volatile("s_waitcnt vmcnt(0)" ::: "memory");
        } else {
            XB_SPIN(xb_ld(&bar[XB_XGEN(b.x)]) == gen, bar);
            __builtin_amdgcn_fence(__ATOMIC_ACQUIRE, "agent");
            asm volatile("s_waitcnt vmcnt(0)" ::: "memory");
        }
    }
    __syncthreads();
}

struct Frame {
    LAS unsigned char* lds;
    int tid, lane, wave, G;
    unsigned char* ws;
};
__device__ __forceinline__ float wave_sum(float v) {
#pragma unroll
    for (int o = 1; o < 64; o <<= 1) v += __shfl_xor(v, o);
    return v;
}
__device__ __forceinline__ bf16* wsb(const Frame& F, size_t off) { return (bf16*)(F.ws + off); }

__device__ __forceinline__ void conv_block(const float* __restrict__ W, int K, int N, bf16* __restrict__ Wt, int kb, int nb, int pairNh, float scale, int lane) {
    const int k0 = kb * 64, n = nb * 64 + lane;
    const float* src = W + (size_t)k0 * N + n;
    float v[64];
#pragma unroll
    for (int i = 0; i < 64; ++i) v[i] = src[(size_t)i * N];
    int row = n;
    if (pairNh) { const int j = n < pairNh ? n : n - pairNh; row = (j >> 7) * 256 + (j & 127) + (n < pairNh ? 0 : 128); }
    v4u* dst = (v4u*)(Wt + (size_t)row * K + k0);
#pragma unroll
    for (int q = 0; q < 8; ++q) { v4u o; o.x = cvt_pk_bf16(v[8 * q] * scale, v[8 * q + 1] * scale); o.y = cvt_pk_bf16(v[8 * q + 2] * scale, v[8 * q + 3] * scale);
        o.z = cvt_pk_bf16(v[8 * q + 4] * scale, v[8 * q + 5] * scale); o.w = cvt_pk_bf16(v[8 * q + 6] * scale, v[8 * q + 7] * scale); dst[q] = o; }
}
constexpr int CI_1IN = (DM / 64) * (2 * DFF / 64), CI_1OUT = (DFF / 64) * (DM / 64), CI_IN = (DM / 64) * (INW / 64), CI_MKV = (DM / 64) * (2048 / 64), CI_GLU = (1024 / 64) * (4096 / 64),
              CI_SWA = (1024 / 64) * (DM / 64), CI_MEM = CI_SWA, CI_OUT = (DM / 64) * (DM / 64), CI_LAYER = 2 * CI_1IN + 2 * CI_1OUT + CI_IN + CI_MKV + CI_GLU + CI_SWA + CI_MEM + CI_OUT;
struct ProIn { const float *f1wi, *f2wi, *f1wo, *f2wo, *win, *wmkv, *wglu, *wswa, *wmem, *wout, *mem, *memn; };
__device__ __forceinline__ void prologue(Frame& F, const ProIn& I) {
    const int gw = blockIdx.x * NWAVES + F.wave, NGW = F.G * NWAVES, lane = F.lane;
    for (int it = gw; it < DEPTH * CI_LAYER; it += NGW) {
        const int l = it / CI_LAYER; int r = it % CI_LAYER; unsigned char* wl = F.ws + WS_W + (size_t)l * W_LAYER;
        const float* src; bf16* dst; int K, N, pairNh = 0;
        if (r < CI_1IN) { src = I.f1wi + (size_t)l * DM * 2 * DFF; dst = (bf16*)(wl + WO_1IN); K = DM; N = 2 * DFF; pairNh = DFF; }
        else if ((r -= CI_1IN) < CI_1IN) { src = I.f2wi + (size_t)l * DM * 2 * DFF; dst = (bf16*)(wl + WO_2IN); K = DM; N = 2 * DFF; pairNh = DFF; }
        else if ((r -= CI_1IN) < CI_1OUT) { src = I.f1wo + (size_t)l * DFF * DM; dst = (bf16*)(wl + WO_1OUT); K = DFF; N = DM; }
        else if ((r -= CI_1OUT) < CI_1OUT) { src = I.f2wo + (size_t)l * DFF * DM; dst = (bf16*)(wl + WO_2OUT); K = DFF; N = DM; }
        else if ((r -= CI_1OUT) < CI_IN) { src = I.win + (size_t)l * DM * INW; dst = (bf16*)(wl + WO_IN); K = DM; N = INW; }
        else if ((r -= CI_IN) < CI_MKV) { src = I.wmkv + (size_t)l * DM * 2048; dst = (bf16*)(wl + WO_MKV); K = DM; N = 2048; }
        else if ((r -= CI_MKV) < CI_GLU) { src = I.wglu + (size_t)l * 1024 * 4096; dst = (bf16*)(wl + WO_GLU); K = 1024; N = 4096; pairNh = 2048; }
        else if ((r -= CI_GLU) < CI_SWA) { src = I.wswa + (size_t)l * 1024 * DM; dst = (bf16*)(wl + WO_SWA); K = 1024; N = DM; }
        else if ((r -= CI_SWA) < CI_MEM) { src = I.wmem + (size_t)l * 1024 * DM; dst = (bf16*)(wl + WO_MEM); K = 1024; N = DM; }
        else { r -= CI_MEM; src = I.wout + (size_t)l * DM * DM; dst = (bf16*)(wl + WO_OUT); K = DM; N = DM; }
        const int nblk = N / 64, kb = r / nblk, nb = r % nblk, n0 = nb * 64;
        float sc = 1.f; if (N == INW) sc = n0 < COL_K ? 0.125f * LOG2E : ((n0 >= COL_MQ && n0 < COL_G) ? 0.0625f * LOG2E : 1.f);
        conv_block(src, K, N, dst, kb, nb, pairNh, sc, lane);
    }
    for (int it = gw; it < DEPTH * 512; it += NGW) {
        const int l = it / 512, row = it % 512;
        const f32x4* xr = (const f32x4*)(I.mem + (size_t)row * DM) + lane; const f32x4* gr = (const f32x4*)(I.memn + (size_t)l * DM) + lane;
        f32x4 v[8]; float s = 0.f;
#pragma unroll
        for (int j = 0; j < 8; ++j) { v[j] = xr[64 * j]; s += (v[j].x * v[j].x + v[j].y * v[j].y) + (v[j].z * v[j].z + v[j].w * v[j].w); }
        const float rstd = 1.0f / sqrtf(wave_sum(s) * (1.f / DM) + RMS_EPS);
        v2u* o8 = (v2u*)(wsb(F, WS_MEMN) + ((size_t)l * 512 + row) * DM) + lane;
#pragma unroll
        for (int j = 0; j < 8; ++j) { const f32x4 g = gr[64 * j]; v2u o; o.x = cvt_pk_bf16(v[j].x * rstd * g.x, v[j].y * rstd * g.y); o.y = cvt_pk_bf16(v[j].z * rstd * g.z, v[j].w * rstd * g.w); o8[64 * j] = o; }
    }
}
template <bool OUTF32>
__device__ __forceinline__ void norm_phase(Frame& F, const float* hin, const float* gain, void* outp) {
    const int gw = blockIdx.x * NWAVES + F.wave, NGW = F.G * NWAVES, lane = F.lane;
    f32x4 g[8];
#pragma unroll
    for (int j = 0; j < 8; ++j) g[j] = ((const f32x4*)gain)[lane + 64 * j];
    for (int m = gw; m < T; m += NGW) {
        const f32x4* xr = (const f32x4*)(hin + (size_t)m * DM) + lane;
        f32x4 v[8]; float s = 0.f;
#pragma unroll
        for (int j = 0; j < 8; ++j) { v[j] = xr[64 * j]; s += (v[j].x * v[j].x + v[j].y * v[j].y) + (v[j].z * v[j].z + v[j].w * v[j].w); }
        const float rstd = 1.0f / sqrtf(wave_sum(s) * (1.f / DM) + RMS_EPS);
        if (OUTF32) { f32x4* o = (f32x4*)((float*)outp + (size_t)m * DM) + lane;
#pragma unroll
            for (int j = 0; j < 8; ++j) o[64 * j] = v[j] * rstd * g[j];
        } else { v2u* o8 = (v2u*)((bf16*)outp + (size_t)m * DM) + lane;
#pragma unroll
            for (int j = 0; j < 8; ++j) { v2u o; o.x = cvt_pk_bf16(v[j].x * rstd * g[j].x, v[j].y * rstd * g[j].y); o.y = cvt_pk_bf16(v[j].z * rstd * g[j].z, v[j].w * rstd * g[j].w); o8[64 * j] = o; } }
    }
}
__device__ __forceinline__ void unpack8(const v4u w, float* f) { f[0] = bf_lo(w.x); f[1] = bf_hi(w.x); f[2] = bf_lo(w.y); f[3] = bf_hi(w.y); f[4] = bf_lo(w.z); f[5] = bf_hi(w.z); f[6] = bf_lo(w.w); f[7] = bf_hi(w.w); }

__device__ __forceinline__ void swa_naive(Frame& F, const float* sinks) {
    const bf16* P = wsb(F, WS_PROJ); bf16* O = wsb(F, WS_OSWA);
    for (int idx = blockIdx.x * 512 + F.tid; idx < T * 16; idx += F.G * 512) {
        const int hq = idx / T, m = idx % T, b = m / SEQ, t = m % SEQ, g = hq >> 2;
        float q[64];
        { const v4u* qp = (const v4u*)(P + (size_t)m * INW + COL_Q + hq * 64);
#pragma unroll
          for (int j = 0; j < 8; ++j) unpack8(qp[j], q + 8 * j); }
        float mrun = sinks[hq] * LOG2E, lrun = 1.f, o[64];
#pragma unroll
        for (int j = 0; j < 64; ++j) o[j] = 0.f;
        const int k0 = t >= 127 ? t - 127 : 0;
        for (int kp = k0; kp <= t; ++kp) {
            const bf16* kr = P + (size_t)(b * SEQ + kp) * INW + COL_K + g * 64; const bf16* vr = kr + (COL_V - COL_K);
            float s0 = 0.f, s1 = 0.f;
#pragma unroll
            for (int j = 0; j < 8; ++j) { float kf[8]; unpack8(((const v4u*)kr)[j], kf);
#pragma unroll
                for (int e = 0; e < 8; e += 2) { s0 += q[8 * j + e] * kf[e]; s1 += q[8 * j + e + 1] * kf[e + 1]; } }
            const float s = s0 + s1, mnew = fmaxf(mrun, s), corr = __builtin_amdgcn_exp2f(mrun - mnew), p = __builtin_amdgcn_exp2f(s - mnew);
            lrun = lrun * corr + p; mrun = mnew;
#pragma unroll
            for (int j = 0; j < 8; ++j) { float vf[8]; unpack8(((const v4u*)vr)[j], vf);
#pragma unroll
                for (int e = 0; e < 8; ++e) o[8 * j + e] = o[8 * j + e] * corr + p * vf[e]; }
        }
        const float inv = 1.0f / lrun; v4u* op = (v4u*)(O + (size_t)m * 1024 + hq * 64);
#pragma unroll
        for (int j = 0; j < 8; ++j) { v4u w; w.x = cvt_pk_bf16(o[8 * j] * inv, o[8 * j + 1] * inv); w.y = cvt_pk_bf16(o[8 * j + 2] * inv, o[8 * j + 3] * inv);
            w.z = cvt_pk_bf16(o[8 * j + 4] * inv, o[8 * j + 5] * inv); w.w = cvt_pk_bf16(o[8 * j + 6] * inv, o[8 * j + 7] * inv); op[j] = w; }
    }
}
__device__ __forceinline__ void memattn_naive(Frame& F) {
    const bf16* P = wsb(F, WS_PROJ); const bf16* KV = wsb(F, WS_MKV); bf16* O = wsb(F, WS_OMEM);
    LAS float* qs = (LAS float*)F.lds;
    LAS float* ss = qs + 32 * 260;
    const int tid = F.tid, ti = tid >> 4, kg = tid & 15;
    for (int unit = blockIdx.x; unit < 1024; unit += F.G) {
        const int b = unit >> 9, hd = (unit >> 7) & 3, tb = unit & 127, m0 = b * SEQ + tb * 32;
        { const v4u* src = (const v4u*)(P + (size_t)(m0 + ti) * INW + COL_MQ + hd * 256 + kg * 16); float f[16]; unpack8(src[0], f); unpack8(src[1], f + 8);
#pragma unroll
          for (int e = 0; e < 16; ++e) qs[ti * 260 + kg * 16 + e] = f[e]; }
        __syncthreads();
        float sc[16];
#pragma unroll 1
        for (int i = 0; i < 16; ++i) { const int key = kg + 16 * i; const v4u* kr = (const v4u*)(KV + (size_t)(b * NMEM + key) * 2048 + hd * 256);
            float a0 = 0.f, a1 = 0.f;
#pragma unroll 8
            for (int d8 = 0; d8 < 32; ++d8) { float kf[8]; unpack8(kr[d8], kf); const LAS f32x4* qp = (const LAS f32x4*)(qs + ti * 260 + d8 * 8); const f32x4 qa = qp[0], qb = qp[1];
                a0 += qa.x * kf[0] + qa.y * kf[1] + qa.z * kf[2] + qa.w * kf[3]; a1 += qb.x * kf[4] + qb.y * kf[5] + qb.z * kf[6] + qb.w * kf[7]; }
            ss[ti * 257 + key] = a0 + a1; }
        __syncthreads();
        float mx = -3.0e38f;
#pragma unroll
        for (int i = 0; i < 16; ++i) { sc[i] = ss[ti * 257 + kg + 16 * i]; mx = fmaxf(mx, sc[i]); }
#pragma unroll
        for (int o = 1; o < 16; o <<= 1) mx = fmaxf(mx, __shfl_xor(mx, o));
        float sum = 0.f;
#pragma unroll
        for (int i = 0; i < 16; ++i) { sc[i] = __builtin_amdgcn_exp2f(sc[i] - mx); sum += sc[i]; }
#pragma unroll
        for (int o = 1; o < 16; o <<= 1) sum += __shfl_xor(sum, o);
        const float inv = 1.0f / sum;
#pragma unroll
        for (int i = 0; i < 16; ++i) ss[ti * 257 + kg + 16 * i] = sc[i] * inv;
        __syncthreads();
        float o[16];
#pragma unroll
        for (int e = 0; e < 16; ++e) o[e] = 0.f;
#pragma unroll 4
        for (int key = 0; key < NMEM; ++key) { const float p = ss[ti * 257 + key]; const v4u* vr = (const v4u*)(KV + (size_t)(b * NMEM + key) * 2048 + 1024 + hd * 256 + kg * 16);
            float vf[16]; unpack8(vr[0], vf); unpack8(vr[1], vf + 8);
#pragma unroll
            for (int e = 0; e < 16; ++e) o[e] += p * vf[e]; }
        v4u* op = (v4u*)(O + (size_t)(m0 + ti) * 1024 + hd * 256 + kg * 16);
        v4u w; w.x = cvt_pk_bf16(o[0], o[1]); w.y = cvt_pk_bf16(o[2], o[3]); w.z = cvt_pk_bf16(o[4], o[5]); w.w = cvt_pk_bf16(o[6], o[7]); op[0] = w;
        w.x = cvt_pk_bf16(o[8], o[9]); w.y = cvt_pk_bf16(o[10], o[11]); w.z = cvt_pk_bf16(o[12], o[13]); w.w = cvt_pk_bf16(o[14], o[15]); op[1] = w;
        __syncthreads();
    }
}
__device__ __forceinline__ void sincos_red(double x, float& s, float& c) {
    const double k = __builtin_rint(x * 0.63661977236758134308); const double r = (x - k * 1.57079632679489655800) - k * 6.123233995736766036e-17; const double r2 = r * r;
    double sp = -7.6471637318198164759e-13; sp = sp * r2 + 1.6059043836821614599e-10; sp = sp * r2 - 2.5052108385441718775e-8; sp = sp * r2 + 2.7557319223985890653e-6; sp = sp * r2 - 1.9841269841269841270e-4; sp = sp * r2 + 8.3333333333333333333e-3; sp = sp * r2 - 1.6666666666666666667e-1;
    const double sr = r + r * r2 * sp;
    double cp = -1.1470745597729724714e-11; cp = cp * r2 + 2.0876756987868098979e-9; cp = cp * r2 - 2.7557319223985890653e-7; cp = cp * r2 + 2.4801587301587301587e-5; cp = cp * r2 - 1.3888888888888888889e-3; cp = cp * r2 + 4.1666666666666666667e-2; cp = cp * r2 - 0.5;
    const double cr = 1.0 + r2 * cp;
    const int q = ((int)k) & 3;
    const double ss = (q & 1) ? cr : sr, cc = (q & 1) ? sr : cr;
    s = (float)((q & 2) ? -ss : ss); c = (float)(((q == 1) || (q == 2)) ? -cc : cc);
}
struct SsmState { float ar, ai, a64r, a64i; float bbr[16], bbi[16]; };
struct SsmIn { const float *lre, *lim, *ldt, *bre, *bim, *cre, *cim, *dsk; };
__device__ __forceinline__ void ssm_params(const SsmIn& I, int g, int p, SsmState& S) {
    const int gp = g * 64 + p;
    const float lr = fminf(I.lre[gp], -1e-4f), li = I.lim[gp], dt = expf(I.ldt[g]);
    const float mag = expf(lr * dt); float sn, cs; const double th = (double)li * (double)dt; sincos_red(th, sn, cs);
    S.ar = mag * cs; S.ai = mag * sn;
    const float mag64 = expf(lr * dt * 64.f); sincos_red(th * 64.0, sn, cs); S.a64r = mag64 * cs; S.a64i = mag64 * sn;
    const float nr = S.ar - 1.f, ni = S.ai, den = lr * lr + li * li, kr = (nr * lr + ni * li) / den, ki = (ni * lr - nr * li) / den;
    const float* br = I.bre + (size_t)gp * 16; const float* bi = I.bim + (size_t)gp * 16;
#pragma unroll
    for (int c = 0; c < 16; ++c) { S.bbr[c] = kr * br[c] - ki * bi[c]; S.bbi[c] = kr * bi[c] + ki * br[c]; }
}
__device__ __forceinline__ void ssm_step(const SsmState& S, const bf16* up, float& sr, float& si) {
    const v4u* u4 = (const v4u*)up; float uf[16]; unpack8(u4[0], uf); unpack8(u4[1], uf + 8);
    float xr = 0.f, xi = 0.f;
#pragma unroll
    for (int c = 0; c < 16; ++c) { xr += S.bbr[c] * uf[c]; xi += S.bbi[c] * uf[c]; }
    const float nr = S.ar * sr - S.ai * si + xr, ni = S.ar * si + S.ai * sr + xi; sr = nr; si = ni;
}
__device__ __forceinline__ void ssm_local(Frame& F, const SsmIn& I) {
    const bf16* P = wsb(F, WS_PROJ); f32x2* SE = (f32x2*)(F.ws + WS_SEND);
    const int gw = blockIdx.x * NWAVES + F.wave, NGW = F.G * NWAVES, p = F.lane;
    for (int u = gw; u < 2 * 64 * 64; u += NGW) {
        const int g = u & 63, ch = (u >> 6) & 63, b = u >> 12;
        SsmState S; ssm_params(I, g, p, S);
        float sr = 0.f, si = 0.f; const bf16* up = P + (size_t)(b * SEQ + ch * 64) * INW + COL_S + g * 16;
#pragma unroll 4
        for (int j = 0; j < 64; ++j) ssm_step(S, up + (size_t)j * INW, sr, si);
        SE[((size_t)(b * 64 + ch) * 64 + g) * 64 + p] = (f32x2){sr, si};
    }
}
__device__ __forceinline__ void ssm_replay(Frame& F, const SsmIn& I) {
    const bf16* P = wsb(F, WS_PROJ); const f32x2* SE = (const f32x2*)(F.ws + WS_SEND); bf16* Y = wsb(F, WS_YS);
    LAS f32x2* Cs = (LAS f32x2*)F.lds;
    LAS float* Ds = (LAS float*)(F.lds + 16 * 65 * 8);
    LAS f32x2* Sw = (LAS f32x2*)(F.lds + 16384) + F.wave * (16 * 65);
    const int p = F.lane, jj = F.lane >> 2, cq = F.lane & 3;
    for (int unit = blockIdx.x; unit < 1024; unit += F.G) {
        const int oct = unit & 7, g = (unit >> 3) & 63, b = unit >> 9, ch = oct * 8 + F.wave;
        for (int e = F.tid; e < 1024; e += 512) { const int c = e >> 6, pp = e & 63; const size_t gi = ((size_t)g * 16 + c) * 64 + pp; Cs[c * 65 + pp] = (f32x2){I.cre[gi], I.cim[gi]}; }
        if (F.tid < 16) Ds[F.tid] = I.dsk[g * 16 + F.tid];
        __syncthreads();
        SsmState S; ssm_params(I, g, p, S);
        float sr = 0.f, si = 0.f;
        for (int j = 0; j < ch; ++j) { const f32x2 e = SE[((size_t)(b * 64 + j) * 64 + g) * 64 + p]; const float nr = S.a64r * sr - S.a64i * si + e.x, ni = S.a64r * si + S.a64i * sr + e.y; sr = nr; si = ni; }
        const size_t tok0 = (size_t)b * SEQ + ch * 64;
#pragma unroll 1
        for (int sub = 0; sub < 4; ++sub) {
#pragma unroll 4
            for (int j = 0; j < 16; ++j) { ssm_step(S, P + (tok0 + sub * 16 + j) * INW + COL_S + g * 16, sr, si); Sw[j * 65 + p] = (f32x2){sr, si}; }
            asm volatile("s_waitcnt lgkmcnt(0)" ::: "memory");
            float acc[4] = {0.f, 0.f, 0.f, 0.f};
#pragma unroll 4
            for (int pp = 0; pp < 64; ++pp) { const f32x2 sv = Sw[jj * 65 + pp];
#pragma unroll
                for (int ci = 0; ci < 4; ++ci) { const f32x2 cv = Cs[(cq * 4 + ci) * 65 + pp]; acc[ci] += cv.x * sv.x - cv.y * sv.y; } }
            const size_t tok = tok0 + sub * 16 + jj; const v2u uw = *(const v2u*)(P + tok * INW + COL_S + g * 16 + cq * 4);
            const float u0 = bf_lo(uw.x), u1 = bf_hi(uw.x), u2 = bf_lo(uw.y), u3 = bf_hi(uw.y);
            v2u o; o.x = cvt_pk_bf16(acc[0] + Ds[cq * 4] * u0, acc[1] + Ds[cq * 4 + 1] * u1); o.y = cvt_pk_bf16(acc[2] + Ds[cq * 4 + 2] * u2, acc[3] + Ds[cq * 4 + 3] * u3);
            *(v2u*)(Y + tok * 1024 + g * 16 + cq * 4) = o;
            asm volatile("s_waitcnt lgkmcnt(0)" ::: "memory");
        }
        __syncthreads();
    }
}

typedef short bf16x8 __attribute__((ext_vector_type(8)));
typedef short s16x4 __attribute__((ext_vector_type(4)));
typedef float f32x16 __attribute__((ext_vector_type(16)));
__device__ __forceinline__ s16x4 lds_tr16(const LAS unsigned char* p) { return __builtin_bit_cast(s16x4, __builtin_amdgcn_ds_read_tr16_b64_v4i16((LAS s16x4*)p)); }
__device__ __forceinline__ bf16x8 cat8(s16x4 lo, s16x4 hi) { return (bf16x8){lo[0], lo[1], lo[2], lo[3], hi[0], hi[1], hi[2], hi[3]}; }
__device__ __forceinline__ bf16x8 pack8(float a0, float a1, float a2, float a3, float a4, float a5, float a6, float a7) {
    v4u w; w.x = cvt_pk_bf16(a0, a1); w.y = cvt_pk_bf16(a2, a3); w.z = cvt_pk_bf16(a4, a5); w.w = cvt_pk_bf16(a6, a7); return __builtin_bit_cast(bf16x8, w); }

__device__ __forceinline__ void swa_mfma(Frame& F, const float* sinks) {
    const bf16* P = wsb(F, WS_PROJ); bf16* O = wsb(F, WS_OSWA);
    LAS unsigned char* Kl = F.lds;
    LAS unsigned char* Vl = F.lds + 36864;
    const int tid = F.tid, lane = F.lane, w = F.wave, r = w >> 1, qh = w & 1, l31 = lane & 31, h = lane >> 5;
    for (int unit = blockIdx.x; unit < 256; unit += F.G) {
        const int n = unit & 31, g = (unit >> 5) & 3, b = unit >> 7;
#pragma unroll
        for (int i = 0; i < 4; ++i) { const int c = tid + 512 * i, key = c >> 3, part = c & 7, pos = (n - 1) * 128 + key;
            v4u kv = {0u, 0u, 0u, 0u}, vv = {0u, 0u, 0u, 0u};
            if (pos >= 0) { const bf16* src = P + (size_t)(b * SEQ + pos) * INW + COL_K + g * 64 + part * 8; kv = *(const v4u*)src; vv = *(const v4u*)(src + (COL_V - COL_K)); }
            *(LAS v4u*)(Kl + key * 144 + part * 16) = kv;
            *(LAS v4u*)(Vl + (part >> 2) * 16384 + key * 64 + (part & 3) * 16) = vv; }
        __syncthreads();
        const int hq = g * 4 + r; const float sink2 = sinks[hq] * LOG2E;
#pragma unroll 1
        for (int qt = 0; qt < 2; ++qt) {
            const int a = qh * 2 + qt, qi = a * 32 + l31; const size_t m = (size_t)b * SEQ + n * 128 + qi;
            bf16x8 qf[4];
#pragma unroll
            for (int ds = 0; ds < 4; ++ds) qf[ds] = *(const bf16x8*)(P + m * INW + COL_Q + hq * 64 + ds * 16 + h * 8);
            f32x16 s[5];
#pragma unroll
            for (int k5 = 0; k5 < 5; ++k5) { f32x16 acc;
#pragma unroll
                for (int e = 0; e < 16; ++e) acc[e] = 0.f;
#pragma unroll
                for (int ds = 0; ds < 4; ++ds) { const bf16x8 kf = *(const LAS bf16x8*)(Kl + (32 * (a + k5) + l31) * 144 + ds * 32 + h * 16); acc = __builtin_amdgcn_mfma_f32_32x32x16_bf16(kf, qf[ds], acc, 0, 0, 0); }
                s[k5] = acc; }
            float mx = sink2;
#pragma unroll
            for (int k5 = 0; k5 < 5; ++k5)
#pragma unroll
                for (int e = 0; e < 16; ++e) { const int kl = 32 * (a + k5) + (e & 3) + 8 * (e >> 2) + 4 * h; const bool ok = (kl > qi) && (kl <= qi + 128) && (n > 0 || kl >= 128);
                    const float v = ok ? s[k5][e] : -1.0e30f; s[k5][e] = v; mx = fmaxf(mx, v); }
            mx = fmaxf(mx, __shfl_xor(mx, 32));
            float sum = 0.f;
#pragma unroll
            for (int k5 = 0; k5 < 5; ++k5)
#pragma unroll
                for (int e = 0; e < 16; ++e) { const float p = __builtin_amdgcn_exp2f(s[k5][e] - mx); s[k5][e] = p; sum += p; }
            sum += __shfl_xor(sum, 32); sum += __builtin_amdgcn_exp2f(sink2 - mx);
            f32x16 o[2];
#pragma unroll
            for (int e = 0; e < 16; ++e) { o[0][e] = 0.f; o[1][e] = 0.f; }
#pragma unroll
            for (int k5 = 0; k5 < 5; ++k5)
#pragma unroll
                for (int s2 = 0; s2 < 2; ++s2) { const bf16x8 pf = pack8(s[k5][8 * s2], s[k5][8 * s2 + 1], s[k5][8 * s2 + 2], s[k5][8 * s2 + 3], s[k5][8 * s2 + 4], s[k5][8 * s2 + 5], s[k5][8 * s2 + 6], s[k5][8 * s2 + 7]);
                    const int base0 = 32 * (a + k5) + 16 * s2 + 4 * h;
#pragma unroll
                    for (int db = 0; db < 2; ++db) { const LAS unsigned char* vp = Vl + db * 16384 + (base0 + ((lane & 15) >> 2)) * 64 + (16 * ((lane >> 4) & 1) + 4 * (lane & 3)) * 2;
                        const bf16x8 vf = cat8(lds_tr16(vp), lds_tr16(vp + 8 * 64)); o[db] = __builtin_amdgcn_mfma_f32_32x32x16_bf16(vf, pf, o[db], 0, 0, 0); } }
            const float inv = 1.0f / sum;
#pragma unroll
            for (int db = 0; db < 2; ++db)
#pragma unroll
                for (int g4 = 0; g4 < 4; ++g4) { v2u wv; wv.x = cvt_pk_bf16(o[db][4 * g4] * inv, o[db][4 * g4 + 1] * inv); wv.y = cvt_pk_bf16(o[db][4 * g4 + 2] * inv, o[db][4 * g4 + 3] * inv);
                    *(v2u*)(O + m * 1024 + hq * 64 + db * 32 + 8 * g4 + 4 * h) = wv; }
        }
        __syncthreads();
    }
}
__device__ __forceinline__ void memattn_mfma(Frame& F) {
    const bf16* P = wsb(F, WS_PROJ); const bf16* KV = wsb(F, WS_MKV); bf16* O = wsb(F, WS_OMEM);
    constexpr int RS = 544, SLOT = 64 * RS;
    const int tid = F.tid, lane = F.lane, w = F.wave, l15 = lane & 15, kq = lane >> 4;
    for (int unit = blockIdx.x; unit < 256; unit += F.G) {
        const int tb = unit & 31, hd = (unit >> 5) & 3, b = unit >> 7; const size_t m = (size_t)b * SEQ + tb * 128 + w * 16 + l15;
        bf16x8 qf[8];
#pragma unroll
        for (int ds = 0; ds < 8; ++ds) qf[ds] = *(const bf16x8*)(P + m * INW + COL_MQ + hd * 256 + ds * 32 + kq * 8);
        v4u st[4];
#define MA_LOAD(t) do { _Pragma("unroll") for (int i_ = 0; i_ < 4; ++i_) { const int c_ = tid + 512 * i_, row_ = c_ >> 5, part_ = c_ & 31; \
            st[i_] = *(const v4u*)(KV + (size_t)(b * NMEM + 64 * ((t) & 3) + row_) * 2048 + ((t) >> 2) * 1024 + hd * 256 + part_ * 8); } } while (0)
#define MA_STORE(buf) do { _Pragma("unroll") for (int i_ = 0; i_ < 4; ++i_) { const int c_ = tid + 512 * i_, row_ = c_ >> 5, part_ = c_ & 31; *(LAS v4u*)((buf) + row_ * RS + part_ * 16) = st[i_]; } } while (0)
        MA_LOAD(0); MA_STORE(F.lds); __syncthreads();
        f32x4 s[16]; f32x4 o[16]; float inv = 0.f;
#pragma unroll
        for (int t = 0; t < 8; ++t) {
            if (t < 7) MA_LOAD(t + 1);
            const LAS unsigned char* cur = F.lds + (t & 1) * SLOT;
            if (t < 4) {
#pragma unroll
                for (int k4 = 0; k4 < 4; ++k4) { f32x4 acc = {0.f, 0.f, 0.f, 0.f};
#pragma unroll
                    for (int ds = 0; ds < 8; ++ds) { const bf16x8 kf = *(const LAS bf16x8*)(cur + (16 * k4 + l15) * RS + ds * 64 + kq * 16); acc = __builtin_amdgcn_mfma_f32_16x16x32_bf16(kf, qf[ds], acc, 0, 0, 0); }
                    s[4 * t + k4] = acc; }
                if (t == 3) {
                    float mx = -3.0e38f;
#pragma unroll
                    for (int i = 0; i < 16; ++i) mx = fmaxf(mx, fmaxf(fmaxf(s[i][0], s[i][1]), fmaxf(s[i][2], s[i][3])));
                    mx = fmaxf(mx, __shfl_xor(mx, 16)); mx = fmaxf(mx, __shfl_xor(mx, 32));
                    float sum = 0.f;
#pragma unroll
                    for (int i = 0; i < 16; ++i)
#pragma unroll
                        for (int e = 0; e < 4; ++e) { const float p = __builtin_amdgcn_exp2f(s[i][e] - mx); s[i][e] = p; sum += p; }
                    sum += __shfl_xor(sum, 16); sum += __shfl_xor(sum, 32); inv = 1.0f / sum;
#pragma unroll
                    for (int i = 0; i < 16; ++i) o[i] = (f32x4){0.f, 0.f, 0.f, 0.f};
                }
            } else {
                const int tv = t - 4;
#pragma unroll
                for (int s2 = 0; s2 < 2; ++s2) { const f32x4 p0 = s[4 * tv + 2 * s2], p1 = s[4 * tv + 2 * s2 + 1]; const bf16x8 pf = pack8(p0[0], p0[1], p0[2], p0[3], p1[0], p1[1], p1[2], p1[3]);
#pragma unroll
                    for (int db = 0; db < 16; ++db) { const LAS unsigned char* vp = cur + (32 * s2 + 4 * kq + (l15 >> 2)) * RS + (16 * db + 4 * (lane & 3)) * 2;
                        const bf16x8 vf = cat8(lds_tr16(vp), lds_tr16(vp + 16 * RS)); o[db] = __builtin_amdgcn_mfma_f32_16x16x32_bf16(vf, pf, o[db], 0, 0, 0); } }
            }
            if (t < 7) MA_STORE(F.lds + ((t + 1) & 1) * SLOT);
            __syncthreads();
        }
#undef MA_LOAD
#undef MA_STORE
#pragma unroll
        for (int db = 0; db < 16; ++db) { v2u wv; wv.x = cvt_pk_bf16(o[db][0] * inv, o[db][1] * inv); wv.y = cvt_pk_bf16(o[db][2] * inv, o[db][3] * inv); *(v2u*)(O + m * 1024 + hd * 256 + 16 * db + 4 * kq) = wv; }
    }
}

__device__ __forceinline__ void cmul(float ar, float ai, float br, float bi, float& cr, float& ci) { cr = ar * br - ai * bi; ci = ar * bi + ai * br; }
__device__ __forceinline__ void ssm_tables(Frame& F, const SsmIn& I0) {
    LAS f32x2* AP = (LAS f32x2*)F.lds;
    LAS f32x2* BB = (LAS f32x2*)(F.lds + 33280);
    LAS f32x2* CC = (LAS f32x2*)(F.lds + 33280 + 8192);
    LAS f32x2* KC = (LAS f32x2*)(F.lds + 33280 + 16384);
    const int t = F.tid;
    for (int unit = blockIdx.x; unit < DEPTH * 64; unit += F.G) {
        const int l = unit >> 6, g = unit & 63, gp0 = unit * 64;
        const float dt = expf(I0.ldt[unit]);
        for (int e = t; e < 65 * 64; e += 512) { const int ee = e >> 6, p = e & 63; const float lr = fminf(I0.lre[gp0 + p], -1e-4f), li = I0.lim[gp0 + p];
            const float mag = expf(lr * dt * (float)ee); float sn, cs; sincos_red((double)li * (double)dt * (double)ee, sn, cs); AP[e] = (f32x2){mag * cs, mag * sn}; }
        __syncthreads();
        if (t < 64) { const float lr = fminf(I0.lre[gp0 + t], -1e-4f), li = I0.lim[gp0 + t]; const f32x2 a = AP[64 + t]; const float nr = a.x - 1.f, ni = a.y, den = lr * lr + li * li;
            KC[t] = (f32x2){(nr * lr + ni * li) / den, (ni * lr - nr * li) / den}; }
        __syncthreads();
        for (int e = t; e < 1024; e += 512) { const int p = e >> 4; const f32x2 k = KC[p]; const float br = I0.bre[(size_t)gp0 * 16 + e], bi = I0.bim[(size_t)gp0 * 16 + e];
            BB[e] = (f32x2){k.x * br - k.y * bi, k.x * bi + k.y * br}; CC[e] = (f32x2){I0.cre[(size_t)gp0 * 16 + e], I0.cim[(size_t)gp0 * 16 + e]}; }
        __syncthreads();
        bf16* WinT = wsb(F, WS_WINT) + (size_t)unit * 131072; bf16* WoutT = wsb(F, WS_WOUTT) + (size_t)unit * 131072; bf16* LB = (bf16*)(F.ws + WS_LB + (size_t)unit * LB_BYTES);
        for (int q = t; q < 16384; q += 512) { const int n = q >> 7, ck = q & 127, j = ck >> 1, half = ck & 1, p = 16 * (n >> 5) + (n & 15), isim = (n >> 4) & 1; const f32x2 a = AP[(63 - j) * 64 + p]; float v[8];
#pragma unroll
            for (int e = 0; e < 8; ++e) { const f32x2 bb = BB[p * 16 + 8 * half + e]; float zr, zi; cmul(a.x, a.y, bb.x, bb.y, zr, zi); v[e] = isim ? zi : zr; }
            *(bf16x8*)(WinT + (size_t)n * 1024 + ck * 8) = pack8(v[0], v[1], v[2], v[3], v[4], v[5], v[6], v[7]); }
        for (int q = t; q < 16384; q += 512) { const int row = q >> 4, ck = q & 15, tau = row >> 4, c = row & 15, isim = ck >> 3, p0 = (8 * ck) & 63; float v[8];
#pragma unroll
            for (int e = 0; e < 8; ++e) { const f32x2 cc = CC[c * 64 + p0 + e], a = AP[(tau + 1) * 64 + p0 + e]; float zr, zi; cmul(cc.x, cc.y, a.x, a.y, zr, zi); v[e] = isim ? -zi : zr; }
            *(bf16x8*)(WoutT + (size_t)row * 128 + ck * 8) = pack8(v[0], v[1], v[2], v[3], v[4], v[5], v[6], v[7]); }
        { const int c = (t >> 4) & 15, c2 = t & 15, lh = t >> 8; float acc[32];
#pragma unroll
          for (int d = 0; d < 32; ++d) acc[d] = 0.f;
#pragma unroll 2
          for (int p = 0; p < 64; ++p) { const f32x2 cc = CC[c * 64 + p], bb = BB[p * 16 + c2]; float zr, zi; cmul(cc.x, cc.y, bb.x, bb.y, zr, zi);
#pragma unroll
              for (int d = 0; d < 32; ++d) { const f32x2 a = AP[(32 * lh + d) * 64 + p]; acc[d] += zr * a.x - zi * a.y; } }
          if (lh == 0 && c == c2) acc[0] += I0.dsk[l * 1024 + g * 16 + c];
#pragma unroll
          for (int d = 0; d < 32; ++d) LB[(((32 * lh + d + 1) * 2 + (c2 >> 3)) * 16 + c) * 8 + (c2 & 7)] = (bf16)(cvt_pk_bf16(acc[d], 0.f) & 0xffffu);
          if (t < 256) LB[t] = 0; }
        __syncthreads();
    }
}
__device__ __forceinline__ void ssm_s1(Frame& F, const SsmIn& I, int l) {
    const bf16* P = wsb(F, WS_PROJ); bf16* SST = wsb(F, WS_SST);
    LAS float* E = (LAS float*)F.lds;
    const int lane = F.lane, w = F.wave, l31 = lane & 31, h = lane >> 5, mi = w & 3, kh = w >> 2;
    for (int unit = blockIdx.x; unit < 256; unit += F.G) {
        const int g = unit >> 2, pq = unit & 3;
        const bf16* WinT = wsb(F, WS_WINT) + (size_t)(l * 64 + g) * 131072 + (size_t)(pq * 32 + l31) * 1024 + 8 * h;
        const int mrow = 32 * mi + l31, bb = mrow >> 6, kk = mrow & 63;
        const bf16* up = P + (size_t)(bb * SEQ + kk * 64) * INW + COL_S + g * 16 + 8 * h;
        f32x16 acc;
#pragma unroll
        for (int e = 0; e < 16; ++e) acc[e] = 0.f;
#pragma unroll 8
        for (int jj = 0; jj < 32; ++jj) { const int j = 32 * kh + jj; const bf16x8 af = *(const bf16x8*)(up + (size_t)j * INW), bf = *(const bf16x8*)(WinT + 16 * j);
            acc = __builtin_amdgcn_mfma_f32_32x32x16_bf16(af, bf, acc, 0, 0, 0); }
#pragma unroll
        for (int e = 0; e < 16; ++e) E[(kh * 128 + 32 * mi + (e & 3) + 8 * (e >> 2) + 4 * h) * 33 + l31] = acc[e];
        __syncthreads();
#pragma unroll 1
        for (int tk = 0; tk < 4; ++tk) { const int task = w * 4 + tk, b = task >> 4, st = task & 15, p = 16 * pq + st, k = lane;
            float xr = E[(b * 64 + k) * 33 + st] + E[(128 + b * 64 + k) * 33 + st], xi = E[(b * 64 + k) * 33 + 16 + st] + E[(128 + b * 64 + k) * 33 + 16 + st];
            const int gp = g * 64 + p; const float lr = fminf(I.lre[gp], -1e-4f), li = I.lim[gp], dt = expf(I.ldt[g]);
            float ar, ai; { const float mag = expf(lr * dt * 64.f); float sn, cs; sincos_red((double)li * (double)dt * 64.0, sn, cs); ar = mag * cs; ai = mag * sn; }
#pragma unroll
            for (int d = 1; d < 64; d <<= 1) { const float yr = __shfl_up(xr, d), yi = __shfl_up(xi, d); if (k >= d) { xr += ar * yr - ai * yi; xi += ar * yi + ai * yr; } const float nr = ar * ar - ai * ai, ni = 2.f * ar * ai; ar = nr; ai = ni; }
            float sr = __shfl_up(xr, 1), si = __shfl_up(xi, 1); if (k == 0) { sr = 0.f; si = 0.f; }
            bf16* dst = SST + ((size_t)(g * 128 + b * 64 + k)) * 128 + p; dst[0] = (bf16)(cvt_pk_bf16(sr, 0.f) & 0xffffu); dst[64] = (bf16)(cvt_pk_bf16(si, 0.f) & 0xffffu); }
        __syncthreads();
    }
}
__device__ __forceinline__ void ssm_s2(Frame& F, int l) {
    const bf16* P = wsb(F, WS_PROJ); const bf16* SST = wsb(F, WS_SST); bf16* Y = wsb(F, WS_YS);
    LAS unsigned char* Ul = F.lds;
    LAS unsigned char* Ll = F.lds + 66048;
    LAS unsigned char* Sl = F.lds + 66048 + 33280;
    const int t = F.tid, lane = F.lane, w = F.wave, l31 = lane & 31, h = lane >> 5;
    for (int unit = blockIdx.x; unit < 256; unit += F.G) {
        const int mt = unit & 1, b = (unit >> 1) & 1, g = unit >> 2;
#pragma unroll
        for (int i = 0; i < 8; ++i) { const int q = t + 512 * i, half = q & 1, ti = q >> 1, ir = ti >> 6, j = ti & 63;
            *(LAS v4u*)(Ul + ir * 2064 + j * 32 + half * 16) = *(const v4u*)(P + (size_t)(b * SEQ + (32 * mt + ir) * 64 + j) * INW + COL_S + g * 16 + 8 * half); }
        { const v4u* src = (const v4u*)(F.ws + WS_LB + (size_t)(l * 64 + g) * LB_BYTES);
          for (int q = t; q < (int)(LB_BYTES / 16); q += 512) *(LAS v4u*)(Ll + q * 16) = src[q]; }
        { const int row = t >> 4, part = t & 15; *(LAS v4u*)(Sl + row * 272 + part * 16) = *(const v4u*)(SST + ((size_t)(g * 128 + b * 64 + 32 * mt + row)) * 128 + part * 8); }
        __syncthreads();
        const bf16* WoutT = wsb(F, WS_WOUTT) + (size_t)(l * 64 + g) * 131072;
#pragma unroll 1
        for (int q = 0; q < 4; ++q) { const int n = (q == 0) ? w : (q == 1) ? 15 - w : (q == 2) ? 16 + w : 31 - w;
            f32x16 acc;
#pragma unroll
            for (int e = 0; e < 16; ++e) acc[e] = 0.f;
#pragma unroll
            for (int ks = 0; ks < 8; ++ks) { const bf16x8 wf = *(const bf16x8*)(WoutT + (size_t)(32 * n + l31) * 128 + 16 * ks + 8 * h), sf = *(const LAS bf16x8*)(Sl + l31 * 272 + ks * 32 + h * 16);
                acc = __builtin_amdgcn_mfma_f32_32x32x16_bf16(wf, sf, acc, 0, 0, 0); }
            const LAS unsigned char* lbp = Ll + ((2 * n + 1 + (l31 >> 4)) * 2 + h) * 256 + (l31 & 15) * 16; const LAS unsigned char* ubp = Ul + l31 * 2064 + h * 16;
#pragma unroll 2
            for (int j = 0; j < 2 * n + 2; ++j) { const bf16x8 kf = *(const LAS bf16x8*)(lbp - j * 512), uf = *(const LAS bf16x8*)(ubp + j * 32); acc = __builtin_amdgcn_mfma_f32_32x32x16_bf16(kf, uf, acc, 0, 0, 0); }
#pragma unroll
            for (int q4 = 0; q4 < 4; ++q4) { const int c0 = 8 * (q4 & 1) + 4 * h, tau = 2 * n + (q4 >> 1); const size_t tok = (size_t)b * SEQ + (32 * mt + l31) * 64 + tau;
                v2u wv; wv.x = cvt_pk_bf16(acc[4 * q4], acc[4 * q4 + 1]); wv.y = cvt_pk_bf16(acc[4 * q4 + 2], acc[4 * q4 + 3]); *(v2u*)(Y + tok * 1024 + g * 16 + c0) = wv; }
        }
        __syncthreads();
    }
}

constexpr int PH_PRO = 0, PH_SB0 = 1, PH_PER_SB = 6, N_SB = 3 * DEPTH, PH_FINAL = PH_SB0 + N_SB * PH_PER_SB, N_PH = PH_FINAL + 1;
struct Args { const float* in[N_IN]; float* out; unsigned char* ws; int ph_lo, ph_hi; };
static_assert(sizeof(Args) == N_IN * 8 + 8 + 8 + 8, "Args has no padding");

typedef __attribute__((address_space(4))) const Args* KArgs;
__device__ __forceinline__ KArgs kargs() { KArgs p = (KArgs)__builtin_amdgcn_kernarg_segment_ptr(); asm volatile("" : "+s"(p)); return p; }
#define AIN(i) (kargs()->in[i])
__global__ void __launch_bounds__(NWAVES * 64, 2) fwd(Args args_unused) {
    extern __shared__ __attribute__((aligned(16))) unsigned char lds[];
    Frame F;
    F.lds = (LAS unsigned char*)lds;
    F.tid = threadIdx.x; F.lane = F.tid & 63; F.wave = __builtin_amdgcn_readfirstlane(F.tid >> 6); F.G = gridDim.x;
    F.ws = kargs()->ws;
    const int lo = kargs()->ph_lo, hi = kargs()->ph_hi;
    volatile LAS unsigned* MISC = (volatile LAS unsigned*)(F.lds + MISC_OFF);
    for (int u = F.tid; u < (LDS_BYTES - LDSCTL_OFF) / 4; u += NWAVES * 64) ((LAS unsigned*)(F.lds + LDSCTL_OFF))[u] = 0u;
    __syncthreads();
    unsigned* barw = (unsigned*)(F.ws + WS_CTL) + CW_BAR;
    XcdBarrier bar; bar.bar = barw; bar.x = 0; bar.st = nullptr;
    if (hi - lo > 1) bar = xcd_barrier_post(barw, MISC + 8);
#define IN(p) (lo <= (p) && (p) < hi)
#define FRESH() do { int t_ = threadIdx.x; asm volatile("" : "+v"(t_)); F.tid = t_; F.lane = t_ & 63; F.wave = __builtin_amdgcn_readfirstlane(t_ >> 6); unsigned char* w_ = kargs()->ws; F.ws = w_; } while (0)
#define SEAM(p, q) do { if (IN(p) && (q) < hi) xcd_barrier(bar); } while (0)

    if (IN(PH_PRO) && EN_PRO) { FRESH(); const ProIn I{AIN(I_F1WI), AIN(I_F2WI), AIN(I_F1WO), AIN(I_F2WO), AIN(I_WIN), AIN(I_WMKV), AIN(I_WGLU), AIN(I_WSWA), AIN(I_WMEMUP), AIN(I_WOUT), AIN(I_MEM), AIN(I_MEMN)}; prologue(F, I);
        const SsmIn I0{AIN(I_LRE), AIN(I_LIM), AIN(I_LDT), AIN(I_BRE), AIN(I_BIM), AIN(I_CRE), AIN(I_CIM), AIN(I_DSK)}; ssm_tables(F, I0); }
    SEAM(PH_PRO, PH_SB0);

    for (int sb = 0; sb < N_SB; ++sb) {
        const int l = sb / 3, ty = sb % 3, pb = PH_SB0 + sb * PH_PER_SB;
        if (pb + PH_PER_SB <= lo || pb >= hi) continue;
#define HIN() ((sb == 0) ? AIN(I_X) : (const float*)(F.ws + WS_H))
#define WL() (F.ws + WS_W + (size_t)l * W_LAYER)
        if (IN(pb) && EN_NORM) { FRESH(); const float* gain = (ty == 0 ? AIN(I_F1N) : ty == 1 ? AIN(I_MIXN) : AIN(I_F2N)) + (size_t)l * DM; norm_phase<false>(F, HIN(), gain, F.ws + WS_XN); }
        SEAM(pb, pb + 1);
        if (ty != 1) {
            if (IN(pb + 1) && EN_G1) { FRESH();
                pg8::SchedTiles S{(const char*)(F.ws + WS_XN), (const char*)(WL() + (ty == 0 ? WO_1IN : WO_2IN)), (size_t)256 * DM * 2, T / 256, 2 * DFF / 256, F.G, (int)blockIdx.x};
                pg8::EpiSwiGLU E{wsb(F, WS_HID), DFF};
                pg8::gemm_phase<pg8::EpiSwiGLU, pg8::SchedTiles, true, true>(F.lds + RING_OFF, DM, S, E);
            }
            SEAM(pb + 1, pb + 5);
        } else {
            if (IN(pb + 1) && EN_G3) { FRESH();
                pg8::SchedProj S{(const char*)(F.ws + WS_XN), (const char*)(WL() + WO_IN), (const char*)(F.ws + WS_MEMN + (size_t)l * 512 * DM * 2), (const char*)(WL() + WO_MKV), (size_t)256 * DM * 2, T / 256, INW / 256, F.G, (int)blockIdx.x};
                pg8::EpiProj E{wsb(F, WS_PROJ), INW, COL_G / 256, wsb(F, WS_MKV), 2048};
                pg8::gemm_phase<pg8::EpiProj, pg8::SchedProj, true, true>(F.lds + RING_OFF, DM, S, E);
            }
            SEAM(pb + 1, pb + 2);
            if (IN(pb + 2) && EN_M1) for (int rep_ = 0; rep_ < REP_M; ++rep_) { FRESH(); swa_mfma(F, AIN(I_SINK) + l * 16); memattn_mfma(F);
                const SsmIn I{AIN(I_LRE) + l * 4096, AIN(I_LIM) + l * 4096, AIN(I_LDT) + l * 64, AIN(I_BRE) + l * 65536, AIN(I_BIM) + l * 65536, AIN(I_CRE) + l * 65536, AIN(I_CIM) + l * 65536, AIN(I_DSK) + l * 1024}; ssm_s1(F, I, l); }
            SEAM(pb + 2, pb + 3);
            if (IN(pb + 3) && EN_M2) for (int rep_ = 0; rep_ < REP_M; ++rep_) { FRESH(); const SsmIn I{AIN(I_LRE) + l * 4096, AIN(I_LIM) + l * 4096, AIN(I_LDT) + l * 64, AIN(I_BRE) + l * 65536, AIN(I_BIM) + l * 65536, AIN(I_CRE) + l * 65536, AIN(I_CIM) + l * 65536, AIN(I_DSK) + l * 1024}; (void)I; ssm_s2(F, l); }
            SEAM(pb + 3, pb + 4);
            if (IN(pb + 4) && EN_G4) { FRESH();
                pg8::SchedMix S{(const char*)(F.ws + WS_OSWA), (const char*)(F.ws + WS_OMEM), (const char*)(F.ws + WS_YS), (const char*)(WL() + WO_SWA), (const char*)(WL() + WO_MEM), (const char*)(WL() + WO_GLU), (size_t)256 * 1024 * 2, T / 256, DM / 256, F.G, (int)blockIdx.x};
                pg8::EpiMix E{(float*)(F.ws + WS_T32), wsb(F, WS_MG), wsb(F, WS_PROJ) + COL_G, INW};
                pg8::gemm_phase<pg8::EpiMix, pg8::SchedMix, true, true>(F.lds + RING_OFF, 1024, S, E);
            }
            SEAM(pb + 4, pb + 5);
        }
        if (IN(pb + 5) && EN_GR) { FRESH();
            const int K = (ty == 1) ? DM : DFF;
            pg8::SchedTiles S{(const char*)(F.ws + (ty == 1 ? WS_MG : WS_HID)), (const char*)(WL() + (ty == 0 ? WO_1OUT : ty == 1 ? WO_OUT : WO_2OUT)), (size_t)256 * K * 2, T / 256, DM / 256, F.G, (int)blockIdx.x};
            pg8::EpiResid E{HIN(), (float*)(F.ws + WS_H), ty == 1 ? 1.0f : 0.5f, DM};
            pg8::gemm_phase<pg8::EpiResid, pg8::SchedTiles, true, true>(F.lds + RING_OFF, K, S, E);
        }
        SEAM(pb + 5, pb + 6);
    }
    if (IN(PH_FINAL)) { FRESH(); norm_phase<true>(F, (const float*)(F.ws + WS_H), AIN(I_FINN), kargs()->out); }
#undef IN
#undef SEAM
}

static bool phase_valid(int p) {
    if (p == PH_PRO || p == PH_FINAL) return true;
    const int sb = (p - PH_SB0) / PH_PER_SB, k = (p - PH_SB0) % PH_PER_SB;
    return (sb % 3 == 1) || k == 0 || k == 1 || k == 5;
}
extern "C" void kernel_launch(void* const* d_in, const int* in_sizes, int n_in, void* d_out, int out_size, void* d_ws, size_t ws_size, hipStream_t stream) {
    static int grid = 0;
    if (grid == 0) {
        if (n_in != N_IN || in_sizes[0] != T * DM || out_size != T * DM || ws_size < WS_END) { fprintf(stderr, "kernel_launch: unexpected shapes: n_in %d in0 %d out %d ws %zu (need %zu); nothing launched\n", n_in, n_in > 0 ? in_sizes[0] : -1, out_size, ws_size, (size_t)WS_END); grid = -1; return; }
        int dev = 0, cus = 0, per_cu = 0;
        if (hipGetDevice(&dev) != hipSuccess || hipDeviceGetAttribute(&cus, hipDeviceAttributeMultiprocessorCount, dev) != hipSuccess) { fprintf(stderr, "kernel_launch: device query failed\n"); grid = -1; return; }
        if (hipFuncSetAttribute((const void*)fwd, hipFuncAttributeMaxDynamicSharedMemorySize, LDS_BYTES) != hipSuccess) { fprintf(stderr, "kernel_launch: hipFuncSetAttribute failed\n"); grid = -1; return; }
        if (hipOccupancyMaxActiveBlocksPerMultiprocessor(&per_cu, (const void*)fwd, NWAVES * 64, LDS_BYTES) != hipSuccess || per_cu < 1) fprintf(stderr, "kernel_launch: note: occupancy query reports %d workgroups per CU\n", per_cu);
        (void)hipGetLastError();
        grid = cus;
    }
    if (grid < 0) return;
    if (hipMemsetAsync((char*)d_ws + WS_CTL, 0, CTL_ZERO_BYTES, stream) != hipSuccess) { fprintf(stderr, "kernel_launch: memset failed\n"); return; }
    Args a{};
    for (int i = 0; i < N_IN; ++i) a.in[i] = (const float*)d_in[i];
    a.out = (float*)d_out; a.ws = (unsigned char*)d_ws;
#if ONE_LAUNCH
    a.ph_lo = 0; a.ph_hi = N_PH;
    hipLaunchKernelGGL(fwd, dim3(grid), dim3(NWAVES * 64), LDS_BYTES, stream, a);
#else
    for (int p = 0; p < N_PH; ++p) { if (!phase_valid(p)) continue; a.ph_lo = p; a.ph_hi = p + 1; hipLaunchKernelGGL(fwd, dim3(grid), dim3(NWAVES * 64), LDS_BYTES, stream, a); }
#endif
    const hipError_t le = hipPeekAtLastError();
    if (le != hipSuccess) fprintf(stderr, "kernel_launch: launch failed: %s\n", hipGetErrorName(le));
}
```

```cpp
#include <hip/hip_runtime.h>
#include <cstdio>
#include <cstdint>

#ifndef EN_PRO
#define EN_PRO 1
#endif
#ifndef EN_NORM
#define EN_NORM 1
#endif
#ifndef EN_G1
#define EN_G1 1
#endif
#ifndef EN_G3
#define EN_G3 1
#endif
#ifndef EN_M1
#define EN_M1 1
#endif
#ifndef EN_M2
#define EN_M2 1
#endif
#ifndef EN_G4
#define EN_G4 1
#endif
#ifndef EN_GR
#define EN_GR 1
#endif
#ifndef REP_M
#define REP_M 1
#endif
#ifndef REP_PRO
#define REP_PRO 1
#endif
#ifndef REP_NORM
#define REP_NORM 1
#endif
#ifndef REP_G1
#define REP_G1 1
#endif
#ifndef REP_G3
#define REP_G3 1
#endif
#ifndef REP_G4
#define REP_G4 1
#endif
#ifndef REP_GR
#define REP_GR 1
#endif
#ifndef ONE_LAUNCH
#define ONE_LAUNCH 1
#endif

namespace pg8 {
#define PG8_LAS __attribute__((address_space(3)))
typedef unsigned short bf16_t;
typedef short bf16x8 __attribute__((ext_vector_type(8)));
typedef float f32x4 __attribute__((ext_vector_type(4)));
typedef unsigned u32x4 __attribute__((ext_vector_type(4)));
constexpr int BM = 256, BK = 64, HALF = 128, HTB = HALF * BK * 2  , STAGE_BYTES = 8 * HTB, NXCD = 8, WGM = 8;

__host__ __device__ __forceinline__ int lds_byte(int r, int c) { const int st = (r >> 4) * 2 + (c >> 5), rr = r & 15, cc = c & 31, ob = rr * 64 + cc * 2; return st * 1024 + (ob ^ (((ob >> 9) & 1) << 5)); }
__host__ __device__ __forceinline__ void stage_rc(int b, int& R, int& C) { const int st = b / 1024, sb = b % 1024, swz = sb ^ (((sb >> 9) & 1) << 5); R = (st >> 1) * 16 + swz / 64; C = (st & 1) * 32 + (swz % 64) / 2; }
__host__ __device__ __forceinline__ int perm32(int rho) { const int n = rho >> 4, i = rho & 15; return 8 * (i >> 2) + 4 * n + (i & 3); }


struct Unit { int pm, pn, kind; };

__device__ __forceinline__ unsigned cvt_pk_bf16(float lo, float hi) { unsigned r; asm volatile("v_cvt_pk_bf16_f32 %0, %1, %2" : "=v"(r) : "v"(lo), "v"(hi)); return r; }
__device__ __forceinline__ float bf_lo(unsigned u) { return __uint_as_float(u << 16); }
__device__ __forceinline__ float bf_hi(unsigned u) { return __uint_as_float(u & 0xffff0000u); }
__device__ __forceinline__ float sigmoidf_fast(float x) { return __builtin_amdgcn_rcpf(1.0f + __builtin_amdgcn_exp2f(-1.4426950408889634f * x)); }

__device__ __forceinline__ void tile_of(int L, int nM, int nN, int& pm, int& pn) {
    const int nwg = nM * nN; int wgid = L; { const int q = nwg / NXCD, r = nwg % NXCD, xcd = wgid % NXCD, off = wgid / NXCD; wgid = (xcd < r ? xcd * (q + 1) : r * (q + 1) + (xcd - r) * q) + off; }
    const int nig = WGM * nN, gid = wgid / nig, fm = gid * WGM, gsz = (nM - fm) < WGM ? (nM - fm) : WGM;
    pm = fm + ((wgid % nig) % gsz); pn = (wgid % nig) / gsz;
}

struct SchedTiles {
    const char* A; const char* Bt; size_t tstep; int nM, nN, G, c;
    __device__ __forceinline__ bool next(int i, Unit& u) const { const int L = i * G + c; if (L >= nM * nN) return false; tile_of(L, nM, nN, u.pm, u.pn); u.kind = 0; return true; }
    __device__ __forceinline__ void operands(const Unit& u, const char*& a, const char*& b) const { a = A + (size_t)u.pm * tstep; b = Bt + (size_t)u.pn * tstep; }
    __device__ __forceinline__ void a_ready(const Unit&) const {}
    __device__ __forceinline__ void done(const Unit&) const {}
};
struct SchedProj {
    const char* A; const char* Bt; const char* A2; const char* Bt2; size_t tstep; int nM, nN, G, c;
    __device__ __forceinline__ bool next(int i, Unit& u) const { const int L = i * G + c, nwg = nM * nN; if (L < nwg) { tile_of(L, nM, nN, u.pm, u.pn); u.kind = 0; return true; }
        if (L < nwg + 16) { const int j = L - nwg; u.pm = j & 1; u.pn = j >> 1; u.kind = 1; return true; } return false; }
    __device__ __forceinline__ void operands(const Unit& u, const char*& a, const char*& b) const { a = (u.kind ? A2 : A) + (size_t)u.pm * tstep; b = (u.kind ? Bt2 : Bt) + (size_t)u.pn * tstep; }
    __device__ __forceinline__ void a_ready(const Unit&) const {}
    __device__ __forceinline__ void done(const Unit&) const {}
};
struct SchedMix {
    const char* Aswa; const char* Amem; const char* Ays; const char* Bswa; const char* Bmem; const char* Bglu; size_t tstep; int nM, nN, G, c;
    __device__ __forceinline__ bool next(int i, Unit& u) const { const int L = (i >> 2) * G + c; if (L >= nM * nN) return false; tile_of(L, nM, nN, u.pm, u.pn); u.kind = i & 3; return true; }
    __device__ __forceinline__ void operands(const Unit& u, const char*& a, const char*& b) const {
        if (u.kind == 0) { a = Aswa + (size_t)u.pm * tstep; b = Bswa + (size_t)u.pn * tstep; }
        else if (u.kind == 1) { a = Amem + (size_t)u.pm * tstep; b = Bmem + (size_t)u.pn * tstep; }
        else { a = Ays + (size_t)u.pm * tstep; b = Bglu + (size_t)(2 * u.pn + (u.kind - 2)) * tstep; } }
    __device__ __forceinline__ void a_ready(const Unit&) const {}
    __device__ __forceinline__ void done(const Unit&) const {}
};

__device__ __forceinline__ float row_rstd(const float* SSQ, size_t row, int fq) {
    const f32x4* q = (const f32x4*)(SSQ + row * 32 + 8 * fq); const f32x4 a = q[0], b = q[1];
    float s = ((a[0] + a[1]) + (a[2] + a[3])) + ((b[0] + b[1]) + (b[2] + b[3])); s += __shfl_xor(s, 16); s += __shfl_xor(s, 32);
    return 1.0f / sqrtf(s * (1.0f / 2048.0f) + 1e-5f);
}
struct RstdTab { const PG8_LAS float* tab; int pm0; const float* SSQ;
    __device__ __forceinline__ float get(const Unit& u, int rowin, int fq) const { const float r = tab[rowin]; return (u.pm == pm0) ? r : __builtin_nanf(""); } };
struct EpiSwiGLU {
    static constexpr bool PERM = true, AFTER_DRAIN = false;
    bf16_t* O; int ldo; RstdTab R;
    __device__ __forceinline__ void operator()(const f32x4 (&acc)[2][2][4][2], const Unit& u, int wr, int wc, int fr, int fq) const {
        const int row0 = u.pm * BM + wr * 64 + fr, col0 = u.pn * HALF + wc * 32 + 8 * fq;
#pragma unroll
        for (int ai = 0; ai < 2; ++ai)
#pragma unroll
            for (int m = 0; m < 4; ++m) { bf16_t* rowp = O + (size_t)(row0 + ai * HALF + m * 16) * ldo + col0; float o[8]; const float rs = R.get(u, wr * 64 + fr + ai * HALF + m * 16, fq);
#pragma unroll
                for (int n = 0; n < 2; ++n)
#pragma unroll
                    for (int e = 0; e < 4; ++e) { const float g = acc[ai][0][m][n][e] * rs, uu = acc[ai][1][m][n][e] * rs; o[4 * n + e] = g * sigmoidf_fast(g) * uu; }
                u32x4 w; w.x = cvt_pk_bf16(o[0], o[1]); w.y = cvt_pk_bf16(o[2], o[3]); w.z = cvt_pk_bf16(o[4], o[5]); w.w = cvt_pk_bf16(o[6], o[7]);
                *(u32x4*)rowp = w; }
    }
};
struct EpiResid {
    static constexpr bool PERM = false, AFTER_DRAIN = false;
    const float* X0; float alpha; int ldc; bf16_t* HB; float* SSQ; bf16_t* HBout;
    __device__ __forceinline__ void operator()(const f32x4 (&acc)[2][2][4][2], const Unit& u, int wr, int wc, int fr, int fq) const {
        const int row0 = u.pm * BM + wr * 64 + fr, col0 = u.pn * BM + wc * 32 + 4 * fq;
#pragma unroll
        for (int ai = 0; ai < 2; ++ai)
#pragma unroll
            for (int m = 0; m < 4; ++m) { const size_t off = (size_t)(row0 + ai * HALF + m * 16) * ldc + col0;
                float ss = 0.f;
#pragma unroll
                for (int bj = 0; bj < 2; ++bj)
#pragma unroll
                    for (int n = 0; n < 2; ++n) { typedef unsigned u32x2 __attribute__((ext_vector_type(2))); f32x4 b;
                        if (X0) b = *(const f32x4*)(X0 + off + bj * HALF + n * 16); else { const u32x2 hw = *(const u32x2*)(HB + off + bj * HALF + n * 16); b = (f32x4){bf_lo(hw.x), bf_hi(hw.x), bf_lo(hw.y), bf_hi(hw.y)}; }
                        const f32x4 v = b + acc[ai][bj][m][n] * alpha;
                        ss += (v[0] * v[0] + v[1] * v[1]) + (v[2] * v[2] + v[3] * v[3]);
                        u32x2 w; w.x = cvt_pk_bf16(v[0], v[1]); w.y = cvt_pk_bf16(v[2], v[3]); *(u32x2*)(HBout + off + bj * HALF + n * 16) = w; }
                ss += __shfl_xor(ss, 16); ss += __shfl_xor(ss, 32);
                if (fq == 0) SSQ[(size_t)(row0 + ai * HALF + m * 16) * 32 + u.pn * 4 + wc] = ss; }
    }
};
struct EpiProj {
    static constexpr bool PERM = true, AFTER_DRAIN = false;
    bf16_t* P; int ldp; int sig_from; bf16_t* KV; int ldk; RstdTab R;
    __device__ __forceinline__ void operator()(const f32x4 (&acc)[2][2][4][2], const Unit& u, int wr, int wc, int fr, int fq) const {
        const int row0 = u.pm * BM + wr * 64 + fr, col0 = u.pn * BM + wc * 32 + 8 * fq;
        bf16_t* base = u.kind ? KV : P; const int ld = u.kind ? ldk : ldp; const bool sig = (u.kind == 0) && (u.pn >= sig_from);
#pragma unroll
        for (int ai = 0; ai < 2; ++ai)
#pragma unroll
            for (int m = 0; m < 4; ++m) { bf16_t* rowp = base + (size_t)(row0 + ai * HALF + m * 16) * ld + col0; const float rs = u.kind ? 1.0f : R.get(u, wr * 64 + fr + ai * HALF + m * 16, fq);
#pragma unroll
                for (int bj = 0; bj < 2; ++bj) { f32x4 v0 = acc[ai][bj][m][0] * rs, v1 = acc[ai][bj][m][1] * rs;
                    if (sig) {
#pragma unroll
                        for (int e = 0; e < 4; ++e) { v0[e] = sigmoidf_fast(v0[e]); v1[e] = sigmoidf_fast(v1[e]); } }
                    u32x4 w; w.x = cvt_pk_bf16(v0[0], v0[1]); w.y = cvt_pk_bf16(v0[2], v0[3]); w.z = cvt_pk_bf16(v1[0], v1[1]); w.w = cvt_pk_bf16(v1[2], v1[3]);
                    *(u32x4*)(rowp + bj * HALF) = w; } }
    }
};
struct EpiMix {
    static constexpr bool PERM = true, AFTER_DRAIN = false;
    float* T32; bf16_t* MG; const bf16_t* Gt; int ldg;
    __device__ __forceinline__ void operator()(const f32x4 (&acc)[2][2][4][2], const Unit& u, int wr, int wc, int fr, int fq) const {
        const int row0 = u.pm * BM + wr * 64 + fr, cw = wc * 32 + 8 * fq;
        if (u.kind < 2) {
            const int gsel = u.kind == 0 ? 0 : 4096;
#pragma unroll
            for (int ai = 0; ai < 2; ++ai)
#pragma unroll
                for (int m = 0; m < 4; ++m) { const size_t row = (size_t)(row0 + ai * HALF + m * 16);
#pragma unroll
                    for (int bj = 0; bj < 2; ++bj) { const int col = u.pn * BM + bj * HALF + cw;
                        const u32x4 gw = *(const u32x4*)(Gt + row * ldg + gsel + col);
                        f32x4 g0 = {bf_lo(gw.x), bf_hi(gw.x), bf_lo(gw.y), bf_hi(gw.y)}, g1 = {bf_lo(gw.z), bf_hi(gw.z), bf_lo(gw.w), bf_hi(gw.w)};
                        f32x4 t0 = acc[ai][bj][m][0] * g0, t1 = acc[ai][bj][m][1] * g1; float* tp = T32 + row * 2048 + col;
                        if (u.kind == 1) { t0 += *(const f32x4*)tp; t1 += *(const f32x4*)(tp + 4); }
                        *(f32x4*)tp = t0; *(f32x4*)(tp + 4) = t1; } }
        } else {
            const int col = u.pn * BM + (u.kind - 2) * HALF + cw;
#pragma unroll
            for (int ai = 0; ai < 2; ++ai)
#pragma unroll
                for (int m = 0; m < 4; ++m) { const size_t row = (size_t)(row0 + ai * HALF + m * 16);
                    const u32x4 gw = *(const u32x4*)(Gt + row * ldg + 2048 + col);
                    const float gg[8] = {bf_lo(gw.x), bf_hi(gw.x), bf_lo(gw.y), bf_hi(gw.y), bf_lo(gw.z), bf_hi(gw.z), bf_lo(gw.w), bf_hi(gw.w)};
                    const float* tp = T32 + row * 2048 + col; const f32x4 t0 = *(const f32x4*)tp, t1 = *(const f32x4*)(tp + 4); float o[8];
#pragma unroll
                    for (int n = 0; n < 2; ++n)
#pragma unroll
                        for (int e = 0; e < 4; ++e) { const float ga = acc[ai][0][m][n][e], gb = acc[ai][1][m][n][e]; o[4 * n + e] = (n ? t1[e] : t0[e]) + gg[4 * n + e] * ga * sigmoidf_fast(gb); }
                    u32x4 w; w.x = cvt_pk_bf16(o[0], o[1]); w.y = cvt_pk_bf16(o[2], o[3]); w.z = cvt_pk_bf16(o[4], o[5]); w.w = cvt_pk_bf16(o[6], o[7]);
                    *(u32x4*)(MG + row * 2048 + col) = w; }
        }
    }
};

template <class Epi, class Sched, bool ALIGN_EPI = false, bool SP2 = false>
__device__ __forceinline__ void gemm_phase(PG8_LAS unsigned char* lds, const int K, const Sched& S, const Epi& E) {
    int tid_ = threadIdx.x; asm volatile("" : "+v"(tid_));
    const int tid = tid_, wid = __builtin_amdgcn_readfirstlane(tid >> 6), lane = tid & 63, wr = wid >> 2, wc = wid & 3, fr = lane & 15, fq = lane >> 4;
    const int nt = K / BK;
    unsigned voffA[2], voffB[2];
#pragma unroll
    for (int i = 0; i < 2; ++i) { int R, C; stage_rc(tid * 16 + i * 8192, R, C); const int Rb = Epi::PERM ? ((R & ~31) + perm32(R & 31)) : R;
        voffA[i] = (unsigned)(R * K + C) * 2u; voffB[i] = (unsigned)(Rb * K + C) * 2u; }
    const size_t kstep = (size_t)(BK * 2);
    const size_t hstep = (size_t)HALF * K * 2;
    const unsigned ldsw = (unsigned)wid * 1024u;
    const int aoff = lds_byte(wr * 64 + fr, fq * 8), boff = lds_byte(wc * 32 + fr, fq * 8);
#define PG8_SA(b, h) (((b) * 2 + (h)) * HTB)
#define PG8_SB(b, h) ((4 + (b) * 2 + (h)) * HTB)
#define PG8_STAGE(bufoff, gbase, voff) do { _Pragma("unroll") for (int _i = 0; _i < 2; ++_i) \
        __builtin_amdgcn_global_load_lds((const unsigned*)((const char*)(gbase) + (voff)[_i]), (PG8_LAS unsigned*)(lds + (bufoff) + ldsw + _i * 8192), 16, 0, 0); } while (0)
#define PG8_LDA(dst, b, h) do { _Pragma("unroll") for (int m = 0; m < 4; ++m) _Pragma("unroll") for (int k = 0; k < 2; ++k) dst[m][k] = *(const PG8_LAS bf16x8*)(lds + PG8_SA(b, h) + aoff + m * 2048 + k * 1024); } while (0)
#define PG8_LDB(dst, b, h) do { _Pragma("unroll") for (int n = 0; n < 2; ++n) _Pragma("unroll") for (int k = 0; k < 2; ++k) dst[n][k] = *(const PG8_LAS bf16x8*)(lds + PG8_SB(b, h) + boff + n * 2048 + k * 1024); } while (0)
#define PG8_MMA(ai, bj, At, Bt) do { __builtin_amdgcn_s_setprio(1); _Pragma("unroll") for (int m = 0; m < 4; ++m) _Pragma("unroll") for (int n = 0; n < 2; ++n) _Pragma("unroll") for (int k = 0; k < 2; ++k) \
        acc[ai][bj][m][n] = __builtin_amdgcn_mfma_f32_16x16x32_bf16(Bt[n][k], At[m][k], acc[ai][bj][m][n], 0, 0, 0); __builtin_amdgcn_s_setprio(0); } while (0)
#define PG8_WAIT_V(n) asm volatile("s_waitcnt vmcnt(" #n ")" ::: "memory")
#define PG8_WAIT_L(n) asm volatile("s_waitcnt lgkmcnt(" #n ")" ::: "memory")
#define PG8_BAR __builtin_amdgcn_s_barrier()
#define PG8_SCHED __builtin_amdgcn_sched_barrier(0)
    Unit cur, nxt; int ui = 0;
    if (!S.next(0, cur)) return;
    f32x4 acc[2][2][4][2];
#pragma unroll
    for (int a = 0; a < 2; ++a)
#pragma unroll
        for (int b = 0; b < 2; ++b)
#pragma unroll
            for (int m = 0; m < 4; ++m)
#pragma unroll
                for (int n = 0; n < 2; ++n) acc[a][b][m][n] = (f32x4){0.f, 0.f, 0.f, 0.f};
    bf16x8 At[4][2], B0[2][2], B1[2][2];
    const char* cA; const char* cB; S.operands(cur, cA, cB);
    S.a_ready(cur);
    if constexpr (SP2) {
        PG8_STAGE(PG8_SB(0, 0), cB, voffB); PG8_STAGE(PG8_SB(0, 1), cB + hstep, voffB); PG8_STAGE(PG8_SA(0, 0), cA, voffA); PG8_STAGE(PG8_SA(0, 1), cA + hstep, voffA);
        if (wr == 1) PG8_BAR;
        PG8_WAIT_V(2); PG8_BAR;
        PG8_STAGE(PG8_SB(1, 0), cB + kstep, voffB); PG8_STAGE(PG8_SA(1, 0), cA + kstep, voffA); PG8_STAGE(PG8_SB(1, 1), cB + hstep + kstep, voffB);
        PG8_WAIT_V(6); PG8_BAR;
    } else {
        PG8_STAGE(PG8_SB(0, 0), cB, voffB); PG8_STAGE(PG8_SA(0, 0), cA, voffA); PG8_STAGE(PG8_SB(0, 1), cB + hstep, voffB); PG8_STAGE(PG8_SA(0, 1), cA + hstep, voffA);
        if (wr == 1) PG8_BAR;
        PG8_WAIT_V(4); PG8_BAR;
        PG8_STAGE(PG8_SB(1, 0), cB + kstep, voffB); PG8_STAGE(PG8_SA(1, 0), cA + kstep, voffA); PG8_STAGE(PG8_SB(1, 1), cB + hstep + kstep, voffB);
        PG8_WAIT_V(6); PG8_BAR;
    }
    for (;;) {
        const bool has_next = S.next(ui + 1, nxt);
        const char* nA = cA; const char* nB = cB; if (has_next) S.operands(nxt, nA, nB);
        for (int t = 0; t < nt; t += 2) {
            const bool last = (t == nt - 2);
            const char* a1 = cA + (size_t)(t + 1) * kstep;
            const char* a2 = last ? nA : cA + (size_t)(t + 2) * kstep; const char* b2 = last ? nB : cB + (size_t)(t + 2) * kstep;
            const char* a3 = a2 + kstep; const char* b3 = b2 + kstep;
            if (last && has_next) S.a_ready(nxt);
            if constexpr (SP2) {
            PG8_LDB(B0, 0, 0); PG8_LDB(B1, 0, 1); PG8_SCHED; PG8_LDA(At, 0, 0); PG8_STAGE(PG8_SA(1, 1), a1 + hstep, voffA);
            PG8_WAIT_V(8); PG8_WAIT_L(0); PG8_BAR; PG8_MMA(0, 0, At, B0); PG8_MMA(0, 1, At, B1); PG8_BAR; PG8_SCHED;
            PG8_LDA(At, 0, 1); PG8_STAGE(PG8_SB(0, 0), b2, voffB); PG8_STAGE(PG8_SB(0, 1), b2 + hstep, voffB); PG8_STAGE(PG8_SA(0, 0), a2, voffA);
            PG8_WAIT_V(8); PG8_WAIT_L(0); PG8_BAR; PG8_MMA(1, 0, At, B0); PG8_MMA(1, 1, At, B1); PG8_BAR; PG8_SCHED;
            PG8_LDB(B0, 1, 0); PG8_LDB(B1, 1, 1); PG8_SCHED; PG8_LDA(At, 1, 0); PG8_STAGE(PG8_SA(0, 1), a2 + hstep, voffA);
            PG8_WAIT_V(8); PG8_WAIT_L(0); PG8_BAR; PG8_MMA(0, 0, At, B0); PG8_MMA(0, 1, At, B1); PG8_BAR; PG8_SCHED;
            PG8_LDA(At, 1, 1); PG8_STAGE(PG8_SB(1, 0), b3, voffB); PG8_STAGE(PG8_SB(1, 1), b3 + hstep, voffB); PG8_STAGE(PG8_SA(1, 0), a3, voffA);
            PG8_WAIT_V(8); PG8_WAIT_L(0); PG8_BAR; PG8_MMA(1, 0, At, B0); PG8_MMA(1, 1, At, B1); PG8_BAR; PG8_SCHED;
            } else {
            PG8_LDB(B0, 0, 0); PG8_SCHED; PG8_LDA(At, 0, 0); PG8_STAGE(PG8_SA(1, 1), a1 + hstep, voffA);
            PG8_WAIT_L(8); PG8_BAR; PG8_WAIT_L(0); PG8_MMA(0, 0, At, B0); PG8_BAR; PG8_SCHED;
            PG8_LDB(B1, 0, 1); PG8_STAGE(PG8_SB(0, 0), b2, voffB);
            PG8_BAR; PG8_WAIT_L(0); PG8_MMA(0, 1, At, B1); PG8_BAR;
            PG8_LDA(At, 0, 1); PG8_STAGE(PG8_SA(0, 0), a2, voffA);
            PG8_BAR; PG8_WAIT_L(0); PG8_MMA(1, 0, At, B0); PG8_BAR; PG8_SCHED;
            PG8_STAGE(PG8_SB(0, 1), b2 + hstep, voffB);
            PG8_WAIT_V(6); PG8_BAR; PG8_MMA(1, 1, At, B1); PG8_BAR;
            PG8_LDB(B0, 1, 0); PG8_SCHED; PG8_LDA(At, 1, 0); PG8_STAGE(PG8_SA(0, 1), a2 + hstep, voffA);
            PG8_WAIT_L(8); PG8_BAR; PG8_WAIT_L(0); PG8_MMA(0, 0, At, B0); PG8_BAR; PG8_SCHED;
            PG8_LDB(B1, 1, 1); PG8_STAGE(PG8_SB(1, 0), b3, voffB);
            PG8_BAR; PG8_WAIT_L(0); PG8_MMA(0, 1, At, B1); PG8_BAR;
            PG8_LDA(At, 1, 1); PG8_STAGE(PG8_SA(1, 0), a3, voffA);
            PG8_BAR; PG8_WAIT_L(0); PG8_MMA(1, 0, At, B0); PG8_BAR; PG8_SCHED;
            PG8_STAGE(PG8_SB(1, 1), b3 + hstep, voffB);
            PG8_WAIT_V(6); PG8_BAR; PG8_MMA(1, 1, At, B1); PG8_BAR;
            }
        }
        if constexpr (ALIGN_EPI) { if (wr == 0) PG8_BAR; }
        if constexpr (!Epi::AFTER_DRAIN) { E(acc, cur, wr, wc, fr, fq); S.done(cur); }
        if (!has_next) break;
#pragma unroll
        for (int a = 0; a < 2; ++a)
#pragma unroll
            for (int b = 0; b < 2; ++b)
#pragma unroll
                for (int m = 0; m < 4; ++m)
#pragma unroll
                    for (int n = 0; n < 2; ++n) acc[a][b][m][n] = (f32x4){0.f, 0.f, 0.f, 0.f};
        cur = nxt; cA = nA; cB = nB; ++ui;
        if constexpr (ALIGN_EPI) { if (wr == 1) PG8_BAR; }
    }
    PG8_WAIT_V(0);
    if constexpr (!ALIGN_EPI) { if (wr == 0) PG8_BAR; }
    PG8_BAR;
    if constexpr (Epi::AFTER_DRAIN) { E.fused(acc, cur, wr, wc, fr, fq, lds, wid, lane); S.done(cur); }
#undef PG8_SA
#undef PG8_SB
#undef PG8_STAGE
#undef PG8_LDA
#undef PG8_LDB
#undef PG8_MMA
#undef PG8_WAIT_V
#undef PG8_WAIT_L
#undef PG8_BAR
#undef PG8_SCHED
}
}

constexpr int BATCH = 2, SEQ = 4096, DM = 2048, DEPTH = 4, NMEM = 256, DFF = 5632;
constexpr int T = BATCH * SEQ;
constexpr int INW = 9728, COL_Q = 0, COL_K = 1024, COL_V = 1280, COL_S = 1536, COL_MQ = 2560, COL_G = 3584;
constexpr float RMS_EPS = 1e-5f, LOG2E = 1.4426950408889634f;
constexpr int NWAVES = 8;
enum { I_X = 0, I_MEM, I_F1N, I_F1WI, I_F1WO, I_MIXN, I_MEMN, I_WIN, I_SINK, I_WMKV, I_LRE, I_LIM, I_LDT, I_BRE, I_BIM, I_CRE, I_CIM, I_DSK, I_WGLU, I_WSWA, I_WMEMUP, I_WOUT, I_F2N, I_F2WI, I_F2WO, I_FINN, N_IN };

constexpr size_t MiB = 1u << 20;
constexpr size_t WS_CTL = 0, CTL_ZERO_BYTES = 1 * MiB;
constexpr size_t WS_W = 2 * MiB, W_LAYER = 202 * MiB;
constexpr size_t WO_1IN = 0, WO_1OUT = 44 * MiB, WO_IN = 66 * MiB, WO_MKV = 104 * MiB, WO_SWA = 112 * MiB, WO_MEM = 116 * MiB, WO_GLU = 120 * MiB, WO_OUT = 128 * MiB, WO_2IN = 136 * MiB, WO_2OUT = 180 * MiB;
constexpr size_t WS_MEMN = WS_W + DEPTH * W_LAYER;
constexpr size_t WS_H = WS_MEMN + 8 * MiB;
constexpr size_t WS_XN = WS_H + 64 * MiB;
constexpr size_t WS_HID = WS_XN + 32 * MiB;
constexpr size_t WS_PROJ = WS_HID + 88 * MiB;
constexpr size_t WS_MKV = WS_PROJ + 152 * MiB;
constexpr size_t WS_OSWA = WS_MKV + 2 * MiB, WS_YS = WS_OSWA + 16 * MiB, WS_OMEM = WS_YS + 16 * MiB;
constexpr size_t WS_T32 = WS_OMEM + 16 * MiB;
constexpr size_t WS_MG = WS_T32 + 64 * MiB;
constexpr size_t WS_SEND = WS_MG + 32 * MiB;
constexpr size_t LB_BYTES = 65 * 512;
constexpr size_t WS_LB = WS_SEND + 4 * MiB;
constexpr size_t WS_WINT = WS_LB + 9 * MiB;
constexpr size_t WS_WOUTT = WS_WINT + 64 * MiB;
constexpr size_t WS_SST = WS_WOUTT + 64 * MiB;
constexpr size_t WS_SSQ = WS_SST + 2 * MiB;
constexpr size_t WS_END = WS_SSQ + 1 * MiB;
static_assert(DEPTH * 64 * LB_BYTES <= 9 * MiB, "lag tables fit");
constexpr int CW_BAR = 4096;

constexpr int RING_OFF = 0, RING_BYTES = 131072;
constexpr int LDSCTL_OFF = RING_BYTES, MISC_OFF = LDSCTL_OFF + 320;
constexpr int LDS_BYTES = 147456;

#define GAS __attribute__((address_space(1)))
#define LAS __attribute__((address_space(3)))
typedef unsigned short bf16;
typedef unsigned v4u __attribute__((ext_vector_type(4)));
typedef unsigned v2u __attribute__((ext_vector_type(2)));
typedef float f32x4 __attribute__((ext_vector_type(4)));
typedef float f32x2 __attribute__((ext_vector_type(2)));
typedef GAS unsigned gu32;
using pg8::cvt_pk_bf16; using pg8::bf_lo; using pg8::bf_hi;

#define XB_TMO      128
#define XB_XCNT(j)  (256  + 64 * (j))
#define XB_XSUB(j)  (1280 + 64 * (j))
#define XB_XGEN(j)  (2304 + 64 * (j))
#define XB_TOP      3328
#define XB_TOPGEN   3392
#define XCD_BAR_WORDS 3456
#define XB_SPIN_CAP (1u << 18)

__device__ __forceinline__ unsigned xb_ld(unsigned* p)              { return __hip_atomic_load(p, __ATOMIC_RELAXED, __HIP_MEMORY_SCOPE_AGENT); }
__device__ __forceinline__ unsigned xb_add(unsigned* p, unsigned v) { return __hip_atomic_fetch_add(p, v, __ATOMIC_RELAXED, __HIP_MEMORY_SCOPE_AGENT); }
__device__ __forceinline__ unsigned xb_xcc_id() { return (unsigned)__builtin_amdgcn_s_getreg((3 << 11) | 20) & 0xFu; }
#define XB_SPIN(cond, bar) do { unsigned _sp = 0; while (cond) { __builtin_amdgcn_s_sleep(1); \
    if ((++_sp & 255u) == 0u) { if (xb_ld(&(bar)[XB_TMO])) break; if (_sp > XB_SPIN_CAP) { atomicAdd(&(bar)[XB_TMO], 1u); break; } } } } while (0)

struct XcdBarrier {
    unsigned* bar; unsigned x;
    volatile LAS unsigned* st;
};

__device__ __forceinline__ XcdBarrier xcd_barrier_post(unsigned* bar, volatile LAS unsigned* st) {
    XcdBarrier b; b.bar = bar; b.x = xb_xcc_id(); b.st = st;
    if (threadIdx.x == 0) (void)xb_add(&bar[XB_XCNT(b.x)], 1u);
    return b;
}
__device__ __forceinline__ void xcd_barrier_complete(unsigned* bar, unsigned x, unsigned& nloc, unsigned& nx) {
    const unsigned G = gridDim.x * gridDim.y * gridDim.z;
    unsigned sum, cnt, mine, sp = 0u;
    for (;;) {
        sum = 0u; cnt = 0u; mine = 0u;
#pragma unroll
        for (unsigned j = 0; j < 16; ++j) { const unsigned c = xb_ld(&bar[XB_XCNT(j)]); sum += c; cnt += (c > 0u) ? 1u : 0u; mine = (j == x) ? c : mine; }
        if (sum == G) break;
        __builtin_amdgcn_s_sleep(1);
        if ((++sp & 255u) == 0u) { if (xb_ld(&bar[XB_TMO])) break; if (sp > XB_SPIN_CAP) { atomicAdd(&bar[XB_TMO], 1u); break; } }
    }
    nloc = mine > 0u ? mine : 1u; nx = cnt > 0u ? cnt : 1u;
}

__device__ __forceinline__ void xcd_barrier(const XcdBarrier& b) {
    asm volatile("s_waitcnt vmcnt(0)" ::: "memory");
    __syncthreads();
    if (threadIdx.x == 0) {
        unsigned* bar = b.bar;
        __builtin_amdgcn_s_waitcnt(0);
        unsigned nloc = b.st[0], nx = b.st[1];
        if (nloc == 0u) { xcd_barrier_complete(bar, b.x, nloc, nx); b.st[0] = nloc; b.st[1] = nx; }
        const unsigned old = xb_add(&bar[XB_XSUB(b.x)], 1u);
        const unsigned gen = old / nloc;
        if (old + 1u == (gen + 1u) * nloc) {
            __builtin_amdgcn_fence(__ATOMIC_RELEASE, "agent");
            asm volatile("s_waitcnt vmcnt(0)" ::: "memory");
            const unsigned og = xb_add(&bar[XB_TOP], 1u);
            const unsigned tg = og / nx;
            if (og + 1u == (tg + 1u) * nx) xb_add(&bar[XB_TOPGEN], 1u);
            else XB_SPIN(xb_ld(&bar[XB_TOPGEN]) == tg, bar);
            __builtin_amdgcn_fence(__ATOMIC_ACQUIRE, "agent");
            xb_add(&bar[XB_XGEN(b.x)], 1u);
            asm volatile("s_waitcnt vmcnt(0)" ::: "memory");
        } else {
            XB_SPIN(xb_ld(&bar[XB_XGEN(b.x)]) == gen, bar);
            __builtin_amdgcn_fence(__ATOMIC_ACQUIRE, "agent");
            asm volatile("s_waitcnt vmcnt(0)" ::: "memory");
        }
    }
    __syncthreads();
}

struct Frame {
    LAS unsigned char* lds;
    int tid, lane, wave, G;
    unsigned char* ws;
};
__device__ __forceinline__ float wave_sum(float v) {
#pragma unroll
    for (int o = 1; o < 64; o <<= 1) v += __shfl_xor(v, o);
    return v;
}
__device__ __forceinline__ bf16* wsb(const Frame& F, size_t off) { return (bf16*)(F.ws + off); }

__device__ __forceinline__ void conv_block(const float* __restrict__ W, int K, int N, bf16* __restrict__ Wt, int kb, int nb, int pairNh, float scale, const float* __restrict__ gk, int lane) {
    const int k0 = kb * 64, n = nb * 64 + lane;
    const float* src = W + (size_t)k0 * N + n;
    float v[64];
#pragma unroll
    for (int i = 0; i < 64; ++i) v[i] = src[(size_t)i * N];
    if (gk) {
#pragma unroll
        for (int i = 0; i < 64; ++i) v[i] *= gk[k0 + i]; }
    int row = n;
    if (pairNh) { const int j = n < pairNh ? n : n - pairNh; row = (j >> 7) * 256 + (j & 127) + (n < pairNh ? 0 : 128); }
    v4u* dst = (v4u*)(Wt + (size_t)row * K + k0);
#pragma unroll
    for (int q = 0; q < 8; ++q) { v4u o; o.x = cvt_pk_bf16(v[8 * q] * scale, v[8 * q + 1] * scale); o.y = cvt_pk_bf16(v[8 * q + 2] * scale, v[8 * q + 3] * scale);
        o.z = cvt_pk_bf16(v[8 * q + 4] * scale, v[8 * q + 5] * scale); o.w = cvt_pk_bf16(v[8 * q + 6] * scale, v[8 * q + 7] * scale); dst[q] = o; }
}
constexpr int CI_1IN = (DM / 64) * (2 * DFF / 64), CI_1OUT = (DFF / 64) * (DM / 64), CI_IN = (DM / 64) * (INW / 64), CI_MKV = (DM / 64) * (2048 / 64), CI_GLU = (1024 / 64) * (4096 / 64),
              CI_SWA = (1024 / 64) * (DM / 64), CI_MEM = CI_SWA, CI_OUT = (DM / 64) * (DM / 64), CI_LAYER = 2 * CI_1IN + 2 * CI_1OUT + CI_IN + CI_MKV + CI_GLU + CI_SWA + CI_MEM + CI_OUT;
struct ProIn { const float *f1wi, *f2wi, *f1wo, *f2wo, *win, *wmkv, *wglu, *wswa, *wmem, *wout, *mem, *memn, *f1n, *f2n, *mixn, *x; };
__device__ __forceinline__ void prologue(Frame& F, const ProIn& I) {
    const int gw = blockIdx.x * NWAVES + F.wave, NGW = F.G * NWAVES, lane = F.lane;
    for (int it = gw; it < DEPTH * CI_LAYER; it += NGW) {
        const int l = it / CI_LAYER; int r = it % CI_LAYER; unsigned char* wl = F.ws + WS_W + (size_t)l * W_LAYER;
        const float* src; bf16* dst; int K, N, pairNh = 0; const float* gk = nullptr;
        if (r < CI_1IN) { src = I.f1wi + (size_t)l * DM * 2 * DFF; dst = (bf16*)(wl + WO_1IN); K = DM; N = 2 * DFF; pairNh = DFF; gk = I.f1n + (size_t)l * DM; }
        else if ((r -= CI_1IN) < CI_1IN) { src = I.f2wi + (size_t)l * DM * 2 * DFF; dst = (bf16*)(wl + WO_2IN); K = DM; N = 2 * DFF; pairNh = DFF; gk = I.f2n + (size_t)l * DM; }
        else if ((r -= CI_1IN) < CI_1OUT) { src = I.f1wo + (size_t)l * DFF * DM; dst = (bf16*)(wl + WO_1OUT); K = DFF; N = DM; }
        else if ((r -= CI_1OUT) < CI_1OUT) { src = I.f2wo + (size_t)l * DFF * DM; dst = (bf16*)(wl + WO_2OUT); K = DFF; N = DM; }
        else if ((r -= CI_1OUT) < CI_IN) { src = I.win + (size_t)l * DM * INW; dst = (bf16*)(wl + WO_IN); K = DM; N = INW; gk = I.mixn + (size_t)l * DM; }
        else if ((r -= CI_IN) < CI_MKV) { src = I.wmkv + (size_t)l * DM * 2048; dst = (bf16*)(wl + WO_MKV); K = DM; N = 2048; }
        else if ((r -= CI_MKV) < CI_GLU) { src = I.wglu + (size_t)l * 1024 * 4096; dst = (bf16*)(wl + WO_GLU); K = 1024; N = 4096; pairNh = 2048; }
        else if ((r -= CI_GLU) < CI_SWA) { src = I.wswa + (size_t)l * 1024 * DM; dst = (bf16*)(wl + WO_SWA); K = 1024; N = DM; }
        else if ((r -= CI_SWA) < CI_MEM) { src = I.wmem + (size_t)l * 1024 * DM; dst = (bf16*)(wl + WO_MEM); K = 1024; N = DM; }
        else { r -= CI_MEM; src = I.wout + (size_t)l * DM * DM; dst = (bf16*)(wl + WO_OUT); K = DM; N = DM; }
        const int nblk = N / 64, kb = r / nblk, nb = r % nblk, n0 = nb * 64;
        float sc = 1.f; if (N == INW) sc = n0 < COL_K ? 0.125f * LOG2E : ((n0 >= COL_MQ && n0 < COL_G) ? 0.0625f * LOG2E : 1.f);
        conv_block(src, K, N, dst, kb, nb, pairNh, sc, gk, lane);
    }
    for (int m = gw; m < T; m += NGW) {
        const f32x4* xr = (const f32x4*)(I.x + (size_t)m * DM) + lane; v2u* o8 = (v2u*)(wsb(F, WS_XN) + (size_t)m * DM) + lane; float s = 0.f;
#pragma unroll
        for (int j = 0; j < 8; ++j) { const f32x4 v = xr[64 * j]; s += (v.x * v.x + v.y * v.y) + (v.z * v.z + v.w * v.w); v2u o; o.x = cvt_pk_bf16(v.x, v.y); o.y = cvt_pk_bf16(v.z, v.w); o8[64 * j] = o; }
        s = wave_sum(s); if (lane < 32) ((float*)(F.ws + WS_SSQ))[(size_t)m * 32 + lane] = lane == 0 ? s : 0.f;
    }
    for (int it = gw; it < DEPTH * 512; it += NGW) {
        const int l = it / 512, row = it % 512;
        const f32x4* xr = (const f32x4*)(I.mem + (size_t)row * DM) + lane; const f32x4* gr = (const f32x4*)(I.memn + (size_t)l * DM) + lane;
        f32x4 v[8]; float s = 0.f;
#pragma unroll
        for (int j = 0; j < 8; ++j) { v[j] = xr[64 * j]; s += (v[j].x * v[j].x + v[j].y * v[j].y) + (v[j].z * v[j].z + v[j].w * v[j].w); }
        const float rstd = 1.0f / sqrtf(wave_sum(s) * (1.f / DM) + RMS_EPS);
        v2u* o8 = (v2u*)(wsb(F, WS_MEMN) + ((size_t)l * 512 + row) * DM) + lane;
#pragma unroll
        for (int j = 0; j < 8; ++j) { const f32x4 g = gr[64 * j]; v2u o; o.x = cvt_pk_bf16(v[j].x * rstd * g.x, v[j].y * rstd * g.y); o.y = cvt_pk_bf16(v[j].z * rstd * g.z, v[j].w * rstd * g.w); o8[64 * j] = o; }
    }
}
constexpr int RSTD_OFF = LDSCTL_OFF + 1024;
__device__ __forceinline__ void rstd_table(Frame& F, int pm) {
    LAS float* tab = (LAS float*)(F.lds + RSTD_OFF);
    if (F.tid < 256) { const f32x4* q = (const f32x4*)((const float*)(F.ws + WS_SSQ) + ((size_t)pm * 256 + F.tid) * 32); float s = 0.f;
#pragma unroll
        for (int j = 0; j < 8; ++j) { const f32x4 a = q[j]; s += (a[0] + a[1]) + (a[2] + a[3]); }
        tab[F.tid] = 1.0f / sqrtf(s * (1.0f / DM) + RMS_EPS); }
    __syncthreads();
}
template <bool OUTF32>
__device__ __forceinline__ void norm_phase(Frame& F, const float* hin, const float* gain, void* outp) {
    const int gw = blockIdx.x * NWAVES + F.wave, NGW = F.G * NWAVES, lane = F.lane;
    f32x4 g[8];
#pragma unroll
    for (int j = 0; j < 8; ++j) g[j] = ((const f32x4*)gain)[lane + 64 * j];
    for (int m = gw; m < T; m += NGW) {
        const f32x4* xr = (const f32x4*)(hin + (size_t)m * DM) + lane;
        f32x4 v[8]; float s = 0.f;
#pragma unroll
        for (int j = 0; j < 8; ++j) { v[j] = xr[64 * j]; s += (v[j].x * v[j].x + v[j].y * v[j].y) + (v[j].z * v[j].z + v[j].w * v[j].w); }
        const float rstd = 1.0f / sqrtf(wave_sum(s) * (1.f / DM) + RMS_EPS);
        if (OUTF32) { f32x4* o = (f32x4*)((float*)outp + (size_t)m * DM) + lane;
#pragma unroll
            for (int j = 0; j < 8; ++j) o[64 * j] = v[j] * rstd * g[j];
        } else { v2u* o8 = (v2u*)((bf16*)outp + (size_t)m * DM) + lane;
#pragma unroll
            for (int j = 0; j < 8; ++j) { v2u o; o.x = cvt_pk_bf16(v[j].x * rstd * g[j].x, v[j].y * rstd * g[j].y); o.y = cvt_pk_bf16(v[j].z * rstd * g[j].z, v[j].w * rstd * g[j].w); o8[64 * j] = o; } }
    }
}
__device__ __forceinline__ void final_norm(Frame& F, const bf16* hb, const float* gain, float* outp) {
    const int gw = blockIdx.x * NWAVES + F.wave, NGW = F.G * NWAVES, lane = F.lane;
    for (int m = gw; m < T; m += NGW) {
        const v4u* xr = (const v4u*)(hb + (size_t)m * DM) + lane; float v[4][8]; float s = 0.f;
#pragma unroll
        for (int j = 0; j < 4; ++j) { const v4u w = xr[64 * j]; v[j][0] = bf_lo(w.x); v[j][1] = bf_hi(w.x); v[j][2] = bf_lo(w.y); v[j][3] = bf_hi(w.y); v[j][4] = bf_lo(w.z); v[j][5] = bf_hi(w.z); v[j][6] = bf_lo(w.w); v[j][7] = bf_hi(w.w);
#pragma unroll
            for (int e = 0; e < 8; ++e) s += v[j][e] * v[j][e]; }
        const float rstd = 1.0f / sqrtf(wave_sum(s) * (1.f / DM) + RMS_EPS);
#pragma unroll
        for (int j = 0; j < 4; ++j) { const f32x4* g = (const f32x4*)(gain + (lane + 64 * j) * 8); f32x4* o = (f32x4*)(outp + (size_t)m * DM + (lane + 64 * j) * 8); const f32x4 g0 = g[0], g1 = g[1];
            o[0] = (f32x4){v[j][0] * rstd * g0[0], v[j][1] * rstd * g0[1], v[j][2] * rstd * g0[2], v[j][3] * rstd * g0[3]}; o[1] = (f32x4){v[j][4] * rstd * g1[0], v[j][5] * rstd * g1[1], v[j][6] * rstd * g1[2], v[j][7] * rstd * g1[3]}; }
    }
}
__device__ __forceinline__ void unpack8(const v4u w, float* f) { f[0] = bf_lo(w.x); f[1] = bf_hi(w.x); f[2] = bf_lo(w.y); f[3] = bf_hi(w.y); f[4] = bf_lo(w.z); f[5] = bf_hi(w.z); f[6] = bf_lo(w.w); f[7] = bf_hi(w.w); }

__device__ __forceinline__ void swa_naive(Frame& F, const float* sinks) {
    const bf16* P = wsb(F, WS_PROJ); bf16* O = wsb(F, WS_OSWA);
    for (int idx = blockIdx.x * 512 + F.tid; idx < T * 16; idx += F.G * 512) {
        const int hq = idx / T, m = idx % T, b = m / SEQ, t = m % SEQ, g = hq >> 2;
        float q[64];
        { const v4u* qp = (const v4u*)(P + (size_t)m * INW + COL_Q + hq * 64);
#pragma unroll
          for (int j = 0; j < 8; ++j) unpack8(qp[j], q + 8 * j); }
        float mrun = sinks[hq] * LOG2E, lrun = 1.f, o[64];
#pragma unroll
        for (int j = 0; j < 64; ++j) o[j] = 0.f;
        const int k0 = t >= 127 ? t - 127 : 0;
        for (int kp = k0; kp <= t; ++kp) {
            const bf16* kr = P + (size_t)(b * SEQ + kp) * INW + COL_K + g * 64; const bf16* vr = kr + (COL_V - COL_K);
            float s0 = 0.f, s1 = 0.f;
#pragma unroll
            for (int j = 0; j < 8; ++j) { float kf[8]; unpack8(((const v4u*)kr)[j], kf);
#pragma unroll
                for (int e = 0; e < 8; e += 2) { s0 += q[8 * j + e] * kf[e]; s1 += q[8 * j + e + 1] * kf[e + 1]; } }
            const float s = s0 + s1, mnew = fmaxf(mrun, s), corr = __builtin_amdgcn_exp2f(mrun - mnew), p = __builtin_amdgcn_exp2f(s - mnew);
            lrun = lrun * corr + p; mrun = mnew;
#pragma unroll
            for (int j = 0; j < 8; ++j) { float vf[8]; unpack8(((const v4u*)vr)[j], vf);
#pragma unroll
                for (int e = 0; e < 8; ++e) o[8 * j + e] = o[8 * j + e] * corr + p * vf[e]; }
        }
        const float inv = 1.0f / lrun; v4u* op = (v4u*)(O + (size_t)m * 1024 + hq * 64);
#pragma unroll
        for (int j = 0; j < 8; ++j) { v4u w; w.x = cvt_pk_bf16(o[8 * j] * inv, o[8 * j + 1] * inv); w.y = cvt_pk_bf16(o[8 * j + 2] * inv, o[8 * j + 3] * inv);
            w.z = cvt_pk_bf16(o[8 * j + 4] * inv, o[8 * j + 5] * inv); w.w = cvt_pk_bf16(o[8 * j + 6] * inv, o[8 * j + 7] * inv); op[j] = w; }
    }
}
__device__ __forceinline__ void memattn_naive(Frame& F) {
    const bf16* P = wsb(F, WS_PROJ); const bf16* KV = wsb(F, WS_MKV); bf16* O = wsb(F, WS_OMEM);
    LAS float* qs = (LAS float*)F.lds;
    LAS float* ss = qs + 32 * 260;
    const int tid = F.tid, ti = tid >> 4, kg = tid & 15;
    for (int unit = blockIdx.x; unit < 1024; unit += F.G) {
        const int b = unit >> 9, hd = (unit >> 7) & 3, tb = unit & 127, m0 = b * SEQ + tb * 32;
        { const v4u* src = (const v4u*)(P + (size_t)(m0 + ti) * INW + COL_MQ + hd * 256 + kg * 16); float f[16]; unpack8(src[0], f); unpack8(src[1], f + 8);
#pragma unroll
          for (int e = 0; e < 16; ++e) qs[ti * 260 + kg * 16 + e] = f[e]; }
        __syncthreads();
        float sc[16];
#pragma unroll 1
        for (int i = 0; i < 16; ++i) { const int key = kg + 16 * i; const v4u* kr = (const v4u*)(KV + (size_t)(b * NMEM + key) * 2048 + hd * 256);
            float a0 = 0.f, a1 = 0.f;
#pragma unroll 8
            for (int d8 = 0; d8 < 32; ++d8) { float kf[8]; unpack8(kr[d8], kf); const LAS f32x4* qp = (const LAS f32x4*)(qs + ti * 260 + d8 * 8); const f32x4 qa = qp[0], qb = qp[1];
                a0 += qa.x * kf[0] + qa.y * kf[1] + qa.z * kf[2] + qa.w * kf[3]; a1 += qb.x * kf[4] + qb.y * kf[5] + qb.z * kf[6] + qb.w * kf[7]; }
            ss[ti * 257 + key] = a0 + a1; }
        __syncthreads();
        float mx = -3.0e38f;
#pragma unroll
        for (int i = 0; i < 16; ++i) { sc[i] = ss[ti * 257 + kg + 16 * i]; mx = fmaxf(mx, sc[i]); }
#pragma unroll
        for (int o = 1; o < 16; o <<= 1) mx = fmaxf(mx, __shfl_xor(mx, o));
        float sum = 0.f;
#pragma unroll
        for (int i = 0; i < 16; ++i) { sc[i] = __builtin_amdgcn_exp2f(sc[i] - mx); sum += sc[i]; }
#pragma unroll
        for (int o = 1; o < 16; o <<= 1) sum += __shfl_xor(sum, o);
        const float inv = 1.0f / sum;
#pragma unroll
        for (int i = 0; i < 16; ++i) ss[ti * 257 + kg + 16 * i] = sc[i] * inv;
        __syncthreads();
        float o[16];
#pragma unroll
        for (int e = 0; e < 16; ++e) o[e] = 0.f;
#pragma unroll 4
        for (int key = 0; key < NMEM; ++key) { const float p = ss[ti * 257 + key]; const v4u* vr = (const v4u*)(KV + (size_t)(b * NMEM + key) * 2048 + 1024 + hd * 256 + kg * 16);
            float vf[16]; unpack8(vr[0], vf); unpack8(vr[1], vf + 8);
#pragma unroll
            for (int e = 0; e < 16; ++e) o[e] += p * vf[e]; }
        v4u* op = (v4u*)(O + (size_t)(m0 + ti) * 1024 + hd * 256 + kg * 16);
        v4u w; w.x = cvt_pk_bf16(o[0], o[1]); w.y = cvt_pk_bf16(o[2], o[3]); w.z = cvt_pk_bf16(o[4], o[5]); w.w = cvt_pk_bf16(o[6], o[7]); op[0] = w;
        w.x = cvt_pk_bf16(o[8], o[9]); w.y = cvt_pk_bf16(o[10], o[11]); w.z = cvt_pk_bf16(o[12], o[13]); w.w = cvt_pk_bf16(o[14], o[15]); op[1] = w;
        __syncthreads();
    }
}
__device__ __forceinline__ void sincos_red(double x, float& s, float& c) {
    const double k = __builtin_rint(x * 0.63661977236758134308); const double r = (x - k * 1.57079632679489655800) - k * 6.123233995736766036e-17; const double r2 = r * r;
    double sp = -7.6471637318198164759e-13; sp = sp * r2 + 1.6059043836821614599e-10; sp = sp * r2 - 2.5052108385441718775e-8; sp = sp * r2 + 2.7557319223985890653e-6; sp = sp * r2 - 1.9841269841269841270e-4; sp = sp * r2 + 8.3333333333333333333e-3; sp = sp * r2 - 1.6666666666666666667e-1;
    const double sr = r + r * r2 * sp;
    double cp = -1.1470745597729724714e-11; cp = cp * r2 + 2.0876756987868098979e-9; cp = cp * r2 - 2.7557319223985890653e-7; cp = cp * r2 + 2.4801587301587301587e-5; cp = cp * r2 - 1.3888888888888888889e-3; cp = cp * r2 + 4.1666666666666666667e-2; cp = cp * r2 - 0.5;
    const double cr = 1.0 + r2 * cp;
    const int q = ((int)k) & 3;
    const double ss = (q & 1) ? cr : sr, cc = (q & 1) ? sr : cr;
    s = (float)((q & 2) ? -ss : ss); c = (float)(((q == 1) || (q == 2)) ? -cc : cc);
}
struct SsmState { float ar, ai, a64r, a64i; float bbr[16], bbi[16]; };
struct SsmIn { const float *lre, *lim, *ldt, *bre, *bim, *cre, *cim, *dsk; };
__device__ __forceinline__ void ssm_params(const SsmIn& I, int g, int p, SsmState& S) {
    const int gp = g * 64 + p;
    const float lr = fminf(I.lre[gp], -1e-4f), li = I.lim[gp], dt = expf(I.ldt[g]);
    const float mag = expf(lr * dt); float sn, cs; const double th = (double)li * (double)dt; sincos_red(th, sn, cs);
    S.ar = mag * cs; S.ai = mag * sn;
    const float mag64 = expf(lr * dt * 64.f); sincos_red(th * 64.0, sn, cs); S.a64r = mag64 * cs; S.a64i = mag64 * sn;
    const float nr = S.ar - 1.f, ni = S.ai, den = lr * lr + li * li, kr = (nr * lr + ni * li) / den, ki = (ni * lr - nr * li) / den;
    const float* br = I.bre + (size_t)gp * 16; const float* bi = I.bim + (size_t)gp * 16;
#pragma unroll
    for (int c = 0; c < 16; ++c) { S.bbr[c] = kr * br[c] - ki * bi[c]; S.bbi[c] = kr * bi[c] + ki * br[c]; }
}
__device__ __forceinline__ void ssm_step(const SsmState& S, const bf16* up, float& sr, float& si) {
    const v4u* u4 = (const v4u*)up; float uf[16]; unpack8(u4[0], uf); unpack8(u4[1], uf + 8);
    float xr = 0.f, xi = 0.f;
#pragma unroll
    for (int c = 0; c < 16; ++c) { xr += S.bbr[c] * uf[c]; xi += S.bbi[c] * uf[c]; }
    const float nr = S.ar * sr - S.ai * si + xr, ni = S.ar * si + S.ai * sr + xi; sr = nr; si = ni;
}
__device__ __forceinline__ void ssm_local(Frame& F, const SsmIn& I) {
    const bf16* P = wsb(F, WS_PROJ); f32x2* SE = (f32x2*)(F.ws + WS_SEND);
    const int gw = blockIdx.x * NWAVES + F.wave, NGW = F.G * NWAVES, p = F.lane;
    for (int u = gw; u < 2 * 64 * 64; u += NGW) {
        const int g = u & 63, ch = (u >> 6) & 63, b = u >> 12;
        SsmState S; ssm_params(I, g, p, S);
        float sr = 0.f, si = 0.f; const bf16* up = P + (size_t)(b * SEQ + ch * 64) * INW + COL_S + g * 16;
#pragma unroll 4
        for (int j = 0; j < 64; ++j) ssm_step(S, up + (size_t)j * INW, sr, si);
        SE[((size_t)(b * 64 + ch) * 64 + g) * 64 + p] = (f32x2){sr, si};
    }
}
__device__ __forceinline__ void ssm_replay(Frame& F, const SsmIn& I) {
    const bf16* P = wsb(F, WS_PROJ); const f32x2* SE = (const f32x2*)(F.ws + WS_SEND); bf16* Y = wsb(F, WS_YS);
    LAS f32x2* Cs = (LAS f32x2*)F.lds;
    LAS float* Ds = (LAS float*)(F.lds + 16 * 65 * 8);
    LAS f32x2* Sw = (LAS f32x2*)(F.lds + 16384) + F.wave * (16 * 65);
    const int p = F.lane, jj = F.lane >> 2, cq = F.lane & 3;
    for (int unit = blockIdx.x; unit < 1024; unit += F.G) {
        const int oct = unit & 7, g = (unit >> 3) & 63, b = unit >> 9, ch = oct * 8 + F.wave;
        for (int e = F.tid; e < 1024; e += 512) { const int c = e >> 6, pp = e & 63; const size_t gi = ((size_t)g * 16 + c) * 64 + pp; Cs[c * 65 + pp] = (f32x2){I.cre[gi], I.cim[gi]}; }
        if (F.tid < 16) Ds[F.tid] = I.dsk[g * 16 + F.tid];
        __syncthreads();
        SsmState S; ssm_params(I, g, p, S);
        float sr = 0.f, si = 0.f;
        for (int j = 0; j < ch; ++j) { const f32x2 e = SE[((size_t)(b * 64 + j) * 64 + g) * 64 + p]; const float nr = S.a64r * sr - S.a64i * si + e.x, ni = S.a64r * si + S.a64i * sr + e.y; sr = nr; si = ni; }
        const size_t tok0 = (size_t)b * SEQ + ch * 64;
#pragma unroll 1
        for (int sub = 0; sub < 4; ++sub) {
#pragma unroll 4
            for (int j = 0; j < 16; ++j) { ssm_step(S, P + (tok0 + sub * 16 + j) * INW + COL_S + g * 16, sr, si); Sw[j * 65 + p] = (f32x2){sr, si}; }
            asm volatile("s_waitcnt lgkmcnt(0)" ::: "memory");
            float acc[4] = {0.f, 0.f, 0.f, 0.f};
#pragma unroll 4
            for (int pp = 0; pp < 64; ++pp) { const f32x2 sv = Sw[jj * 65 + pp];
#pragma unroll
                for (int ci = 0; ci < 4; ++ci) { const f32x2 cv = Cs[(cq * 4 + ci) * 65 + pp]; acc[ci] += cv.x * sv.x - cv.y * sv.y; } }
            const size_t tok = tok0 + sub * 16 + jj; const v2u uw = *(const v2u*)(P + tok * INW + COL_S + g * 16 + cq * 4);
            const float u0 = bf_lo(uw.x), u1 = bf_hi(uw.x), u2 = bf_lo(uw.y), u3 = bf_hi(uw.y);
            v2u o; o.x = cvt_pk_bf16(acc[0] + Ds[cq * 4] * u0, acc[1] + Ds[cq * 4 + 1] * u1); o.y = cvt_pk_bf16(acc[2] + Ds[cq * 4 + 2] * u2, acc[3] + Ds[cq * 4 + 3] * u3);
            *(v2u*)(Y + tok * 1024 + g * 16 + cq * 4) = o;
            asm volatile("s_waitcnt lgkmcnt(0)" ::: "memory");
        }
        __syncthreads();
    }
}

typedef short bf16x8 __attribute__((ext_vector_type(8)));
typedef short s16x4 __attribute__((ext_vector_type(4)));
typedef float f32x16 __attribute__((ext_vector_type(16)));
__device__ __forceinline__ s16x4 lds_tr16(const LAS unsigned char* p) { return __builtin_bit_cast(s16x4, __builtin_amdgcn_ds_read_tr16_b64_v4i16((LAS s16x4*)p)); }
__device__ __forceinline__ bf16x8 cat8(s16x4 lo, s16x4 hi) { return (bf16x8){lo[0], lo[1], lo[2], lo[3], hi[0], hi[1], hi[2], hi[3]}; }
__device__ __forceinline__ bf16x8 pack8(float a0, float a1, float a2, float a3, float a4, float a5, float a6, float a7) {
    v4u w; w.x = cvt_pk_bf16(a0, a1); w.y = cvt_pk_bf16(a2, a3); w.z = cvt_pk_bf16(a4, a5); w.w = cvt_pk_bf16(a6, a7); return __builtin_bit_cast(bf16x8, w); }

__device__ __forceinline__ void swa_mfma(Frame& F, const float* sinks) {
    const bf16* P = wsb(F, WS_PROJ); bf16* O = wsb(F, WS_OSWA);
    LAS unsigned char* Kl = F.lds;
    LAS unsigned char* Vl = F.lds + 36864;
    const int tid = F.tid, lane = F.lane, w = F.wave, r = w >> 1, qh = w & 1, l31 = lane & 31, h = lane >> 5;
    for (int unit = blockIdx.x; unit < 256; unit += F.G) {
        const int n = unit & 31, g = (unit >> 5) & 3, b = unit >> 7;
#pragma unroll
        for (int i = 0; i < 4; ++i) { const int c = tid + 512 * i, key = c >> 3, part = c & 7, pos = (n - 1) * 128 + key;
            v4u kv = {0u, 0u, 0u, 0u}, vv = {0u, 0u, 0u, 0u};
            if (pos >= 0) { const bf16* src = P + (size_t)(b * SEQ + pos) * INW + COL_K + g * 64 + part * 8; kv = *(const v4u*)src; vv = *(const v4u*)(src + (COL_V - COL_K)); }
            *(LAS v4u*)(Kl + key * 144 + part * 16) = kv;
            *(LAS v4u*)(Vl + (part >> 2) * 16384 + key * 64 + (part & 3) * 16) = vv; }
        __syncthreads();
        const int hq = g * 4 + r; const float sink2 = sinks[hq] * LOG2E;
#pragma unroll 1
        for (int qt = 0; qt < 2; ++qt) {
            const int a = qh * 2 + qt, qi = a * 32 + l31; const size_t m = (size_t)b * SEQ + n * 128 + qi;
            bf16x8 qf[4];
#pragma unroll
            for (int ds = 0; ds < 4; ++ds) qf[ds] = *(const bf16x8*)(P + m * INW + COL_Q + hq * 64 + ds * 16 + h * 8);
            f32x16 s[5];
#pragma unroll
            for (int k5 = 0; k5 < 5; ++k5) { f32x16 acc;
#pragma unroll
                for (int e = 0; e < 16; ++e) acc[e] = 0.f;
#pragma unroll
                for (int ds = 0; ds < 4; ++ds) { const bf16x8 kf = *(const LAS bf16x8*)(Kl + (32 * (a + k5) + l31) * 144 + ds * 32 + h * 16); acc = __builtin_amdgcn_mfma_f32_32x32x16_bf16(kf, qf[ds], acc, 0, 0, 0); }
                s[k5] = acc; }
            float mx = sink2;
#pragma unroll
            for (int k5 = 0; k5 < 5; ++k5)
#pragma unroll
                for (int e = 0; e < 16; ++e) { const int kl = 32 * (a + k5) + (e & 3) + 8 * (e >> 2) + 4 * h; const bool ok = (kl > qi) && (kl <= qi + 128) && (n > 0 || kl >= 128);
                    const float v = ok ? s[k5][e] : -1.0e30f; s[k5][e] = v; mx = fmaxf(mx, v); }
            mx = fmaxf(mx, __shfl_xor(mx, 32));
            float sum = 0.f;
#pragma unroll
            for (int k5 = 0; k5 < 5; ++k5)
#pragma unroll
                for (int e = 0; e < 16; ++e) { const float p = __builtin_amdgcn_exp2f(s[k5][e] - mx); s[k5][e] = p; sum += p; }
            sum += __shfl_xor(sum, 32); sum += __builtin_amdgcn_exp2f(sink2 - mx);
            f32x16 o[2];
#pragma unroll
            for (int e = 0; e < 16; ++e) { o[0][e] = 0.f; o[1][e] = 0.f; }
#pragma unroll
            for (int k5 = 0; k5 < 5; ++k5)
#pragma unroll
                for (int s2 = 0; s2 < 2; ++s2) { const bf16x8 pf = pack8(s[k5][8 * s2], s[k5][8 * s2 + 1], s[k5][8 * s2 + 2], s[k5][8 * s2 + 3], s[k5][8 * s2 + 4], s[k5][8 * s2 + 5], s[k5][8 * s2 + 6], s[k5][8 * s2 + 7]);
                    const int base0 = 32 * (a + k5) + 16 * s2 + 4 * h;
#pragma unroll
                    for (int db = 0; db < 2; ++db) { const LAS unsigned char* vp = Vl + db * 16384 + (base0 + ((lane & 15) >> 2)) * 64 + (16 * ((lane >> 4) & 1) + 4 * (lane & 3)) * 2;
                        const bf16x8 vf = cat8(lds_tr16(vp), lds_tr16(vp + 8 * 64)); o[db] = __builtin_amdgcn_mfma_f32_32x32x16_bf16(vf, pf, o[db], 0, 0, 0); } }
            const float inv = 1.0f / sum;
#pragma unroll
            for (int db = 0; db < 2; ++db)
#pragma unroll
                for (int g4 = 0; g4 < 4; ++g4) { v2u wv; wv.x = cvt_pk_bf16(o[db][4 * g4] * inv, o[db][4 * g4 + 1] * inv); wv.y = cvt_pk_bf16(o[db][4 * g4 + 2] * inv, o[db][4 * g4 + 3] * inv);
                    *(v2u*)(O + m * 1024 + hq * 64 + db * 32 + 8 * g4 + 4 * h) = wv; }
        }
        __syncthreads();
    }
}
__device__ __forceinline__ void memattn_mfma(Frame& F) {
    const bf16* P = wsb(F, WS_PROJ); const bf16* KV = wsb(F, WS_MKV); bf16* O = wsb(F, WS_OMEM);
    constexpr int RS = 544, SLOT = 64 * RS;
    const int tid = F.tid, lane = F.lane, w = F.wave, l15 = lane & 15, kq = lane >> 4;
    for (int unit = blockIdx.x; unit < 256; unit += F.G) {
        const int tb = unit & 31, hd = (unit >> 5) & 3, b = unit >> 7; const size_t m = (size_t)b * SEQ + tb * 128 + w * 16 + l15;
        bf16x8 qf[8];
#pragma unroll
        for (int ds = 0; ds < 8; ++ds) qf[ds] = *(const bf16x8*)(P + m * INW + COL_MQ + hd * 256 + ds * 32 + kq * 8);
        v4u st[4];
#define MA_LOAD(t) do { _Pragma("unroll") for (int i_ = 0; i_ < 4; ++i_) { const int c_ = tid + 512 * i_, row_ = c_ >> 5, part_ = c_ & 31; \
            st[i_] = *(const v4u*)(KV + (size_t)(b * NMEM + 64 * ((t) & 3) + row_) * 2048 + ((t) >> 2) * 1024 + hd * 256 + part_ * 8); } } while (0)
#define MA_STORE(buf) do { _Pragma("unroll") for (int i_ = 0; i_ < 4; ++i_) { const int c_ = tid + 512 * i_, row_ = c_ >> 5, part_ = c_ & 31; *(LAS v4u*)((buf) + row_ * RS + part_ * 16) = st[i_]; } } while (0)
        MA_LOAD(0); MA_STORE(F.lds); __syncthreads();
        f32x4 s[16]; f32x4 o[16]; float inv = 0.f;
#pragma unroll
        for (int t = 0; t < 8; ++t) {
            if (t < 7) MA_LOAD(t + 1);
            const LAS unsigned char* cur = F.lds + (t & 1) * SLOT;
            if (t < 4) {
#pragma unroll
                for (int k4 = 0; k4 < 4; ++k4) { f32x4 acc = {0.f, 0.f, 0.f, 0.f};
#pragma unroll
                    for (int ds = 0; ds < 8; ++ds) { const bf16x8 kf = *(const LAS bf16x8*)(cur + (16 * k4 + l15) * RS + ds * 64 + kq * 16); acc = __builtin_amdgcn_mfma_f32_16x16x32_bf16(kf, qf[ds], acc, 0, 0, 0); }
                    s[4 * t + k4] = acc; }
                if (t == 3) {
                    float mx = -3.0e38f;
#pragma unroll
                    for (int i = 0; i < 16; ++i) mx = fmaxf(mx, fmaxf(fmaxf(s[i][0], s[i][1]), fmaxf(s[i][2], s[i][3])));
                    mx = fmaxf(mx, __shfl_xor(mx, 16)); mx = fmaxf(mx, __shfl_xor(mx, 32));
                    float sum = 0.f;
#pragma unroll
                    for (int i = 0; i < 16; ++i)
#pragma unroll
                        for (int e = 0; e < 4; ++e) { const float p = __builtin_amdgcn_exp2f(s[i][e] - mx); s[i][e] = p; sum += p; }
                    sum += __shfl_xor(sum, 16); sum += __shfl_xor(sum, 32); inv = 1.0f / sum;
#pragma unroll
                    for (int i = 0; i < 16; ++i) o[i] = (f32x4){0.f, 0.f, 0.f, 0.f};
                }
            } else {
                const int tv = t - 4;
#pragma unroll
                for (int s2 = 0; s2 < 2; ++s2) { const f32x4 p0 = s[4 * tv + 2 * s2], p1 = s[4 * tv + 2 * s2 + 1]; const bf16x8 pf = pack8(p0[0], p0[1], p0[2], p0[3], p1[0], p1[1], p1[2], p1[3]);
#pragma unroll
                    for (int db = 0; db < 16; ++db) { const LAS unsigned char* vp = cur + (32 * s2 + 4 * kq + (l15 >> 2)) * RS + (16 * db + 4 * (lane & 3)) * 2;
                        const bf16x8 vf = cat8(lds_tr16(vp), lds_tr16(vp + 16 * RS)); o[db] = __builtin_amdgcn_mfma_f32_16x16x32_bf16(vf, pf, o[db], 0, 0, 0); } }
            }
            if (t < 7) MA_STORE(F.lds + ((t + 1) & 1) * SLOT);
            __syncthreads();
        }
#undef MA_LOAD
#undef MA_STORE
#pragma unroll
        for (int db = 0; db < 16; ++db) { v2u wv; wv.x = cvt_pk_bf16(o[db][0] * inv, o[db][1] * inv); wv.y = cvt_pk_bf16(o[db][2] * inv, o[db][3] * inv); *(v2u*)(O + m * 1024 + hd * 256 + 16 * db + 4 * kq) = wv; }
    }
}

__device__ __forceinline__ void cmul(float ar, float ai, float br, float bi, float& cr, float& ci) { cr = ar * br - ai * bi; ci = ar * bi + ai * br; }
__device__ __forceinline__ void ssm_tables(Frame& F, const SsmIn& I0) {
    LAS f32x2* AP = (LAS f32x2*)F.lds;
    LAS f32x2* BB = (LAS f32x2*)(F.lds + 33280);
    LAS f32x2* CC = (LAS f32x2*)(F.lds + 33280 + 8192);
    LAS f32x2* KC = (LAS f32x2*)(F.lds + 33280 + 16384);
    const int t = F.tid;
    for (int unit = blockIdx.x; unit < DEPTH * 64; unit += F.G) {
        const int l = unit >> 6, g = unit & 63, gp0 = unit * 64;
        const float dt = expf(I0.ldt[unit]);
        for (int e = t; e < 65 * 64; e += 512) { const int ee = e >> 6, p = e & 63; const float lr = fminf(I0.lre[gp0 + p], -1e-4f), li = I0.lim[gp0 + p];
            const float mag = expf(lr * dt * (float)ee); float sn, cs; sincos_red((double)li * (double)dt * (double)ee, sn, cs); AP[e] = (f32x2){mag * cs, mag * sn}; }
        __syncthreads();
        if (t < 64) { const float lr = fminf(I0.lre[gp0 + t], -1e-4f), li = I0.lim[gp0 + t]; const f32x2 a = AP[64 + t]; const float nr = a.x - 1.f, ni = a.y, den = lr * lr + li * li;
            KC[t] = (f32x2){(nr * lr + ni * li) / den, (ni * lr - nr * li) / den}; }
        __syncthreads();
        for (int e = t; e < 1024; e += 512) { const int p = e >> 4; const f32x2 k = KC[p]; const float br = I0.bre[(size_t)gp0 * 16 + e], bi = I0.bim[(size_t)gp0 * 16 + e];
            BB[e] = (f32x2){k.x * br - k.y * bi, k.x * bi + k.y * br}; CC[e] = (f32x2){I0.cre[(size_t)gp0 * 16 + e], I0.cim[(size_t)gp0 * 16 + e]}; }
        __syncthreads();
        bf16* WinT = wsb(F, WS_WINT) + (size_t)unit * 131072; bf16* WoutT = wsb(F, WS_WOUTT) + (size_t)unit * 131072; bf16* LB = (bf16*)(F.ws + WS_LB + (size_t)unit * LB_BYTES);
        for (int q = t; q < 16384; q += 512) { const int n = q >> 7, ck = q & 127, j = ck >> 1, half = ck & 1, p = 16 * (n >> 5) + (n & 15), isim = (n >> 4) & 1; const f32x2 a = AP[(63 - j) * 64 + p]; float v[8];
#pragma unroll
            for (int e = 0; e < 8; ++e) { const f32x2 bb = BB[p * 16 + 8 * half + e]; float zr, zi; cmul(a.x, a.y, bb.x, bb.y, zr, zi); v[e] = isim ? zi : zr; }
            *(bf16x8*)(WinT + (size_t)n * 1024 + ck * 8) = pack8(v[0], v[1], v[2], v[3], v[4], v[5], v[6], v[7]); }
        for (int q = t; q < 16384; q += 512) { const int row = q >> 4, ck = q & 15, tau = row >> 4, c = row & 15, isim = ck >> 3, p0 = (8 * ck) & 63; float v[8];
#pragma unroll
            for (int e = 0; e < 8; ++e) { const f32x2 cc = CC[c * 64 + p0 + e], a = AP[(tau + 1) * 64 + p0 + e]; float zr, zi; cmul(cc.x, cc.y, a.x, a.y, zr, zi); v[e] = isim ? -zi : zr; }
            *(bf16x8*)(WoutT + (size_t)row * 128 + ck * 8) = pack8(v[0], v[1], v[2], v[3], v[4], v[5], v[6], v[7]); }
        { const int c = (t >> 4) & 15, c2 = t & 15, lh = t >> 8; float acc[32];
#pragma unroll
          for (int d = 0; d < 32; ++d) acc[d] = 0.f;
#pragma unroll 2
          for (int p = 0; p < 64; ++p) { const f32x2 cc = CC[c * 64 + p], bb = BB[p * 16 + c2]; float zr, zi; cmul(cc.x, cc.y, bb.x, bb.y, zr, zi);
#pragma unroll
              for (int d = 0; d < 32; ++d) { const f32x2 a = AP[(32 * lh + d) * 64 + p]; acc[d] += zr * a.x - zi * a.y; } }
          if (lh == 0 && c == c2) acc[0] += I0.dsk[l * 1024 + g * 16 + c];
#pragma unroll
          for (int d = 0; d < 32; ++d) LB[(((32 * lh + d + 1) * 2 + (c2 >> 3)) * 16 + c) * 8 + (c2 & 7)] = (bf16)(cvt_pk_bf16(acc[d], 0.f) & 0xffffu);
          if (t < 256) LB[t] = 0; }
        __syncthreads();
    }
}
__device__ __forceinline__ void ssm_s1(Frame& F, const SsmIn& I, int l) {
    const bf16* P = wsb(F, WS_PROJ); bf16* SST = wsb(F, WS_SST);
    LAS float* E = (LAS float*)F.lds;
    const int lane = F.lane, w = F.wave, l31 = lane & 31, h = lane >> 5, mi = w & 3, kh = w >> 2;
    for (int unit = blockIdx.x; unit < 256; unit += F.G) {
        const int g = unit >> 2, pq = unit & 3;
        const bf16* WinT = wsb(F, WS_WINT) + (size_t)(l * 64 + g) * 131072 + (size_t)(pq * 32 + l31) * 1024 + 8 * h;
        const int mrow = 32 * mi + l31, bb = mrow >> 6, kk = mrow & 63;
        const bf16* up = P + (size_t)(bb * SEQ + kk * 64) * INW + COL_S + g * 16 + 8 * h;
        f32x16 acc;
#pragma unroll
        for (int e = 0; e < 16; ++e) acc[e] = 0.f;
#pragma unroll 8
        for (int jj = 0; jj < 32; ++jj) { const int j = 32 * kh + jj; const bf16x8 af = *(const bf16x8*)(up + (size_t)j * INW), bf = *(const bf16x8*)(WinT + 16 * j);
            acc = __builtin_amdgcn_mfma_f32_32x32x16_bf16(af, bf, acc, 0, 0, 0); }
#pragma unroll
        for (int e = 0; e < 16; ++e) E[(kh * 128 + 32 * mi + (e & 3) + 8 * (e >> 2) + 4 * h) * 33 + l31] = acc[e];
        __syncthreads();
#pragma unroll 1
        for (int tk = 0; tk < 4; ++tk) { const int task = w * 4 + tk, b = task >> 4, st = task & 15, p = 16 * pq + st, k = lane;
            float xr = E[(b * 64 + k) * 33 + st] + E[(128 + b * 64 + k) * 33 + st], xi = E[(b * 64 + k) * 33 + 16 + st] + E[(128 + b * 64 + k) * 33 + 16 + st];
            const int gp = g * 64 + p; const float lr = fminf(I.lre[gp], -1e-4f), li = I.lim[gp], dt = expf(I.ldt[g]);
            float ar, ai; { const float mag = expf(lr * dt * 64.f); float sn, cs; sincos_red((double)li * (double)dt * 64.0, sn, cs); ar = mag * cs; ai = mag * sn; }
#pragma unroll
            for (int d = 1; d < 64; d <<= 1) { const float yr = __shfl_up(xr, d), yi = __shfl_up(xi, d); if (k >= d) { xr += ar * yr - ai * yi; xi += ar * yi + ai * yr; } const float nr = ar * ar - ai * ai, ni = 2.f * ar * ai; ar = nr; ai = ni; }
            float sr = __shfl_up(xr, 1), si = __shfl_up(xi, 1); if (k == 0) { sr = 0.f; si = 0.f; }
            bf16* dst = SST + ((size_t)(g * 128 + b * 64 + k)) * 128 + p; dst[0] = (bf16)(cvt_pk_bf16(sr, 0.f) & 0xffffu); dst[64] = (bf16)(cvt_pk_bf16(si, 0.f) & 0xffffu); }
        __syncthreads();
    }
}
__device__ __forceinline__ void ssm_s2(Frame& F, int l) {
    const bf16* P = wsb(F, WS_PROJ); const bf16* SST = wsb(F, WS_SST); bf16* Y = wsb(F, WS_YS);
    LAS unsigned char* Ul = F.lds;
    LAS unsigned char* Ll = F.lds + 66048;
    LAS unsigned char* Sl = F.lds + 66048 + 33280;
    const int t = F.tid, lane = F.lane, w = F.wave, l31 = lane & 31, h = lane >> 5;
    for (int unit = blockIdx.x; unit < 256; unit += F.G) {
        const int mt = unit & 1, b = (unit >> 1) & 1, g = unit >> 2;
#pragma unroll
        for (int i = 0; i < 8; ++i) { const int q = t + 512 * i, half = q & 1, ti = q >> 1, ir = ti >> 6, j = ti & 63;
            *(LAS v4u*)(Ul + ir * 2064 + j * 32 + half * 16) = *(const v4u*)(P + (size_t)(b * SEQ + (32 * mt + ir) * 64 + j) * INW + COL_S + g * 16 + 8 * half); }
        { const v4u* src = (const v4u*)(F.ws + WS_LB + (size_t)(l * 64 + g) * LB_BYTES);
          for (int q = t; q < (int)(LB_BYTES / 16); q += 512) *(LAS v4u*)(Ll + q * 16) = src[q]; }
        { const int row = t >> 4, part = t & 15; *(LAS v4u*)(Sl + row * 272 + part * 16) = *(const v4u*)(SST + ((size_t)(g * 128 + b * 64 + 32 * mt + row)) * 128 + part * 8); }
        __syncthreads();
        const bf16* WoutT = wsb(F, WS_WOUTT) + (size_t)(l * 64 + g) * 131072;
#pragma unroll 1
        for (int q = 0; q < 4; ++q) { const int n = (q == 0) ? w : (q == 1) ? 15 - w : (q == 2) ? 16 + w : 31 - w;
            f32x16 acc;
#pragma unroll
            for (int e = 0; e < 16; ++e) acc[e] = 0.f;
#pragma unroll
            for (int ks = 0; ks < 8; ++ks) { const bf16x8 wf = *(const bf16x8*)(WoutT + (size_t)(32 * n + l31) * 128 + 16 * ks + 8 * h), sf = *(const LAS bf16x8*)(Sl + l31 * 272 + ks * 32 + h * 16);
                acc = __builtin_amdgcn_mfma_f32_32x32x16_bf16(wf, sf, acc, 0, 0, 0); }
            const LAS unsigned char* lbp = Ll + ((2 * n + 1 + (l31 >> 4)) * 2 + h) * 256 + (l31 & 15) * 16; const LAS unsigned char* ubp = Ul + l31 * 2064 + h * 16;
#pragma unroll 2
            for (int j = 0; j < 2 * n + 2; ++j) { const bf16x8 kf = *(const LAS bf16x8*)(lbp - j * 512), uf = *(const LAS bf16x8*)(ubp + j * 32); acc = __builtin_amdgcn_mfma_f32_32x32x16_bf16(kf, uf, acc, 0, 0, 0); }
#pragma unroll
            for (int q4 = 0; q4 < 4; ++q4) { const int c0 = 8 * (q4 & 1) + 4 * h, tau = 2 * n + (q4 >> 1); const size_t tok = (size_t)b * SEQ + (32 * mt + l31) * 64 + tau;
                v2u wv; wv.x = cvt_pk_bf16(acc[4 * q4], acc[4 * q4 + 1]); wv.y = cvt_pk_bf16(acc[4 * q4 + 2], acc[4 * q4 + 3]); *(v2u*)(Y + tok * 1024 + g * 16 + c0) = wv; }
        }
        __syncthreads();
    }
}

constexpr int PH_PRO = 0, PH_SB0 = 1, PH_PER_SB = 6, N_SB = 3 * DEPTH, PH_FINAL = PH_SB0 + N_SB * PH_PER_SB, N_PH = PH_FINAL + 1;
struct Args { const float* in[N_IN]; float* out; unsigned char* ws; int ph_lo, ph_hi; };
static_assert(sizeof(Args) == N_IN * 8 + 8 + 8 + 8, "Args has no padding");

typedef __attribute__((address_space(4))) const Args* KArgs;
__device__ __forceinline__ KArgs kargs() { KArgs p = (KArgs)__builtin_amdgcn_kernarg_segment_ptr(); asm volatile("" : "+s"(p)); return p; }
#define AIN(i) (kargs()->in[i])
__global__ void __launch_bounds__(NWAVES * 64, 2) fwd(Args args_unused) {
    extern __shared__ __attribute__((aligned(16))) unsigned char lds[];
    Frame F;
    F.lds = (LAS unsigned char*)lds;
    F.tid = threadIdx.x; F.lane = F.tid & 63; F.wave = __builtin_amdgcn_readfirstlane(F.tid >> 6); F.G = gridDim.x;
    F.ws = kargs()->ws;
    const int lo = kargs()->ph_lo, hi = kargs()->ph_hi;
    volatile LAS unsigned* MISC = (volatile LAS unsigned*)(F.lds + MISC_OFF);
    for (int u = F.tid; u < (LDS_BYTES - LDSCTL_OFF) / 4; u += NWAVES * 64) ((LAS unsigned*)(F.lds + LDSCTL_OFF))[u] = 0u;
    __syncthreads();
    unsigned* barw = (unsigned*)(F.ws + WS_CTL) + CW_BAR;
    XcdBarrier bar; bar.bar = barw; bar.x = 0; bar.st = nullptr;
    if (hi - lo > 1) bar = xcd_barrier_post(barw, MISC + 8);
#define IN(p) (lo <= (p) && (p) < hi)
#define FRESH() do { int t_ = threadIdx.x; asm volatile("" : "+v"(t_)); F.tid = t_; F.lane = t_ & 63; F.wave = __builtin_amdgcn_readfirstlane(t_ >> 6); unsigned char* w_ = kargs()->ws; F.ws = w_; } while (0)
#define SEAM(p, q) do { if (IN(p) && (q) < hi) xcd_barrier(bar); } while (0)

    if (IN(PH_PRO) && EN_PRO) for (int rep_ = 0; rep_ < REP_PRO; ++rep_) { FRESH(); const ProIn I{AIN(I_F1WI), AIN(I_F2WI), AIN(I_F1WO), AIN(I_F2WO), AIN(I_WIN), AIN(I_WMKV), AIN(I_WGLU), AIN(I_WSWA), AIN(I_WMEMUP), AIN(I_WOUT), AIN(I_MEM), AIN(I_MEMN), AIN(I_F1N), AIN(I_F2N), AIN(I_MIXN), AIN(I_X)}; prologue(F, I);
        const SsmIn I0{AIN(I_LRE), AIN(I_LIM), AIN(I_LDT), AIN(I_BRE), AIN(I_BIM), AIN(I_CRE), AIN(I_CIM), AIN(I_DSK)}; ssm_tables(F, I0); }
    SEAM(PH_PRO, PH_SB0);

    for (int sb = 0; sb < N_SB; ++sb) {
        const int l = sb / 3, ty = sb % 3, pb = PH_SB0 + sb * PH_PER_SB;
        if (pb + PH_PER_SB <= lo || pb >= hi) continue;
#define HIN() ((sb == 0) ? AIN(I_X) : (const float*)(F.ws + WS_H))
#define WL() (F.ws + WS_W + (size_t)l * W_LAYER)
        if (ty != 1) {
            if (IN(pb + 1) && EN_G1) for (int rep_ = 0; rep_ < REP_G1; ++rep_) { FRESH();
                pg8::SchedTiles S{(const char*)(F.ws + WS_XN), (const char*)(WL() + (ty == 0 ? WO_1IN : WO_2IN)), (size_t)256 * DM * 2, T / 256, 2 * DFF / 256, F.G, (int)blockIdx.x};
                pg8::Unit u0; int pm0 = -1; if (S.next(0, u0)) { pm0 = u0.pm; rstd_table(F, pm0); }
                pg8::EpiSwiGLU E{wsb(F, WS_HID), DFF, pg8::RstdTab{(const LAS float*)(F.lds + RSTD_OFF), pm0, (const float*)(F.ws + WS_SSQ)}};
                pg8::gemm_phase<pg8::EpiSwiGLU, pg8::SchedTiles, true, true>(F.lds + RING_OFF, DM, S, E);
            }
            SEAM(pb + 1, pb + 5);
        } else {
            if (IN(pb + 1) && EN_G3) for (int rep_ = 0; rep_ < REP_G3; ++rep_) { FRESH();
                pg8::SchedProj S{(const char*)(F.ws + WS_XN), (const char*)(WL() + WO_IN), (const char*)(F.ws + WS_MEMN + (size_t)l * 512 * DM * 2), (const char*)(WL() + WO_MKV), (size_t)256 * DM * 2, T / 256, INW / 256, F.G, (int)blockIdx.x};
                pg8::Unit u0; int pm0 = -1; if (S.next(0, u0)) { pm0 = u0.pm; rstd_table(F, pm0); }
                pg8::EpiProj E{wsb(F, WS_PROJ), INW, COL_G / 256, wsb(F, WS_MKV), 2048, pg8::RstdTab{(const LAS float*)(F.lds + RSTD_OFF), pm0, (const float*)(F.ws + WS_SSQ)}};
                pg8::gemm_phase<pg8::EpiProj, pg8::SchedProj, true, true>(F.lds + RING_OFF, DM, S, E);
            }
            SEAM(pb + 1, pb + 2);
            if (IN(pb + 2) && EN_M1) for (int rep_ = 0; rep_ < REP_M; ++rep_) { FRESH(); swa_mfma(F, AIN(I_SINK) + l * 16); memattn_mfma(F);
                const SsmIn I{AIN(I_LRE) + l * 4096, AIN(I_LIM) + l * 4096, AIN(I_LDT) + l * 64, AIN(I_BRE) + l * 65536, AIN(I_BIM) + l * 65536, AIN(I_CRE) + l * 65536, AIN(I_CIM) + l * 65536, AIN(I_DSK) + l * 1024}; ssm_s1(F, I, l); }
            SEAM(pb + 2, pb + 3);
            if (IN(pb + 3) && EN_M2) for (int rep_ = 0; rep_ < REP_M; ++rep_) { FRESH(); const SsmIn I{AIN(I_LRE) + l * 4096, AIN(I_LIM) + l * 4096, AIN(I_LDT) + l * 64, AIN(I_BRE) + l * 65536, AIN(I_BIM) + l * 65536, AIN(I_CRE) + l * 65536, AIN(I_CIM) + l * 65536, AIN(I_DSK) + l * 1024}; (void)I; ssm_s2(F, l); }
            SEAM(pb + 3, pb + 4);
            if (IN(pb + 4) && EN_G4) for (int rep_ = 0; rep_ < REP_G4; ++rep_) { FRESH();
                pg8::SchedMix S{(const char*)(F.ws + WS_OSWA), (const char*)(F.ws + WS_OMEM), (const char*)(F.ws + WS_YS), (const char*)(WL() + WO_SWA), (const char*)(WL() + WO_MEM), (const char*)(WL() + WO_GLU), (size_t)256 * 1024 * 2, T / 256, DM / 256, F.G, (int)blockIdx.x};
                pg8::EpiMix E{(float*)(F.ws + WS_T32), wsb(F, WS_MG), wsb(F, WS_PROJ) + COL_G, INW};
                pg8::gemm_phase<pg8::EpiMix, pg8::SchedMix, true, true>(F.lds + RING_OFF, 1024, S, E);
            }
            SEAM(pb + 4, pb + 5);
        }
        if (IN(pb + 5) && EN_GR) for (int rep_ = 0; rep_ < REP_GR; ++rep_) { FRESH();
            const int K = (ty == 1) ? DM : DFF;
            pg8::SchedTiles S{(const char*)(F.ws + (ty == 1 ? WS_MG : WS_HID)), (const char*)(WL() + (ty == 0 ? WO_1OUT : ty == 1 ? WO_OUT : WO_2OUT)), (size_t)256 * K * 2, T / 256, DM / 256, F.G, (int)blockIdx.x};
            pg8::EpiResid E{(sb == 0) ? AIN(I_X) : nullptr, ty == 1 ? 1.0f : 0.5f, DM, wsb(F, WS_XN), (float*)(F.ws + (rep_ ? WS_T32 : WS_SSQ)), wsb(F, rep_ ? WS_H : WS_XN)};
            pg8::gemm_phase<pg8::EpiResid, pg8::SchedTiles, true, true>(F.lds + RING_OFF, K, S, E);
        }
        SEAM(pb + 5, pb + 6);
    }
    if (IN(PH_FINAL)) { FRESH(); final_norm(F, wsb(F, WS_XN), AIN(I_FINN), kargs()->out); }
#undef IN
#undef SEAM
}

static bool phase_valid(int p) {
    if (p == PH_PRO || p == PH_FINAL) return true;
    const int sb = (p - PH_SB0) / PH_PER_SB, k = (p - PH_SB0) % PH_PER_SB;
    return k != 0 && ((sb % 3 == 1) || k == 1 || k == 5);
}
extern "C" void kernel_launch(void* const* d_in, const int* in_sizes, int n_in, void* d_out, int out_size, void* d_ws, size_t ws_size, hipStream_t stream) {
    static int grid = 0;
    if (grid == 0) {
        if (n_in != N_IN || in_sizes[0] != T * DM || out_size != T * DM || ws_size < WS_END) { fprintf(stderr, "kernel_launch: unexpected shapes: n_in %d in0 %d out %d ws %zu (need %zu); nothing launched\n", n_in, n_in > 0 ? in_sizes[0] : -1, out_size, ws_size, (size_t)WS_END); grid = -1; return; }
        int dev = 0, cus = 0, per_cu = 0;
        if (hipGetDevice(&dev) != hipSuccess || hipDeviceGetAttribute(&cus, hipDeviceAttributeMultiprocessorCount, dev) != hipSuccess) { fprintf(stderr, "kernel_launch: device query failed\n"); grid = -1; return; }
        if (hipFuncSetAttribute((const void*)fwd, hipFuncAttributeMaxDynamicSharedMemorySize, LDS_BYTES) != hipSuccess) { fprintf(stderr, "kernel_launch: hipFuncSetAttribute failed\n"); grid = -1; return; }
        if (hipOccupancyMaxActiveBlocksPerMultiprocessor(&per_cu, (const void*)fwd, NWAVES * 64, LDS_BYTES) != hipSuccess || per_cu < 1) fprintf(stderr, "kernel_launch: note: occupancy query reports %d workgroups per CU\n", per_cu);
        (void)hipGetLastError();
        grid = cus;
    }
    if (grid < 0) return;
    if (hipMemsetAsync((char*)d_ws + WS_CTL, 0, CTL_ZERO_BYTES, stream) != hipSuccess) { fprintf(stderr, "kernel_launch: memset failed\n"); return; }
    Args a{};
    for (int i = 0; i < N_IN; ++i) a.in[i] = (const float*)d_in[i];
    a.out = (float*)d_out; a.ws = (unsigned char*)d_ws;
#if ONE_LAUNCH
    a.ph_lo = 0; a.ph_hi = N_PH;
    hipLaunchKernelGGL(fwd, dim3(grid), dim3(NWAVES * 64), LDS_BYTES, stream, a);
#else
    for (int p = 0; p < N_PH; ++p) { if (!phase_valid(p)) continue; a.ph_lo = p; a.ph_hi = p + 1; hipLaunchKernelGGL(fwd, dim3(grid), dim3(NWAVES * 64), LDS_BYTES, stream, a); }
#endif
    const hipError_t le = hipPeekAtLastError();
    if (le != hipSuccess) fprintf(stderr, "kernel_launch: launch failed: %s\n", hipGetErrorName(le));
}
```

```cpp
#include <hip/hip_runtime.h>
#include <cstdio>
#include <cstdint>

#ifndef EN_PRO
#define EN_PRO 1
#endif
#ifndef EN_NORM
#define EN_NORM 1
#endif
#ifndef EN_G1
#define EN_G1 1
#endif
#ifndef EN_G3
#define EN_G3 1
#endif
#ifndef EN_M1
#define EN_M1 1
#endif
#ifndef EN_M2
#define EN_M2 1
#endif
#ifndef EN_G4
#define EN_G4 1
#endif
#ifndef EN_GR
#define EN_GR 1
#endif
#ifndef REP_M
#define REP_M 1
#endif
#ifndef REP_PRO
#define REP_PRO 1
#endif
#ifndef REP_NORM
#define REP_NORM 1
#endif
#ifndef REP_G1
#define REP_G1 1
#endif
#ifndef REP_G3
#define REP_G3 1
#endif
#ifndef REP_G4
#define REP_G4 1
#endif
#ifndef REP_GR
#define REP_GR 1
#endif
#ifndef ONE_LAUNCH
#define ONE_LAUNCH 1
#endif

namespace pg8 {
#define PG8_LAS __attribute__((address_space(3)))
typedef unsigned short bf16_t;
typedef short bf16x8 __attribute__((ext_vector_type(8)));
typedef float f32x4 __attribute__((ext_vector_type(4)));
typedef unsigned u32x4 __attribute__((ext_vector_type(4)));
constexpr int BM = 256, BK = 64, HALF = 128, HTB = HALF * BK * 2  , STAGE_BYTES = 8 * HTB, NXCD = 8, WGM = 8;

__host__ __device__ __forceinline__ int lds_byte(int r, int c) { const int st = (r >> 4) * 2 + (c >> 5), rr = r & 15, cc = c & 31, ob = rr * 64 + cc * 2; return st * 1024 + (ob ^ (((ob >> 9) & 1) << 5)); }
__host__ __device__ __forceinline__ void stage_rc(int b, int& R, int& C) { const int st = b / 1024, sb = b % 1024, swz = sb ^ (((sb >> 9) & 1) << 5); R = (st >> 1) * 16 + swz / 64; C = (st & 1) * 32 + (swz % 64) / 2; }
__host__ __device__ __forceinline__ int perm32(int rho) { const int n = rho >> 4, i = rho & 15; return 8 * (i >> 2) + 4 * n + (i & 3); }


struct Unit { int pm, pn, kind; };

__device__ __forceinline__ unsigned cvt_pk_bf16(float lo, float hi) { unsigned r; asm volatile("v_cvt_pk_bf16_f32 %0, %1, %2" : "=v"(r) : "v"(lo), "v"(hi)); return r; }
__device__ __forceinline__ float bf_lo(unsigned u) { return __uint_as_float(u << 16); }
__device__ __forceinline__ float bf_hi(unsigned u) { return __uint_as_float(u & 0xffff0000u); }
__device__ __forceinline__ float sigmoidf_fast(float x) { return __builtin_amdgcn_rcpf(1.0f + __builtin_amdgcn_exp2f(-1.4426950408889634f * x)); }

__device__ __forceinline__ void tile_of(int L, int nM, int nN, int& pm, int& pn) {
    const int nwg = nM * nN; int wgid = L; { const int q = nwg / NXCD, r = nwg % NXCD, xcd = wgid % NXCD, off = wgid / NXCD; wgid = (xcd < r ? xcd * (q + 1) : r * (q + 1) + (xcd - r) * q) + off; }
    const int nig = WGM * nN, gid = wgid / nig, fm = gid * WGM, gsz = (nM - fm) < WGM ? (nM - fm) : WGM;
    pm = fm + ((wgid % nig) % gsz); pn = (wgid % nig) / gsz;
}

struct SchedTiles {
    const char* A; const char* Bt; size_t tstep; int nM, nN, G, c;
    __device__ __forceinline__ bool next(int i, Unit& u) const { const int L = i * G + c; if (L >= nM * nN) return false; tile_of(L, nM, nN, u.pm, u.pn); u.kind = 0; return true; }
    __device__ __forceinline__ void operands(const Unit& u, const char*& a, const char*& b) const { a = A + (size_t)u.pm * tstep; b = Bt + (size_t)u.pn * tstep; }
    __device__ __forceinline__ void a_ready(const Unit&) const {}
    __device__ __forceinline__ void done(const Unit&) const {}
};
struct SchedProj {
    const char* A; const char* Bt; const char* A2; const char* Bt2; size_t tstep; int nM, nN, G, c;
    __device__ __forceinline__ bool next(int i, Unit& u) const { const int L = i * G + c, nwg = nM * nN; if (L < nwg) { tile_of(L, nM, nN, u.pm, u.pn); u.kind = 0; return true; }
        if (L < nwg + 16) { const int j = L - nwg; u.pm = j & 1; u.pn = j >> 1; u.kind = 1; return true; } return false; }
    __device__ __forceinline__ void operands(const Unit& u, const char*& a, const char*& b) const { a = (u.kind ? A2 : A) + (size_t)u.pm * tstep; b = (u.kind ? Bt2 : Bt) + (size_t)u.pn * tstep; }
    __device__ __forceinline__ void a_ready(const Unit&) const {}
    __device__ __forceinline__ void done(const Unit&) const {}
};
struct SchedMix {
    const char* Aswa; const char* Amem; const char* Ays; const char* Bswa; const char* Bmem; const char* Bglu; size_t tstep; int nM, nN, G, c;
    __device__ __forceinline__ bool next(int i, Unit& u) const { const int L = (i >> 2) * G + c; if (L >= nM * nN) return false; tile_of(L, nM, nN, u.pm, u.pn); u.kind = i & 3; return true; }
    __device__ __forceinline__ void operands(const Unit& u, const char*& a, const char*& b) const {
        if (u.kind == 0) { a = Aswa + (size_t)u.pm * tstep; b = Bswa + (size_t)u.pn * tstep; }
        else if (u.kind == 1) { a = Amem + (size_t)u.pm * tstep; b = Bmem + (size_t)u.pn * tstep; }
        else { a = Ays + (size_t)u.pm * tstep; b = Bglu + (size_t)(2 * u.pn + (u.kind - 2)) * tstep; } }
    __device__ __forceinline__ void a_ready(const Unit&) const {}
    __device__ __forceinline__ void done(const Unit&) const {}
};

__device__ __forceinline__ float row_rstd(const float* SSQ, size_t row, int fq) {
    const f32x4* q = (const f32x4*)(SSQ + row * 32 + 8 * fq); const f32x4 a = q[0], b = q[1];
    float s = ((a[0] + a[1]) + (a[2] + a[3])) + ((b[0] + b[1]) + (b[2] + b[3])); s += __shfl_xor(s, 16); s += __shfl_xor(s, 32);
    return 1.0f / sqrtf(s * (1.0f / 2048.0f) + 1e-5f);
}
struct RstdTab { const PG8_LAS float* tab; int pm0; const float* SSQ;
    __device__ __forceinline__ float get(const Unit& u, int rowin, int fq) const { const float r = tab[rowin]; return (u.pm == pm0) ? r : __builtin_nanf(""); } };
struct EpiSwiGLU {
    static constexpr bool PERM = true, AFTER_DRAIN = false;
    bf16_t* O; int ldo; RstdTab R;
    __device__ __forceinline__ void operator()(const f32x4 (&acc)[2][2][4][2], const Unit& u, int wr, int wc, int fr, int fq) const {
        const int row0 = u.pm * BM + wr * 64 + fr, col0 = u.pn * HALF + wc * 32 + 8 * fq;
#pragma unroll
        for (int ai = 0; ai < 2; ++ai)
#pragma unroll
            for (int m = 0; m < 4; ++m) { bf16_t* rowp = O + (size_t)(row0 + ai * HALF + m * 16) * ldo + col0; float o[8]; const float rs = R.get(u, wr * 64 + fr + ai * HALF + m * 16, fq);
#pragma unroll
                for (int n = 0; n < 2; ++n)
#pragma unroll
                    for (int e = 0; e < 4; ++e) { const float g = acc[ai][0][m][n][e] * rs, uu = acc[ai][1][m][n][e] * rs; o[4 * n + e] = g * sigmoidf_fast(g) * uu; }
                u32x4 w; w.x = cvt_pk_bf16(o[0], o[1]); w.y = cvt_pk_bf16(o[2], o[3]); w.z = cvt_pk_bf16(o[4], o[5]); w.w = cvt_pk_bf16(o[6], o[7]);
                *(u32x4*)rowp = w; }
    }
};
struct EpiResid {
    static constexpr bool PERM = false, AFTER_DRAIN = false;
    const float* X0; float alpha; int ldc; bf16_t* HB; float* SSQ; bf16_t* HBout;
    __device__ __forceinline__ void operator()(const f32x4 (&acc)[2][2][4][2], const Unit& u, int wr, int wc, int fr, int fq) const {
        const int row0 = u.pm * BM + wr * 64 + fr, col0 = u.pn * BM + wc * 32 + 4 * fq;
#pragma unroll
        for (int ai = 0; ai < 2; ++ai)
#pragma unroll
            for (int m = 0; m < 4; ++m) { const size_t off = (size_t)(row0 + ai * HALF + m * 16) * ldc + col0;
                float ss = 0.f;
#pragma unroll
                for (int bj = 0; bj < 2; ++bj)
#pragma unroll
                    for (int n = 0; n < 2; ++n) { typedef unsigned u32x2 __attribute__((ext_vector_type(2))); f32x4 b;
                        if (X0) b = *(const f32x4*)(X0 + off + bj * HALF + n * 16); else { const u32x2 hw = *(const u32x2*)(HB + off + bj * HALF + n * 16); b = (f32x4){bf_lo(hw.x), bf_hi(hw.x), bf_lo(hw.y), bf_hi(hw.y)}; }
                        const f32x4 v = b + acc[ai][bj][m][n] * alpha;
                        ss += (v[0] * v[0] + v[1] * v[1]) + (v[2] * v[2] + v[3] * v[3]);
                        u32x2 w; w.x = cvt_pk_bf16(v[0], v[1]); w.y = cvt_pk_bf16(v[2], v[3]); *(u32x2*)(HBout + off + bj * HALF + n * 16) = w; }
                ss += __shfl_xor(ss, 16); ss += __shfl_xor(ss, 32);
                if (fq == 0) SSQ[(size_t)(row0 + ai * HALF + m * 16) * 32 + u.pn * 4 + wc] = ss; }
    }
};
struct EpiProj {
    static constexpr bool PERM = true, AFTER_DRAIN = false;
    bf16_t* P; int ldp; int sig_from; bf16_t* KV; int ldk; RstdTab R;
    __device__ __forceinline__ void operator()(const f32x4 (&acc)[2][2][4][2], const Unit& u, int wr, int wc, int fr, int fq) const {
        const int row0 = u.pm * BM + wr * 64 + fr, col0 = u.pn * BM + wc * 32 + 8 * fq;
        bf16_t* base = u.kind ? KV : P; const int ld = u.kind ? ldk : ldp; const bool sig = (u.kind == 0) && (u.pn >= sig_from);
#pragma unroll
        for (int ai = 0; ai < 2; ++ai)
#pragma unroll
            for (int m = 0; m < 4; ++m) { bf16_t* rowp = base + (size_t)(row0 + ai * HALF + m * 16) * ld + col0; const float rs = u.kind ? 1.0f : R.get(u, wr * 64 + fr + ai * HALF + m * 16, fq);
#pragma unroll
                for (int bj = 0; bj < 2; ++bj) { f32x4 v0 = acc[ai][bj][m][0] * rs, v1 = acc[ai][bj][m][1] * rs;
                    if (sig) {
#pragma unroll
                        for (int e = 0; e < 4; ++e) { v0[e] = sigmoidf_fast(v0[e]); v1[e] = sigmoidf_fast(v1[e]); } }
                    u32x4 w; w.x = cvt_pk_bf16(v0[0], v0[1]); w.y = cvt_pk_bf16(v0[2], v0[3]); w.z = cvt_pk_bf16(v1[0], v1[1]); w.w = cvt_pk_bf16(v1[2], v1[3]);
                    *(u32x4*)(rowp + bj * HALF) = w; } }
    }
};
struct EpiMix {
    static constexpr bool PERM = true, AFTER_DRAIN = false;
    bf16_t* MG; const bf16_t* Gt; int ldg;
    __device__ __forceinline__ void operator()(const f32x4 (&acc)[2][2][4][2], const Unit& u, int wr, int wc, int fr, int fq) const {
        const int row0 = u.pm * BM + wr * 64 + fr, cw = wc * 32 + 8 * fq;
        if (u.kind < 2) {
            const int gsel = u.kind == 0 ? 0 : 4096;
#pragma unroll
            for (int ai = 0; ai < 2; ++ai)
#pragma unroll
                for (int m = 0; m < 4; ++m) { const size_t row = (size_t)(row0 + ai * HALF + m * 16);
#pragma unroll
                    for (int bj = 0; bj < 2; ++bj) { const int col = u.pn * BM + bj * HALF + cw;
                        const u32x4 gw = *(const u32x4*)(Gt + row * ldg + gsel + col);
                        const f32x4 g0 = {bf_lo(gw.x), bf_hi(gw.x), bf_lo(gw.y), bf_hi(gw.y)}, g1 = {bf_lo(gw.z), bf_hi(gw.z), bf_lo(gw.w), bf_hi(gw.w)};
                        f32x4 t0 = acc[ai][bj][m][0] * g0, t1 = acc[ai][bj][m][1] * g1; bf16_t* tp = MG + row * 2048 + col;
                        if (u.kind == 1) { const u32x4 tw = *(const u32x4*)tp; t0 += (f32x4){bf_lo(tw.x), bf_hi(tw.x), bf_lo(tw.y), bf_hi(tw.y)}; t1 += (f32x4){bf_lo(tw.z), bf_hi(tw.z), bf_lo(tw.w), bf_hi(tw.w)}; }
                        u32x4 w; w.x = cvt_pk_bf16(t0[0], t0[1]); w.y = cvt_pk_bf16(t0[2], t0[3]); w.z = cvt_pk_bf16(t1[0], t1[1]); w.w = cvt_pk_bf16(t1[2], t1[3]); *(u32x4*)tp = w; } }
        } else {
            const int col = u.pn * BM + (u.kind - 2) * HALF + cw;
#pragma unroll
            for (int ai = 0; ai < 2; ++ai)
#pragma unroll
                for (int m = 0; m < 4; ++m) { const size_t row = (size_t)(row0 + ai * HALF + m * 16);
                    const u32x4 gw = *(const u32x4*)(Gt + row * ldg + 2048 + col);
                    const float gg[8] = {bf_lo(gw.x), bf_hi(gw.x), bf_lo(gw.y), bf_hi(gw.y), bf_lo(gw.z), bf_hi(gw.z), bf_lo(gw.w), bf_hi(gw.w)};
                    bf16_t* tp = MG + row * 2048 + col; const u32x4 tw = *(const u32x4*)tp;
                    const float tt[8] = {bf_lo(tw.x), bf_hi(tw.x), bf_lo(tw.y), bf_hi(tw.y), bf_lo(tw.z), bf_hi(tw.z), bf_lo(tw.w), bf_hi(tw.w)}; float o[8];
#pragma unroll
                    for (int n = 0; n < 2; ++n)
#pragma unroll
                        for (int e = 0; e < 4; ++e) { const float ga = acc[ai][0][m][n][e], gb = acc[ai][1][m][n][e]; o[4 * n + e] = tt[4 * n + e] + gg[4 * n + e] * ga * sigmoidf_fast(gb); }
                    u32x4 w; w.x = cvt_pk_bf16(o[0], o[1]); w.y = cvt_pk_bf16(o[2], o[3]); w.z = cvt_pk_bf16(o[4], o[5]); w.w = cvt_pk_bf16(o[6], o[7]);
                    *(u32x4*)tp = w; }
        }
    }
};

template <class Epi, class Sched, bool ALIGN_EPI = false, bool SP2 = false>
__device__ __forceinline__ void gemm_phase(PG8_LAS unsigned char* lds, const int K, const Sched& S, const Epi& E) {
    int tid_ = threadIdx.x; asm volatile("" : "+v"(tid_));
    const int tid = tid_, wid = __builtin_amdgcn_readfirstlane(tid >> 6), lane = tid & 63, wr = wid >> 2, wc = wid & 3, fr = lane & 15, fq = lane >> 4;
    const int nt = K / BK;
    unsigned voffA[2], voffB[2];
#pragma unroll
    for (int i = 0; i < 2; ++i) { int R, C; stage_rc(tid * 16 + i * 8192, R, C); const int Rb = Epi::PERM ? ((R & ~31) + perm32(R & 31)) : R;
        voffA[i] = (unsigned)(R * K + C) * 2u; voffB[i] = (unsigned)(Rb * K + C) * 2u; }
    const size_t kstep = (size_t)(BK * 2);
    const size_t hstep = (size_t)HALF * K * 2;
    const unsigned ldsw = (unsigned)wid * 1024u;
    const int aoff = lds_byte(wr * 64 + fr, fq * 8), boff = lds_byte(wc * 32 + fr, fq * 8);
#define PG8_SA(b, h) (((b) * 2 + (h)) * HTB)
#define PG8_SB(b, h) ((4 + (b) * 2 + (h)) * HTB)
#define PG8_STAGE(bufoff, gbase, voff) do { _Pragma("unroll") for (int _i = 0; _i < 2; ++_i) \
        __builtin_amdgcn_global_load_lds((const unsigned*)((const char*)(gbase) + (voff)[_i]), (PG8_LAS unsigned*)(lds + (bufoff) + ldsw + _i * 8192), 16, 0, 0); } while (0)
#define PG8_LDA(dst, b, h) do { _Pragma("unroll") for (int m = 0; m < 4; ++m) _Pragma("unroll") for (int k = 0; k < 2; ++k) dst[m][k] = *(const PG8_LAS bf16x8*)(lds + PG8_SA(b, h) + aoff + m * 2048 + k * 1024); } while (0)
#define PG8_LDB(dst, b, h) do { _Pragma("unroll") for (int n = 0; n < 2; ++n) _Pragma("unroll") for (int k = 0; k < 2; ++k) dst[n][k] = *(const PG8_LAS bf16x8*)(lds + PG8_SB(b, h) + boff + n * 2048 + k * 1024); } while (0)
#define PG8_MMA(ai, bj, At, Bt) do { __builtin_amdgcn_s_setprio(1); _Pragma("unroll") for (int m = 0; m < 4; ++m) _Pragma("unroll") for (int n = 0; n < 2; ++n) _Pragma("unroll") for (int k = 0; k < 2; ++k) \
        acc[ai][bj][m][n] = __builtin_amdgcn_mfma_f32_16x16x32_bf16(Bt[n][k], At[m][k], acc[ai][bj][m][n], 0, 0, 0); __builtin_amdgcn_s_setprio(0); } while (0)
#define PG8_WAIT_V(n) asm volatile("s_waitcnt vmcnt(" #n ")" ::: "memory")
#define PG8_WAIT_L(n) asm volatile("s_waitcnt lgkmcnt(" #n ")" ::: "memory")
#define PG8_BAR __builtin_amdgcn_s_barrier()
#define PG8_SCHED __builtin_amdgcn_sched_barrier(0)
    Unit cur, nxt; int ui = 0;
    if (!S.next(0, cur)) return;
    f32x4 acc[2][2][4][2];
#pragma unroll
    for (int a = 0; a < 2; ++a)
#pragma unroll
        for (int b = 0; b < 2; ++b)
#pragma unroll
            for (int m = 0; m < 4; ++m)
#pragma unroll
                for (int n = 0; n < 2; ++n) acc[a][b][m][n] = (f32x4){0.f, 0.f, 0.f, 0.f};
    bf16x8 At[4][2], B0[2][2], B1[2][2];
    const char* cA; const char* cB; S.operands(cur, cA, cB);
    S.a_ready(cur);
    if constexpr (SP2) {
        PG8_STAGE(PG8_SB(0, 0), cB, voffB); PG8_STAGE(PG8_SB(0, 1), cB + hstep, voffB); PG8_STAGE(PG8_SA(0, 0), cA, voffA); PG8_STAGE(PG8_SA(0, 1), cA + hstep, voffA);
        if (wr == 1) PG8_BAR;
        PG8_WAIT_V(2); PG8_BAR;
        PG8_STAGE(PG8_SB(1, 0), cB + kstep, voffB); PG8_STAGE(PG8_SA(1, 0), cA + kstep, voffA); PG8_STAGE(PG8_SB(1, 1), cB + hstep + kstep, voffB);
        PG8_WAIT_V(6); PG8_BAR;
    } else {
        PG8_STAGE(PG8_SB(0, 0), cB, voffB); PG8_STAGE(PG8_SA(0, 0), cA, voffA); PG8_STAGE(PG8_SB(0, 1), cB + hstep, voffB); PG8_STAGE(PG8_SA(0, 1), cA + hstep, voffA);
        if (wr == 1) PG8_BAR;
        PG8_WAIT_V(4); PG8_BAR;
        PG8_STAGE(PG8_SB(1, 0), cB + kstep, voffB); PG8_STAGE(PG8_SA(1, 0), cA + kstep, voffA); PG8_STAGE(PG8_SB(1, 1), cB + hstep + kstep, voffB);
        PG8_WAIT_V(6); PG8_BAR;
    }
    for (;;) {
        const bool has_next = S.next(ui + 1, nxt);
        const char* nA = cA; const char* nB = cB; if (has_next) S.operands(nxt, nA, nB);
        for (int t = 0; t < nt; t += 2) {
            const bool last = (t == nt - 2);
            const char* a1 = cA + (size_t)(t + 1) * kstep;
            const char* a2 = last ? nA : cA + (size_t)(t + 2) * kstep; const char* b2 = last ? nB : cB + (size_t)(t + 2) * kstep;
            const char* a3 = a2 + kstep; const char* b3 = b2 + kstep;
            if (last && has_next) S.a_ready(nxt);
            if constexpr (SP2) {
            PG8_LDB(B0, 0, 0); PG8_LDB(B1, 0, 1); PG8_SCHED; PG8_LDA(At, 0, 0); PG8_STAGE(PG8_SA(1, 1), a1 + hstep, voffA);
            PG8_WAIT_V(8); PG8_WAIT_L(0); PG8_BAR; PG8_MMA(0, 0, At, B0); PG8_MMA(0, 1, At, B1); PG8_BAR; PG8_SCHED;
            PG8_LDA(At, 0, 1); PG8_STAGE(PG8_SB(0, 0), b2, voffB); PG8_STAGE(PG8_SB(0, 1), b2 + hstep, voffB); PG8_STAGE(PG8_SA(0, 0), a2, voffA);
            PG8_WAIT_V(8); PG8_WAIT_L(0); PG8_BAR; PG8_MMA(1, 0, At, B0); PG8_MMA(1, 1, At, B1); PG8_BAR; PG8_SCHED;
            PG8_LDB(B0, 1, 0); PG8_LDB(B1, 1, 1); PG8_SCHED; PG8_LDA(At, 1, 0); PG8_STAGE(PG8_SA(0, 1), a2 + hstep, voffA);
            PG8_WAIT_V(8); PG8_WAIT_L(0); PG8_BAR; PG8_MMA(0, 0, At, B0); PG8_MMA(0, 1, At, B1); PG8_BAR; PG8_SCHED;
            PG8_LDA(At, 1, 1); PG8_STAGE(PG8_SB(1, 0), b3, voffB); PG8_STAGE(PG8_SB(1, 1), b3 + hstep, voffB); PG8_STAGE(PG8_SA(1, 0), a3, voffA);
            PG8_WAIT_V(8); PG8_WAIT_L(0); PG8_BAR; PG8_MMA(1, 0, At, B0); PG8_MMA(1, 1, At, B1); PG8_BAR; PG8_SCHED;
            } else {
            PG8_LDB(B0, 0, 0); PG8_SCHED; PG8_LDA(At, 0, 0); PG8_STAGE(PG8_SA(1, 1), a1 + hstep, voffA);
            PG8_WAIT_L(8); PG8_BAR; PG8_WAIT_L(0); PG8_MMA(0, 0, At, B0); PG8_BAR; PG8_SCHED;
            PG8_LDB(B1, 0, 1); PG8_STAGE(PG8_SB(0, 0), b2, voffB);
            PG8_BAR; PG8_WAIT_L(0); PG8_MMA(0, 1, At, B1); PG8_BAR;
            PG8_LDA(At, 0, 1); PG8_STAGE(PG8_SA(0, 0), a2, voffA);
            PG8_BAR; PG8_WAIT_L(0); PG8_MMA(1, 0, At, B0); PG8_BAR; PG8_SCHED;
            PG8_STAGE(PG8_SB(0, 1), b2 + hstep, voffB);
            PG8_WAIT_V(6); PG8_BAR; PG8_MMA(1, 1, At, B1); PG8_BAR;
            PG8_LDB(B0, 1, 0); PG8_SCHED; PG8_LDA(At, 1, 0); PG8_STAGE(PG8_SA(0, 1), a2 + hstep, voffA);
            PG8_WAIT_L(8); PG8_BAR; PG8_WAIT_L(0); PG8_MMA(0, 0, At, B0); PG8_BAR; PG8_SCHED;
            PG8_LDB(B1, 1, 1); PG8_STAGE(PG8_SB(1, 0), b3, voffB);
            PG8_BAR; PG8_WAIT_L(0); PG8_MMA(0, 1, At, B1); PG8_BAR;
            PG8_LDA(At, 1, 1); PG8_STAGE(PG8_SA(1, 0), a3, voffA);
            PG8_BAR; PG8_WAIT_L(0); PG8_MMA(1, 0, At, B0); PG8_BAR; PG8_SCHED;
            PG8_STAGE(PG8_SB(1, 1), b3 + hstep, voffB);
            PG8_WAIT_V(6); PG8_BAR; PG8_MMA(1, 1, At, B1); PG8_BAR;
            }
        }
        if constexpr (ALIGN_EPI) { if (wr == 0) PG8_BAR; }
        if constexpr (!Epi::AFTER_DRAIN) { E(acc, cur, wr, wc, fr, fq); S.done(cur); }
        if (!has_next) break;
#pragma unroll
        for (int a = 0; a < 2; ++a)
#pragma unroll
            for (int b = 0; b < 2; ++b)
#pragma unroll
                for (int m = 0; m < 4; ++m)
#pragma unroll
                    for (int n = 0; n < 2; ++n) acc[a][b][m][n] = (f32x4){0.f, 0.f, 0.f, 0.f};
        cur = nxt; cA = nA; cB = nB; ++ui;
        if constexpr (ALIGN_EPI) { if (wr == 1) PG8_BAR; }
    }
    PG8_WAIT_V(0);
    if constexpr (!ALIGN_EPI) { if (wr == 0) PG8_BAR; }
    PG8_BAR;
    if constexpr (Epi::AFTER_DRAIN) { E.fused(acc, cur, wr, wc, fr, fq, lds, wid, lane); S.done(cur); }
#undef PG8_SA
#undef PG8_SB
#undef PG8_STAGE
#undef PG8_LDA
#undef PG8_LDB
#undef PG8_MMA
#undef PG8_WAIT_V
#undef PG8_WAIT_L
#undef PG8_BAR
#undef PG8_SCHED
}
}

constexpr int BATCH = 2, SEQ = 4096, DM = 2048, DEPTH = 4, NMEM = 256, DFF = 5632;
constexpr int T = BATCH * SEQ;
constexpr int INW = 9728, COL_Q = 0, COL_K = 1024, COL_V = 1280, COL_S = 1536, COL_MQ = 2560, COL_G = 3584;
constexpr float RMS_EPS = 1e-5f, LOG2E = 1.4426950408889634f;
constexpr int NWAVES = 8;
enum { I_X = 0, I_MEM, I_F1N, I_F1WI, I_F1WO, I_MIXN, I_MEMN, I_WIN, I_SINK, I_WMKV, I_LRE, I_LIM, I_LDT, I_BRE, I_BIM, I_CRE, I_CIM, I_DSK, I_WGLU, I_WSWA, I_WMEMUP, I_WOUT, I_F2N, I_F2WI, I_F2WO, I_FINN, N_IN };

constexpr size_t MiB = 1u << 20;
constexpr size_t WS_CTL = 0, CTL_ZERO_BYTES = 1 * MiB;
constexpr size_t WS_W = 2 * MiB, W_LAYER = 202 * MiB;
constexpr size_t WO_1IN = 0, WO_1OUT = 44 * MiB, WO_IN = 66 * MiB, WO_MKV = 104 * MiB, WO_SWA = 112 * MiB, WO_MEM = 116 * MiB, WO_GLU = 120 * MiB, WO_OUT = 128 * MiB, WO_2IN = 136 * MiB, WO_2OUT = 180 * MiB;
constexpr size_t WS_MEMN = WS_W + DEPTH * W_LAYER;
constexpr size_t WS_H = WS_MEMN + 8 * MiB;
constexpr size_t WS_XN = WS_H + 64 * MiB;
constexpr size_t WS_HID = WS_XN + 32 * MiB;
constexpr size_t WS_PROJ = WS_HID + 88 * MiB;
constexpr size_t WS_MKV = WS_PROJ + 152 * MiB;
constexpr size_t WS_OSWA = WS_MKV + 2 * MiB, WS_YS = WS_OSWA + 16 * MiB, WS_OMEM = WS_YS + 16 * MiB;
constexpr size_t WS_T32 = WS_OMEM + 16 * MiB;
constexpr size_t WS_MG = WS_T32 + 64 * MiB;
constexpr size_t WS_SEND = WS_MG + 32 * MiB;
constexpr size_t LB_BYTES = 65 * 512;
constexpr size_t WS_LB = WS_SEND + 4 * MiB;
constexpr size_t WS_WINT = WS_LB + 9 * MiB;
constexpr size_t WS_WOUTT = WS_WINT + 64 * MiB;
constexpr size_t WS_SST = WS_WOUTT + 64 * MiB;
constexpr size_t WS_SSQ = WS_SST + 2 * MiB;
constexpr size_t WS_END = WS_SSQ + 1 * MiB;
static_assert(DEPTH * 64 * LB_BYTES <= 9 * MiB, "lag tables fit");
constexpr int CW_BAR = 4096;

constexpr int RING_OFF = 0, RING_BYTES = 131072;
constexpr int LDSCTL_OFF = RING_BYTES, MISC_OFF = LDSCTL_OFF + 320;
constexpr int LDS_BYTES = 147456;

#define GAS __attribute__((address_space(1)))
#define LAS __attribute__((address_space(3)))
typedef unsigned short bf16;
typedef unsigned v4u __attribute__((ext_vector_type(4)));
typedef unsigned v2u __attribute__((ext_vector_type(2)));
typedef float f32x4 __attribute__((ext_vector_type(4)));
typedef float f32x2 __attribute__((ext_vector_type(2)));
typedef GAS unsigned gu32;
using pg8::cvt_pk_bf16; using pg8::bf_lo; using pg8::bf_hi;

#define XB_TMO      128
#define XB_XCNT(j)  (256  + 64 * (j))
#define XB_XSUB(j)  (1280 + 64 * (j))
#define XB_XGEN(j)  (2304 + 64 * (j))
#define XB_TOP      3328
#define XB_TOPGEN   3392
#define XCD_BAR_WORDS 3456
#define XB_SPIN_CAP (1u << 18)

__device__ __forceinline__ unsigned xb_ld(unsigned* p)              { return __hip_atomic_load(p, __ATOMIC_RELAXED, __HIP_MEMORY_SCOPE_AGENT); }
__device__ __forceinline__ unsigned xb_add(unsigned* p, unsigned v) { return __hip_atomic_fetch_add(p, v, __ATOMIC_RELAXED, __HIP_MEMORY_SCOPE_AGENT); }
__device__ __forceinline__ unsigned xb_xcc_id() { return (unsigned)__builtin_amdgcn_s_getreg((3 << 11) | 20) & 0xFu; }
#define XB_SPIN(cond, bar) do { unsigned _sp = 0; while (cond) { __builtin_amdgcn_s_sleep(1); \
    if ((++_sp & 255u) == 0u) { if (xb_ld(&(bar)[XB_TMO])) break; if (_sp > XB_SPIN_CAP) { atomicAdd(&(bar)[XB_TMO], 1u); break; } } } } while (0)

struct XcdBarrier {
    unsigned* bar; unsigned x;
    volatile LAS unsigned* st;
};

__device__ __forceinline__ XcdBarrier xcd_barrier_post(unsigned* bar, volatile LAS unsigned* st) {
    XcdBarrier b; b.bar = bar; b.x = xb_xcc_id(); b.st = st;
    if (threadIdx.x == 0) (void)xb_add(&bar[XB_XCNT(b.x)], 1u);
    return b;
}
__device__ __forceinline__ void xcd_barrier_complete(unsigned* bar, unsigned x, unsigned& nloc, unsigned& nx) {
    const unsigned G = gridDim.x * gridDim.y * gridDim.z;
    unsigned sum, cnt, mine, sp = 0u;
    for (;;) {
        sum = 0u; cnt = 0u; mine = 0u;
#pragma unroll
        for (unsigned j = 0; j < 16; ++j) { const unsigned c = xb_ld(&bar[XB_XCNT(j)]); sum += c; cnt += (c > 0u) ? 1u : 0u; mine = (j == x) ? c : mine; }
        if (sum == G) break;
        __builtin_amdgcn_s_sleep(1);
        if ((++sp & 255u) == 0u) { if (xb_ld(&bar[XB_TMO])) break; if (sp > XB_SPIN_CAP) { atomicAdd(&bar[XB_TMO], 1u); break; } }
    }
    nloc = mine > 0u ? mine : 1u; nx = cnt > 0u ? cnt : 1u;
}

__device__ __forceinline__ void xcd_barrier(const XcdBarrier& b) {
    asm volatile("s_waitcnt vmcnt(0)" ::: "memory");
    __syncthreads();
    if (threadIdx.x == 0) {
        unsigned* bar = b.bar;
        __builtin_amdgcn_s_waitcnt(0);
        unsigned nloc = b.st[0], nx = b.st[1];
        if (nloc == 0u) { xcd_barrier_complete(bar, b.x, nloc, nx); b.st[0] = nloc; b.st[1] = nx; }
        const unsigned old = xb_add(&bar[XB_XSUB(b.x)], 1u);
        const unsigned gen = old / nloc;
        if (old + 1u == (gen + 1u) * nloc) {
            __builtin_amdgcn_fence(__ATOMIC_RELEASE, "agent");
            asm volatile("s_waitcnt vmcnt(0)" ::: "memory");
            const unsigned og = xb_add(&bar[XB_TOP], 1u);
            const unsigned tg = og / nx;
            if (og + 1u == (tg + 1u) * nx) xb_add(&bar[XB_TOPGEN], 1u);
            else XB_SPIN(xb_ld(&bar[XB_TOPGEN]) == tg, bar);
            __builtin_amdgcn_fence(__ATOMIC_ACQUIRE, "agent");
            xb_add(&bar[XB_XGEN(b.x)], 1u);
            asm volatile("s_waitcnt vmcnt(0)" ::: "memory");
        } else {
            XB_SPIN(xb_ld(&bar[XB_XGEN(b.x)]) == gen, bar);
            __builtin_amdgcn_fence(__ATOMIC_ACQUIRE, "agent");
            asm volatile("s_waitcnt vmcnt(0)" ::: "memory");
        }
    }
    __syncthreads();
}

struct Frame {
    LAS unsigned char* lds;
    int tid, lane, wave, G;
    unsigned char* ws;
};
__device__ __forceinline__ float wave_sum(float v) {
#pragma unroll
    for (int o = 1; o < 64; o <<= 1) v += __shfl_xor(v, o);
    return v;
}
__device__ __forceinline__ bf16* wsb(const Frame& F, size_t off) { return (bf16*)(F.ws + off); }

struct ConvItem { const float* src; const float* gk; bf16* dst; int K, N; float scale; };
__device__ __forceinline__ void conv_load(const ConvItem& c, float (&v)[64]) {
#pragma unroll
    for (int i = 0; i < 64; ++i) v[i] = c.src[(size_t)i * c.N];
}
__device__ __forceinline__ void conv_store(const ConvItem& c, float (&v)[64], int lane, LAS unsigned char* scr) {
    if (c.gk) {
#pragma unroll
        for (int i = 0; i < 64; ++i) v[i] *= c.gk[i]; }
    const float scale = c.scale;
#pragma unroll
    for (int q = 0; q < 8; ++q) { v4u o; o.x = cvt_pk_bf16(v[8 * q] * scale, v[8 * q + 1] * scale); o.y = cvt_pk_bf16(v[8 * q + 2] * scale, v[8 * q + 3] * scale);
        o.z = cvt_pk_bf16(v[8 * q + 4] * scale, v[8 * q + 5] * scale); o.w = cvt_pk_bf16(v[8 * q + 6] * scale, v[8 * q + 7] * scale); *(LAS v4u*)(scr + lane * 144 + q * 16) = o; }
    asm volatile("s_waitcnt lgkmcnt(0)" ::: "memory");
#pragma unroll
    for (int i = 0; i < 8; ++i) { const v4u o = *(const LAS v4u*)(scr + (8 * i + (lane >> 3)) * 144 + (lane & 7) * 16); *(v4u*)(c.dst + (size_t)(8 * i) * c.K) = o; }
    asm volatile("s_waitcnt lgkmcnt(0)" ::: "memory");
}
constexpr int CI_1IN = (DM / 64) * (2 * DFF / 64), CI_1OUT = (DFF / 64) * (DM / 64), CI_IN = (DM / 64) * (INW / 64), CI_MKV = (DM / 64) * (2048 / 64), CI_GLU = (1024 / 64) * (4096 / 64),
              CI_SWA = (1024 / 64) * (DM / 64), CI_MEM = CI_SWA, CI_OUT = (DM / 64) * (DM / 64), CI_LAYER = 2 * CI_1IN + 2 * CI_1OUT + CI_IN + CI_MKV + CI_GLU + CI_SWA + CI_MEM + CI_OUT;
struct ProIn { const float *f1wi, *f2wi, *f1wo, *f2wo, *win, *wmkv, *wglu, *wswa, *wmem, *wout, *mem, *memn, *f1n, *f2n, *mixn, *x; };
__device__ __forceinline__ void prologue(Frame& F, const ProIn& I) {
    const int gw = blockIdx.x * NWAVES + F.wave, NGW = F.G * NWAVES, lane = F.lane;
    auto item = [&](int it, ConvItem& c) {
        const int l = it / CI_LAYER; int r = it % CI_LAYER; unsigned char* wl = F.ws + WS_W + (size_t)l * W_LAYER;
        const float* src; bf16* dst; int K, N, pairNh = 0; const float* gk = nullptr;
        if (r < CI_1IN) { src = I.f1wi + (size_t)l * DM * 2 * DFF; dst = (bf16*)(wl + WO_1IN); K = DM; N = 2 * DFF; pairNh = DFF; gk = I.f1n + (size_t)l * DM; }
        else if ((r -= CI_1IN) < CI_1IN) { src = I.f2wi + (size_t)l * DM * 2 * DFF; dst = (bf16*)(wl + WO_2IN); K = DM; N = 2 * DFF; pairNh = DFF; gk = I.f2n + (size_t)l * DM; }
        else if ((r -= CI_1IN) < CI_1OUT) { src = I.f1wo + (size_t)l * DFF * DM; dst = (bf16*)(wl + WO_1OUT); K = DFF; N = DM; }
        else if ((r -= CI_1OUT) < CI_1OUT) { src = I.f2wo + (size_t)l * DFF * DM; dst = (bf16*)(wl + WO_2OUT); K = DFF; N = DM; }
        else if ((r -= CI_1OUT) < CI_IN) { src = I.win + (size_t)l * DM * INW; dst = (bf16*)(wl + WO_IN); K = DM; N = INW; gk = I.mixn + (size_t)l * DM; }
        else if ((r -= CI_IN) < CI_MKV) { src = I.wmkv + (size_t)l * DM * 2048; dst = (bf16*)(wl + WO_MKV); K = DM; N = 2048; }
        else if ((r -= CI_MKV) < CI_GLU) { src = I.wglu + (size_t)l * 1024 * 4096; dst = (bf16*)(wl + WO_GLU); K = 1024; N = 4096; pairNh = 2048; }
        else if ((r -= CI_GLU) < CI_SWA) { src = I.wswa + (size_t)l * 1024 * DM; dst = (bf16*)(wl + WO_SWA); K = 1024; N = DM; }
        else if ((r -= CI_SWA) < CI_MEM) { src = I.wmem + (size_t)l * 1024 * DM; dst = (bf16*)(wl + WO_MEM); K = 1024; N = DM; }
        else { r -= CI_MEM; src = I.wout + (size_t)l * DM * DM; dst = (bf16*)(wl + WO_OUT); K = DM; N = DM; }
        const int nblk = N / 64, kb = r / nblk, nb = r % nblk, n0 = nb * 64, k0 = kb * 64;
        float sc = 1.f; if (N == INW) sc = n0 < COL_K ? 0.125f * LOG2E : ((n0 >= COL_MQ && n0 < COL_G) ? 0.0625f * LOG2E : 1.f);
        int row0 = n0; if (pairNh) { const int j = n0 < pairNh ? n0 : n0 - pairNh; row0 = (j >> 7) * 256 + (j & 127) + (n0 < pairNh ? 0 : 128); }
        c.src = src + (size_t)k0 * N + n0 + lane; c.gk = gk ? gk + k0 : nullptr; c.dst = dst + (size_t)(row0 + (lane >> 3)) * K + k0 + 8 * (lane & 7); c.K = K; c.N = N; c.scale = sc;
    };
    {
        LAS unsigned char* scr = F.lds + F.wave * 9216; constexpr int NIT = DEPTH * CI_LAYER;
        float va[64], vb[64]; ConvItem ca, cb; int it = gw;
        if (it < NIT) { item(it, ca); conv_load(ca, va); }
        while (it < NIT) {
            const int it1 = it + NGW; if (it1 < NIT) { item(it1, cb); conv_load(cb, vb); }
            conv_store(ca, va, lane, scr);
            if (it1 >= NIT) break;
            const int it2 = it1 + NGW; if (it2 < NIT) { item(it2, ca); conv_load(ca, va); }
            conv_store(cb, vb, lane, scr);
            it = it2;
        }
    }
    for (int m = gw; m < T; m += NGW) {
        const f32x4* xr = (const f32x4*)(I.x + (size_t)m * DM) + lane; v2u* o8 = (v2u*)(wsb(F, WS_XN) + (size_t)m * DM) + lane; float s = 0.f;
#pragma unroll
        for (int j = 0; j < 8; ++j) { const f32x4 v = xr[64 * j]; s += (v.x * v.x + v.y * v.y) + (v.z * v.z + v.w * v.w); v2u o; o.x = cvt_pk_bf16(v.x, v.y); o.y = cvt_pk_bf16(v.z, v.w); o8[64 * j] = o; }
        s = wave_sum(s); if (lane < 32) ((float*)(F.ws + WS_SSQ))[(size_t)m * 32 + lane] = lane == 0 ? s : 0.f;
    }
    for (int it = gw; it < DEPTH * 512; it += NGW) {
        const int l = it / 512, row = it % 512;
        const f32x4* xr = (const f32x4*)(I.mem + (size_t)row * DM) + lane; const f32x4* gr = (const f32x4*)(I.memn + (size_t)l * DM) + lane;
        f32x4 v[8]; float s = 0.f;
#pragma unroll
        for (int j = 0; j < 8; ++j) { v[j] = xr[64 * j]; s += (v[j].x * v[j].x + v[j].y * v[j].y) + (v[j].z * v[j].z + v[j].w * v[j].w); }
        const float rstd = 1.0f / sqrtf(wave_sum(s) * (1.f / DM) + RMS_EPS);
        v2u* o8 = (v2u*)(wsb(F, WS_MEMN) + ((size_t)l * 512 + row) * DM) + lane;
#pragma unroll
        for (int j = 0; j < 8; ++j) { const f32x4 g = gr[64 * j]; v2u o; o.x = cvt_pk_bf16(v[j].x * rstd * g.x, v[j].y * rstd * g.y); o.y = cvt_pk_bf16(v[j].z * rstd * g.z, v[j].w * rstd * g.w); o8[64 * j] = o; }
    }
}
constexpr int RSTD_OFF = LDSCTL_OFF + 1024;
__device__ __forceinline__ void rstd_table(Frame& F, int pm) {
    LAS float* tab = (LAS float*)(F.lds + RSTD_OFF);
    if (F.tid < 256) { const f32x4* q = (const f32x4*)((const float*)(F.ws + WS_SSQ) + ((size_t)pm * 256 + F.tid) * 32); float s = 0.f;
#pragma unroll
        for (int j = 0; j < 8; ++j) { const f32x4 a = q[j]; s += (a[0] + a[1]) + (a[2] + a[3]); }
        tab[F.tid] = 1.0f / sqrtf(s * (1.0f / DM) + RMS_EPS); }
    __syncthreads();
}
template <bool OUTF32>
__device__ __forceinline__ void norm_phase(Frame& F, const float* hin, const float* gain, void* outp) {
    const int gw = blockIdx.x * NWAVES + F.wave, NGW = F.G * NWAVES, lane = F.lane;
    f32x4 g[8];
#pragma unroll
    for (int j = 0; j < 8; ++j) g[j] = ((const f32x4*)gain)[lane + 64 * j];
    for (int m = gw; m < T; m += NGW) {
        const f32x4* xr = (const f32x4*)(hin + (size_t)m * DM) + lane;
        f32x4 v[8]; float s = 0.f;
#pragma unroll
        for (int j = 0; j < 8; ++j) { v[j] = xr[64 * j]; s += (v[j].x * v[j].x + v[j].y * v[j].y) + (v[j].z * v[j].z + v[j].w * v[j].w); }
        const float rstd = 1.0f / sqrtf(wave_sum(s) * (1.f / DM) + RMS_EPS);
        if (OUTF32) { f32x4* o = (f32x4*)((float*)outp + (size_t)m * DM) + lane;
#pragma unroll
            for (int j = 0; j < 8; ++j) o[64 * j] = v[j] * rstd * g[j];
        } else { v2u* o8 = (v2u*)((bf16*)outp + (size_t)m * DM) + lane;
#pragma unroll
            for (int j = 0; j < 8; ++j) { v2u o; o.x = cvt_pk_bf16(v[j].x * rstd * g[j].x, v[j].y * rstd * g[j].y); o.y = cvt_pk_bf16(v[j].z * rstd * g[j].z, v[j].w * rstd * g[j].w); o8[64 * j] = o; } }
    }
}
__device__ __forceinline__ void final_norm(Frame& F, const bf16* hb, const float* gain, float* outp) {
    const int gw = blockIdx.x * NWAVES + F.wave, NGW = F.G * NWAVES, lane = F.lane;
    for (int m = gw; m < T; m += NGW) {
        const v4u* xr = (const v4u*)(hb + (size_t)m * DM) + lane; float v[4][8]; float s = 0.f;
#pragma unroll
        for (int j = 0; j < 4; ++j) { const v4u w = xr[64 * j]; v[j][0] = bf_lo(w.x); v[j][1] = bf_hi(w.x); v[j][2] = bf_lo(w.y); v[j][3] = bf_hi(w.y); v[j][4] = bf_lo(w.z); v[j][5] = bf_hi(w.z); v[j][6] = bf_lo(w.w); v[j][7] = bf_hi(w.w);
#pragma unroll
            for (int e = 0; e < 8; ++e) s += v[j][e] * v[j][e]; }
        const float rstd = 1.0f / sqrtf(wave_sum(s) * (1.f / DM) + RMS_EPS);
#pragma unroll
        for (int j = 0; j < 4; ++j) { const f32x4* g = (const f32x4*)(gain + (lane + 64 * j) * 8); f32x4* o = (f32x4*)(outp + (size_t)m * DM + (lane + 64 * j) * 8); const f32x4 g0 = g[0], g1 = g[1];
            o[0] = (f32x4){v[j][0] * rstd * g0[0], v[j][1] * rstd * g0[1], v[j][2] * rstd * g0[2], v[j][3] * rstd * g0[3]}; o[1] = (f32x4){v[j][4] * rstd * g1[0], v[j][5] * rstd * g1[1], v[j][6] * rstd * g1[2], v[j][7] * rstd * g1[3]}; }
    }
}
__device__ __forceinline__ void unpack8(const v4u w, float* f) { f[0] = bf_lo(w.x); f[1] = bf_hi(w.x); f[2] = bf_lo(w.y); f[3] = bf_hi(w.y); f[4] = bf_lo(w.z); f[5] = bf_hi(w.z); f[6] = bf_lo(w.w); f[7] = bf_hi(w.w); }

__device__ __forceinline__ void swa_naive(Frame& F, const float* sinks) {
    const bf16* P = wsb(F, WS_PROJ); bf16* O = wsb(F, WS_OSWA);
    for (int idx = blockIdx.x * 512 + F.tid; idx < T * 16; idx += F.G * 512) {
        const int hq = idx / T, m = idx % T, b = m / SEQ, t = m % SEQ, g = hq >> 2;
        float q[64];
        { const v4u* qp = (const v4u*)(P + (size_t)m * INW + COL_Q + hq * 64);
#pragma unroll
          for (int j = 0; j < 8; ++j) unpack8(qp[j], q + 8 * j); }
        float mrun = sinks[hq] * LOG2E, lrun = 1.f, o[64];
#pragma unroll
        for (int j = 0; j < 64; ++j) o[j] = 0.f;
        const int k0 = t >= 127 ? t - 127 : 0;
        for (int kp = k0; kp <= t; ++kp) {
            const bf16* kr = P + (size_t)(b * SEQ + kp) * INW + COL_K + g * 64; const bf16* vr = kr + (COL_V - COL_K);
            float s0 = 0.f, s1 = 0.f;
#pragma unroll
            for (int j = 0; j < 8; ++j) { float kf[8]; unpack8(((const v4u*)kr)[j], kf);
#pragma unroll
                for (int e = 0; e < 8; e += 2) { s0 += q[8 * j + e] * kf[e]; s1 += q[8 * j + e + 1] * kf[e + 1]; } }
            const float s = s0 + s1, mnew = fmaxf(mrun, s), corr = __builtin_amdgcn_exp2f(mrun - mnew), p = __builtin_amdgcn_exp2f(s - mnew);
            lrun = lrun * corr + p; mrun = mnew;
#pragma unroll
            for (int j = 0; j < 8; ++j) { float vf[8]; unpack8(((const v4u*)vr)[j], vf);
#pragma unroll
                for (int e = 0; e < 8; ++e) o[8 * j + e] = o[8 * j + e] * corr + p * vf[e]; }
        }
        const float inv = 1.0f / lrun; v4u* op = (v4u*)(O + (size_t)m * 1024 + hq * 64);
#pragma unroll
        for (int j = 0; j < 8; ++j) { v4u w; w.x = cvt_pk_bf16(o[8 * j] * inv, o[8 * j + 1] * inv); w.y = cvt_pk_bf16(o[8 * j + 2] * inv, o[8 * j + 3] * inv);
            w.z = cvt_pk_bf16(o[8 * j + 4] * inv, o[8 * j + 5] * inv); w.w = cvt_pk_bf16(o[8 * j + 6] * inv, o[8 * j + 7] * inv); op[j] = w; }
    }
}
__device__ __forceinline__ void memattn_naive(Frame& F) {
    const bf16* P = wsb(F, WS_PROJ); const bf16* KV = wsb(F, WS_MKV); bf16* O = wsb(F, WS_OMEM);
    LAS float* qs = (LAS float*)F.lds;
    LAS float* ss = qs + 32 * 260;
    const int tid = F.tid, ti = tid >> 4, kg = tid & 15;
    for (int unit = blockIdx.x; unit < 1024; unit += F.G) {
        const int b = unit >> 9, hd = (unit >> 7) & 3, tb = unit & 127, m0 = b * SEQ + tb * 32;
        { const v4u* src = (const v4u*)(P + (size_t)(m0 + ti) * INW + COL_MQ + hd * 256 + kg * 16); float f[16]; unpack8(src[0], f); unpack8(src[1], f + 8);
#pragma unroll
          for (int e = 0; e < 16; ++e) qs[ti * 260 + kg * 16 + e] = f[e]; }
        __syncthreads();
        float sc[16];
#pragma unroll 1
        for (int i = 0; i < 16; ++i) { const int key = kg + 16 * i; const v4u* kr = (const v4u*)(KV + (size_t)(b * NMEM + key) * 2048 + hd * 256);
            float a0 = 0.f, a1 = 0.f;
#pragma unroll 8
            for (int d8 = 0; d8 < 32; ++d8) { float kf[8]; unpack8(kr[d8], kf); const LAS f32x4* qp = (const LAS f32x4*)(qs + ti * 260 + d8 * 8); const f32x4 qa = qp[0], qb = qp[1];
                a0 += qa.x * kf[0] + qa.y * kf[1] + qa.z * kf[2] + qa.w * kf[3]; a1 += qb.x * kf[4] + qb.y * kf[5] + qb.z * kf[6] + qb.w * kf[7]; }
            ss[ti * 257 + key] = a0 + a1; }
        __syncthreads();
        float mx = -3.0e38f;
#pragma unroll
        for (int i = 0; i < 16; ++i) { sc[i] = ss[ti * 257 + kg + 16 * i]; mx = fmaxf(mx, sc[i]); }
#pragma unroll
        for (int o = 1; o < 16; o <<= 1) mx = fmaxf(mx, __shfl_xor(mx, o));
        float sum = 0.f;
#pragma unroll
        for (int i = 0; i < 16; ++i) { sc[i] = __builtin_amdgcn_exp2f(sc[i] - mx); sum += sc[i]; }
#pragma unroll
        for (int o = 1; o < 16; o <<= 1) sum += __shfl_xor(sum, o);
        const float inv = 1.0f / sum;
#pragma unroll
        for (int i = 0; i < 16; ++i) ss[ti * 257 + kg + 16 * i] = sc[i] * inv;
        __syncthreads();
        float o[16];
#pragma unroll
        for (int e = 0; e < 16; ++e) o[e] = 0.f;
#pragma unroll 4
        for (int key = 0; key < NMEM; ++key) { const float p = ss[ti * 257 + key]; const v4u* vr = (const v4u*)(KV + (size_t)(b * NMEM + key) * 2048 + 1024 + hd * 256 + kg * 16);
            float vf[16]; unpack8(vr[0], vf); unpack8(vr[1], vf + 8);
#pragma unroll
            for (int e = 0; e < 16; ++e) o[e] += p * vf[e]; }
        v4u* op = (v4u*)(O + (size_t)(m0 + ti) * 1024 + hd * 256 + kg * 16);
        v4u w; w.x = cvt_pk_bf16(o[0], o[1]); w.y = cvt_pk_bf16(o[2], o[3]); w.z = cvt_pk_bf16(o[4], o[5]); w.w = cvt_pk_bf16(o[6], o[7]); op[0] = w;
        w.x = cvt_pk_bf16(o[8], o[9]); w.y = cvt_pk_bf16(o[10], o[11]); w.z = cvt_pk_bf16(o[12], o[13]); w.w = cvt_pk_bf16(o[14], o[15]); op[1] = w;
        __syncthreads();
    }
}
__device__ __forceinline__ void sincos_red(double x, float& s, float& c) {
    const double k = __builtin_rint(x * 0.63661977236758134308); const double r = (x - k * 1.57079632679489655800) - k * 6.123233995736766036e-17; const double r2 = r * r;
    double sp = -7.6471637318198164759e-13; sp = sp * r2 + 1.6059043836821614599e-10; sp = sp * r2 - 2.5052108385441718775e-8; sp = sp * r2 + 2.7557319223985890653e-6; sp = sp * r2 - 1.9841269841269841270e-4; sp = sp * r2 + 8.3333333333333333333e-3; sp = sp * r2 - 1.6666666666666666667e-1;
    const double sr = r + r * r2 * sp;
    double cp = -1.1470745597729724714e-11; cp = cp * r2 + 2.0876756987868098979e-9; cp = cp * r2 - 2.7557319223985890653e-7; cp = cp * r2 + 2.4801587301587301587e-5; cp = cp * r2 - 1.3888888888888888889e-3; cp = cp * r2 + 4.1666666666666666667e-2; cp = cp * r2 - 0.5;
    const double cr = 1.0 + r2 * cp;
    const int q = ((int)k) & 3;
    const double ss = (q & 1) ? cr : sr, cc = (q & 1) ? sr : cr;
    s = (float)((q & 2) ? -ss : ss); c = (float)(((q == 1) || (q == 2)) ? -cc : cc);
}
struct SsmState { float ar, ai, a64r, a64i; float bbr[16], bbi[16]; };
struct SsmIn { const float *lre, *lim, *ldt, *bre, *bim, *cre, *cim, *dsk; };
__device__ __forceinline__ void ssm_params(const SsmIn& I, int g, int p, SsmState& S) {
    const int gp = g * 64 + p;
    const float lr = fminf(I.lre[gp], -1e-4f), li = I.lim[gp], dt = expf(I.ldt[g]);
    const float mag = expf(lr * dt); float sn, cs; const double th = (double)li * (double)dt; sincos_red(th, sn, cs);
    S.ar = mag * cs; S.ai = mag * sn;
    const float mag64 = expf(lr * dt * 64.f); sincos_red(th * 64.0, sn, cs); S.a64r = mag64 * cs; S.a64i = mag64 * sn;
    const float nr = S.ar - 1.f, ni = S.ai, den = lr * lr + li * li, kr = (nr * lr + ni * li) / den, ki = (ni * lr - nr * li) / den;
    const float* br = I.bre + (size_t)gp * 16; const float* bi = I.bim + (size_t)gp * 16;
#pragma unroll
    for (int c = 0; c < 16; ++c) { S.bbr[c] = kr * br[c] - ki * bi[c]; S.bbi[c] = kr * bi[c] + ki * br[c]; }
}
__device__ __forceinline__ void ssm_step(const SsmState& S, const bf16* up, float& sr, float& si) {
    const v4u* u4 = (const v4u*)up; float uf[16]; unpack8(u4[0], uf); unpack8(u4[1], uf + 8);
    float xr = 0.f, xi = 0.f;
#pragma unroll
    for (int c = 0; c < 16; ++c) { xr += S.bbr[c] * uf[c]; xi += S.bbi[c] * uf[c]; }
    const float nr = S.ar * sr - S.ai * si + xr, ni = S.ar * si + S.ai * sr + xi; sr = nr; si = ni;
}
__device__ __forceinline__ void ssm_local(Frame& F, const SsmIn& I) {
    const bf16* P = wsb(F, WS_PROJ); f32x2* SE = (f32x2*)(F.ws + WS_SEND);
    const int gw = blockIdx.x * NWAVES + F.wave, NGW = F.G * NWAVES, p = F.lane;
    for (int u = gw; u < 2 * 64 * 64; u += NGW) {
        const int g = u & 63, ch = (u >> 6) & 63, b = u >> 12;
        SsmState S; ssm_params(I, g, p, S);
        float sr = 0.f, si = 0.f; const bf16* up = P + (size_t)(b * SEQ + ch * 64) * INW + COL_S + g * 16;
#pragma unroll 4
        for (int j = 0; j < 64; ++j) ssm_step(S, up + (size_t)j * INW, sr, si);
        SE[((size_t)(b * 64 + ch) * 64 + g) * 64 + p] = (f32x2){sr, si};
    }
}
__device__ __forceinline__ void ssm_replay(Frame& F, const SsmIn& I) {
    const bf16* P = wsb(F, WS_PROJ); const f32x2* SE = (const f32x2*)(F.ws + WS_SEND); bf16* Y = wsb(F, WS_YS);
    LAS f32x2* Cs = (LAS f32x2*)F.lds;
    LAS float* Ds = (LAS float*)(F.lds + 16 * 65 * 8);
    LAS f32x2* Sw = (LAS f32x2*)(F.lds + 16384) + F.wave * (16 * 65);
    const int p = F.lane, jj = F.lane >> 2, cq = F.lane & 3;
    for (int unit = blockIdx.x; unit < 1024; unit += F.G) {
        const int oct = unit & 7, g = (unit >> 3) & 63, b = unit >> 9, ch = oct * 8 + F.wave;
        for (int e = F.tid; e < 1024; e += 512) { const int c = e >> 6, pp = e & 63; const size_t gi = ((size_t)g * 16 + c) * 64 + pp; Cs[c * 65 + pp] = (f32x2){I.cre[gi], I.cim[gi]}; }
        if (F.tid < 16) Ds[F.tid] = I.dsk[g * 16 + F.tid];
        __syncthreads();
        SsmState S; ssm_params(I, g, p, S);
        float sr = 0.f, si = 0.f;
        for (int j = 0; j < ch; ++j) { const f32x2 e = SE[((size_t)(b * 64 + j) * 64 + g) * 64 + p]; const float nr = S.a64r * sr - S.a64i * si + e.x, ni = S.a64r * si + S.a64i * sr + e.y; sr = nr; si = ni; }
        const size_t tok0 = (size_t)b * SEQ + ch * 64;
#pragma unroll 1
        for (int sub = 0; sub < 4; ++sub) {
#pragma unroll 4
            for (int j = 0; j < 16; ++j) { ssm_step(S, P + (tok0 + sub * 16 + j) * INW + COL_S + g * 16, sr, si); Sw[j * 65 + p] = (f32x2){sr, si}; }
            asm volatile("s_waitcnt lgkmcnt(0)" ::: "memory");
            float acc[4] = {0.f, 0.f, 0.f, 0.f};
#pragma unroll 4
            for (int pp = 0; pp < 64; ++pp) { const f32x2 sv = Sw[jj * 65 + pp];
#pragma unroll
                for (int ci = 0; ci < 4; ++ci) { const f32x2 cv = Cs[(cq * 4 + ci) * 65 + pp]; acc[ci] += cv.x * sv.x - cv.y * sv.y; } }
            const size_t tok = tok0 + sub * 16 + jj; const v2u uw = *(const v2u*)(P + tok * INW + COL_S + g * 16 + cq * 4);
            const float u0 = bf_lo(uw.x), u1 = bf_hi(uw.x), u2 = bf_lo(uw.y), u3 = bf_hi(uw.y);
            v2u o; o.x = cvt_pk_bf16(acc[0] + Ds[cq * 4] * u0, acc[1] + Ds[cq * 4 + 1] * u1); o.y = cvt_pk_bf16(acc[2] + Ds[cq * 4 + 2] * u2, acc[3] + Ds[cq * 4 + 3] * u3);
            *(v2u*)(Y + tok * 1024 + g * 16 + cq * 4) = o;
            asm volatile("s_waitcnt lgkmcnt(0)" ::: "memory");
        }
        __syncthreads();
    }
}

typedef short bf16x8 __attribute__((ext_vector_type(8)));
typedef short s16x4 __attribute__((ext_vector_type(4)));
typedef float f32x16 __attribute__((ext_vector_type(16)));
__device__ __forceinline__ s16x4 lds_tr16(const LAS unsigned char* p) { return __builtin_bit_cast(s16x4, __builtin_amdgcn_ds_read_tr16_b64_v4i16((LAS s16x4*)p)); }
__device__ __forceinline__ bf16x8 cat8(s16x4 lo, s16x4 hi) { return (bf16x8){lo[0], lo[1], lo[2], lo[3], hi[0], hi[1], hi[2], hi[3]}; }
__device__ __forceinline__ bf16x8 pack8(float a0, float a1, float a2, float a3, float a4, float a5, float a6, float a7) {
    v4u w; w.x = cvt_pk_bf16(a0, a1); w.y = cvt_pk_bf16(a2, a3); w.z = cvt_pk_bf16(a4, a5); w.w = cvt_pk_bf16(a6, a7); return __builtin_bit_cast(bf16x8, w); }

__device__ __forceinline__ void swa_mfma(Frame& F, const float* sinks) {
    const bf16* P = wsb(F, WS_PROJ); bf16* O = wsb(F, WS_OSWA);
    LAS unsigned char* Kl = F.lds;
    LAS unsigned char* Vl = F.lds + 36864;
    const int tid = F.tid, lane = F.lane, w = F.wave, r = w >> 1, qh = w & 1, l31 = lane & 31, h = lane >> 5;
    for (int unit = blockIdx.x; unit < 256; unit += F.G) {
        const int n = unit & 31, g = (unit >> 5) & 3, b = unit >> 7;
#pragma unroll
        for (int i = 0; i < 4; ++i) { const int c = tid + 512 * i, key = c >> 3, part = c & 7, pos = (n - 1) * 128 + key;
            v4u kv = {0u, 0u, 0u, 0u}, vv = {0u, 0u, 0u, 0u};
            if (pos >= 0) { const bf16* src = P + (size_t)(b * SEQ + pos) * INW + COL_K + g * 64 + part * 8; kv = *(const v4u*)src; vv = *(const v4u*)(src + (COL_V - COL_K)); }
            *(LAS v4u*)(Kl + key * 144 + part * 16) = kv;
            *(LAS v4u*)(Vl + (part >> 2) * 16384 + key * 64 + (part & 3) * 16) = vv; }
        __syncthreads();
        const int hq = g * 4 + r; const float sink2 = sinks[hq] * LOG2E;
#pragma unroll 1
        for (int qt = 0; qt < 2; ++qt) {
            const int a = qh * 2 + qt, qi = a * 32 + l31; const size_t m = (size_t)b * SEQ + n * 128 + qi;
            bf16x8 qf[4];
#pragma unroll
            for (int ds = 0; ds < 4; ++ds) qf[ds] = *(const bf16x8*)(P + m * INW + COL_Q + hq * 64 + ds * 16 + h * 8);
            f32x16 s[5];
#pragma unroll
            for (int k5 = 0; k5 < 5; ++k5) { f32x16 acc;
#pragma unroll
                for (int e = 0; e < 16; ++e) acc[e] = 0.f;
#pragma unroll
                for (int ds = 0; ds < 4; ++ds) { const bf16x8 kf = *(const LAS bf16x8*)(Kl + (32 * (a + k5) + l31) * 144 + ds * 32 + h * 16); acc = __builtin_amdgcn_mfma_f32_32x32x16_bf16(kf, qf[ds], acc, 0, 0, 0); }
                s[k5] = acc; }
            float mx = sink2;
#pragma unroll
            for (int k5 = 0; k5 < 5; ++k5)
#pragma unroll
                for (int e = 0; e < 16; ++e) { const int kl = 32 * (a + k5) + (e & 3) + 8 * (e >> 2) + 4 * h; const bool ok = (kl > qi) && (kl <= qi + 128) && (n > 0 || kl >= 128);
                    const float v = ok ? s[k5][e] : -1.0e30f; s[k5][e] = v; mx = fmaxf(mx, v); }
            mx = fmaxf(mx, __shfl_xor(mx, 32));
            float sum = 0.f;
#pragma unroll
            for (int k5 = 0; k5 < 5; ++k5)
#pragma unroll
                for (int e = 0; e < 16; ++e) { const float p = __builtin_amdgcn_exp2f(s[k5][e] - mx); s[k5][e] = p; sum += p; }
            sum += __shfl_xor(sum, 32); sum += __builtin_amdgcn_exp2f(sink2 - mx);
            f32x16 o[2];
#pragma unroll
            for (int e = 0; e < 16; ++e) { o[0][e] = 0.f; o[1][e] = 0.f; }
#pragma unroll
            for (int k5 = 0; k5 < 5; ++k5)
#pragma unroll
                for (int s2 = 0; s2 < 2; ++s2) { const bf16x8 pf = pack8(s[k5][8 * s2], s[k5][8 * s2 + 1], s[k5][8 * s2 + 2], s[k5][8 * s2 + 3], s[k5][8 * s2 + 4], s[k5][8 * s2 + 5], s[k5][8 * s2 + 6], s[k5][8 * s2 + 7]);
                    const int base0 = 32 * (a + k5) + 16 * s2 + 4 * h;
#pragma unroll
                    for (int db = 0; db < 2; ++db) { const LAS unsigned char* vp = Vl + db * 16384 + (base0 + ((lane & 15) >> 2)) * 64 + (16 * ((lane >> 4) & 1) + 4 * (lane & 3)) * 2;
                        const bf16x8 vf = cat8(lds_tr16(vp), lds_tr16(vp + 8 * 64)); o[db] = __builtin_amdgcn_mfma_f32_32x32x16_bf16(vf, pf, o[db], 0, 0, 0); } }
            const float inv = 1.0f / sum;
#pragma unroll
            for (int db = 0; db < 2; ++db)
#pragma unroll
                for (int g4 = 0; g4 < 4; ++g4) { v2u wv; wv.x = cvt_pk_bf16(o[db][4 * g4] * inv, o[db][4 * g4 + 1] * inv); wv.y = cvt_pk_bf16(o[db][4 * g4 + 2] * inv, o[db][4 * g4 + 3] * inv);
                    *(v2u*)(O + m * 1024 + hq * 64 + db * 32 + 8 * g4 + 4 * h) = wv; }
        }
        __syncthreads();
    }
}
__device__ __forceinline__ void memattn_mfma(Frame& F) {
    const bf16* P = wsb(F, WS_PROJ); const bf16* KV = wsb(F, WS_MKV); bf16* O = wsb(F, WS_OMEM);
    constexpr int RS = 544, SLOT = 64 * RS;
    const int tid = F.tid, lane = F.lane, w = F.wave, l15 = lane & 15, kq = lane >> 4;
    for (int unit = blockIdx.x; unit < 256; unit += F.G) {
        const int tb = unit & 31, hd = (unit >> 5) & 3, b = unit >> 7; const size_t m = (size_t)b * SEQ + tb * 128 + w * 16 + l15;
        bf16x8 qf[8];
#pragma unroll
        for (int ds = 0; ds < 8; ++ds) qf[ds] = *(const bf16x8*)(P + m * INW + COL_MQ + hd * 256 + ds * 32 + kq * 8);
        v4u st[4];
#define MA_LOAD(t) do { _Pragma("unroll") for (int i_ = 0; i_ < 4; ++i_) { const int c_ = tid + 512 * i_, row_ = c_ >> 5, part_ = c_ & 31; \
            st[i_] = *(const v4u*)(KV + (size_t)(b * NMEM + 64 * ((t) & 3) + row_) * 2048 + ((t) >> 2) * 1024 + hd * 256 + part_ * 8); } } while (0)
#define MA_STORE(buf) do { _Pragma("unroll") for (int i_ = 0; i_ < 4; ++i_) { const int c_ = tid + 512 * i_, row_ = c_ >> 5, part_ = c_ & 31; *(LAS v4u*)((buf) + row_ * RS + part_ * 16) = st[i_]; } } while (0)
        MA_LOAD(0); MA_STORE(F.lds); __syncthreads();
        f32x4 s[16]; f32x4 o[16]; float inv = 0.f;
#pragma unroll
        for (int t = 0; t < 8; ++t) {
            if (t < 7) MA_LOAD(t + 1);
            const LAS unsigned char* cur = F.lds + (t & 1) * SLOT;
            if (t < 4) {
#pragma unroll
                for (int k4 = 0; k4 < 4; ++k4) { f32x4 acc = {0.f, 0.f, 0.f, 0.f};
#pragma unroll
                    for (int ds = 0; ds < 8; ++ds) { const bf16x8 kf = *(const LAS bf16x8*)(cur + (16 * k4 + l15) * RS + ds * 64 + kq * 16); acc = __builtin_amdgcn_mfma_f32_16x16x32_bf16(kf, qf[ds], acc, 0, 0, 0); }
                    s[4 * t + k4] = acc; }
                if (t == 3) {
                    float mx = -3.0e38f;
#pragma unroll
                    for (int i = 0; i < 16; ++i) mx = fmaxf(mx, fmaxf(fmaxf(s[i][0], s[i][1]), fmaxf(s[i][2], s[i][3])));
                    mx = fmaxf(mx, __shfl_xor(mx, 16)); mx = fmaxf(mx, __shfl_xor(mx, 32));
                    float sum = 0.f;
#pragma unroll
                    for (int i = 0; i < 16; ++i)
#pragma unroll
                        for (int e = 0; e < 4; ++e) { const float p = __builtin_amdgcn_exp2f(s[i][e] - mx); s[i][e] = p; sum += p; }
                    sum += __shfl_xor(sum, 16); sum += __shfl_xor(sum, 32); inv = 1.0f / sum;
#pragma unroll
                    for (int i = 0; i < 16; ++i) o[i] = (f32x4){0.f, 0.f, 0.f, 0.f};
                }
            } else {
                const int tv = t - 4;
#pragma unroll
                for (int s2 = 0; s2 < 2; ++s2) { const f32x4 p0 = s[4 * tv + 2 * s2], p1 = s[4 * tv + 2 * s2 + 1]; const bf16x8 pf = pack8(p0[0], p0[1], p0[2], p0[3], p1[0], p1[1], p1[2], p1[3]);
#pragma unroll
                    for (int db = 0; db < 16; ++db) { const LAS unsigned char* vp = cur + (32 * s2 + 4 * kq + (l15 >> 2)) * RS + (16 * db + 4 * (lane & 3)) * 2;
                        const bf16x8 vf = cat8(lds_tr16(vp), lds_tr16(vp + 16 * RS)); o[db] = __builtin_amdgcn_mfma_f32_16x16x32_bf16(vf, pf, o[db], 0, 0, 0); } }
            }
            if (t < 7) MA_STORE(F.lds + ((t + 1) & 1) * SLOT);
            __syncthreads();
        }
#undef MA_LOAD
#undef MA_STORE
#pragma unroll
        for (int db = 0; db < 16; ++db) { v2u wv; wv.x = cvt_pk_bf16(o[db][0] * inv, o[db][1] * inv); wv.y = cvt_pk_bf16(o[db][2] * inv, o[db][3] * inv); *(v2u*)(O + m * 1024 + hd * 256 + 16 * db + 4 * kq) = wv; }
    }
}

__device__ __forceinline__ void cmul(float ar, float ai, float br, float bi, float& cr, float& ci) { cr = ar * br - ai * bi; ci = ar * bi + ai * br; }
__device__ __forceinline__ void ssm_tables(Frame& F, const SsmIn& I0) {
    LAS f32x2* AP = (LAS f32x2*)F.lds;
    LAS f32x2* BB = (LAS f32x2*)(F.lds + 33280);
    LAS f32x2* CC = (LAS f32x2*)(F.lds + 33280 + 8192);
    LAS f32x2* KC = (LAS f32x2*)(F.lds + 33280 + 16384);
    const int t = F.tid;
    for (int unit = blockIdx.x; unit < DEPTH * 64; unit += F.G) {
        const int l = unit >> 6, g = unit & 63, gp0 = unit * 64;
        const float dt = expf(I0.ldt[unit]);
        for (int e = t; e < 65 * 64; e += 512) { const int ee = e >> 6, p = e & 63; const float lr = fminf(I0.lre[gp0 + p], -1e-4f), li = I0.lim[gp0 + p];
            const float mag = expf(lr * dt * (float)ee); float sn, cs; sincos_red((double)li * (double)dt * (double)ee, sn, cs); AP[e] = (f32x2){mag * cs, mag * sn}; }
        __syncthreads();
        if (t < 64) { const float lr = fminf(I0.lre[gp0 + t], -1e-4f), li = I0.lim[gp0 + t]; const f32x2 a = AP[64 + t]; const float nr = a.x - 1.f, ni = a.y, den = lr * lr + li * li;
            KC[t] = (f32x2){(nr * lr + ni * li) / den, (ni * lr - nr * li) / den}; }
        __syncthreads();
        for (int e = t; e < 1024; e += 512) { const int p = e >> 4; const f32x2 k = KC[p]; const float br = I0.bre[(size_t)gp0 * 16 + e], bi = I0.bim[(size_t)gp0 * 16 + e];
            BB[e] = (f32x2){k.x * br - k.y * bi, k.x * bi + k.y * br}; CC[e] = (f32x2){I0.cre[(size_t)gp0 * 16 + e], I0.cim[(size_t)gp0 * 16 + e]}; }
        __syncthreads();
        bf16* WinT = wsb(F, WS_WINT) + (size_t)unit * 131072; bf16* WoutT = wsb(F, WS_WOUTT) + (size_t)unit * 131072; bf16* LB = (bf16*)(F.ws + WS_LB + (size_t)unit * LB_BYTES);
        for (int q = t; q < 16384; q += 512) { const int n = q >> 7, ck = q & 127, j = ck >> 1, half = ck & 1, p = 16 * (n >> 5) + (n & 15), isim = (n >> 4) & 1; const f32x2 a = AP[(63 - j) * 64 + p]; float v[8];
#pragma unroll
            for (int e = 0; e < 8; ++e) { const f32x2 bb = BB[p * 16 + 8 * half + e]; float zr, zi; cmul(a.x, a.y, bb.x, bb.y, zr, zi); v[e] = isim ? zi : zr; }
            *(bf16x8*)(WinT + (size_t)n * 1024 + ck * 8) = pack8(v[0], v[1], v[2], v[3], v[4], v[5], v[6], v[7]); }
        for (int q = t; q < 16384; q += 512) { const int row = q >> 4, ck = q & 15, tau = row >> 4, c = row & 15, isim = ck >> 3, p0 = (8 * ck) & 63; float v[8];
#pragma unroll
            for (int e = 0; e < 8; ++e) { const f32x2 cc = CC[c * 64 + p0 + e], a = AP[(tau + 1) * 64 + p0 + e]; float zr, zi; cmul(cc.x, cc.y, a.x, a.y, zr, zi); v[e] = isim ? -zi : zr; }
            *(bf16x8*)(WoutT + (size_t)row * 128 + ck * 8) = pack8(v[0], v[1], v[2], v[3], v[4], v[5], v[6], v[7]); }
        { const int c = (t >> 4) & 15, c2 = t & 15, lh = t >> 8; float acc[32];
#pragma unroll
          for (int d = 0; d < 32; ++d) acc[d] = 0.f;
#pragma unroll 2
          for (int p = 0; p < 64; ++p) { const f32x2 cc = CC[c * 64 + p], bb = BB[p * 16 + c2]; float zr, zi; cmul(cc.x, cc.y, bb.x, bb.y, zr, zi);
#pragma unroll
              for (int d = 0; d < 32; ++d) { const f32x2 a = AP[(32 * lh + d) * 64 + p]; acc[d] += zr * a.x - zi * a.y; } }
          if (lh == 0 && c == c2) acc[0] += I0.dsk[l * 1024 + g * 16 + c];
#pragma unroll
          for (int d = 0; d < 32; ++d) LB[(((32 * lh + d + 1) * 2 + (c2 >> 3)) * 16 + c) * 8 + (c2 & 7)] = (bf16)(cvt_pk_bf16(acc[d], 0.f) & 0xffffu);
          if (t < 256) LB[t] = 0; }
        __syncthreads();
    }
}
__device__ __forceinline__ void ssm_s1(Frame& F, const SsmIn& I, int l) {
    const bf16* P = wsb(F, WS_PROJ); bf16* SST = wsb(F, WS_SST);
    LAS float* E = (LAS float*)F.lds;
    const int lane = F.lane, w = F.wave, l31 = lane & 31, h = lane >> 5, mi = w & 3, kh = w >> 2;
    for (int unit = blockIdx.x; unit < 256; unit += F.G) {
        const int g = unit >> 2, pq = unit & 3;
        const bf16* WinT = wsb(F, WS_WINT) + (size_t)(l * 64 + g) * 131072 + (size_t)(pq * 32 + l31) * 1024 + 8 * h;
        const int mrow = 32 * mi + l31, bb = mrow >> 6, kk = mrow & 63;
        const bf16* up = P + (size_t)(bb * SEQ + kk * 64) * INW + COL_S + g * 16 + 8 * h;
        f32x16 acc;
#pragma unroll
        for (int e = 0; e < 16; ++e) acc[e] = 0.f;
#pragma unroll 8
        for (int jj = 0; jj < 32; ++jj) { const int j = 32 * kh + jj; const bf16x8 af = *(const bf16x8*)(up + (size_t)j * INW), bf = *(const bf16x8*)(WinT + 16 * j);
            acc = __builtin_amdgcn_mfma_f32_32x32x16_bf16(af, bf, acc, 0, 0, 0); }
#pragma unroll
        for (int e = 0; e < 16; ++e) E[(kh * 128 + 32 * mi + (e & 3) + 8 * (e >> 2) + 4 * h) * 33 + l31] = acc[e];
        __syncthreads();
#pragma unroll 1
        for (int tk = 0; tk < 4; ++tk) { const int task = w * 4 + tk, b = task >> 4, st = task & 15, p = 16 * pq + st, k = lane;
            float xr = E[(b * 64 + k) * 33 + st] + E[(128 + b * 64 + k) * 33 + st], xi = E[(b * 64 + k) * 33 + 16 + st] + E[(128 + b * 64 + k) * 33 + 16 + st];
            const int gp = g * 64 + p; const float lr = fminf(I.lre[gp], -1e-4f), li = I.lim[gp], dt = expf(I.ldt[g]);
            float ar, ai; { const float mag = expf(lr * dt * 64.f); float sn, cs; sincos_red((double)li * (double)dt * 64.0, sn, cs); ar = mag * cs; ai = mag * sn; }
#pragma unroll
            for (int d = 1; d < 64; d <<= 1) { const float yr = __shfl_up(xr, d), yi = __shfl_up(xi, d); if (k >= d) { xr += ar * yr - ai * yi; xi += ar * yi + ai * yr; } const float nr = ar * ar - ai * ai, ni = 2.f * ar * ai; ar = nr; ai = ni; }
            float sr = __shfl_up(xr, 1), si = __shfl_up(xi, 1); if (k == 0) { sr = 0.f; si = 0.f; }
            bf16* dst = SST + ((size_t)(g * 128 + b * 64 + k)) * 128 + p; dst[0] = (bf16)(cvt_pk_bf16(sr, 0.f) & 0xffffu); dst[64] = (bf16)(cvt_pk_bf16(si, 0.f) & 0xffffu); }
        __syncthreads();
    }
}
__device__ __forceinline__ void ssm_s2(Frame& F, int l) {
    const bf16* P = wsb(F, WS_PROJ); const bf16* SST = wsb(F, WS_SST); bf16* Y = wsb(F, WS_YS);
    LAS unsigned char* Ul = F.lds;
    LAS unsigned char* Ll = F.lds + 66048;
    LAS unsigned char* Sl = F.lds + 66048 + 33280;
    const int t = F.tid, lane = F.lane, w = F.wave, l31 = lane & 31, h = lane >> 5;
    for (int unit = blockIdx.x; unit < 256; unit += F.G) {
        const int mt = unit & 1, b = (unit >> 1) & 1, g = unit >> 2;
#pragma unroll
        for (int i = 0; i < 8; ++i) { const int q = t + 512 * i, half = q & 1, ti = q >> 1, ir = ti >> 6, j = ti & 63;
            *(LAS v4u*)(Ul + ir * 2064 + j * 32 + half * 16) = *(const v4u*)(P + (size_t)(b * SEQ + (32 * mt + ir) * 64 + j) * INW + COL_S + g * 16 + 8 * half); }
        { const v4u* src = (const v4u*)(F.ws + WS_LB + (size_t)(l * 64 + g) * LB_BYTES);
          for (int q = t; q < (int)(LB_BYTES / 16); q += 512) *(LAS v4u*)(Ll + q * 16) = src[q]; }
        { const int row = t >> 4, part = t & 15; *(LAS v4u*)(Sl + row * 272 + part * 16) = *(const v4u*)(SST + ((size_t)(g * 128 + b * 64 + 32 * mt + row)) * 128 + part * 8); }
        __syncthreads();
        const bf16* WoutT = wsb(F, WS_WOUTT) + (size_t)(l * 64 + g) * 131072;
#pragma unroll 1
        for (int q = 0; q < 4; ++q) { const int n = (q == 0) ? w : (q == 1) ? 15 - w : (q == 2) ? 16 + w : 31 - w;
            f32x16 acc;
#pragma unroll
            for (int e = 0; e < 16; ++e) acc[e] = 0.f;
#pragma unroll
            for (int ks = 0; ks < 8; ++ks) { const bf16x8 wf = *(const bf16x8*)(WoutT + (size_t)(32 * n + l31) * 128 + 16 * ks + 8 * h), sf = *(const LAS bf16x8*)(Sl + l31 * 272 + ks * 32 + h * 16);
                acc = __builtin_amdgcn_mfma_f32_32x32x16_bf16(wf, sf, acc, 0, 0, 0); }
            const LAS unsigned char* lbp = Ll + ((2 * n + 1 + (l31 >> 4)) * 2 + h) * 256 + (l31 & 15) * 16; const LAS unsigned char* ubp = Ul + l31 * 2064 + h * 16;
#pragma unroll 2
            for (int j = 0; j < 2 * n + 2; ++j) { const bf16x8 kf = *(const LAS bf16x8*)(lbp - j * 512), uf = *(const LAS bf16x8*)(ubp + j * 32); acc = __builtin_amdgcn_mfma_f32_32x32x16_bf16(kf, uf, acc, 0, 0, 0); }
#pragma unroll
            for (int q4 = 0; q4 < 4; ++q4) { const int c0 = 8 * (q4 & 1) + 4 * h, tau = 2 * n + (q4 >> 1); const size_t tok = (size_t)b * SEQ + (32 * mt + l31) * 64 + tau;
                v2u wv; wv.x = cvt_pk_bf16(acc[4 * q4], acc[4 * q4 + 1]); wv.y = cvt_pk_bf16(acc[4 * q4 + 2], acc[4 * q4 + 3]); *(v2u*)(Y + tok * 1024 + g * 16 + c0) = wv; }
        }
        __syncthreads();
    }
}

constexpr int PH_PRO = 0, PH_SB0 = 1, PH_PER_SB = 6, N_SB = 3 * DEPTH, PH_FINAL = PH_SB0 + N_SB * PH_PER_SB, N_PH = PH_FINAL + 1;
struct Args { const float* in[N_IN]; float* out; unsigned char* ws; int ph_lo, ph_hi; };
static_assert(sizeof(Args) == N_IN * 8 + 8 + 8 + 8, "Args has no padding");

typedef __attribute__((address_space(4))) const Args* KArgs;
__device__ __forceinline__ KArgs kargs() { KArgs p = (KArgs)__builtin_amdgcn_kernarg_segment_ptr(); asm volatile("" : "+s"(p)); return p; }
#define AIN(i) (kargs()->in[i])
__global__ void __launch_bounds__(NWAVES * 64, 2) fwd(Args args_unused) {
    extern __shared__ __attribute__((aligned(16))) unsigned char lds[];
    Frame F;
    F.lds = (LAS unsigned char*)lds;
    F.tid = threadIdx.x; F.lane = F.tid & 63; F.wave = __builtin_amdgcn_readfirstlane(F.tid >> 6); F.G = gridDim.x;
    F.ws = kargs()->ws;
    const int lo = kargs()->ph_lo, hi = kargs()->ph_hi;
    volatile LAS unsigned* MISC = (volatile LAS unsigned*)(F.lds + MISC_OFF);
    for (int u = F.tid; u < (LDS_BYTES - LDSCTL_OFF) / 4; u += NWAVES * 64) ((LAS unsigned*)(F.lds + LDSCTL_OFF))[u] = 0u;
    __syncthreads();
    unsigned* barw = (unsigned*)(F.ws + WS_CTL) + CW_BAR;
    XcdBarrier bar; bar.bar = barw; bar.x = 0; bar.st = nullptr;
    if (hi - lo > 1) bar = xcd_barrier_post(barw, MISC + 8);
#define IN(p) (lo <= (p) && (p) < hi)
#define FRESH() do { int t_ = threadIdx.x; asm volatile("" : "+v"(t_)); F.tid = t_; F.lane = t_ & 63; F.wave = __builtin_amdgcn_readfirstlane(t_ >> 6); unsigned char* w_ = kargs()->ws; F.ws = w_; } while (0)
#define SEAM(p, q) do { if (IN(p) && (q) < hi) xcd_barrier(bar); } while (0)

    if (IN(PH_PRO) && EN_PRO) for (int rep_ = 0; rep_ < REP_PRO; ++rep_) { FRESH(); const ProIn I{AIN(I_F1WI), AIN(I_F2WI), AIN(I_F1WO), AIN(I_F2WO), AIN(I_WIN), AIN(I_WMKV), AIN(I_WGLU), AIN(I_WSWA), AIN(I_WMEMUP), AIN(I_WOUT), AIN(I_MEM), AIN(I_MEMN), AIN(I_F1N), AIN(I_F2N), AIN(I_MIXN), AIN(I_X)}; prologue(F, I);
        const SsmIn I0{AIN(I_LRE), AIN(I_LIM), AIN(I_LDT), AIN(I_BRE), AIN(I_BIM), AIN(I_CRE), AIN(I_CIM), AIN(I_DSK)}; ssm_tables(F, I0); }
    SEAM(PH_PRO, PH_SB0);

    for (int sb = 0; sb < N_SB; ++sb) {
        const int l = sb / 3, ty = sb % 3, pb = PH_SB0 + sb * PH_PER_SB;
        if (pb + PH_PER_SB <= lo || pb >= hi) continue;
#define HIN() ((sb == 0) ? AIN(I_X) : (const float*)(F.ws + WS_H))
#define WL() (F.ws + WS_W + (size_t)l * W_LAYER)
        if (ty != 1) {
            if (IN(pb + 1) && EN_G1) for (int rep_ = 0; rep_ < REP_G1; ++rep_) { FRESH();
                pg8::SchedTiles S{(const char*)(F.ws + WS_XN), (const char*)(WL() + (ty == 0 ? WO_1IN : WO_2IN)), (size_t)256 * DM * 2, T / 256, 2 * DFF / 256, F.G, (int)blockIdx.x};
                pg8::Unit u0; int pm0 = -1; if (S.next(0, u0)) { pm0 = u0.pm; rstd_table(F, pm0); }
                pg8::EpiSwiGLU E{wsb(F, WS_HID), DFF, pg8::RstdTab{(const LAS float*)(F.lds + RSTD_OFF), pm0, (const float*)(F.ws + WS_SSQ)}};
                pg8::gemm_phase<pg8::EpiSwiGLU, pg8::SchedTiles, true, true>(F.lds + RING_OFF, DM, S, E);
            }
            SEAM(pb + 1, pb + 5);
        } else {
            if (IN(pb + 1) && EN_G3) for (int rep_ = 0; rep_ < REP_G3; ++rep_) { FRESH();
                pg8::SchedProj S{(const char*)(F.ws + WS_XN), (const char*)(WL() + WO_IN), (const char*)(F.ws + WS_MEMN + (size_t)l * 512 * DM * 2), (const char*)(WL() + WO_MKV), (size_t)256 * DM * 2, T / 256, INW / 256, F.G, (int)blockIdx.x};
                pg8::Unit u0; int pm0 = -1; if (S.next(0, u0)) { pm0 = u0.pm; rstd_table(F, pm0); }
                pg8::EpiProj E{wsb(F, WS_PROJ), INW, COL_G / 256, wsb(F, WS_MKV), 2048, pg8::RstdTab{(const LAS float*)(F.lds + RSTD_OFF), pm0, (const float*)(F.ws + WS_SSQ)}};
                pg8::gemm_phase<pg8::EpiProj, pg8::SchedProj, true, true>(F.lds + RING_OFF, DM, S, E);
            }
            SEAM(pb + 1, pb + 2);
            if (IN(pb + 2) && EN_M1) for (int rep_ = 0; rep_ < REP_M; ++rep_) { FRESH(); swa_mfma(F, AIN(I_SINK) + l * 16); memattn_mfma(F);
                const SsmIn I{AIN(I_LRE) + l * 4096, AIN(I_LIM) + l * 4096, AIN(I_LDT) + l * 64, AIN(I_BRE) + l * 65536, AIN(I_BIM) + l * 65536, AIN(I_CRE) + l * 65536, AIN(I_CIM) + l * 65536, AIN(I_DSK) + l * 1024}; ssm_s1(F, I, l); }
            SEAM(pb + 2, pb + 3);
            if (IN(pb + 3) && EN_M2) for (int rep_ = 0; rep_ < REP_M; ++rep_) { FRESH(); const SsmIn I{AIN(I_LRE) + l * 4096, AIN(I_LIM) + l * 4096, AIN(I_LDT) + l * 64, AIN(I_BRE) + l * 65536, AIN(I_BIM) + l * 65536, AIN(I_CRE) + l * 65536, AIN(I_CIM) + l * 65536, AIN(I_DSK) + l * 1024}; (void)I; ssm_s2(F, l); }
            SEAM(pb + 3, pb + 4);
            if (IN(pb + 4) && EN_G4) for (int rep_ = 0; rep_ < REP_G4; ++rep_) { FRESH();
                pg8::SchedMix S{(const char*)(F.ws + WS_OSWA), (const char*)(F.ws + WS_OMEM), (const char*)(F.ws + WS_YS), (const char*)(WL() + WO_SWA), (const char*)(WL() + WO_MEM), (const char*)(WL() + WO_GLU), (size_t)256 * 1024 * 2, T / 256, DM / 256, F.G, (int)blockIdx.x};
                pg8::EpiMix E{wsb(F, WS_MG), wsb(F, WS_PROJ) + COL_G, INW};
                pg8::gemm_phase<pg8::EpiMix, pg8::SchedMix, true, true>(F.lds + RING_OFF, 1024, S, E);
            }
            SEAM(pb + 4, pb + 5);
        }
        if (IN(pb + 5) && EN_GR) for (int rep_ = 0; rep_ < REP_GR; ++rep_) { FRESH();
            const int K = (ty == 1) ? DM : DFF;
            pg8::SchedTiles S{(const char*)(F.ws + (ty == 1 ? WS_MG : WS_HID)), (const char*)(WL() + (ty == 0 ? WO_1OUT : ty == 1 ? WO_OUT : WO_2OUT)), (size_t)256 * K * 2, T / 256, DM / 256, F.G, (int)blockIdx.x};
            pg8::EpiResid E{(sb == 0) ? AIN(I_X) : nullptr, ty == 1 ? 1.0f : 0.5f, DM, wsb(F, WS_XN), (float*)(F.ws + (rep_ ? WS_T32 : WS_SSQ)), wsb(F, rep_ ? WS_H : WS_XN)};
            pg8::gemm_phase<pg8::EpiResid, pg8::SchedTiles, true, true>(F.lds + RING_OFF, K, S, E);
        }
        SEAM(pb + 5, pb + 6);
    }
    if (IN(PH_FINAL)) { FRESH(); final_norm(F, wsb(F, WS_XN), AIN(I_FINN), kargs()->out); }
#undef IN
#undef SEAM
}

static bool phase_valid(int p) {
    if (p == PH_PRO || p == PH_FINAL) return true;
    const int sb = (p - PH_SB0) / PH_PER_SB, k = (p - PH_SB0) % PH_PER_SB;
    return k != 0 && ((sb % 3 == 1) || k == 1 || k == 5);
}
extern "C" void kernel_launch(void* const* d_in, const int* in_sizes, int n_in, void* d_out, int out_size, void* d_ws, size_t ws_size, hipStream_t stream) {
    static int grid = 0;
    if (grid == 0) {
        if (n_in != N_IN || in_sizes[0] != T * DM || out_size != T * DM || ws_size < WS_END) { fprintf(stderr, "kernel_launch: unexpected shapes: n_in %d in0 %d out %d ws %zu (need %zu); nothing launched\n", n_in, n_in > 0 ? in_sizes[0] : -1, out_size, ws_size, (size_t)WS_END); grid = -1; return; }
        int dev = 0, cus = 0, per_cu = 0;
        if (hipGetDevice(&dev) != hipSuccess || hipDeviceGetAttribute(&cus, hipDeviceAttributeMultiprocessorCount, dev) != hipSuccess) { fprintf(stderr, "kernel_launch: device query failed\n"); grid = -1; return; }
        if (hipFuncSetAttribute((const void*)fwd, hipFuncAttributeMaxDynamicSharedMemorySize, LDS_BYTES) != hipSuccess) { fprintf(stderr, "kernel_launch: hipFuncSetAttribute failed\n"); grid = -1; return; }
        if (hipOccupancyMaxActiveBlocksPerMultiprocessor(&per_cu, (const void*)fwd, NWAVES * 64, LDS_BYTES) != hipSuccess || per_cu < 1) fprintf(stderr, "kernel_launch: note: occupancy query reports %d workgroups per CU\n", per_cu);
        (void)hipGetLastError();
        grid = cus;
    }
    if (grid < 0) return;
    if (hipMemsetAsync((char*)d_ws + WS_CTL, 0, CTL_ZERO_BYTES, stream) != hipSuccess) { fprintf(stderr, "kernel_launch: memset failed\n"); return; }
    Args a{};
    for (int i = 0; i < N_IN; ++i) a.in[i] = (const float*)d_in[i];
    a.out = (float*)d_out; a.ws = (unsigned char*)d_ws;
#if ONE_LAUNCH
    a.ph_lo = 0; a.ph_hi = N_PH;
    hipLaunchKernelGGL(fwd, dim3(grid), dim3(NWAVES * 64), LDS_BYTES, stream, a);
#else
    for (int p = 0; p < N_PH; ++p) { if (!phase_valid(p)) continue; a.ph_lo = p; a.ph_hi = p + 1; hipLaunchKernelGGL(fwd, dim3(grid), dim3(NWAVES * 64), LDS_BYTES, stream, a); }
#endif
    const hipError_t le = hipPeekAtLastError();
    if (le != hipSuccess) fprintf(stderr, "kernel_launch: launch failed: %s\n", hipGetErrorName(le));
}
```

```cpp
#include <hip/hip_runtime.h>
#include <cstdio>
#include <cstdint>

#ifndef EN_PRO
#define EN_PRO 1
#endif
#ifndef EN_NORM
#define EN_NORM 1
#endif
#ifndef EN_G1
#define EN_G1 1
#endif
#ifndef EN_G3
#define EN_G3 1
#endif
#ifndef EN_M1
#define EN_M1 1
#endif
#ifndef EN_M2
#define EN_M2 1
#endif
#ifndef EN_G4
#define EN_G4 1
#endif
#ifndef EN_GR
#define EN_GR 1
#endif
#ifndef REP_SWA
#define REP_SWA 1
#endif
#ifndef REP_MA
#define REP_MA 1
#endif
#ifndef REP_S1
#define REP_S1 1
#endif
#ifndef REP_S2
#define REP_S2 1
#endif
#ifndef REP_M
#define REP_M 1
#endif
#ifndef REP_PRO
#define REP_PRO 1
#endif
#ifndef REP_NORM
#define REP_NORM 1
#endif
#ifndef REP_G1
#define REP_G1 1
#endif
#ifndef REP_G3
#define REP_G3 1
#endif
#ifndef REP_G4
#define REP_G4 1
#endif
#ifndef REP_GR
#define REP_GR 1
#endif
#ifndef DIAG
#define DIAG 0
#endif
#ifndef DIAG_SCALE0
#define DIAG_SCALE0 1.0f
#endif
#ifndef DIAG_SCALE1
#define DIAG_SCALE1 0.01f
#endif
#ifndef ONE_LAUNCH
#define ONE_LAUNCH 1
#endif

namespace pg8 {
#define PG8_LAS __attribute__((address_space(3)))
typedef unsigned short bf16_t;
typedef short bf16x8 __attribute__((ext_vector_type(8)));
typedef float f32x4 __attribute__((ext_vector_type(4)));
typedef unsigned u32x4 __attribute__((ext_vector_type(4)));
constexpr int BM = 256, BK = 64, HALF = 128, HTB = HALF * BK * 2  , STAGE_BYTES = 8 * HTB, NXCD = 8, WGM = 8;

__host__ __device__ __forceinline__ int lds_byte(int r, int c) { const int st = (r >> 4) * 2 + (c >> 5), rr = r & 15, cc = c & 31, ob = rr * 64 + cc * 2; return st * 1024 + (ob ^ (((ob >> 9) & 1) << 5)); }
__host__ __device__ __forceinline__ void stage_rc(int b, int& R, int& C) { const int st = b / 1024, sb = b % 1024, swz = sb ^ (((sb >> 9) & 1) << 5); R = (st >> 1) * 16 + swz / 64; C = (st & 1) * 32 + (swz % 64) / 2; }
__host__ __device__ __forceinline__ int perm32(int rho) { const int n = rho >> 4, i = rho & 15; return 8 * (i >> 2) + 4 * n + (i & 3); }


struct Unit { int pm, pn, kind; };

typedef float f32x2_cv __attribute__((ext_vector_type(2))); typedef __bf16 bf16x2_cv __attribute__((ext_vector_type(2)));
__device__ __forceinline__ unsigned cvt_pk_bf16(float lo, float hi) { const f32x2_cv v = {lo, hi}; const bf16x2_cv b = __builtin_convertvector(v, bf16x2_cv); return __builtin_bit_cast(unsigned, b); }
__device__ __forceinline__ float bf_lo(unsigned u) { return __uint_as_float(u << 16); }
__device__ __forceinline__ float bf_hi(unsigned u) { return __uint_as_float(u & 0xffff0000u); }
__device__ __forceinline__ float sigmoidf_fast(float x) { return __builtin_amdgcn_rcpf(1.0f + __builtin_amdgcn_exp2f(-1.4426950408889634f * x)); }

__device__ __forceinline__ void tile_of(int L, int nM, int nN, int& pm, int& pn) {
    const int nwg = nM * nN; int wgid = L; { const int q = nwg / NXCD, r = nwg % NXCD, xcd = wgid % NXCD, off = wgid / NXCD; wgid = (xcd < r ? xcd * (q + 1) : r * (q + 1) + (xcd - r) * q) + off; }
    const int nig = WGM * nN, gid = wgid / nig, fm = gid * WGM, gsz = (nM - fm) < WGM ? (nM - fm) : WGM;
    pm = fm + ((wgid % nig) % gsz); pn = (wgid % nig) / gsz;
}

struct SchedTiles {
    static constexpr bool HAS_HALF = false;
    const char* A; const char* Bt; size_t tstep; int nM, nN, G, c;
    __device__ __forceinline__ bool next(int i, Unit& u) const { const int L = i * G + c; if (L >= nM * nN) return false; tile_of(L, nM, nN, u.pm, u.pn); u.kind = 0; return true; }
    __device__ __forceinline__ void operands(const Unit& u, const char*& a, const char*& b) const { a = A + (size_t)u.pm * tstep; b = Bt + (size_t)u.pn * tstep; }
    __device__ __forceinline__ void a_ready(const Unit&) const {}
    __device__ __forceinline__ void done(const Unit&) const {}
};
struct SchedG1 {
    static constexpr bool HAS_HALF = true;
    const char* A; const char* Bt; size_t tstep; int nM, nN, G, c;
    __device__ __forceinline__ bool next(int i, Unit& u) const {
        if (i < 5) { tile_of(i * 256 + c, 32, 44, u.pm, u.pn); u.kind = 0; return true; }
        if (i > 5) return false; const int x = c & 7, j = c >> 3, r = j & 7, q = j >> 3; u.pm = 8 * (x >> 1) + r; u.pn = ((x & 1) ? 42 : 20) + (q >> 1); u.kind = 2 + (q & 1); return true; }
    __device__ __forceinline__ bool is_half(const Unit& u) const { return u.kind >= 2; }
    __device__ __forceinline__ void operands(const Unit& u, const char*& a, const char*& b) const { a = A + (size_t)u.pm * tstep + (u.kind == 3 ? (tstep >> 1) : 0); b = Bt + (size_t)u.pn * tstep; }
    __device__ __forceinline__ void a_ready(const Unit&) const {}
    __device__ __forceinline__ void done(const Unit&) const {}
};
struct SchedProj {
    static constexpr bool HAS_HALF = false;
    const char* A; const char* Bt; const char* A2; const char* Bt2; size_t tstep; int nM, nN, G, c;
    __device__ __forceinline__ bool next(int i, Unit& u) const { const int L = i * G + c, nwg = nM * nN; if (L < nwg) { tile_of(L, nM, nN, u.pm, u.pn); u.kind = 0; return true; }
        if (L < nwg + 16) { const int j = L - nwg; u.pm = j & 1; u.pn = j >> 1; u.kind = 1; return true; } return false; }
    __device__ __forceinline__ void operands(const Unit& u, const char*& a, const char*& b) const { a = (u.kind ? A2 : A) + (size_t)u.pm * tstep; b = (u.kind ? Bt2 : Bt) + (size_t)u.pn * tstep; }
    __device__ __forceinline__ void a_ready(const Unit&) const {}
    __device__ __forceinline__ void done(const Unit&) const {}
};
struct SchedMix {
    static constexpr bool HAS_HALF = false;
    const char* Aswa; const char* Amem; const char* Ays; const char* Bswa; const char* Bmem; const char* Bglu; size_t tstep; int nM, nN, G, c;
    __device__ __forceinline__ bool next(int i, Unit& u) const { const int L = (i >> 2) * G + c; if (L >= nM * nN) return false; tile_of(L, nM, nN, u.pm, u.pn); u.kind = i & 3; return true; }
    __device__ __forceinline__ void operands(const Unit& u, const char*& a, const char*& b) const {
        if (u.kind == 0) { a = Aswa + (size_t)u.pm * tstep; b = Bswa + (size_t)u.pn * tstep; }
        else if (u.kind == 1) { a = Amem + (size_t)u.pm * tstep; b = Bmem + (size_t)u.pn * tstep; }
        else { a = Ays + (size_t)u.pm * tstep; b = Bglu + (size_t)(2 * u.pn + (u.kind - 2)) * tstep; } }
    __device__ __forceinline__ void a_ready(const Unit&) const {}
    __device__ __forceinline__ void done(const Unit&) const {}
};

__device__ __forceinline__ float row_rstd(const float* SSQ, size_t row, int fq) {
    const f32x4* q = (const f32x4*)(SSQ + row * 32 + 8 * fq); const f32x4 a = q[0], b = q[1];
    float s = ((a[0] + a[1]) + (a[2] + a[3])) + ((b[0] + b[1]) + (b[2] + b[3])); s += __shfl_xor(s, 16); s += __shfl_xor(s, 32);
    return 1.0f / sqrtf(s * (1.0f / 2048.0f) + 1e-5f);
}
struct RstdTab { const PG8_LAS float* tab; int pm0; const float* SSQ;
    __device__ __forceinline__ float get(const Unit& u, int rowin, int fq) const { const float r = tab[rowin]; return (u.pm == pm0) ? r : __builtin_nanf(""); } };
struct EpiSwiGLU {
    static constexpr bool PERM = true, AFTER_DRAIN = false;
    bf16_t* O; int ldo; RstdTab R;
    __device__ __forceinline__ void operator()(const f32x4 (&acc)[2][2][4][2], const Unit& u, int wr, int wc, int fr, int fq) const {
        const int hoff = (u.kind == 3) ? HALF : 0, row0 = u.pm * BM + hoff + wr * 64 + fr, col0 = u.pn * HALF + wc * 32 + 8 * fq;
#pragma unroll
        for (int ai = 0; ai < 2; ++ai) { if (ai == 1 && u.kind >= 2) break;
#pragma unroll
            for (int m = 0; m < 4; ++m) { bf16_t* rowp = O + (size_t)(row0 + ai * HALF + m * 16) * ldo + col0; float o[8]; const float rs = R.get(u, hoff + wr * 64 + fr + ai * HALF + m * 16, fq);
#pragma unroll
                for (int n = 0; n < 2; ++n)
#pragma unroll
                    for (int e = 0; e < 4; ++e) { const float g = acc[ai][0][m][n][e] * rs, uu = acc[ai][1][m][n][e] * rs; o[4 * n + e] = g * sigmoidf_fast(g) * uu; }
                u32x4 w; w.x = cvt_pk_bf16(o[0], o[1]); w.y = cvt_pk_bf16(o[2], o[3]); w.z = cvt_pk_bf16(o[4], o[5]); w.w = cvt_pk_bf16(o[6], o[7]);
                *(u32x4*)rowp = w; } }
    }
};
struct EpiResid {
    static constexpr bool PERM = false, AFTER_DRAIN = false;
    const float* X0; float alpha; int ldc; bf16_t* HB; float* SSQ; bf16_t* HBout;
    __device__ __forceinline__ void operator()(const f32x4 (&acc)[2][2][4][2], const Unit& u, int wr, int wc, int fr, int fq) const {
        const int row0 = u.pm * BM + wr * 64 + fr, col0 = u.pn * BM + wc * 32 + 4 * fq;
#pragma unroll
        for (int ai = 0; ai < 2; ++ai)
#pragma unroll
            for (int m = 0; m < 4; ++m) { const size_t off = (size_t)(row0 + ai * HALF + m * 16) * ldc + col0;
                float ss = 0.f;
#pragma unroll
                for (int bj = 0; bj < 2; ++bj)
#pragma unroll
                    for (int n = 0; n < 2; ++n) { typedef unsigned u32x2 __attribute__((ext_vector_type(2))); f32x4 b;
                        if (X0) b = *(const f32x4*)(X0 + off + bj * HALF + n * 16); else { const u32x2 hw = *(const u32x2*)(HB + off + bj * HALF + n * 16); b = (f32x4){bf_lo(hw.x), bf_hi(hw.x), bf_lo(hw.y), bf_hi(hw.y)}; }
                        const f32x4 v = b + acc[ai][bj][m][n] * alpha;
                        ss += (v[0] * v[0] + v[1] * v[1]) + (v[2] * v[2] + v[3] * v[3]);
                        u32x2 w; w.x = cvt_pk_bf16(v[0], v[1]); w.y = cvt_pk_bf16(v[2], v[3]); *(u32x2*)(HBout + off + bj * HALF + n * 16) = w; }
                ss += __shfl_xor(ss, 16); ss += __shfl_xor(ss, 32);
                if (fq == 0) SSQ[(size_t)(row0 + ai * HALF + m * 16) * 32 + u.pn * 4 + wc] = ss; }
    }
};
struct EpiProj {
    static constexpr bool PERM = true, AFTER_DRAIN = false;
    bf16_t* P; int ldp; int sig_from; bf16_t* KV; int ldk; RstdTab R; bf16_t* SIN;
    __device__ __forceinline__ void operator()(const f32x4 (&acc)[2][2][4][2], const Unit& u, int wr, int wc, int fr, int fq) const {
        const int row0 = u.pm * BM + wr * 64 + fr, col0 = u.pn * BM + wc * 32 + 8 * fq;
        bf16_t* base = u.kind ? KV : P; const int ld = u.kind ? ldk : ldp; const bool sig = (u.kind == 0) && (u.pn >= sig_from);
#pragma unroll
        for (int ai = 0; ai < 2; ++ai)
#pragma unroll
            for (int m = 0; m < 4; ++m) { bf16_t* rowp = base + (size_t)(row0 + ai * HALF + m * 16) * ld + col0; const float rs = u.kind ? 1.0f : R.get(u, wr * 64 + fr + ai * HALF + m * 16, fq);
#pragma unroll
                for (int bj = 0; bj < 2; ++bj) { f32x4 v0 = acc[ai][bj][m][0] * rs, v1 = acc[ai][bj][m][1] * rs;
                    if (sig) {
#pragma unroll
                        for (int e = 0; e < 4; ++e) { v0[e] = sigmoidf_fast(v0[e]); v1[e] = sigmoidf_fast(v1[e]); } }
                    u32x4 w; w.x = cvt_pk_bf16(v0[0], v0[1]); w.y = cvt_pk_bf16(v0[2], v0[3]); w.z = cvt_pk_bf16(v1[0], v1[1]); w.w = cvt_pk_bf16(v1[2], v1[3]);
                    if (u.kind == 0 && u.pn >= 6 && u.pn < 10) { const int cs = (u.pn - 6) * BM + bj * HALF + wc * 32 + 8 * fq; *(u32x4*)(SIN + ((size_t)(cs >> 4) * 8192 + (size_t)(row0 + ai * HALF + m * 16)) * 16 + (cs & 15)) = w; }
                    else *(u32x4*)(rowp + bj * HALF) = w; } }
    }
};
struct EpiMix {
    static constexpr bool PERM = true, AFTER_DRAIN = false;
    bf16_t* MG; const bf16_t* Gt; int ldg;
    __device__ __forceinline__ void operator()(const f32x4 (&acc)[2][2][4][2], const Unit& u, int wr, int wc, int fr, int fq) const {
        const int row0 = u.pm * BM + wr * 64 + fr, cw = wc * 32 + 8 * fq;
        if (u.kind < 2) {
            const int gsel = u.kind == 0 ? 0 : 4096;
#pragma unroll
            for (int ai = 0; ai < 2; ++ai)
#pragma unroll
                for (int m = 0; m < 4; ++m) { const size_t row = (size_t)(row0 + ai * HALF + m * 16);
#pragma unroll
                    for (int bj = 0; bj < 2; ++bj) { const int col = u.pn * BM + bj * HALF + cw;
                        const u32x4 gw = *(const u32x4*)(Gt + row * ldg + gsel + col);
                        const f32x4 g0 = {bf_lo(gw.x), bf_hi(gw.x), bf_lo(gw.y), bf_hi(gw.y)}, g1 = {bf_lo(gw.z), bf_hi(gw.z), bf_lo(gw.w), bf_hi(gw.w)};
                        f32x4 t0 = acc[ai][bj][m][0] * g0, t1 = acc[ai][bj][m][1] * g1; bf16_t* tp = MG + row * 2048 + col;
                        if (u.kind == 1) { const u32x4 tw = *(const u32x4*)tp; t0 += (f32x4){bf_lo(tw.x), bf_hi(tw.x), bf_lo(tw.y), bf_hi(tw.y)}; t1 += (f32x4){bf_lo(tw.z), bf_hi(tw.z), bf_lo(tw.w), bf_hi(tw.w)}; }
                        u32x4 w; w.x = cvt_pk_bf16(t0[0], t0[1]); w.y = cvt_pk_bf16(t0[2], t0[3]); w.z = cvt_pk_bf16(t1[0], t1[1]); w.w = cvt_pk_bf16(t1[2], t1[3]); *(u32x4*)tp = w; } }
        } else {
            const int col = u.pn * BM + (u.kind - 2) * HALF + cw;
#pragma unroll
            for (int ai = 0; ai < 2; ++ai)
#pragma unroll
                for (int m = 0; m < 4; ++m) { const size_t row = (size_t)(row0 + ai * HALF + m * 16);
                    const u32x4 gw = *(const u32x4*)(Gt + row * ldg + 2048 + col);
                    const float gg[8] = {bf_lo(gw.x), bf_hi(gw.x), bf_lo(gw.y), bf_hi(gw.y), bf_lo(gw.z), bf_hi(gw.z), bf_lo(gw.w), bf_hi(gw.w)};
                    bf16_t* tp = MG + row * 2048 + col; const u32x4 tw = *(const u32x4*)tp;
                    const float tt[8] = {bf_lo(tw.x), bf_hi(tw.x), bf_lo(tw.y), bf_hi(tw.y), bf_lo(tw.z), bf_hi(tw.z), bf_lo(tw.w), bf_hi(tw.w)}; float o[8];
#pragma unroll
                    for (int n = 0; n < 2; ++n)
#pragma unroll
                        for (int e = 0; e < 4; ++e) { const float ga = acc[ai][0][m][n][e], gb = acc[ai][1][m][n][e]; o[4 * n + e] = tt[4 * n + e] + gg[4 * n + e] * ga * sigmoidf_fast(gb); }
                    u32x4 w; w.x = cvt_pk_bf16(o[0], o[1]); w.y = cvt_pk_bf16(o[2], o[3]); w.z = cvt_pk_bf16(o[4], o[5]); w.w = cvt_pk_bf16(o[6], o[7]);
                    *(u32x4*)tp = w; }
        }
    }
};

template <class Epi, class Sched, bool ALIGN_EPI = false, bool SP2 = false>
__device__ __forceinline__ void gemm_phase(PG8_LAS unsigned char* lds, const int K, const Sched& S, const Epi& E) {
    int tid_ = threadIdx.x; asm volatile("" : "+v"(tid_));
    const int tid = tid_, wid = __builtin_amdgcn_readfirstlane(tid >> 6), lane = tid & 63, wr = wid >> 2, wc = wid & 3, fr = lane & 15, fq = lane >> 4;
    static_assert(SP2, "this copy of the body keeps only the two-super-phase K-loop");
    const int nt = K / BK;
    unsigned voffA[2], voffB[2];
#pragma unroll
    for (int i = 0; i < 2; ++i) { int R, C; stage_rc(tid * 16 + i * 8192, R, C); const int Rb = Epi::PERM ? ((R & ~31) + perm32(R & 31)) : R;
        voffA[i] = (unsigned)(R * K + C) * 2u; voffB[i] = (unsigned)(Rb * K + C) * 2u; }
    const size_t kstep = (size_t)(BK * 2);
    const size_t hstep = (size_t)HALF * K * 2;
    const unsigned ldsw = (unsigned)wid * 1024u;
    const int aoff = lds_byte(wr * 64 + fr, fq * 8), boff = lds_byte(wc * 32 + fr, fq * 8);
#define PG8_SA(b, h) (((b) * 2 + (h)) * HTB)
#define PG8_SB(b, h) ((4 + (b) * 2 + (h)) * HTB)
#define PG8_STAGE(bufoff, gbase, voff) do { _Pragma("unroll") for (int _i = 0; _i < 2; ++_i) \
        __builtin_amdgcn_global_load_lds((const unsigned*)((const char*)(gbase) + (voff)[_i]), (PG8_LAS unsigned*)(lds + (bufoff) + ldsw + _i * 8192), 16, 0, 0); } while (0)
#define PG8_LDA(dst, b, h) do { _Pragma("unroll") for (int m = 0; m < 4; ++m) _Pragma("unroll") for (int k = 0; k < 2; ++k) dst[m][k] = *(const PG8_LAS bf16x8*)(lds + PG8_SA(b, h) + aoff + m * 2048 + k * 1024); } while (0)
#define PG8_LDB(dst, b, h) do { _Pragma("unroll") for (int n = 0; n < 2; ++n) _Pragma("unroll") for (int k = 0; k < 2; ++k) dst[n][k] = *(const PG8_LAS bf16x8*)(lds + PG8_SB(b, h) + boff + n * 2048 + k * 1024); } while (0)
#define PG8_MMA(ai, bj, At, Bt) do { __builtin_amdgcn_s_setprio(1); _Pragma("unroll") for (int m = 0; m < 4; ++m) _Pragma("unroll") for (int n = 0; n < 2; ++n) _Pragma("unroll") for (int k = 0; k < 2; ++k) \
        acc[ai][bj][m][n] = __builtin_amdgcn_mfma_f32_16x16x32_bf16(Bt[n][k], At[m][k], acc[ai][bj][m][n], 0, 0, 0); __builtin_amdgcn_s_setprio(0); } while (0)
#define PG8_WAIT_V(n) asm volatile("s_waitcnt vmcnt(" #n ")" ::: "memory")
#define PG8_WAIT_L(n) asm volatile("s_waitcnt lgkmcnt(" #n ")" ::: "memory")
#define PG8_BAR __builtin_amdgcn_s_barrier()
#define PG8_SCHED __builtin_amdgcn_sched_barrier(0)
    Unit cur, nxt; int ui = 0;
    if (!S.next(0, cur)) return;
    f32x4 acc[2][2][4][2];
#pragma unroll
    for (int a = 0; a < 2; ++a)
#pragma unroll
        for (int b = 0; b < 2; ++b)
#pragma unroll
            for (int m = 0; m < 4; ++m)
#pragma unroll
                for (int n = 0; n < 2; ++n) acc[a][b][m][n] = (f32x4){0.f, 0.f, 0.f, 0.f};
    bf16x8 At[4][2], B0[2][2], B1[2][2];
    const char* cA; const char* cB; S.operands(cur, cA, cB);
    S.a_ready(cur);
    if constexpr (SP2) {
        PG8_STAGE(PG8_SB(0, 0), cB, voffB); PG8_STAGE(PG8_SB(0, 1), cB + hstep, voffB); PG8_STAGE(PG8_SA(0, 0), cA, voffA); PG8_STAGE(PG8_SA(0, 1), cA + hstep, voffA);
        if (wr == 1) PG8_BAR;
        PG8_WAIT_V(2); PG8_BAR;
        PG8_STAGE(PG8_SB(1, 0), cB + kstep, voffB); PG8_STAGE(PG8_SA(1, 0), cA + kstep, voffA); PG8_STAGE(PG8_SB(1, 1), cB + hstep + kstep, voffB);
        PG8_WAIT_V(6); PG8_BAR;
    } else {
        PG8_STAGE(PG8_SB(0, 0), cB, voffB); PG8_STAGE(PG8_SA(0, 0), cA, voffA); PG8_STAGE(PG8_SB(0, 1), cB + hstep, voffB); PG8_STAGE(PG8_SA(0, 1), cA + hstep, voffA);
        if (wr == 1) PG8_BAR;
        PG8_WAIT_V(4); PG8_BAR;
        PG8_STAGE(PG8_SB(1, 0), cB + kstep, voffB); PG8_STAGE(PG8_SA(1, 0), cA + kstep, voffA); PG8_STAGE(PG8_SB(1, 1), cB + hstep + kstep, voffB);
        PG8_WAIT_V(6); PG8_BAR;
    }
    for (;;) {
        const bool has_next = S.next(ui + 1, nxt);
        const char* nA = cA; const char* nB = cB; if (has_next) S.operands(nxt, nA, nB);
#define PG8_KLOOP(HF)         for (int t = 0; t < nt; t += 2) { \
            const bool last = (t == nt - 2); \
            const char* a1 = cA + (size_t)(t + 1) * kstep; \
            const char* a2 = last ? nA : cA + (size_t)(t + 2) * kstep; const char* b2 = last ? nB : cB + (size_t)(t + 2) * kstep; \
            const char* a3 = a2 + kstep; const char* b3 = b2 + kstep; \
            if (last && has_next) S.a_ready(nxt); \
            PG8_LDB(B0, 0, 0); PG8_LDB(B1, 0, 1); PG8_SCHED; PG8_LDA(At, 0, 0); PG8_STAGE(PG8_SA(1, 1), a1 + hstep, voffA); \
            PG8_WAIT_V(8); PG8_WAIT_L(0); PG8_BAR; PG8_MMA(0, 0, At, B0); PG8_MMA(0, 1, At, B1); PG8_BAR; PG8_SCHED; \
            if (!(HF)) PG8_LDA(At, 0, 1); PG8_STAGE(PG8_SB(0, 0), b2, voffB); PG8_STAGE(PG8_SB(0, 1), b2 + hstep, voffB); PG8_STAGE(PG8_SA(0, 0), a2, voffA); \
            PG8_WAIT_V(8); PG8_WAIT_L(0); PG8_BAR; if (!(HF)) { PG8_MMA(1, 0, At, B0); PG8_MMA(1, 1, At, B1); } PG8_BAR; PG8_SCHED; \
            PG8_LDB(B0, 1, 0); PG8_LDB(B1, 1, 1); PG8_SCHED; PG8_LDA(At, 1, 0); PG8_STAGE(PG8_SA(0, 1), a2 + hstep, voffA); \
            PG8_WAIT_V(8); PG8_WAIT_L(0); PG8_BAR; PG8_MMA(0, 0, At, B0); PG8_MMA(0, 1, At, B1); PG8_BAR; PG8_SCHED; \
            if (!(HF)) PG8_LDA(At, 1, 1); PG8_STAGE(PG8_SB(1, 0), b3, voffB); PG8_STAGE(PG8_SB(1, 1), b3 + hstep, voffB); PG8_STAGE(PG8_SA(1, 0), a3, voffA); \
            PG8_WAIT_V(8); PG8_WAIT_L(0); PG8_BAR; if (!(HF)) { PG8_MMA(1, 0, At, B0); PG8_MMA(1, 1, At, B1); } PG8_BAR; PG8_SCHED; \
        }
        if constexpr (Sched::HAS_HALF) { if (S.is_half(cur)) { PG8_KLOOP(true) } else { PG8_KLOOP(false) } } else { PG8_KLOOP(false) }
#undef PG8_KLOOP
        if constexpr (ALIGN_EPI) { if (wr == 0) PG8_BAR; }
        if constexpr (!Epi::AFTER_DRAIN) { E(acc, cur, wr, wc, fr, fq); S.done(cur); }
        if (!has_next) break;
#pragma unroll
        for (int a = 0; a < 2; ++a)
#pragma unroll
            for (int b = 0; b < 2; ++b)
#pragma unroll
                for (int m = 0; m < 4; ++m)
#pragma unroll
                    for (int n = 0; n < 2; ++n) acc[a][b][m][n] = (f32x4){0.f, 0.f, 0.f, 0.f};
        cur = nxt; cA = nA; cB = nB; ++ui;
        if constexpr (ALIGN_EPI) { if (wr == 1) PG8_BAR; }
    }
    PG8_WAIT_V(0);
    if constexpr (!ALIGN_EPI) { if (wr == 0) PG8_BAR; }
    PG8_BAR;
    if constexpr (Epi::AFTER_DRAIN) { E.fused(acc, cur, wr, wc, fr, fq, lds, wid, lane); S.done(cur); }
#undef PG8_SA
#undef PG8_SB
#undef PG8_STAGE
#undef PG8_LDA
#undef PG8_LDB
#undef PG8_MMA
#undef PG8_WAIT_V
#undef PG8_WAIT_L
#undef PG8_BAR
#undef PG8_SCHED
}
}

constexpr int BATCH = 2, SEQ = 4096, DM = 2048, DEPTH = 4, NMEM = 256, DFF = 5632;
constexpr int T = BATCH * SEQ;
constexpr int INW = 9728, COL_Q = 0, COL_K = 1024, COL_V = 1280, COL_S = 1536, COL_MQ = 2560, COL_G = 3584;
constexpr float RMS_EPS = 1e-5f, LOG2E = 1.4426950408889634f;
constexpr int NWAVES = 8;
enum { I_X = 0, I_MEM, I_F1N, I_F1WI, I_F1WO, I_MIXN, I_MEMN, I_WIN, I_SINK, I_WMKV, I_LRE, I_LIM, I_LDT, I_BRE, I_BIM, I_CRE, I_CIM, I_DSK, I_WGLU, I_WSWA, I_WMEMUP, I_WOUT, I_F2N, I_F2WI, I_F2WO, I_FINN, N_IN };

constexpr size_t MiB = 1u << 20;
constexpr size_t WS_CTL = 0, CTL_ZERO_BYTES = 1 * MiB;
constexpr size_t WS_W = 2 * MiB, W_LAYER = 202 * MiB;
constexpr size_t WO_1IN = 0, WO_1OUT = 44 * MiB, WO_IN = 66 * MiB, WO_MKV = 104 * MiB, WO_SWA = 112 * MiB, WO_MEM = 116 * MiB, WO_GLU = 120 * MiB, WO_OUT = 128 * MiB, WO_2IN = 136 * MiB, WO_2OUT = 180 * MiB;
constexpr size_t WS_MEMN = WS_W + DEPTH * W_LAYER;
constexpr size_t WS_H = WS_MEMN + 8 * MiB;
constexpr size_t WS_XN = WS_H + 64 * MiB;
constexpr size_t WS_HID = WS_XN + 32 * MiB;
constexpr size_t WS_PROJ = WS_HID + 88 * MiB;
constexpr size_t WS_MKV = WS_PROJ + 152 * MiB;
constexpr size_t WS_OSWA = WS_MKV + 2 * MiB, WS_YS = WS_OSWA + 16 * MiB, WS_OMEM = WS_YS + 16 * MiB;
constexpr size_t WS_T32 = WS_OMEM + 16 * MiB;
constexpr size_t WS_MG = WS_T32 + 64 * MiB;
constexpr size_t WS_SEND = WS_MG + 32 * MiB;
constexpr size_t LB_BYTES = 65 * 512;
constexpr size_t WS_LB = WS_SEND + 4 * MiB;
constexpr size_t WS_WINT = WS_LB + 9 * MiB;
constexpr size_t WS_WOUTT = WS_WINT + 64 * MiB;
constexpr size_t WS_SST = WS_WOUTT + 64 * MiB;
constexpr size_t WS_A64 = WS_SST + 2 * MiB;
constexpr size_t WS_SSQ = WS_A64 + 1 * MiB;
constexpr size_t WS_SIN = WS_SSQ + 1 * MiB;
constexpr size_t WS_END = WS_SIN + 16 * MiB;
static_assert(DEPTH * 64 * LB_BYTES <= 9 * MiB, "lag tables fit");
constexpr int CW_BAR = 4096;

constexpr int RING_OFF = 0, RING_BYTES = 131072;
constexpr int LDSCTL_OFF = RING_BYTES, MISC_OFF = LDSCTL_OFF + 320;
constexpr int LDS_BYTES = 147456;

#define GAS __attribute__((address_space(1)))
#define LAS __attribute__((address_space(3)))
typedef unsigned short bf16;
typedef unsigned v4u __attribute__((ext_vector_type(4)));
typedef unsigned v2u __attribute__((ext_vector_type(2)));
typedef float f32x4 __attribute__((ext_vector_type(4)));
typedef float f32x2 __attribute__((ext_vector_type(2)));
typedef GAS unsigned gu32;
using pg8::cvt_pk_bf16; using pg8::bf_lo; using pg8::bf_hi;

#define XB_TMO      128
#define XB_XCNT(j)  (256  + 64 * (j))
#define XB_XSUB(j)  (1280 + 64 * (j))
#define XB_XGEN(j)  (2304 + 64 * (j))
#define XB_TOP      3328
#define XB_TOPGEN   3392
#define XCD_BAR_WORDS 3456
#define XB_SPIN_CAP (1u << 18)

__device__ __forceinline__ unsigned xb_ld(unsigned* p)              { return __hip_atomic_load(p, __ATOMIC_RELAXED, __HIP_MEMORY_SCOPE_AGENT); }
__device__ __forceinline__ unsigned xb_add(unsigned* p, unsigned v) { return __hip_atomic_fetch_add(p, v, __ATOMIC_RELAXED, __HIP_MEMORY_SCOPE_AGENT); }
__device__ __forceinline__ unsigned xb_xcc_id() { return (unsigned)__builtin_amdgcn_s_getreg((3 << 11) | 20) & 0xFu; }
#define XB_SPIN(cond, bar) do { unsigned _sp = 0; while (cond) { __builtin_amdgcn_s_sleep(1); \
    if ((++_sp & 255u) == 0u) { if (xb_ld(&(bar)[XB_TMO])) break; if (_sp > XB_SPIN_CAP) { atomicAdd(&(bar)[XB_TMO], 1u); break; } } } } while (0)

struct XcdBarrier {
    unsigned* bar; unsigned x;
    volatile LAS unsigned* st;
};

__device__ __forceinline__ XcdBarrier xcd_barrier_post(unsigned* bar, volatile LAS unsigned* st) {
    XcdBarrier b; b.bar = bar; b.x = xb_xcc_id(); b.st = st;
    if (threadIdx.x == 0) (void)xb_add(&bar[XB_XCNT(b.x)], 1u);
    return b;
}
__device__ __forceinline__ void xcd_barrier_complete(unsigned* bar, unsigned x, unsigned& nloc, unsigned& nx) {
    const unsigned G = gridDim.x * gridDim.y * gridDim.z;
    unsigned sum, cnt, mine, sp = 0u;
    for (;;) {
        sum = 0u; cnt = 0u; mine = 0u;
#pragma unroll
        for (unsigned j = 0; j < 16; ++j) { const unsigned c = xb_ld(&bar[XB_XCNT(j)]); sum += c; cnt += (c > 0u) ? 1u : 0u; mine = (j == x) ? c : mine; }
        if (sum == G) break;
        __builtin_amdgcn_s_sleep(1);
        if ((++sp & 255u) == 0u) { if (xb_ld(&bar[XB_TMO])) break; if (sp > XB_SPIN_CAP) { atomicAdd(&bar[XB_TMO], 1u); break; } }
    }
    nloc = mine > 0u ? mine : 1u; nx = cnt > 0u ? cnt : 1u;
}

__device__ __forceinline__ void xcd_barrier(const XcdBarrier& b) {
    asm volatile("s_waitcnt vmcnt(0)" ::: "memory");
    __syncthreads();
    if (threadIdx.x == 0) {
#if DIAG
        const unsigned long long dt0_ = __builtin_amdgcn_s_memrealtime();
#endif
        unsigned* bar = b.bar;
        __builtin_amdgcn_s_waitcnt(0);
        unsigned nloc = b.st[0], nx = b.st[1];
        if (nloc == 0u) { xcd_barrier_complete(bar, b.x, nloc, nx); b.st[0] = nloc; b.st[1] = nx; }
        const unsigned old = xb_add(&bar[XB_XSUB(b.x)], 1u);
        const unsigned gen = old / nloc;
        if (old + 1u == (gen + 1u) * nloc) {
            __builtin_amdgcn_fence(__ATOMIC_RELEASE, "agent");
            asm volatile("s_waitcnt vmcnt(0)" ::: "memory");
            const unsigned og = xb_add(&bar[XB_TOP], 1u);
            const unsigned tg = og / nx;
            if (og + 1u == (tg + 1u) * nx) xb_add(&bar[XB_TOPGEN], 1u);
            else XB_SPIN(xb_ld(&bar[XB_TOPGEN]) == tg, bar);
            __builtin_amdgcn_fence(__ATOMIC_ACQUIRE, "agent");
            xb_add(&bar[XB_XGEN(b.x)], 1u);
            asm volatile("s_waitcnt vmcnt(0)" ::: "memory");
        } else {
            XB_SPIN(xb_ld(&bar[XB_XGEN(b.x)]) == gen, bar);
            __builtin_amdgcn_fence(__ATOMIC_ACQUIRE, "agent");
            asm volatile("s_waitcnt vmcnt(0)" ::: "memory");
        }
#if DIAG
        b.st[8] += (unsigned)(__builtin_amdgcn_s_memrealtime() - dt0_);
#endif
    }
    __syncthreads();
}

struct Frame {
    LAS unsigned char* lds;
    int tid, lane, wave, G;
    unsigned char* ws;
};
__device__ __forceinline__ float wave_sum(float v) {
#pragma unroll
    for (int o = 1; o < 64; o <<= 1) v += __shfl_xor(v, o);
    return v;
}
__device__ __forceinline__ bf16* wsb(const Frame& F, size_t off) { return (bf16*)(F.ws + off); }

struct ConvItem { const float* src; const float* gk; bf16* dst; int K, N; float scale; };
__device__ __forceinline__ void conv_load(const ConvItem& c, float (&v)[64]) {
#pragma unroll
    for (int i = 0; i < 64; ++i) v[i] = c.src[(size_t)i * c.N];
}
__device__ __forceinline__ void conv_store(const ConvItem& c, float (&v)[64], int lane, LAS unsigned char* scr) {
    if (c.gk) {
#pragma unroll
        for (int i = 0; i < 64; ++i) v[i] *= c.gk[i]; }
    const float scale = c.scale;
#pragma unroll
    for (int q = 0; q < 8; ++q) { v4u o; o.x = cvt_pk_bf16(v[8 * q] * scale, v[8 * q + 1] * scale); o.y = cvt_pk_bf16(v[8 * q + 2] * scale, v[8 * q + 3] * scale);
        o.z = cvt_pk_bf16(v[8 * q + 4] * scale, v[8 * q + 5] * scale); o.w = cvt_pk_bf16(v[8 * q + 6] * scale, v[8 * q + 7] * scale); *(LAS v4u*)(scr + lane * 144 + q * 16) = o; }
    asm volatile("s_waitcnt lgkmcnt(0)" ::: "memory");
#pragma unroll
    for (int i = 0; i < 8; ++i) { const v4u o = *(const LAS v4u*)(scr + (8 * i + (lane >> 3)) * 144 + (lane & 7) * 16); *(v4u*)(c.dst + (size_t)(8 * i) * c.K) = o; }
    asm volatile("s_waitcnt lgkmcnt(0)" ::: "memory");
}
constexpr int CI_1IN = (DM / 64) * (2 * DFF / 64), CI_1OUT = (DFF / 64) * (DM / 64), CI_IN = (DM / 64) * (INW / 64), CI_MKV = (DM / 64) * (2048 / 64), CI_GLU = (1024 / 64) * (4096 / 64),
              CI_SWA = (1024 / 64) * (DM / 64), CI_MEM = CI_SWA, CI_OUT = (DM / 64) * (DM / 64), CI_LAYER = 2 * CI_1IN + 2 * CI_1OUT + CI_IN + CI_MKV + CI_GLU + CI_SWA + CI_MEM + CI_OUT;
struct ProIn { const float *f1wi, *f2wi, *f1wo, *f2wo, *win, *wmkv, *wglu, *wswa, *wmem, *wout, *mem, *memn, *f1n, *f2n, *mixn, *x; };
__device__ __forceinline__ void prologue(Frame& F, const ProIn& I) {
    const int gw = blockIdx.x * NWAVES + F.wave, NGW = F.G * NWAVES, lane = F.lane;
    auto item = [&](int it, ConvItem& c) {
        const int l = it / CI_LAYER; int r = it % CI_LAYER; unsigned char* wl = F.ws + WS_W + (size_t)l * W_LAYER;
        const float* src; bf16* dst; int K, N, pairNh = 0; const float* gk = nullptr;
        if (r < CI_1IN) { src = I.f1wi + (size_t)l * DM * 2 * DFF; dst = (bf16*)(wl + WO_1IN); K = DM; N = 2 * DFF; pairNh = DFF; gk = I.f1n + (size_t)l * DM; }
        else if ((r -= CI_1IN) < CI_1IN) { src = I.f2wi + (size_t)l * DM * 2 * DFF; dst = (bf16*)(wl + WO_2IN); K = DM; N = 2 * DFF; pairNh = DFF; gk = I.f2n + (size_t)l * DM; }
        else if ((r -= CI_1IN) < CI_1OUT) { src = I.f1wo + (size_t)l * DFF * DM; dst = (bf16*)(wl + WO_1OUT); K = DFF; N = DM; }
        else if ((r -= CI_1OUT) < CI_1OUT) { src = I.f2wo + (size_t)l * DFF * DM; dst = (bf16*)(wl + WO_2OUT); K = DFF; N = DM; }
        else if ((r -= CI_1OUT) < CI_IN) { src = I.win + (size_t)l * DM * INW; dst = (bf16*)(wl + WO_IN); K = DM; N = INW; gk = I.mixn + (size_t)l * DM; }
        else if ((r -= CI_IN) < CI_MKV) { src = I.wmkv + (size_t)l * DM * 2048; dst = (bf16*)(wl + WO_MKV); K = DM; N = 2048; }
        else if ((r -= CI_MKV) < CI_GLU) { src = I.wglu + (size_t)l * 1024 * 4096; dst = (bf16*)(wl + WO_GLU); K = 1024; N = 4096; pairNh = 2048; }
        else if ((r -= CI_GLU) < CI_SWA) { src = I.wswa + (size_t)l * 1024 * DM; dst = (bf16*)(wl + WO_SWA); K = 1024; N = DM; }
        else if ((r -= CI_SWA) < CI_MEM) { src = I.wmem + (size_t)l * 1024 * DM; dst = (bf16*)(wl + WO_MEM); K = 1024; N = DM; }
        else { r -= CI_MEM; src = I.wout + (size_t)l * DM * DM; dst = (bf16*)(wl + WO_OUT); K = DM; N = DM; }
        const int nblk = N / 64, r8 = r >> 3, wv = r & 7, kb = 8 * (r8 / nblk) + wv, nb = r8 % nblk, n0 = nb * 64, k0 = kb * 64;
        float sc = 1.f; if (N == INW) sc = n0 < COL_K ? 0.125f * LOG2E : ((n0 >= COL_MQ && n0 < COL_G) ? 0.0625f * LOG2E : 1.f);
        int row0 = n0; if (pairNh) { const int j = n0 < pairNh ? n0 : n0 - pairNh; row0 = (j >> 7) * 256 + (j & 127) + (n0 < pairNh ? 0 : 128); }
        c.src = src + (size_t)k0 * N + n0 + lane; c.gk = gk ? gk + k0 : nullptr; c.dst = dst + (size_t)(row0 + (lane >> 3)) * K + k0 + 8 * (lane & 7); c.K = K; c.N = N; c.scale = sc;
    };
    {
        LAS unsigned char* scr = F.lds + F.wave * 9216; constexpr int NIT = DEPTH * CI_LAYER;
        float va[64], vb[64]; ConvItem ca, cb; int it = gw;
        if (it < NIT) { item(it, ca); conv_load(ca, va); }
        while (it < NIT) {
            const int it1 = it + NGW; if (it1 < NIT) { item(it1, cb); conv_load(cb, vb); }
            conv_store(ca, va, lane, scr);
            if (it1 >= NIT) break;
            const int it2 = it1 + NGW; if (it2 < NIT) { item(it2, ca); conv_load(ca, va); }
            conv_store(cb, vb, lane, scr);
            it = it2;
        }
    }
    for (int m = gw; m < T; m += NGW) {
        const f32x4* xr = (const f32x4*)(I.x + (size_t)m * DM) + lane; v2u* o8 = (v2u*)(wsb(F, WS_XN) + (size_t)m * DM) + lane; float s = 0.f;
#pragma unroll
        for (int j = 0; j < 8; ++j) { const f32x4 v = xr[64 * j]; s += (v.x * v.x + v.y * v.y) + (v.z * v.z + v.w * v.w); v2u o; o.x = cvt_pk_bf16(v.x, v.y); o.y = cvt_pk_bf16(v.z, v.w); o8[64 * j] = o; }
        s = wave_sum(s); if (lane < 32) ((float*)(F.ws + WS_SSQ))[(size_t)m * 32 + lane] = lane == 0 ? s : 0.f;
    }
    for (int it = gw; it < DEPTH * 512; it += NGW) {
        const int l = it / 512, row = it % 512;
        const f32x4* xr = (const f32x4*)(I.mem + (size_t)row * DM) + lane; const f32x4* gr = (const f32x4*)(I.memn + (size_t)l * DM) + lane;
        f32x4 v[8]; float s = 0.f;
#pragma unroll
        for (int j = 0; j < 8; ++j) { v[j] = xr[64 * j]; s += (v[j].x * v[j].x + v[j].y * v[j].y) + (v[j].z * v[j].z + v[j].w * v[j].w); }
        const float rstd = 1.0f / sqrtf(wave_sum(s) * (1.f / DM) + RMS_EPS);
        v2u* o8 = (v2u*)(wsb(F, WS_MEMN) + ((size_t)l * 512 + row) * DM) + lane;
#pragma unroll
        for (int j = 0; j < 8; ++j) { const f32x4 g = gr[64 * j]; v2u o; o.x = cvt_pk_bf16(v[j].x * rstd * g.x, v[j].y * rstd * g.y); o.y = cvt_pk_bf16(v[j].z * rstd * g.z, v[j].w * rstd * g.w); o8[64 * j] = o; }
    }
}
constexpr int RSTD_OFF = LDSCTL_OFF + 1024;
__device__ __forceinline__ void rstd_table(Frame& F, int pm) {
    LAS float* tab = (LAS float*)(F.lds + RSTD_OFF);
    if (F.tid < 256) { const f32x4* q = (const f32x4*)((const float*)(F.ws + WS_SSQ) + ((size_t)pm * 256 + F.tid) * 32); float s = 0.f;
#pragma unroll
        for (int j = 0; j < 8; ++j) { const f32x4 a = q[j]; s += (a[0] + a[1]) + (a[2] + a[3]); }
        tab[F.tid] = 1.0f / sqrtf(s * (1.0f / DM) + RMS_EPS); }
    __syncthreads();
}
template <bool OUTF32>
__device__ __forceinline__ void norm_phase(Frame& F, const float* hin, const float* gain, void* outp) {
    const int gw = blockIdx.x * NWAVES + F.wave, NGW = F.G * NWAVES, lane = F.lane;
    f32x4 g[8];
#pragma unroll
    for (int j = 0; j < 8; ++j) g[j] = ((const f32x4*)gain)[lane + 64 * j];
    for (int m = gw; m < T; m += NGW) {
        const f32x4* xr = (const f32x4*)(hin + (size_t)m * DM) + lane;
        f32x4 v[8]; float s = 0.f;
#pragma unroll
        for (int j = 0; j < 8; ++j) { v[j] = xr[64 * j]; s += (v[j].x * v[j].x + v[j].y * v[j].y) + (v[j].z * v[j].z + v[j].w * v[j].w); }
        const float rstd = 1.0f / sqrtf(wave_sum(s) * (1.f / DM) + RMS_EPS);
        if (OUTF32) { f32x4* o = (f32x4*)((float*)outp + (size_t)m * DM) + lane;
#pragma unroll
            for (int j = 0; j < 8; ++j) o[64 * j] = v[j] * rstd * g[j];
        } else { v2u* o8 = (v2u*)((bf16*)outp + (size_t)m * DM) + lane;
#pragma unroll
            for (int j = 0; j < 8; ++j) { v2u o; o.x = cvt_pk_bf16(v[j].x * rstd * g[j].x, v[j].y * rstd * g[j].y); o.y = cvt_pk_bf16(v[j].z * rstd * g[j].z, v[j].w * rstd * g[j].w); o8[64 * j] = o; } }
    }
}
__device__ __forceinline__ void final_norm(Frame& F, const bf16* hb, const float* gain, float* outp) {
    const int gw = blockIdx.x * NWAVES + F.wave, NGW = F.G * NWAVES, lane = F.lane;
    for (int m = gw; m < T; m += NGW) {
        const v4u* xr = (const v4u*)(hb + (size_t)m * DM) + lane; float v[4][8]; float s = 0.f;
#pragma unroll
        for (int j = 0; j < 4; ++j) { const v4u w = xr[64 * j]; v[j][0] = bf_lo(w.x); v[j][1] = bf_hi(w.x); v[j][2] = bf_lo(w.y); v[j][3] = bf_hi(w.y); v[j][4] = bf_lo(w.z); v[j][5] = bf_hi(w.z); v[j][6] = bf_lo(w.w); v[j][7] = bf_hi(w.w);
#pragma unroll
            for (int e = 0; e < 8; ++e) s += v[j][e] * v[j][e]; }
        const float rstd = 1.0f / sqrtf(wave_sum(s) * (1.f / DM) + RMS_EPS);
#pragma unroll
        for (int j = 0; j < 4; ++j) { const f32x4* g = (const f32x4*)(gain + (lane + 64 * j) * 8); f32x4* o = (f32x4*)(outp + (size_t)m * DM + (lane + 64 * j) * 8); const f32x4 g0 = g[0], g1 = g[1];
            o[0] = (f32x4){v[j][0] * rstd * g0[0], v[j][1] * rstd * g0[1], v[j][2] * rstd * g0[2], v[j][3] * rstd * g0[3]}; o[1] = (f32x4){v[j][4] * rstd * g1[0], v[j][5] * rstd * g1[1], v[j][6] * rstd * g1[2], v[j][7] * rstd * g1[3]}; }
    }
}
__device__ __forceinline__ void unpack8(const v4u w, float* f) { f[0] = bf_lo(w.x); f[1] = bf_hi(w.x); f[2] = bf_lo(w.y); f[3] = bf_hi(w.y); f[4] = bf_lo(w.z); f[5] = bf_hi(w.z); f[6] = bf_lo(w.w); f[7] = bf_hi(w.w); }

__device__ __forceinline__ void swa_naive(Frame& F, const float* sinks) {
    const bf16* P = wsb(F, WS_PROJ); bf16* O = wsb(F, WS_OSWA);
    for (int idx = blockIdx.x * 512 + F.tid; idx < T * 16; idx += F.G * 512) {
        const int hq = idx / T, m = idx % T, b = m / SEQ, t = m % SEQ, g = hq >> 2;
        float q[64];
        { const v4u* qp = (const v4u*)(P + (size_t)m * INW + COL_Q + hq * 64);
#pragma unroll
          for (int j = 0; j < 8; ++j) unpack8(qp[j], q + 8 * j); }
        float mrun = sinks[hq] * LOG2E, lrun = 1.f, o[64];
#pragma unroll
        for (int j = 0; j < 64; ++j) o[j] = 0.f;
        const int k0 = t >= 127 ? t - 127 : 0;
        for (int kp = k0; kp <= t; ++kp) {
            const bf16* kr = P + (size_t)(b * SEQ + kp) * INW + COL_K + g * 64; const bf16* vr = kr + (COL_V - COL_K);
            float s0 = 0.f, s1 = 0.f;
#pragma unroll
            for (int j = 0; j < 8; ++j) { float kf[8]; unpack8(((const v4u*)kr)[j], kf);
#pragma unroll
                for (int e = 0; e < 8; e += 2) { s0 += q[8 * j + e] * kf[e]; s1 += q[8 * j + e + 1] * kf[e + 1]; } }
            const float s = s0 + s1, mnew = fmaxf(mrun, s), corr = __builtin_amdgcn_exp2f(mrun - mnew), p = __builtin_amdgcn_exp2f(s - mnew);
            lrun = lrun * corr + p; mrun = mnew;
#pragma unroll
            for (int j = 0; j < 8; ++j) { float vf[8]; unpack8(((const v4u*)vr)[j], vf);
#pragma unroll
                for (int e = 0; e < 8; ++e) o[8 * j + e] = o[8 * j + e] * corr + p * vf[e]; }
        }
        const float inv = 1.0f / lrun; v4u* op = (v4u*)(O + (size_t)m * 1024 + hq * 64);
#pragma unroll
        for (int j = 0; j < 8; ++j) { v4u w; w.x = cvt_pk_bf16(o[8 * j] * inv, o[8 * j + 1] * inv); w.y = cvt_pk_bf16(o[8 * j + 2] * inv, o[8 * j + 3] * inv);
            w.z = cvt_pk_bf16(o[8 * j + 4] * inv, o[8 * j + 5] * inv); w.w = cvt_pk_bf16(o[8 * j + 6] * inv, o[8 * j + 7] * inv); op[j] = w; }
    }
}
__device__ __forceinline__ void memattn_naive(Frame& F) {
    const bf16* P = wsb(F, WS_PROJ); const bf16* KV = wsb(F, WS_MKV); bf16* O = wsb(F, WS_OMEM);
    LAS float* qs = (LAS float*)F.lds;
    LAS float* ss = qs + 32 * 260;
    const int tid = F.tid, ti = tid >> 4, kg = tid & 15;
    for (int unit = blockIdx.x; unit < 1024; unit += F.G) {
        const int b = unit >> 9, hd = (unit >> 7) & 3, tb = unit & 127, m0 = b * SEQ + tb * 32;
        { const v4u* src = (const v4u*)(P + (size_t)(m0 + ti) * INW + COL_MQ + hd * 256 + kg * 16); float f[16]; unpack8(src[0], f); unpack8(src[1], f + 8);
#pragma unroll
          for (int e = 0; e < 16; ++e) qs[ti * 260 + kg * 16 + e] = f[e]; }
        __syncthreads();
        float sc[16];
#pragma unroll 1
        for (int i = 0; i < 16; ++i) { const int key = kg + 16 * i; const v4u* kr = (const v4u*)(KV + (size_t)(b * NMEM + key) * 2048 + hd * 256);
            float a0 = 0.f, a1 = 0.f;
#pragma unroll 8
            for (int d8 = 0; d8 < 32; ++d8) { float kf[8]; unpack8(kr[d8], kf); const LAS f32x4* qp = (const LAS f32x4*)(qs + ti * 260 + d8 * 8); const f32x4 qa = qp[0], qb = qp[1];
                a0 += qa.x * kf[0] + qa.y * kf[1] + qa.z * kf[2] + qa.w * kf[3]; a1 += qb.x * kf[4] + qb.y * kf[5] + qb.z * kf[6] + qb.w * kf[7]; }
            ss[ti * 257 + key] = a0 + a1; }
        __syncthreads();
        float mx = -3.0e38f;
#pragma unroll
        for (int i = 0; i < 16; ++i) { sc[i] = ss[ti * 257 + kg + 16 * i]; mx = fmaxf(mx, sc[i]); }
#pragma unroll
        for (int o = 1; o < 16; o <<= 1) mx = fmaxf(mx, __shfl_xor(mx, o));
        float sum = 0.f;
#pragma unroll
        for (int i = 0; i < 16; ++i) { sc[i] = __builtin_amdgcn_exp2f(sc[i] - mx); sum += sc[i]; }
#pragma unroll
        for (int o = 1; o < 16; o <<= 1) sum += __shfl_xor(sum, o);
        const float inv = 1.0f / sum;
#pragma unroll
        for (int i = 0; i < 16; ++i) ss[ti * 257 + kg + 16 * i] = sc[i] * inv;
        __syncthreads();
        float o[16];
#pragma unroll
        for (int e = 0; e < 16; ++e) o[e] = 0.f;
#pragma unroll 4
        for (int key = 0; key < NMEM; ++key) { const float p = ss[ti * 257 + key]; const v4u* vr = (const v4u*)(KV + (size_t)(b * NMEM + key) * 2048 + 1024 + hd * 256 + kg * 16);
            float vf[16]; unpack8(vr[0], vf); unpack8(vr[1], vf + 8);
#pragma unroll
            for (int e = 0; e < 16; ++e) o[e] += p * vf[e]; }
        v4u* op = (v4u*)(O + (size_t)(m0 + ti) * 1024 + hd * 256 + kg * 16);
        v4u w; w.x = cvt_pk_bf16(o[0], o[1]); w.y = cvt_pk_bf16(o[2], o[3]); w.z = cvt_pk_bf16(o[4], o[5]); w.w = cvt_pk_bf16(o[6], o[7]); op[0] = w;
        w.x = cvt_pk_bf16(o[8], o[9]); w.y = cvt_pk_bf16(o[10], o[11]); w.z = cvt_pk_bf16(o[12], o[13]); w.w = cvt_pk_bf16(o[14], o[15]); op[1] = w;
        __syncthreads();
    }
}
__device__ __forceinline__ void sincos_red(double x, float& s, float& c) {
    const double k = __builtin_rint(x * 0.63661977236758134308); const double r = (x - k * 1.57079632679489655800) - k * 6.123233995736766036e-17; const double r2 = r * r;
    double sp = -7.6471637318198164759e-13; sp = sp * r2 + 1.6059043836821614599e-10; sp = sp * r2 - 2.5052108385441718775e-8; sp = sp * r2 + 2.7557319223985890653e-6; sp = sp * r2 - 1.9841269841269841270e-4; sp = sp * r2 + 8.3333333333333333333e-3; sp = sp * r2 - 1.6666666666666666667e-1;
    const double sr = r + r * r2 * sp;
    double cp = -1.1470745597729724714e-11; cp = cp * r2 + 2.0876756987868098979e-9; cp = cp * r2 - 2.7557319223985890653e-7; cp = cp * r2 + 2.4801587301587301587e-5; cp = cp * r2 - 1.3888888888888888889e-3; cp = cp * r2 + 4.1666666666666666667e-2; cp = cp * r2 - 0.5;
    const double cr = 1.0 + r2 * cp;
    const int q = ((int)k) & 3;
    const double ss = (q & 1) ? cr : sr, cc = (q & 1) ? sr : cr;
    s = (float)((q & 2) ? -ss : ss); c = (float)(((q == 1) || (q == 2)) ? -cc : cc);
}
struct SsmState { float ar, ai, a64r, a64i; float bbr[16], bbi[16]; };
struct SsmIn { const float *lre, *lim, *ldt, *bre, *bim, *cre, *cim, *dsk; };
__device__ __forceinline__ void ssm_params(const SsmIn& I, int g, int p, SsmState& S) {
    const int gp = g * 64 + p;
    const float lr = fminf(I.lre[gp], -1e-4f), li = I.lim[gp], dt = expf(I.ldt[g]);
    const float mag = expf(lr * dt); float sn, cs; const double th = (double)li * (double)dt; sincos_red(th, sn, cs);
    S.ar = mag * cs; S.ai = mag * sn;
    const float mag64 = expf(lr * dt * 64.f); sincos_red(th * 64.0, sn, cs); S.a64r = mag64 * cs; S.a64i = mag64 * sn;
    const float nr = S.ar - 1.f, ni = S.ai, den = lr * lr + li * li, kr = (nr * lr + ni * li) / den, ki = (ni * lr - nr * li) / den;
    const float* br = I.bre + (size_t)gp * 16; const float* bi = I.bim + (size_t)gp * 16;
#pragma unroll
    for (int c = 0; c < 16; ++c) { S.bbr[c] = kr * br[c] - ki * bi[c]; S.bbi[c] = kr * bi[c] + ki * br[c]; }
}
__device__ __forceinline__ void ssm_step(const SsmState& S, const bf16* up, float& sr, float& si) {
    const v4u* u4 = (const v4u*)up; float uf[16]; unpack8(u4[0], uf); unpack8(u4[1], uf + 8);
    float xr = 0.f, xi = 0.f;
#pragma unroll
    for (int c = 0; c < 16; ++c) { xr += S.bbr[c] * uf[c]; xi += S.bbi[c] * uf[c]; }
    const float nr = S.ar * sr - S.ai * si + xr, ni = S.ar * si + S.ai * sr + xi; sr = nr; si = ni;
}
__device__ __forceinline__ void ssm_local(Frame& F, const SsmIn& I) {
    const bf16* P = wsb(F, WS_PROJ); f32x2* SE = (f32x2*)(F.ws + WS_SEND);
    const int gw = blockIdx.x * NWAVES + F.wave, NGW = F.G * NWAVES, p = F.lane;
    for (int u = gw; u < 2 * 64 * 64; u += NGW) {
        const int g = u & 63, ch = (u >> 6) & 63, b = u >> 12;
        SsmState S; ssm_params(I, g, p, S);
        float sr = 0.f, si = 0.f; const bf16* up = P + (size_t)(b * SEQ + ch * 64) * INW + COL_S + g * 16;
#pragma unroll 4
        for (int j = 0; j < 64; ++j) ssm_step(S, up + (size_t)j * INW, sr, si);
        SE[((size_t)(b * 64 + ch) * 64 + g) * 64 + p] = (f32x2){sr, si};
    }
}
__device__ __forceinline__ void ssm_replay(Frame& F, const SsmIn& I) {
    const bf16* P = wsb(F, WS_PROJ); const f32x2* SE = (const f32x2*)(F.ws + WS_SEND); bf16* Y = wsb(F, WS_YS);
    LAS f32x2* Cs = (LAS f32x2*)F.lds;
    LAS float* Ds = (LAS float*)(F.lds + 16 * 65 * 8);
    LAS f32x2* Sw = (LAS f32x2*)(F.lds + 16384) + F.wave * (16 * 65);
    const int p = F.lane, jj = F.lane >> 2, cq = F.lane & 3;
    for (int unit = blockIdx.x; unit < 1024; unit += F.G) {
        const int oct = unit & 7, g = (unit >> 3) & 63, b = unit >> 9, ch = oct * 8 + F.wave;
        for (int e = F.tid; e < 1024; e += 512) { const int c = e >> 6, pp = e & 63; const size_t gi = ((size_t)g * 16 + c) * 64 + pp; Cs[c * 65 + pp] = (f32x2){I.cre[gi], I.cim[gi]}; }
        if (F.tid < 16) Ds[F.tid] = I.dsk[g * 16 + F.tid];
        __syncthreads();
        SsmState S; ssm_params(I, g, p, S);
        float sr = 0.f, si = 0.f;
        for (int j = 0; j < ch; ++j) { const f32x2 e = SE[((size_t)(b * 64 + j) * 64 + g) * 64 + p]; const float nr = S.a64r * sr - S.a64i * si + e.x, ni = S.a64r * si + S.a64i * sr + e.y; sr = nr; si = ni; }
        const size_t tok0 = (size_t)b * SEQ + ch * 64;
#pragma unroll 1
        for (int sub = 0; sub < 4; ++sub) {
#pragma unroll 4
            for (int j = 0; j < 16; ++j) { ssm_step(S, P + (tok0 + sub * 16 + j) * INW + COL_S + g * 16, sr, si); Sw[j * 65 + p] = (f32x2){sr, si}; }
            asm volatile("s_waitcnt lgkmcnt(0)" ::: "memory");
            float acc[4] = {0.f, 0.f, 0.f, 0.f};
#pragma unroll 4
            for (int pp = 0; pp < 64; ++pp) { const f32x2 sv = Sw[jj * 65 + pp];
#pragma unroll
                for (int ci = 0; ci < 4; ++ci) { const f32x2 cv = Cs[(cq * 4 + ci) * 65 + pp]; acc[ci] += cv.x * sv.x - cv.y * sv.y; } }
            const size_t tok = tok0 + sub * 16 + jj; const v2u uw = *(const v2u*)(P + tok * INW + COL_S + g * 16 + cq * 4);
            const float u0 = bf_lo(uw.x), u1 = bf_hi(uw.x), u2 = bf_lo(uw.y), u3 = bf_hi(uw.y);
            v2u o; o.x = cvt_pk_bf16(acc[0] + Ds[cq * 4] * u0, acc[1] + Ds[cq * 4 + 1] * u1); o.y = cvt_pk_bf16(acc[2] + Ds[cq * 4 + 2] * u2, acc[3] + Ds[cq * 4 + 3] * u3);
            *(v2u*)(Y + tok * 1024 + g * 16 + cq * 4) = o;
            asm volatile("s_waitcnt lgkmcnt(0)" ::: "memory");
        }
        __syncthreads();
    }
}

typedef short bf16x8 __attribute__((ext_vector_type(8)));
typedef short s16x4 __attribute__((ext_vector_type(4)));
typedef float f32x16 __attribute__((ext_vector_type(16)));
__device__ __forceinline__ s16x4 lds_tr16(const LAS unsigned char* p) { return __builtin_bit_cast(s16x4, __builtin_amdgcn_ds_read_tr16_b64_v4i16((LAS s16x4*)p)); }
__device__ __forceinline__ bf16x8 cat8(s16x4 lo, s16x4 hi) { return (bf16x8){lo[0], lo[1], lo[2], lo[3], hi[0], hi[1], hi[2], hi[3]}; }
__device__ __forceinline__ bf16x8 pack8(float a0, float a1, float a2, float a3, float a4, float a5, float a6, float a7) {
    v4u w; w.x = cvt_pk_bf16(a0, a1); w.y = cvt_pk_bf16(a2, a3); w.z = cvt_pk_bf16(a4, a5); w.w = cvt_pk_bf16(a6, a7); return __builtin_bit_cast(bf16x8, w); }

__device__ __forceinline__ void swa_mfma(Frame& F, const float* sinks) {
    const bf16* P = wsb(F, WS_PROJ); bf16* O = wsb(F, WS_OSWA);
    LAS unsigned char* Kl = F.lds;
    LAS unsigned char* Vl = F.lds + 36864;
    const int tid = F.tid, lane = F.lane, w = F.wave, r = w >> 1, qh = w & 1, l31 = lane & 31, h = lane >> 5;
    for (int ub_ = blockIdx.x; ub_ < 256; ub_ += F.G) { const int unit = (F.G == 256) ? ((ub_ & 7) * 32 + (ub_ >> 3)) : ub_;
        const int n = unit & 31, g = (unit >> 5) & 3, b = unit >> 7;
#pragma unroll
        for (int i = 0; i < 4; ++i) { const int c = tid + 512 * i, key = c >> 3, part = c & 7, pos = (n - 1) * 128 + key;
            v4u kv = {0u, 0u, 0u, 0u}, vv = {0u, 0u, 0u, 0u};
            if (pos >= 0) { const bf16* src = P + (size_t)(b * SEQ + pos) * INW + COL_K + g * 64 + part * 8; kv = *(const v4u*)src; vv = *(const v4u*)(src + (COL_V - COL_K)); }
            *(LAS v4u*)(Kl + key * 144 + part * 16) = kv;
            *(LAS v4u*)(Vl + (part >> 2) * 16384 + key * 64 + (part & 3) * 16) = vv; }
        __syncthreads();
        const int hq = g * 4 + r; const float sink2 = sinks[hq] * LOG2E;
#pragma unroll 1
        for (int qt = 0; qt < 2; ++qt) {
            const int a = qh * 2 + qt, qi = a * 32 + l31; const size_t m = (size_t)b * SEQ + n * 128 + qi;
            bf16x8 qf[4];
#pragma unroll
            for (int ds = 0; ds < 4; ++ds) qf[ds] = *(const bf16x8*)(P + m * INW + COL_Q + hq * 64 + ds * 16 + h * 8);
            f32x16 s[5];
#pragma unroll
            for (int k5 = 0; k5 < 5; ++k5) { f32x16 acc;
#pragma unroll
                for (int e = 0; e < 16; ++e) acc[e] = 0.f;
#pragma unroll
                for (int ds = 0; ds < 4; ++ds) { const bf16x8 kf = *(const LAS bf16x8*)(Kl + (32 * (a + k5) + l31) * 144 + ds * 32 + h * 16); acc = __builtin_amdgcn_mfma_f32_32x32x16_bf16(kf, qf[ds], acc, 0, 0, 0); }
                s[k5] = acc; }
            float mx = sink2;
#pragma unroll
            for (int k5 = 0; k5 < 5; ++k5)
#pragma unroll
                for (int e = 0; e < 16; ++e) { const int kl = 32 * (a + k5) + (e & 3) + 8 * (e >> 2) + 4 * h; const bool ok = (kl > qi) && (kl <= qi + 128) && (n > 0 || kl >= 128);
                    const float v = ok ? s[k5][e] : -1.0e30f; s[k5][e] = v; mx = fmaxf(mx, v); }
            mx = fmaxf(mx, __shfl_xor(mx, 32));
            float sum = 0.f;
#pragma unroll
            for (int k5 = 0; k5 < 5; ++k5)
#pragma unroll
                for (int e = 0; e < 16; ++e) { const float p = __builtin_amdgcn_exp2f(s[k5][e] - mx); s[k5][e] = p; sum += p; }
            sum += __shfl_xor(sum, 32); sum += __builtin_amdgcn_exp2f(sink2 - mx);
            f32x16 o[2];
#pragma unroll
            for (int e = 0; e < 16; ++e) { o[0][e] = 0.f; o[1][e] = 0.f; }
#pragma unroll
            for (int k5 = 0; k5 < 5; ++k5)
#pragma unroll
                for (int s2 = 0; s2 < 2; ++s2) { const bf16x8 pf = pack8(s[k5][8 * s2], s[k5][8 * s2 + 1], s[k5][8 * s2 + 2], s[k5][8 * s2 + 3], s[k5][8 * s2 + 4], s[k5][8 * s2 + 5], s[k5][8 * s2 + 6], s[k5][8 * s2 + 7]);
                    const int base0 = 32 * (a + k5) + 16 * s2 + 4 * h;
#pragma unroll
                    for (int db = 0; db < 2; ++db) { const LAS unsigned char* vp = Vl + db * 16384 + (base0 + ((lane & 15) >> 2)) * 64 + (16 * ((lane >> 4) & 1) + 4 * (lane & 3)) * 2;
                        const bf16x8 vf = cat8(lds_tr16(vp), lds_tr16(vp + 8 * 64)); o[db] = __builtin_amdgcn_mfma_f32_32x32x16_bf16(vf, pf, o[db], 0, 0, 0); } }
            const float inv = 1.0f / sum;
#pragma unroll
            for (int db = 0; db < 2; ++db)
#pragma unroll
                for (int g4 = 0; g4 < 4; ++g4) { v2u wv; wv.x = cvt_pk_bf16(o[db][4 * g4] * inv, o[db][4 * g4 + 1] * inv); wv.y = cvt_pk_bf16(o[db][4 * g4 + 2] * inv, o[db][4 * g4 + 3] * inv);
                    *(v2u*)(O + m * 1024 + hq * 64 + db * 32 + 8 * g4 + 4 * h) = wv; }
        }
        __syncthreads();
    }
}
__device__ __forceinline__ void memattn_mfma(Frame& F) {
    const bf16* P = wsb(F, WS_PROJ); const bf16* KV = wsb(F, WS_MKV); bf16* O = wsb(F, WS_OMEM);
    constexpr int RS = 544, SLOT = 64 * RS;
    const int tid = F.tid, lane = F.lane, w = F.wave, l15 = lane & 15, kq = lane >> 4;
    for (int ub_ = blockIdx.x; ub_ < 256; ub_ += F.G) { const int unit = (F.G == 256) ? ((ub_ & 7) * 32 + (ub_ >> 3)) : ub_;
        const int tb = unit & 31, hd = (unit >> 5) & 3, b = unit >> 7; const size_t m = (size_t)b * SEQ + tb * 128 + w * 16 + l15;
        bf16x8 qf[8];
#pragma unroll
        for (int ds = 0; ds < 8; ++ds) qf[ds] = *(const bf16x8*)(P + m * INW + COL_MQ + hd * 256 + ds * 32 + kq * 8);
        v4u st[4];
#define MA_LOAD(t) do { _Pragma("unroll") for (int i_ = 0; i_ < 4; ++i_) { const int c_ = tid + 512 * i_, row_ = c_ >> 5, part_ = c_ & 31; \
            st[i_] = *(const v4u*)(KV + (size_t)(b * NMEM + 64 * ((t) & 3) + row_) * 2048 + ((t) >> 2) * 1024 + hd * 256 + part_ * 8); } } while (0)
#define MA_STORE(buf) do { _Pragma("unroll") for (int i_ = 0; i_ < 4; ++i_) { const int c_ = tid + 512 * i_, row_ = c_ >> 5, part_ = c_ & 31; *(LAS v4u*)((buf) + row_ * RS + part_ * 16) = st[i_]; } } while (0)
        MA_LOAD(0); MA_STORE(F.lds); __syncthreads();
        f32x4 s[16]; f32x4 o[16]; float inv = 0.f;
#pragma unroll
        for (int t = 0; t < 8; ++t) {
            if (t < 7) MA_LOAD(t + 1);
            const LAS unsigned char* cur = F.lds + (t & 1) * SLOT;
            if (t < 4) {
#pragma unroll
                for (int k4 = 0; k4 < 4; ++k4) { f32x4 acc = {0.f, 0.f, 0.f, 0.f};
#pragma unroll
                    for (int ds = 0; ds < 8; ++ds) { const bf16x8 kf = *(const LAS bf16x8*)(cur + (16 * k4 + l15) * RS + ds * 64 + kq * 16); acc = __builtin_amdgcn_mfma_f32_16x16x32_bf16(kf, qf[ds], acc, 0, 0, 0); }
                    s[4 * t + k4] = acc; }
                if (t == 3) {
                    float mx = -3.0e38f;
#pragma unroll
                    for (int i = 0; i < 16; ++i) mx = fmaxf(mx, fmaxf(fmaxf(s[i][0], s[i][1]), fmaxf(s[i][2], s[i][3])));
                    mx = fmaxf(mx, __shfl_xor(mx, 16)); mx = fmaxf(mx, __shfl_xor(mx, 32));
                    float sum = 0.f;
#pragma unroll
                    for (int i = 0; i < 16; ++i)
#pragma unroll
                        for (int e = 0; e < 4; ++e) { const float p = __builtin_amdgcn_exp2f(s[i][e] - mx); s[i][e] = p; sum += p; }
                    sum += __shfl_xor(sum, 16); sum += __shfl_xor(sum, 32); inv = 1.0f / sum;
#pragma unroll
                    for (int i = 0; i < 16; ++i) o[i] = (f32x4){0.f, 0.f, 0.f, 0.f};
                }
            } else {
                const int tv = t - 4;
#pragma unroll
                for (int s2 = 0; s2 < 2; ++s2) { const f32x4 p0 = s[4 * tv + 2 * s2], p1 = s[4 * tv + 2 * s2 + 1]; const bf16x8 pf = pack8(p0[0], p0[1], p0[2], p0[3], p1[0], p1[1], p1[2], p1[3]);
#pragma unroll
                    for (int db = 0; db < 16; ++db) { const LAS unsigned char* vp = cur + (32 * s2 + 4 * kq + (l15 >> 2)) * RS + (16 * db + 4 * (lane & 3)) * 2;
                        const bf16x8 vf = cat8(lds_tr16(vp), lds_tr16(vp + 16 * RS)); o[db] = __builtin_amdgcn_mfma_f32_16x16x32_bf16(vf, pf, o[db], 0, 0, 0); } }
            }
            if (t < 7) MA_STORE(F.lds + ((t + 1) & 1) * SLOT);
            __syncthreads();
        }
#undef MA_LOAD
#undef MA_STORE
#pragma unroll
        for (int db = 0; db < 16; ++db) { v2u wv; wv.x = cvt_pk_bf16(o[db][0] * inv, o[db][1] * inv); wv.y = cvt_pk_bf16(o[db][2] * inv, o[db][3] * inv); *(v2u*)(O + m * 1024 + hd * 256 + 16 * db + 4 * kq) = wv; }
    }
}

__device__ __forceinline__ void cmul(float ar, float ai, float br, float bi, float& cr, float& ci) { cr = ar * br - ai * bi; ci = ar * bi + ai * br; }
__device__ __forceinline__ void ssm_tables(Frame& F, const SsmIn& I0) {
    LAS f32x2* AP = (LAS f32x2*)F.lds;
    LAS f32x2* BB = (LAS f32x2*)(F.lds + 33280);
    LAS f32x2* CC = (LAS f32x2*)(F.lds + 33280 + 8192);
    LAS f32x2* KC = (LAS f32x2*)(F.lds + 33280 + 16384);
    const int t = F.tid;
    for (int unit = blockIdx.x; unit < DEPTH * 64; unit += F.G) {
        const int l = unit >> 6, g = unit & 63, gp0 = unit * 64;
        const float dt = expf(I0.ldt[unit]);
        for (int e = t; e < 65 * 64; e += 512) { const int ee = e >> 6, p = e & 63; const float lr = fminf(I0.lre[gp0 + p], -1e-4f), li = I0.lim[gp0 + p];
            const float mag = expf(lr * dt * (float)ee); float sn, cs; sincos_red((double)li * (double)dt * (double)ee, sn, cs); AP[e] = (f32x2){mag * cs, mag * sn}; }
        __syncthreads();
        if (t < 64) { ((f32x2*)(F.ws + WS_A64))[gp0 + t] = AP[64 * 64 + t];
            const float lr = fminf(I0.lre[gp0 + t], -1e-4f), li = I0.lim[gp0 + t]; const f32x2 a = AP[64 + t]; const float nr = a.x - 1.f, ni = a.y, den = lr * lr + li * li;
            KC[t] = (f32x2){(nr * lr + ni * li) / den, (ni * lr - nr * li) / den}; }
        __syncthreads();
        for (int e = t; e < 1024; e += 512) { const int p = e >> 4; const f32x2 k = KC[p]; const float br = I0.bre[(size_t)gp0 * 16 + e], bi = I0.bim[(size_t)gp0 * 16 + e];
            BB[e] = (f32x2){k.x * br - k.y * bi, k.x * bi + k.y * br}; CC[e] = (f32x2){I0.cre[(size_t)gp0 * 16 + e], I0.cim[(size_t)gp0 * 16 + e]}; }
        __syncthreads();
        bf16* WinT = wsb(F, WS_WINT) + (size_t)unit * 131072; bf16* WoutT = wsb(F, WS_WOUTT) + (size_t)unit * 131072; bf16* LB = (bf16*)(F.ws + WS_LB + (size_t)unit * LB_BYTES);
        for (int q = t; q < 16384; q += 512) { const int n = q >> 7, ck = q & 127, j = ck >> 1, half = ck & 1, p = 16 * (n >> 5) + (n & 15), isim = (n >> 4) & 1; const f32x2 a = AP[(63 - j) * 64 + p]; float v[8];
#pragma unroll
            for (int e = 0; e < 8; ++e) { const f32x2 bb = BB[p * 16 + 8 * half + e]; float zr, zi; cmul(a.x, a.y, bb.x, bb.y, zr, zi); v[e] = isim ? zi : zr; }
            *(bf16x8*)(WinT + (size_t)n * 1024 + ck * 8) = pack8(v[0], v[1], v[2], v[3], v[4], v[5], v[6], v[7]); }
        for (int q = t; q < 16384; q += 512) { const int row = q >> 4, ck = q & 15, tau = row >> 4, c = row & 15, isim = ck >> 3, p0 = (8 * ck) & 63; float v[8];
#pragma unroll
            for (int e = 0; e < 8; ++e) { const f32x2 cc = CC[c * 64 + p0 + e], a = AP[(tau + 1) * 64 + p0 + e]; float zr, zi; cmul(cc.x, cc.y, a.x, a.y, zr, zi); v[e] = isim ? -zi : zr; }
            *(bf16x8*)(WoutT + (size_t)row * 128 + ck * 8) = pack8(v[0], v[1], v[2], v[3], v[4], v[5], v[6], v[7]); }
        { const int c = (t >> 4) & 15, c2 = t & 15, lh = t >> 8; float acc[32];
#pragma unroll
          for (int d = 0; d < 32; ++d) acc[d] = 0.f;
#pragma unroll 2
          for (int p = 0; p < 64; ++p) { const f32x2 cc = CC[c * 64 + p], bb = BB[p * 16 + c2]; float zr, zi; cmul(cc.x, cc.y, bb.x, bb.y, zr, zi);
#pragma unroll
              for (int d = 0; d < 32; ++d) { const f32x2 a = AP[(32 * lh + d) * 64 + p]; acc[d] += zr * a.x - zi * a.y; } }
          if (lh == 0 && c == c2) acc[0] += I0.dsk[l * 1024 + g * 16 + c];
#pragma unroll
          for (int d = 0; d < 32; ++d) LB[(((32 * lh + d + 1) * 2 + (c2 >> 3)) * 16 + c) * 8 + (c2 & 7)] = (bf16)(cvt_pk_bf16(acc[d], 0.f) & 0xffffu);
          if (t < 256) LB[t] = 0; }
        __syncthreads();
    }
}
__device__ __forceinline__ void ssm_s1(Frame& F, const SsmIn& I, int l) {
    const bf16* P = wsb(F, WS_PROJ); bf16* SST = wsb(F, WS_SST);
    LAS float* E = (LAS float*)F.lds;
    const int lane = F.lane, w = F.wave, l31 = lane & 31, h = lane >> 5, mi = w & 3, kh = w >> 2;
    for (int ub_ = blockIdx.x; ub_ < 256; ub_ += F.G) { const int unit = (F.G == 256) ? ((ub_ & 7) * 32 + (ub_ >> 3)) : ub_;
        const int g = unit >> 2, pq = unit & 3;
        const bf16* WinT = wsb(F, WS_WINT) + (size_t)(l * 64 + g) * 131072 + (size_t)(pq * 32 + l31) * 1024 + 8 * h;
        const int mrow = 32 * mi + l31, bb = mrow >> 6, kk = mrow & 63;
        const bf16* up = wsb(F, WS_SIN) + ((size_t)g * T + bb * SEQ + kk * 64) * 16 + 8 * h;
        f32x16 acc;
#pragma unroll
        for (int e = 0; e < 16; ++e) acc[e] = 0.f;
#pragma unroll 16
        for (int jj = 0; jj < 32; ++jj) { const int j = 32 * kh + jj; const bf16x8 af = *(const bf16x8*)(up + (size_t)j * 16), bf = *(const bf16x8*)(WinT + 16 * j);
            acc = __builtin_amdgcn_mfma_f32_32x32x16_bf16(af, bf, acc, 0, 0, 0); }
#pragma unroll
        for (int e = 0; e < 16; ++e) E[(kh * 128 + 32 * mi + (e & 3) + 8 * (e >> 2) + 4 * h) * 33 + l31] = acc[e];
        __syncthreads();
#pragma unroll 1
        for (int tk = 0; tk < 4; ++tk) { const int task = w * 4 + tk, b = task >> 4, st = task & 15, p = 16 * pq + st, k = lane;
            float xr = E[(b * 64 + k) * 33 + st] + E[(128 + b * 64 + k) * 33 + st], xi = E[(b * 64 + k) * 33 + 16 + st] + E[(128 + b * 64 + k) * 33 + 16 + st];
            float ar, ai; { const f32x2 a64 = ((const f32x2*)(F.ws + WS_A64))[(l * 64 + g) * 64 + p]; ar = a64.x; ai = a64.y; }
#pragma unroll
            for (int d = 1; d < 64; d <<= 1) { const float yr = __shfl_up(xr, d), yi = __shfl_up(xi, d); if (k >= d) { xr += ar * yr - ai * yi; xi += ar * yi + ai * yr; } const float nr = ar * ar - ai * ai, ni = 2.f * ar * ai; ar = nr; ai = ni; }
            float sr = __shfl_up(xr, 1), si = __shfl_up(xi, 1); if (k == 0) { sr = 0.f; si = 0.f; }
            bf16* dst = SST + ((size_t)(g * 128 + b * 64 + k)) * 128 + p; dst[0] = (bf16)(cvt_pk_bf16(sr, 0.f) & 0xffffu); dst[64] = (bf16)(cvt_pk_bf16(si, 0.f) & 0xffffu); }
        __syncthreads();
    }
}
__device__ __forceinline__ void ssm_s2(Frame& F, int l) {
    const bf16* P = wsb(F, WS_PROJ); const bf16* SST = wsb(F, WS_SST); bf16* Y = wsb(F, WS_YS);
    LAS unsigned char* Ul = F.lds;
    LAS unsigned char* Ll = F.lds + 66048;
    LAS unsigned char* Sl = F.lds + 66048 + 33280;
    const int t = F.tid, lane = F.lane, w = F.wave, l31 = lane & 31, h = lane >> 5;
    for (int ub_ = blockIdx.x; ub_ < 256; ub_ += F.G) { const int unit = (F.G == 256) ? ((ub_ & 7) * 32 + (ub_ >> 3)) : ub_;
        const int mt = unit & 1, b = (unit >> 1) & 1, g = unit >> 2;
        const bf16* WoutT = wsb(F, WS_WOUTT) + (size_t)(l * 64 + g) * 131072;
        bf16x8 wfr[4][8];
#pragma unroll
        for (int q = 0; q < 4; ++q) { const int n = (q == 0) ? w : (q == 1) ? 15 - w : (q == 2) ? 16 + w : 31 - w;
#pragma unroll
            for (int ks = 0; ks < 8; ++ks) wfr[q][ks] = *(const bf16x8*)(WoutT + (size_t)(32 * n + l31) * 128 + 16 * ks + 8 * h); }
#pragma unroll
        for (int i = 0; i < 8; ++i) { const int q = t + 512 * i, half = q & 1, ti = q >> 1, ir = ti >> 6, j = ti & 63;
            *(LAS v4u*)(Ul + ir * 2064 + j * 32 + half * 16) = *(const v4u*)(wsb(F, WS_SIN) + ((size_t)g * T + b * SEQ + (32 * mt) * 64) * 16 + (size_t)q * 8); }
        { const v4u* src = (const v4u*)(F.ws + WS_LB + (size_t)(l * 64 + g) * LB_BYTES);
          for (int q = t; q < (int)(LB_BYTES / 16); q += 512) *(LAS v4u*)(Ll + q * 16) = src[q]; }
        { const int row = t >> 4, part = t & 15; *(LAS v4u*)(Sl + row * 272 + part * 16) = *(const v4u*)(SST + ((size_t)(g * 128 + b * 64 + 32 * mt + row)) * 128 + part * 8); }
        __syncthreads();
#pragma unroll
        for (int q = 0; q < 4; ++q) { const int n = (q == 0) ? w : (q == 1) ? 15 - w : (q == 2) ? 16 + w : 31 - w;
            f32x16 acc;
#pragma unroll
            for (int e = 0; e < 16; ++e) acc[e] = 0.f;
#pragma unroll
            for (int ks = 0; ks < 8; ++ks) { const bf16x8 sf = *(const LAS bf16x8*)(Sl + l31 * 272 + ks * 32 + h * 16);
                acc = __builtin_amdgcn_mfma_f32_32x32x16_bf16(wfr[q][ks], sf, acc, 0, 0, 0); }
            const LAS unsigned char* lbp = Ll + ((2 * n + 1 + (l31 >> 4)) * 2 + h) * 256 + (l31 & 15) * 16; const LAS unsigned char* ubp = Ul + l31 * 2064 + h * 16;
#pragma unroll 4
            for (int j = 0; j < 2 * n + 2; ++j) { const bf16x8 kf = *(const LAS bf16x8*)(lbp - j * 512), uf = *(const LAS bf16x8*)(ubp + j * 32); acc = __builtin_amdgcn_mfma_f32_32x32x16_bf16(kf, uf, acc, 0, 0, 0); }
#pragma unroll
            for (int q4 = 0; q4 < 4; ++q4) { const int c0 = 8 * (q4 & 1) + 4 * h, tau = 2 * n + (q4 >> 1); const size_t tok = (size_t)b * SEQ + (32 * mt + l31) * 64 + tau;
                v2u wv; wv.x = cvt_pk_bf16(acc[4 * q4], acc[4 * q4 + 1]); wv.y = cvt_pk_bf16(acc[4 * q4 + 2], acc[4 * q4 + 3]); *(v2u*)(Y + tok * 1024 + g * 16 + c0) = wv; }
        }
        __syncthreads();
    }
}

constexpr int PH_PRO = 0, PH_SB0 = 1, PH_PER_SB = 6, N_SB = 3 * DEPTH, PH_FINAL = PH_SB0 + N_SB * PH_PER_SB, N_PH = PH_FINAL + 1;
struct Args { const float* in[N_IN]; float* out; unsigned char* ws; int ph_lo, ph_hi; };
static_assert(sizeof(Args) == N_IN * 8 + 8 + 8 + 8, "Args has no padding");

typedef __attribute__((address_space(4))) const Args* KArgs;
__device__ __forceinline__ KArgs kargs() { KArgs p = (KArgs)__builtin_amdgcn_kernarg_segment_ptr(); asm volatile("" : "+s"(p)); return p; }
#define AIN(i) (kargs()->in[i])
__global__ void __launch_bounds__(NWAVES * 64, 2) fwd(Args args_unused) {
    extern __shared__ __attribute__((aligned(16))) unsigned char lds[];
    Frame F;
    F.lds = (LAS unsigned char*)lds;
    F.tid = threadIdx.x; F.lane = F.tid & 63; F.wave = __builtin_amdgcn_readfirstlane(F.tid >> 6); F.G = gridDim.x;
    F.ws = kargs()->ws;
    volatile LAS unsigned* MISC = (volatile LAS unsigned*)(F.lds + MISC_OFF);
    for (int u = F.tid; u < (LDS_BYTES - LDSCTL_OFF) / 4; u += NWAVES * 64) ((LAS unsigned*)(F.lds + LDSCTL_OFF))[u] = 0u;
    __syncthreads();
    unsigned* barw = (unsigned*)(F.ws + WS_CTL) + CW_BAR;
    XcdBarrier bar; bar.bar = barw; bar.x = 0; bar.st = nullptr;
    if (kargs()->ph_hi - kargs()->ph_lo > 1) (void)xcd_barrier_post(barw, MISC + 8);
#define IN(p) (kargs()->ph_lo <= (p) && (p) < kargs()->ph_hi)
#define hi (kargs()->ph_hi)
#define BARNOW() XcdBarrier{(unsigned*)(kargs()->ws + WS_CTL) + CW_BAR, xb_xcc_id(), (volatile LAS unsigned*)((LAS unsigned char*)lds + MISC_OFF) + 8}
#define FRESH() do { int t_ = threadIdx.x; asm volatile("" : "+v"(t_)); F.tid = t_; F.lane = t_ & 63; F.wave = __builtin_amdgcn_readfirstlane(t_ >> 6); unsigned char* w_ = kargs()->ws; F.ws = w_; } while (0)
#if DIAG
#define SEAM(p, q) do { if (IN(p) && (q) < hi) { xcd_barrier(BARNOW()); if ((q) == PH_FINAL && threadIdx.x == 0) { const unsigned dwt = MISC[16]; unsigned* dw = (unsigned*)(kargs()->ws + WS_CTL) + 2048; atomicMax(dw, dwt); atomicAdd(dw + 128, dwt >> 8); } } } while (0)
#else
#define SEAM(p, q) do { if (IN(p) && (q) < hi) xcd_barrier(BARNOW()); } while (0)
#endif

    if (IN(PH_PRO) && EN_PRO) for (int rep_ = 0; rep_ < REP_PRO; ++rep_) { FRESH(); const ProIn I{AIN(I_F1WI), AIN(I_F2WI), AIN(I_F1WO), AIN(I_F2WO), AIN(I_WIN), AIN(I_WMKV), AIN(I_WGLU), AIN(I_WSWA), AIN(I_WMEMUP), AIN(I_WOUT), AIN(I_MEM), AIN(I_MEMN), AIN(I_F1N), AIN(I_F2N), AIN(I_MIXN), AIN(I_X)}; prologue(F, I);
        const SsmIn I0{AIN(I_LRE), AIN(I_LIM), AIN(I_LDT), AIN(I_BRE), AIN(I_BIM), AIN(I_CRE), AIN(I_CIM), AIN(I_DSK)}; ssm_tables(F, I0); }
    SEAM(PH_PRO, PH_SB0);

    for (int sb = 0; sb < N_SB; ++sb) {
        const int l = sb / 3, ty = sb % 3, pb = PH_SB0 + sb * PH_PER_SB;
        if (pb + PH_PER_SB <= kargs()->ph_lo || pb >= hi) continue;
#define HIN() ((sb == 0) ? AIN(I_X) : (const float*)(F.ws + WS_H))
#define WL() (F.ws + WS_W + (size_t)l * W_LAYER)
        if (ty != 1) {
            if (IN(pb + 1) && EN_G1) for (int rep_ = 0; rep_ < REP_G1; ++rep_) { FRESH();
                pg8::SchedG1 S{(const char*)(F.ws + WS_XN), (const char*)(WL() + (ty == 0 ? WO_1IN : WO_2IN)), (size_t)256 * DM * 2, T / 256, 2 * DFF / 256, F.G, (int)blockIdx.x};
                pg8::Unit u0; int pm0 = -1; if (S.next(0, u0)) { pm0 = u0.pm; rstd_table(F, pm0); }
                pg8::EpiSwiGLU E{wsb(F, WS_HID), DFF, pg8::RstdTab{(const LAS float*)(F.lds + RSTD_OFF), pm0, (const float*)(F.ws + WS_SSQ)}};
                pg8::gemm_phase<pg8::EpiSwiGLU, pg8::SchedG1, true, true>(F.lds + RING_OFF, DM, S, E);
            }
            SEAM(pb + 1, pb + 5);
        } else {
            if (IN(pb + 1) && EN_G3) for (int rep_ = 0; rep_ < REP_G3; ++rep_) { FRESH();
                pg8::SchedProj S{(const char*)(F.ws + WS_XN), (const char*)(WL() + WO_IN), (const char*)(F.ws + WS_MEMN + (size_t)l * 512 * DM * 2), (const char*)(WL() + WO_MKV), (size_t)256 * DM * 2, T / 256, INW / 256, F.G, (int)blockIdx.x};
                pg8::Unit u0; int pm0 = -1; if (S.next(0, u0)) { pm0 = u0.pm; rstd_table(F, pm0); }
                pg8::EpiProj E{wsb(F, WS_PROJ), INW, COL_G / 256, wsb(F, WS_MKV), 2048, pg8::RstdTab{(const LAS float*)(F.lds + RSTD_OFF), pm0, (const float*)(F.ws + WS_SSQ)}, wsb(F, WS_SIN)};
                pg8::gemm_phase<pg8::EpiProj, pg8::SchedProj, true, true>(F.lds + RING_OFF, DM, S, E);
            }
            SEAM(pb + 1, pb + 2);
            if (IN(pb + 2) && EN_M1) for (int rep_ = 0; rep_ < REP_M; ++rep_) { FRESH(); for (int r2_ = 0; r2_ < REP_SWA; ++r2_) swa_mfma(F, AIN(I_SINK) + l * 16); for (int r2_ = 0; r2_ < REP_MA; ++r2_) memattn_mfma(F);
                const SsmIn I{AIN(I_LRE) + l * 4096, AIN(I_LIM) + l * 4096, AIN(I_LDT) + l * 64, AIN(I_BRE) + l * 65536, AIN(I_BIM) + l * 65536, AIN(I_CRE) + l * 65536, AIN(I_CIM) + l * 65536, AIN(I_DSK) + l * 1024}; for (int r2_ = 0; r2_ < REP_S1; ++r2_) ssm_s1(F, I, l); }
            SEAM(pb + 2, pb + 3);
            if (IN(pb + 3) && EN_M2) for (int rep_ = 0; rep_ < REP_M; ++rep_) { FRESH(); const SsmIn I{AIN(I_LRE) + l * 4096, AIN(I_LIM) + l * 4096, AIN(I_LDT) + l * 64, AIN(I_BRE) + l * 65536, AIN(I_BIM) + l * 65536, AIN(I_CRE) + l * 65536, AIN(I_CIM) + l * 65536, AIN(I_DSK) + l * 1024}; (void)I; for (int r2_ = 0; r2_ < REP_S2; ++r2_) ssm_s2(F, l); }
            SEAM(pb + 3, pb + 4);
            if (IN(pb + 4) && EN_G4) for (int rep_ = 0; rep_ < REP_G4; ++rep_) { FRESH();
                pg8::SchedMix S{(const char*)(F.ws + WS_OSWA), (const char*)(F.ws + WS_OMEM), (const char*)(F.ws + WS_YS), (const char*)(WL() + WO_SWA), (const char*)(WL() + WO_MEM), (const char*)(WL() + WO_GLU), (size_t)256 * 1024 * 2, T / 256, DM / 256, F.G, (int)blockIdx.x};
                pg8::EpiMix E{wsb(F, WS_MG), wsb(F, WS_PROJ) + COL_G, INW};
                pg8::gemm_phase<pg8::EpiMix, pg8::SchedMix, true, true>(F.lds + RING_OFF, 1024, S, E);
            }
            SEAM(pb + 4, pb + 5);
        }
        if (IN(pb + 5) && EN_GR) for (int rep_ = 0; rep_ < REP_GR; ++rep_) { FRESH();
            const int K = (ty == 1) ? DM : DFF;
            pg8::SchedTiles S{(const char*)(F.ws + (ty == 1 ? WS_MG : WS_HID)), (const char*)(WL() + (ty == 0 ? WO_1OUT : ty == 1 ? WO_OUT : WO_2OUT)), (size_t)256 * K * 2, T / 256, DM / 256, F.G, (int)blockIdx.x};
            pg8::EpiResid E{(sb == 0) ? AIN(I_X) : nullptr, ty == 1 ? 1.0f : 0.5f, DM, wsb(F, WS_XN), (float*)(F.ws + (rep_ ? WS_T32 : WS_SSQ)), wsb(F, rep_ ? WS_H : WS_XN)};
            pg8::gemm_phase<pg8::EpiResid, pg8::SchedTiles, true, true>(F.lds + RING_OFF, K, S, E);
        }
        SEAM(pb + 5, pb + 6);
    }
    if (IN(PH_FINAL)) { FRESH(); final_norm(F, wsb(F, WS_XN), AIN(I_FINN), kargs()->out);
#if DIAG
        xcd_barrier(BARNOW());
        if (blockIdx.x == 0) { const unsigned* dw = (const unsigned*)(F.ws + WS_CTL) + 2048; const float vmax = (float)__hip_atomic_load(dw, __ATOMIC_RELAXED, __HIP_MEMORY_SCOPE_AGENT) * 0.01f, vmean = (float)__hip_atomic_load(dw + 128, __ATOMIC_RELAXED, __HIP_MEMORY_SCOPE_AGENT) * 2.56f / 256.f;
            float* o = kargs()->out; if (F.tid == 0) o[0] = vmax * DIAG_SCALE0; for (int i = 1 + F.tid; i < 1 + (1 << 20); i += 512) o[i] += vmean * DIAG_SCALE1; }
#endif
    }
#undef IN
#undef hi
#undef SEAM
}

static bool phase_valid(int p) {
    if (p == PH_PRO || p == PH_FINAL) return true;
    const int sb = (p - PH_SB0) / PH_PER_SB, k = (p - PH_SB0) % PH_PER_SB;
    return k != 0 && ((sb % 3 == 1) || k == 1 || k == 5);
}
extern "C" void kernel_launch(void* const* d_in, const int* in_sizes, int n_in, void* d_out, int out_size, void* d_ws, size_t ws_size, hipStream_t stream) {
    static int grid = 0;
    if (grid == 0) {
        if (n_in != N_IN || in_sizes[0] != T * DM || out_size != T * DM || ws_size < WS_END) { fprintf(stderr, "kernel_launch: unexpected shapes: n_in %d in0 %d out %d ws %zu (need %zu); nothing launched\n", n_in, n_in > 0 ? in_sizes[0] : -1, out_size, ws_size, (size_t)WS_END); grid = -1; return; }
        int dev = 0, cus = 0, per_cu = 0;
        if (hipGetDevice(&dev) != hipSuccess || hipDeviceGetAttribute(&cus, hipDeviceAttributeMultiprocessorCount, dev) != hipSuccess) { fprintf(stderr, "kernel_launch: device query failed\n"); grid = -1; return; }
        if (hipFuncSetAttribute((const void*)fwd, hipFuncAttributeMaxDynamicSharedMemorySize, LDS_BYTES) != hipSuccess) { fprintf(stderr, "kernel_launch: hipFuncSetAttribute failed\n"); grid = -1; return; }
        if (hipOccupancyMaxActiveBlocksPerMultiprocessor(&per_cu, (const void*)fwd, NWAVES * 64, LDS_BYTES) != hipSuccess || per_cu < 1) fprintf(stderr, "kernel_launch: note: occupancy query reports %d workgroups per CU\n", per_cu);
        (void)hipGetLastError();
        if (cus != 256) { fprintf(stderr, "kernel_launch: built for a 256-CU device (got %d); nothing launched\n", cus); grid = -1; return; }
        grid = cus;
    }
    if (grid < 0) return;
    if (hipMemsetAsync((char*)d_ws + WS_CTL, 0, CTL_ZERO_BYTES, stream) != hipSuccess) { fprintf(stderr, "kernel_launch: memset failed\n"); return; }
    Args a{};
    for (int i = 0; i < N_IN; ++i) a.in[i] = (const float*)d_in[i];
    a.out = (float*)d_out; a.ws = (unsigned char*)d_ws;
#if ONE_LAUNCH
    a.ph_lo = 0; a.ph_hi = N_PH;
    hipLaunchKernelGGL(fwd, dim3(grid), dim3(NWAVES * 64), LDS_BYTES, stream, a);
#else
    for (int p = 0; p < N_PH; ++p) { if (!phase_valid(p)) continue; a.ph_lo = p; a.ph_hi = p + 1; hipLaunchKernelGGL(fwd, dim3(grid), dim3(NWAVES * 64), LDS_BYTES, stream, a); }
#endif
    const hipError_t le = hipPeekAtLastError();
    if (le != hipSuccess) fprintf(stderr, "kernel_launch: launch failed: %s\n", hipGetErrorName(le));
}
```

```cpp
#include <hip/hip_runtime.h>
#include <cstdio>
#include <cstdint>

#ifndef EN_PRO
#define EN_PRO 1
#endif
#ifndef EN_NORM
#define EN_NORM 1
#endif
#ifndef EN_G1
#define EN_G1 1
#endif
#ifndef EN_G3
#define EN_G3 1
#endif
#ifndef EN_M1
#define EN_M1 1
#endif
#ifndef EN_M2
#define EN_M2 1
#endif
#ifndef EN_G4
#define EN_G4 1
#endif
#ifndef EN_GR
#define EN_GR 1
#endif
#ifndef REP_SWA
#define REP_SWA 1
#endif
#ifndef REP_MA
#define REP_MA 1
#endif
#ifndef REP_S1
#define REP_S1 1
#endif
#ifndef REP_S2
#define REP_S2 1
#endif
#ifndef REP_M
#define REP_M 1
#endif
#ifndef REP_PRO
#define REP_PRO 1
#endif
#ifndef REP_NORM
#define REP_NORM 1
#endif
#ifndef REP_G1
#define REP_G1 1
#endif
#ifndef REP_G3
#define REP_G3 1
#endif
#ifndef REP_G4
#define REP_G4 1
#endif
#ifndef REP_GR
#define REP_GR 1
#endif
#ifndef DIAG
#define DIAG 0
#endif
#ifndef DIAG_SCALE0
#define DIAG_SCALE0 1.0f
#endif
#ifndef DIAG_SCALE1
#define DIAG_SCALE1 0.01f
#endif
#ifndef ONE_LAUNCH
#define ONE_LAUNCH 1
#endif

namespace pg8 {
#define PG8_LAS __attribute__((address_space(3)))
typedef unsigned short bf16_t;
typedef short bf16x8 __attribute__((ext_vector_type(8)));
typedef float f32x4 __attribute__((ext_vector_type(4)));
typedef unsigned u32x4 __attribute__((ext_vector_type(4)));
constexpr int BM = 256, BK = 64, HALF = 128, HTB = HALF * BK * 2  , STAGE_BYTES = 8 * HTB, NXCD = 8, WGM = 8;

__host__ __device__ __forceinline__ int lds_byte(int r, int c) { const int st = (r >> 4) * 2 + (c >> 5), rr = r & 15, cc = c & 31, ob = rr * 64 + cc * 2; return st * 1024 + (ob ^ (((ob >> 9) & 1) << 5)); }
__host__ __device__ __forceinline__ void stage_rc(int b, int& R, int& C) { const int st = b / 1024, sb = b % 1024, swz = sb ^ (((sb >> 9) & 1) << 5); R = (st >> 1) * 16 + swz / 64; C = (st & 1) * 32 + (swz % 64) / 2; }
__host__ __device__ __forceinline__ int perm32(int rho) { const int n = rho >> 4, i = rho & 15; return 8 * (i >> 2) + 4 * n + (i & 3); }


struct Unit { int pm, pn, kind; };

typedef float f32x2_cv __attribute__((ext_vector_type(2))); typedef __bf16 bf16x2_cv __attribute__((ext_vector_type(2)));
__device__ __forceinline__ unsigned cvt_pk_bf16(float lo, float hi) { const f32x2_cv v = {lo, hi}; const bf16x2_cv b = __builtin_convertvector(v, bf16x2_cv); return __builtin_bit_cast(unsigned, b); }
__device__ __forceinline__ float bf_lo(unsigned u) { return __uint_as_float(u << 16); }
__device__ __forceinline__ float bf_hi(unsigned u) { return __uint_as_float(u & 0xffff0000u); }
__device__ __forceinline__ float sigmoidf_fast(float x) { return __builtin_amdgcn_rcpf(1.0f + __builtin_amdgcn_exp2f(-1.4426950408889634f * x)); }

__device__ __forceinline__ void tile_of(int L, int nM, int nN, int& pm, int& pn) {
    const int nwg = nM * nN; int wgid = L; { const int q = nwg / NXCD, r = nwg % NXCD, xcd = wgid % NXCD, off = wgid / NXCD; wgid = (xcd < r ? xcd * (q + 1) : r * (q + 1) + (xcd - r) * q) + off; }
    const int nig = WGM * nN, gid = wgid / nig, fm = gid * WGM, gsz = (nM - fm) < WGM ? (nM - fm) : WGM;
    pm = fm + ((wgid % nig) % gsz); pn = (wgid % nig) / gsz;
}

struct SchedTiles {
    static constexpr bool HAS_HALF = false;
    const char* A; const char* Bt; size_t tstep; int nM, nN, G, c;
    __device__ __forceinline__ bool next(int i, Unit& u) const { const int L = i * G + c; if (L >= nM * nN) return false; tile_of(L, nM, nN, u.pm, u.pn); u.kind = 0; return true; }
    __device__ __forceinline__ void operands(const Unit& u, const char*& a, const char*& b) const { a = A + (size_t)u.pm * tstep; b = Bt + (size_t)u.pn * tstep; }
    __device__ __forceinline__ void a_ready(const Unit&) const {}
    __device__ __forceinline__ void done(const Unit&) const {}
};
struct SchedG1 {
    static constexpr bool HAS_HALF = true;
    const char* A; const char* Bt; size_t tstep; int nM, nN, G, c;
    __device__ __forceinline__ bool next(int i, Unit& u) const {
        if (i < 5) { tile_of(i * 256 + c, 32, 44, u.pm, u.pn); u.kind = 0; return true; }
        if (i > 5) return false; const int x = c & 7, j = c >> 3, r = j & 7, q = j >> 3; u.pm = 8 * (x >> 1) + r; u.pn = ((x & 1) ? 42 : 20) + (q >> 1); u.kind = 2 + (q & 1); return true; }
    __device__ __forceinline__ bool is_half(const Unit& u) const { return u.kind >= 2; }
    __device__ __forceinline__ void operands(const Unit& u, const char*& a, const char*& b) const { a = A + (size_t)u.pm * tstep + (u.kind == 3 ? (tstep >> 1) : 0); b = Bt + (size_t)u.pn * tstep; }
    __device__ __forceinline__ void a_ready(const Unit&) const {}
    __device__ __forceinline__ void done(const Unit&) const {}
};
struct SchedProj {
    static constexpr bool HAS_HALF = false;
    const char* A; const char* Bt; const char* A2; const char* Bt2; size_t tstep; int nM, nN, G, c;
    __device__ __forceinline__ bool next(int i, Unit& u) const { const int L = i * G + c, nwg = nM * nN; if (L < nwg) { tile_of(L, nM, nN, u.pm, u.pn); u.kind = 0; return true; }
        if (L < nwg + 16) { const int j = L - nwg; u.pm = j & 1; u.pn = j >> 1; u.kind = 1; return true; } return false; }
    __device__ __forceinline__ void operands(const Unit& u, const char*& a, const char*& b) const { a = (u.kind ? A2 : A) + (size_t)u.pm * tstep; b = (u.kind ? Bt2 : Bt) + (size_t)u.pn * tstep; }
    __device__ __forceinline__ void a_ready(const Unit&) const {}
    __device__ __forceinline__ void done(const Unit&) const {}
};
struct SchedMix {
    static constexpr bool HAS_HALF = false;
    const char* Aswa; const char* Amem; const char* Ays; const char* Bswa; const char* Bmem; const char* Bglu; size_t tstep; int nM, nN, G, c;
    __device__ __forceinline__ bool next(int i, Unit& u) const { const int L = (i >> 2) * G + c; if (L >= nM * nN) return false; tile_of(L, nM, nN, u.pm, u.pn); u.kind = i & 3; return true; }
    __device__ __forceinline__ void operands(const Unit& u, const char*& a, const char*& b) const {
        if (u.kind == 0) { a = Aswa + (size_t)u.pm * tstep; b = Bswa + (size_t)u.pn * tstep; }
        else if (u.kind == 1) { a = Amem + (size_t)u.pm * tstep; b = Bmem + (size_t)u.pn * tstep; }
        else { a = Ays + (size_t)u.pm * tstep; b = Bglu + (size_t)(2 * u.pn + (u.kind - 2)) * tstep; } }
    __device__ __forceinline__ void a_ready(const Unit&) const {}
    __device__ __forceinline__ void done(const Unit&) const {}
};

__device__ __forceinline__ float row_rstd(const float* SSQ, size_t row, int fq) {
    const f32x4* q = (const f32x4*)(SSQ + row * 32 + 8 * fq); const f32x4 a = q[0], b = q[1];
    float s = ((a[0] + a[1]) + (a[2] + a[3])) + ((b[0] + b[1]) + (b[2] + b[3])); s += __shfl_xor(s, 16); s += __shfl_xor(s, 32);
    return 1.0f / sqrtf(s * (1.0f / 2048.0f) + 1e-5f);
}
struct RstdTab { const PG8_LAS float* tab; int pm0; const float* SSQ;
    __device__ __forceinline__ float get(const Unit& u, int rowin, int fq) const { const float r = tab[rowin]; return (u.pm == pm0) ? r : __builtin_nanf(""); } };
struct EpiSwiGLU {
    static constexpr bool PERM = true, AFTER_DRAIN = false;
    bf16_t* O; int ldo; RstdTab R;
    __device__ __forceinline__ void operator()(const f32x4 (&acc)[2][2][4][2], const Unit& u, int wr, int wc, int fr, int fq) const {
        const int hoff = (u.kind == 3) ? HALF : 0, row0 = u.pm * BM + hoff + wr * 64 + fr, col0 = u.pn * HALF + wc * 32 + 8 * fq;
#pragma unroll
        for (int ai = 0; ai < 2; ++ai) { if (ai == 1 && u.kind >= 2) break;
#pragma unroll
            for (int m = 0; m < 4; ++m) { bf16_t* rowp = O + (size_t)(row0 + ai * HALF + m * 16) * ldo + col0; float o[8]; const float rs = R.get(u, hoff + wr * 64 + fr + ai * HALF + m * 16, fq);
#pragma unroll
                for (int n = 0; n < 2; ++n)
#pragma unroll
                    for (int e = 0; e < 4; ++e) { const float g = acc[ai][0][m][n][e] * rs, uu = acc[ai][1][m][n][e] * rs; o[4 * n + e] = g * sigmoidf_fast(g) * uu; }
                u32x4 w; w.x = cvt_pk_bf16(o[0], o[1]); w.y = cvt_pk_bf16(o[2], o[3]); w.z = cvt_pk_bf16(o[4], o[5]); w.w = cvt_pk_bf16(o[6], o[7]);
                *(u32x4*)rowp = w; } }
    }
};
struct EpiResid {
    static constexpr bool PERM = false, AFTER_DRAIN = false;
    const float* X0; float alpha; int ldc; bf16_t* HB; float* SSQ; bf16_t* HBout;
    typedef unsigned u32x2 __attribute__((ext_vector_type(2)));
    static __device__ __forceinline__ void finish(const f32x4 (&v)[2][2], int ai, int m, int pn, int row0, int col0, int wc, int fq, int ldc, bf16_t* HBout, float* SSQ) {
        const size_t off = (size_t)(row0 + ai * HALF + m * 16) * ldc + col0; float ss = 0.f;
#pragma unroll
        for (int bj = 0; bj < 2; ++bj)
#pragma unroll
            for (int n = 0; n < 2; ++n) { const f32x4 x = v[bj][n]; ss += (x[0] * x[0] + x[1] * x[1]) + (x[2] * x[2] + x[3] * x[3]);
                u32x2 w; w.x = cvt_pk_bf16(x[0], x[1]); w.y = cvt_pk_bf16(x[2], x[3]); *(u32x2*)(HBout + off + bj * HALF + n * 16) = w; }
        ss += __shfl_xor(ss, 16); ss += __shfl_xor(ss, 32);
        if (fq == 0) SSQ[(size_t)(row0 + ai * HALF + m * 16) * 32 + pn * 4 + wc] = ss;
    }
    __device__ __forceinline__ void operator()(const f32x4 (&acc)[2][2][4][2], const Unit& u, int wr, int wc, int fr, int fq) const {
        int row0 = u.pm * BM + wr * 64 + fr, col0 = u.pn * BM + wc * 32 + 4 * fq;
        asm volatile("" : "+v"(row0), "+v"(col0));
        const int pn_ = u.pn, ldc_ = ldc; bf16_t* const hbo_ = HBout; float* const ssq_ = SSQ; const float alpha_ = alpha; const float* const x0_ = X0; const bf16_t* const hb_ = HB;
        if (x0_) {
#pragma unroll
            for (int ai = 0; ai < 2; ++ai)
#pragma unroll
                for (int mp = 0; mp < 2; ++mp) { f32x4 b[2][2][2];
#pragma unroll
                    for (int mm = 0; mm < 2; ++mm)
#pragma unroll
                        for (int bj = 0; bj < 2; ++bj)
#pragma unroll
                            for (int n = 0; n < 2; ++n) b[mm][bj][n] = *(const f32x4*)(x0_ + (size_t)(row0 + ai * HALF + (2 * mp + mm) * 16) * ldc_ + col0 + bj * HALF + n * 16);
#pragma unroll
                    for (int mm = 0; mm < 2; ++mm) { f32x4 v[2][2];
#pragma unroll
                        for (int bj = 0; bj < 2; ++bj)
#pragma unroll
                            for (int n = 0; n < 2; ++n) v[bj][n] = b[mm][bj][n] + acc[ai][bj][2 * mp + mm][n] * alpha_;
                        finish(v, ai, 2 * mp + mm, pn_, row0, col0, wc, fq, ldc_, hbo_, ssq_); }
                    }
        } else {
#pragma unroll
            for (int ai = 0; ai < 2; ++ai) { u32x2 hw[4][2][2];
#pragma unroll
                for (int m = 0; m < 4; ++m)
#pragma unroll
                    for (int bj = 0; bj < 2; ++bj)
#pragma unroll
                        for (int n = 0; n < 2; ++n) hw[m][bj][n] = *(const u32x2*)(hb_ + (size_t)(row0 + ai * HALF + m * 16) * ldc_ + col0 + bj * HALF + n * 16);
#pragma unroll
                for (int m = 0; m < 4; ++m) { f32x4 v[2][2];
#pragma unroll
                    for (int bj = 0; bj < 2; ++bj)
#pragma unroll
                        for (int n = 0; n < 2; ++n) { const u32x2 h2 = hw[m][bj][n]; v[bj][n] = (f32x4){bf_lo(h2.x), bf_hi(h2.x), bf_lo(h2.y), bf_hi(h2.y)} + acc[ai][bj][m][n] * alpha_; }
                    finish(v, ai, m, pn_, row0, col0, wc, fq, ldc_, hbo_, ssq_); }
                }
        }
    }
};
struct EpiProj {
    static constexpr bool PERM = true, AFTER_DRAIN = false;
    bf16_t* P; int ldp; int sig_from; bf16_t* KV; int ldk; RstdTab R; bf16_t* SIN;
    __device__ __forceinline__ void operator()(const f32x4 (&acc)[2][2][4][2], const Unit& u, int wr, int wc, int fr, int fq) const {
        const int row0 = u.pm * BM + wr * 64 + fr, col0 = u.pn * BM + wc * 32 + 8 * fq;
        bf16_t* base = u.kind ? KV : P; const int ld = u.kind ? ldk : ldp; const bool sig = (u.kind == 0) && (u.pn >= sig_from);
#pragma unroll
        for (int ai = 0; ai < 2; ++ai)
#pragma unroll
            for (int m = 0; m < 4; ++m) { bf16_t* rowp = base + (size_t)(row0 + ai * HALF + m * 16) * ld + col0; const float rs = u.kind ? 1.0f : R.get(u, wr * 64 + fr + ai * HALF + m * 16, fq);
#pragma unroll
                for (int bj = 0; bj < 2; ++bj) { f32x4 v0 = acc[ai][bj][m][0] * rs, v1 = acc[ai][bj][m][1] * rs;
                    if (sig) {
#pragma unroll
                        for (int e = 0; e < 4; ++e) { v0[e] = sigmoidf_fast(v0[e]); v1[e] = sigmoidf_fast(v1[e]); } }
                    u32x4 w; w.x = cvt_pk_bf16(v0[0], v0[1]); w.y = cvt_pk_bf16(v0[2], v0[3]); w.z = cvt_pk_bf16(v1[0], v1[1]); w.w = cvt_pk_bf16(v1[2], v1[3]);
                    if (u.kind == 0 && u.pn >= 6 && u.pn < 10) { const int cs = (u.pn - 6) * BM + bj * HALF + wc * 32 + 8 * fq; *(u32x4*)(SIN + ((size_t)(cs >> 4) * 8192 + (size_t)(row0 + ai * HALF + m * 16)) * 16 + (cs & 15)) = w; }
                    else *(u32x4*)(rowp + bj * HALF) = w; } }
    }
};
struct EpiMix {
    static constexpr bool PERM = true, AFTER_DRAIN = false;
    bf16_t* MG; const bf16_t* Gt; int ldg;
    __device__ __forceinline__ void operator()(const f32x4 (&acc)[2][2][4][2], const Unit& u, int wr, int wc, int fr, int fq) const {
        int row0 = u.pm * BM + wr * 64 + fr, cw = wc * 32 + 8 * fq;
        asm volatile("" : "+v"(row0), "+v"(cw));
        if (u.kind < 2) {
            const int gsel = u.kind == 0 ? 0 : 4096;
#pragma unroll
            for (int ai = 0; ai < 2; ++ai)
#pragma unroll
                for (int mp = 0; mp < 2; ++mp) { u32x4 gw[2][2], tw[2][2];
#pragma unroll
                    for (int mm = 0; mm < 2; ++mm)
#pragma unroll
                        for (int bj = 0; bj < 2; ++bj) { const size_t row = (size_t)(row0 + ai * HALF + (2 * mp + mm) * 16); const int col = u.pn * BM + bj * HALF + cw;
                            gw[mm][bj] = *(const u32x4*)(Gt + row * ldg + gsel + col); if (u.kind == 1) tw[mm][bj] = *(const u32x4*)(MG + row * 2048 + col); else tw[mm][bj] = (u32x4){0u, 0u, 0u, 0u}; }
#pragma unroll
                    for (int mm = 0; mm < 2; ++mm)
#pragma unroll
                        for (int bj = 0; bj < 2; ++bj) { const int m = 2 * mp + mm; const size_t row = (size_t)(row0 + ai * HALF + m * 16); const int col = u.pn * BM + bj * HALF + cw; const u32x4 g = gw[mm][bj], t = tw[mm][bj];
                            const f32x4 g0 = {bf_lo(g.x), bf_hi(g.x), bf_lo(g.y), bf_hi(g.y)}, g1 = {bf_lo(g.z), bf_hi(g.z), bf_lo(g.w), bf_hi(g.w)};
                            const f32x4 t0 = acc[ai][bj][m][0] * g0 + (f32x4){bf_lo(t.x), bf_hi(t.x), bf_lo(t.y), bf_hi(t.y)}, t1 = acc[ai][bj][m][1] * g1 + (f32x4){bf_lo(t.z), bf_hi(t.z), bf_lo(t.w), bf_hi(t.w)};
                            u32x4 w; w.x = cvt_pk_bf16(t0[0], t0[1]); w.y = cvt_pk_bf16(t0[2], t0[3]); w.z = cvt_pk_bf16(t1[0], t1[1]); w.w = cvt_pk_bf16(t1[2], t1[3]); *(u32x4*)(MG + row * 2048 + col) = w; }
                    }
        } else {
            const int col = u.pn * BM + (u.kind - 2) * HALF + cw;
#pragma unroll
            for (int ai = 0; ai < 2; ++ai) { u32x4 gw[4], tw[4];
#pragma unroll
                for (int m = 0; m < 4; ++m) { const size_t row = (size_t)(row0 + ai * HALF + m * 16); gw[m] = *(const u32x4*)(Gt + row * ldg + 2048 + col); tw[m] = *(const u32x4*)(MG + row * 2048 + col); }
#pragma unroll
                for (int m = 0; m < 4; ++m) { const size_t row = (size_t)(row0 + ai * HALF + m * 16); const u32x4 g = gw[m], t = tw[m];
                    const float gg[8] = {bf_lo(g.x), bf_hi(g.x), bf_lo(g.y), bf_hi(g.y), bf_lo(g.z), bf_hi(g.z), bf_lo(g.w), bf_hi(g.w)};
                    const float tt[8] = {bf_lo(t.x), bf_hi(t.x), bf_lo(t.y), bf_hi(t.y), bf_lo(t.z), bf_hi(t.z), bf_lo(t.w), bf_hi(t.w)}; float o[8];
#pragma unroll
                    for (int n = 0; n < 2; ++n)
#pragma unroll
                        for (int e = 0; e < 4; ++e) { const float ga = acc[ai][0][m][n][e], gb = acc[ai][1][m][n][e]; o[4 * n + e] = tt[4 * n + e] + gg[4 * n + e] * ga * sigmoidf_fast(gb); }
                    u32x4 w; w.x = cvt_pk_bf16(o[0], o[1]); w.y = cvt_pk_bf16(o[2], o[3]); w.z = cvt_pk_bf16(o[4], o[5]); w.w = cvt_pk_bf16(o[6], o[7]);
                    *(u32x4*)(MG + row * 2048 + col) = w; }
                }
        }
    }
};

template <class Epi, class Sched, bool ALIGN_EPI = false, bool SP2 = false>
__device__ __forceinline__ void gemm_phase(PG8_LAS unsigned char* lds, const int K, const Sched& S, const Epi& E) {
    int tid_ = threadIdx.x; asm volatile("" : "+v"(tid_));
    const int tid = tid_, wid = __builtin_amdgcn_readfirstlane(tid >> 6), lane = tid & 63, wr = wid >> 2, wc = wid & 3, fr = lane & 15, fq = lane >> 4;
    static_assert(SP2, "this copy of the body keeps only the two-super-phase K-loop");
    const int nt = K / BK;
    unsigned voffA[2], voffB[2];
#pragma unroll
    for (int i = 0; i < 2; ++i) { int R, C; stage_rc(tid * 16 + i * 8192, R, C); const int Rb = Epi::PERM ? ((R & ~31) + perm32(R & 31)) : R;
        voffA[i] = (unsigned)(R * K + C) * 2u; voffB[i] = (unsigned)(Rb * K + C) * 2u; }
    const size_t kstep = (size_t)(BK * 2);
    const size_t hstep = (size_t)HALF * K * 2;
    const unsigned ldsw = (unsigned)wid * 1024u;
    const int aoff = lds_byte(wr * 64 + fr, fq * 8), boff = lds_byte(wc * 32 + fr, fq * 8);
#define PG8_SA(b, h) (((b) * 2 + (h)) * HTB)
#define PG8_SB(b, h) ((4 + (b) * 2 + (h)) * HTB)
#define PG8_STAGE(bufoff, gbase, voff) do { _Pragma("unroll") for (int _i = 0; _i < 2; ++_i) \
        __builtin_amdgcn_global_load_lds((const unsigned*)((const char*)(gbase) + (voff)[_i]), (PG8_LAS unsigned*)(lds + (bufoff) + ldsw + _i * 8192), 16, 0, 0); } while (0)
#define PG8_LDA(dst, b, h) do { _Pragma("unroll") for (int m = 0; m < 4; ++m) _Pragma("unroll") for (int k = 0; k < 2; ++k) dst[m][k] = *(const PG8_LAS bf16x8*)(lds + PG8_SA(b, h) + aoff + m * 2048 + k * 1024); } while (0)
#define PG8_LDB(dst, b, h) do { _Pragma("unroll") for (int n = 0; n < 2; ++n) _Pragma("unroll") for (int k = 0; k < 2; ++k) dst[n][k] = *(const PG8_LAS bf16x8*)(lds + PG8_SB(b, h) + boff + n * 2048 + k * 1024); } while (0)
#define PG8_MMA(ai, bj, At, Bt) do { __builtin_amdgcn_s_setprio(1); _Pragma("unroll") for (int m = 0; m < 4; ++m) _Pragma("unroll") for (int n = 0; n < 2; ++n) _Pragma("unroll") for (int k = 0; k < 2; ++k) \
        acc[ai][bj][m][n] = __builtin_amdgcn_mfma_f32_16x16x32_bf16(Bt[n][k], At[m][k], acc[ai][bj][m][n], 0, 0, 0); __builtin_amdgcn_s_setprio(0); } while (0)
#define PG8_WAIT_V(n) asm volatile("s_waitcnt vmcnt(" #n ")" ::: "memory")
#define PG8_WAIT_L(n) asm volatile("s_waitcnt lgkmcnt(" #n ")" ::: "memory")
#define PG8_BAR __builtin_amdgcn_s_barrier()
#define PG8_SCHED __builtin_amdgcn_sched_barrier(0)
    Unit cur, nxt; int ui = 0;
    if (!S.next(0, cur)) return;
    f32x4 acc[2][2][4][2];
#pragma unroll
    for (int a = 0; a < 2; ++a)
#pragma unroll
        for (int b = 0; b < 2; ++b)
#pragma unroll
            for (int m = 0; m < 4; ++m)
#pragma unroll
                for (int n = 0; n < 2; ++n) acc[a][b][m][n] = (f32x4){0.f, 0.f, 0.f, 0.f};
    bf16x8 At[4][2], B0[2][2], B1[2][2];
    const char* cA; const char* cB; S.operands(cur, cA, cB);
    S.a_ready(cur);
    if constexpr (SP2) {
        PG8_STAGE(PG8_SB(0, 0), cB, voffB); PG8_STAGE(PG8_SB(0, 1), cB + hstep, voffB); PG8_STAGE(PG8_SA(0, 0), cA, voffA); PG8_STAGE(PG8_SA(0, 1), cA + hstep, voffA);
        if (wr == 1) PG8_BAR;
        PG8_WAIT_V(2); PG8_BAR;
        PG8_STAGE(PG8_SB(1, 0), cB + kstep, voffB); PG8_STAGE(PG8_SA(1, 0), cA + kstep, voffA); PG8_STAGE(PG8_SB(1, 1), cB + hstep + kstep, voffB);
        PG8_WAIT_V(6); PG8_BAR;
    } else {
        PG8_STAGE(PG8_SB(0, 0), cB, voffB); PG8_STAGE(PG8_SA(0, 0), cA, voffA); PG8_STAGE(PG8_SB(0, 1), cB + hstep, voffB); PG8_STAGE(PG8_SA(0, 1), cA + hstep, voffA);
        if (wr == 1) PG8_BAR;
        PG8_WAIT_V(4); PG8_BAR;
        PG8_STAGE(PG8_SB(1, 0), cB + kstep, voffB); PG8_STAGE(PG8_SA(1, 0), cA + kstep, voffA); PG8_STAGE(PG8_SB(1, 1), cB + hstep + kstep, voffB);
        PG8_WAIT_V(6); PG8_BAR;
    }
    for (;;) {
        const bool has_next = S.next(ui + 1, nxt);
        const char* nA = cA; const char* nB = cB; if (has_next) S.operands(nxt, nA, nB);
#define PG8_KLOOP(HF)         for (int t = 0; t < nt; t += 2) { \
            const bool last = (t == nt - 2); \
            const char* a1 = cA + (size_t)(t + 1) * kstep; \
            const char* a2 = last ? nA : cA + (size_t)(t + 2) * kstep; const char* b2 = last ? nB : cB + (size_t)(t + 2) * kstep; \
            const char* a3 = a2 + kstep; const char* b3 = b2 + kstep; \
            if (last && has_next) S.a_ready(nxt); \
            PG8_LDB(B0, 0, 0); PG8_LDB(B1, 0, 1); PG8_SCHED; PG8_LDA(At, 0, 0); PG8_STAGE(PG8_SA(1, 1), a1 + hstep, voffA); \
            PG8_WAIT_V(8); PG8_WAIT_L(0); PG8_BAR; PG8_MMA(0, 0, At, B0); PG8_MMA(0, 1, At, B1); PG8_BAR; PG8_SCHED; \
            if (!(HF)) PG8_LDA(At, 0, 1); PG8_STAGE(PG8_SB(0, 0), b2, voffB); PG8_STAGE(PG8_SB(0, 1), b2 + hstep, voffB); PG8_STAGE(PG8_SA(0, 0), a2, voffA); \
            PG8_WAIT_V(8); PG8_WAIT_L(0); PG8_BAR; if (!(HF)) { PG8_MMA(1, 0, At, B0); PG8_MMA(1, 1, At, B1); } PG8_BAR; PG8_SCHED; \
            PG8_LDB(B0, 1, 0); PG8_LDB(B1, 1, 1); PG8_SCHED; PG8_LDA(At, 1, 0); PG8_STAGE(PG8_SA(0, 1), a2 + hstep, voffA); \
            PG8_WAIT_V(8); PG8_WAIT_L(0); PG8_BAR; PG8_MMA(0, 0, At, B0); PG8_MMA(0, 1, At, B1); PG8_BAR; PG8_SCHED; \
            if (!(HF)) PG8_LDA(At, 1, 1); PG8_STAGE(PG8_SB(1, 0), b3, voffB); PG8_STAGE(PG8_SB(1, 1), b3 + hstep, voffB); PG8_STAGE(PG8_SA(1, 0), a3, voffA); \
            PG8_WAIT_V(8); PG8_WAIT_L(0); PG8_BAR; if (!(HF)) { PG8_MMA(1, 0, At, B0); PG8_MMA(1, 1, At, B1); } PG8_BAR; PG8_SCHED; \
        }
        if constexpr (Sched::HAS_HALF) { if (S.is_half(cur)) { PG8_KLOOP(true) } else { PG8_KLOOP(false) } } else { PG8_KLOOP(false) }
#undef PG8_KLOOP
        if constexpr (ALIGN_EPI) { if (wr == 0) PG8_BAR; }
        if constexpr (!Epi::AFTER_DRAIN) { E(acc, cur, wr, wc, fr, fq); S.done(cur); }
        if (!has_next) break;
#pragma unroll
        for (int a = 0; a < 2; ++a)
#pragma unroll
            for (int b = 0; b < 2; ++b)
#pragma unroll
                for (int m = 0; m < 4; ++m)
#pragma unroll
                    for (int n = 0; n < 2; ++n) acc[a][b][m][n] = (f32x4){0.f, 0.f, 0.f, 0.f};
        cur = nxt; cA = nA; cB = nB; ++ui;
        if constexpr (ALIGN_EPI) { if (wr == 1) PG8_BAR; }
    }
    PG8_WAIT_V(0);
    if constexpr (!ALIGN_EPI) { if (wr == 0) PG8_BAR; }
    PG8_BAR;
    if constexpr (Epi::AFTER_DRAIN) { E.fused(acc, cur, wr, wc, fr, fq, lds, wid, lane); S.done(cur); }
#undef PG8_SA
#undef PG8_SB
#undef PG8_STAGE
#undef PG8_LDA
#undef PG8_LDB
#undef PG8_MMA
#undef PG8_WAIT_V
#undef PG8_WAIT_L
#undef PG8_BAR
#undef PG8_SCHED
}
}

constexpr int BATCH = 2, SEQ = 4096, DM = 2048, DEPTH = 4, NMEM = 256, DFF = 5632;
constexpr int T = BATCH * SEQ;
constexpr int INW = 9728, COL_Q = 0, COL_K = 1024, COL_V = 1280, COL_S = 1536, COL_MQ = 2560, COL_G = 3584;
constexpr float RMS_EPS = 1e-5f, LOG2E = 1.4426950408889634f;
constexpr int NWAVES = 8;
enum { I_X = 0, I_MEM, I_F1N, I_F1WI, I_F1WO, I_MIXN, I_MEMN, I_WIN, I_SINK, I_WMKV, I_LRE, I_LIM, I_LDT, I_BRE, I_BIM, I_CRE, I_CIM, I_DSK, I_WGLU, I_WSWA, I_WMEMUP, I_WOUT, I_F2N, I_F2WI, I_F2WO, I_FINN, N_IN };

constexpr size_t MiB = 1u << 20;
constexpr size_t WS_CTL = 0, CTL_ZERO_BYTES = 1 * MiB;
constexpr size_t WS_W = 2 * MiB, W_LAYER = 202 * MiB;
constexpr size_t WO_1IN = 0, WO_1OUT = 44 * MiB, WO_IN = 66 * MiB, WO_MKV = 104 * MiB, WO_SWA = 112 * MiB, WO_MEM = 116 * MiB, WO_GLU = 120 * MiB, WO_OUT = 128 * MiB, WO_2IN = 136 * MiB, WO_2OUT = 180 * MiB;
constexpr size_t WS_MEMN = WS_W + DEPTH * W_LAYER;
constexpr size_t WS_H = WS_MEMN + 8 * MiB;
constexpr size_t WS_XN = WS_H + 64 * MiB;
constexpr size_t WS_HID = WS_XN + 32 * MiB;
constexpr size_t WS_PROJ = WS_HID + 88 * MiB;
constexpr size_t WS_MKV = WS_PROJ + 152 * MiB;
constexpr size_t WS_OSWA = WS_MKV + 2 * MiB, WS_YS = WS_OSWA + 16 * MiB, WS_OMEM = WS_YS + 16 * MiB;
constexpr size_t WS_T32 = WS_OMEM + 16 * MiB;
constexpr size_t WS_MG = WS_T32 + 64 * MiB;
constexpr size_t WS_SEND = WS_MG + 32 * MiB;
constexpr size_t LB_BYTES = 65 * 512;
constexpr size_t WS_LB = WS_SEND + 4 * MiB;
constexpr size_t WS_WINT = WS_LB + 9 * MiB;
constexpr size_t WS_WOUTT = WS_WINT + 64 * MiB;
constexpr size_t WS_SST = WS_WOUTT + 64 * MiB;
constexpr size_t WS_A64 = WS_SST + 2 * MiB;
constexpr size_t WS_SSQ = WS_A64 + 1 * MiB;
constexpr size_t WS_SIN = WS_SSQ + 1 * MiB;
constexpr size_t WS_END = WS_SIN + 16 * MiB;
static_assert(DEPTH * 64 * LB_BYTES <= 9 * MiB, "lag tables fit");
constexpr int CW_BAR = 4096;

constexpr int RING_OFF = 0, RING_BYTES = 131072;
constexpr int LDSCTL_OFF = RING_BYTES, MISC_OFF = LDSCTL_OFF + 320;
constexpr int LDS_BYTES = 147456;

#define GAS __attribute__((address_space(1)))
#define LAS __attribute__((address_space(3)))
typedef unsigned short bf16;
typedef unsigned v4u __attribute__((ext_vector_type(4)));
typedef unsigned v2u __attribute__((ext_vector_type(2)));
typedef float f32x4 __attribute__((ext_vector_type(4)));
typedef float f32x2 __attribute__((ext_vector_type(2)));
typedef GAS unsigned gu32;
using pg8::cvt_pk_bf16; using pg8::bf_lo; using pg8::bf_hi;

#define XB_TMO      128
#define XB_XCNT(j)  (256  + 64 * (j))
#define XB_XSUB(j)  (1280 + 64 * (j))
#define XB_XGEN(j)  (2304 + 64 * (j))
#define XB_TOP      3328
#define XB_TOPGEN   3392
#define XCD_BAR_WORDS 3456
#define XB_SPIN_CAP (1u << 18)

__device__ __forceinline__ unsigned xb_ld(unsigned* p)              { return __hip_atomic_load(p, __ATOMIC_RELAXED, __HIP_MEMORY_SCOPE_AGENT); }
__device__ __forceinline__ unsigned xb_add(unsigned* p, unsigned v) { return __hip_atomic_fetch_add(p, v, __ATOMIC_RELAXED, __HIP_MEMORY_SCOPE_AGENT); }
__device__ __forceinline__ unsigned xb_xcc_id() { return (unsigned)__builtin_amdgcn_s_getreg((3 << 11) | 20) & 0xFu; }
#define XB_SPIN(cond, bar) do { unsigned _sp = 0; while (cond) { __builtin_amdgcn_s_sleep(1); \
    if ((++_sp & 255u) == 0u) { if (xb_ld(&(bar)[XB_TMO])) break; if (_sp > XB_SPIN_CAP) { atomicAdd(&(bar)[XB_TMO], 1u); break; } } } } while (0)

struct XcdBarrier {
    unsigned* bar; unsigned x;
    volatile LAS unsigned* st;
};

__device__ __forceinline__ XcdBarrier xcd_barrier_post(unsigned* bar, volatile LAS unsigned* st) {
    XcdBarrier b; b.bar = bar; b.x = xb_xcc_id(); b.st = st;
    if (threadIdx.x == 0) (void)xb_add(&bar[XB_XCNT(b.x)], 1u);
    return b;
}
__device__ __forceinline__ void xcd_barrier_complete(unsigned* bar, unsigned x, unsigned& nloc, unsigned& nx) {
    const unsigned G = gridDim.x * gridDim.y * gridDim.z;
    unsigned sum, cnt, mine, sp = 0u;
    for (;;) {
        sum = 0u; cnt = 0u; mine = 0u;
#pragma unroll
        for (unsigned j = 0; j < 16; ++j) { const unsigned c = xb_ld(&bar[XB_XCNT(j)]); sum += c; cnt += (c > 0u) ? 1u : 0u; mine = (j == x) ? c : mine; }
        if (sum == G) break;
        __builtin_amdgcn_s_sleep(1);
        if ((++sp & 255u) == 0u) { if (xb_ld(&bar[XB_TMO])) break; if (sp > XB_SPIN_CAP) { atomicAdd(&bar[XB_TMO], 1u); break; } }
    }
    nloc = mine > 0u ? mine : 1u; nx = cnt > 0u ? cnt : 1u;
}

__device__ __forceinline__ void xcd_barrier(const XcdBarrier& b) {
    asm volatile("s_waitcnt vmcnt(0)" ::: "memory");
    __syncthreads();
    if (threadIdx.x == 0) {
#if DIAG
        const unsigned long long dt0_ = __builtin_amdgcn_s_memrealtime();
#endif
        unsigned* bar = b.bar;
        __builtin_amdgcn_s_waitcnt(0);
        unsigned nloc = b.st[0], nx = b.st[1];
        if (nloc == 0u) { xcd_barrier_complete(bar, b.x, nloc, nx); b.st[0] = nloc; b.st[1] = nx; }
        const unsigned old = xb_add(&bar[XB_XSUB(b.x)], 1u);
        const unsigned gen = old / nloc;
        if (old + 1u == (gen + 1u) * nloc) {
            __builtin_amdgcn_fence(__ATOMIC_RELEASE, "agent");
            asm volatile("s_waitcnt vmcnt(0)" ::: "memory");
            const unsigned og = xb_add(&bar[XB_TOP], 1u);
            const unsigned tg = og / nx;
            if (og + 1u == (tg + 1u) * nx) xb_add(&bar[XB_TOPGEN], 1u);
            else XB_SPIN(xb_ld(&bar[XB_TOPGEN]) == tg, bar);
            __builtin_amdgcn_fence(__ATOMIC_ACQUIRE, "agent");
            xb_add(&bar[XB_XGEN(b.x)], 1u);
            asm volatile("s_waitcnt vmcnt(0)" ::: "memory");
        } else {
            XB_SPIN(xb_ld(&bar[XB_XGEN(b.x)]) == gen, bar);
            __builtin_amdgcn_fence(__ATOMIC_ACQUIRE, "agent");
            asm volatile("s_waitcnt vmcnt(0)" ::: "memory");
        }
#if DIAG
        b.st[8] += (unsigned)(__builtin_amdgcn_s_memrealtime() - dt0_);
#endif
    }
    __syncthreads();
}

struct Frame {
    LAS unsigned char* lds;
    int tid, lane, wave, G;
    unsigned char* ws;
};
__device__ __forceinline__ float wave_sum(float v) {
#pragma unroll
    for (int o = 1; o < 64; o <<= 1) v += __shfl_xor(v, o);
    return v;
}
__device__ __forceinline__ bf16* wsb(const Frame& F, size_t off) { return (bf16*)(F.ws + off); }

struct ConvItem { const float* src; const float* gk; bf16* dst; int K, N; float scale; };
__device__ __forceinline__ void conv_load(const ConvItem& c, float (&v)[64]) {
#pragma unroll
    for (int i = 0; i < 64; ++i) v[i] = c.src[(size_t)i * c.N];
}
__device__ __forceinline__ void conv_store(const ConvItem& c, float (&v)[64], int lane, LAS unsigned char* scr) {
    if (c.gk) {
#pragma unroll
        for (int i = 0; i < 64; ++i) v[i] *= c.gk[i]; }
    const float scale = c.scale;
#pragma unroll
    for (int q = 0; q < 8; ++q) { v4u o; o.x = cvt_pk_bf16(v[8 * q] * scale, v[8 * q + 1] * scale); o.y = cvt_pk_bf16(v[8 * q + 2] * scale, v[8 * q + 3] * scale);
        o.z = cvt_pk_bf16(v[8 * q + 4] * scale, v[8 * q + 5] * scale); o.w = cvt_pk_bf16(v[8 * q + 6] * scale, v[8 * q + 7] * scale); *(LAS v4u*)(scr + lane * 144 + q * 16) = o; }
    asm volatile("s_waitcnt lgkmcnt(0)" ::: "memory");
#pragma unroll
    for (int i = 0; i < 8; ++i) { const v4u o = *(const LAS v4u*)(scr + (8 * i + (lane >> 3)) * 144 + (lane & 7) * 16); *(v4u*)(c.dst + (size_t)(8 * i) * c.K) = o; }
    asm volatile("s_waitcnt lgkmcnt(0)" ::: "memory");
}
constexpr int CI_1IN = (DM / 64) * (2 * DFF / 64), CI_1OUT = (DFF / 64) * (DM / 64), CI_IN = (DM / 64) * (INW / 64), CI_MKV = (DM / 64) * (2048 / 64), CI_GLU = (1024 / 64) * (4096 / 64),
              CI_SWA = (1024 / 64) * (DM / 64), CI_MEM = CI_SWA, CI_OUT = (DM / 64) * (DM / 64), CI_LAYER = 2 * CI_1IN + 2 * CI_1OUT + CI_IN + CI_MKV + CI_GLU + CI_SWA + CI_MEM + CI_OUT;
struct ProIn { const float *f1wi, *f2wi, *f1wo, *f2wo, *win, *wmkv, *wglu, *wswa, *wmem, *wout, *mem, *memn, *f1n, *f2n, *mixn, *x; };
__device__ __forceinline__ void prologue(Frame& F, const ProIn& I) {
    const int gw = blockIdx.x * NWAVES + F.wave, NGW = F.G * NWAVES, lane = F.lane;
    auto item = [&](int it, ConvItem& c) {
        const int l = it / CI_LAYER; int r = it % CI_LAYER; unsigned char* wl = F.ws + WS_W + (size_t)l * W_LAYER;
        const float* src; bf16* dst; int K, N, pairNh = 0; const float* gk = nullptr;
        if (r < CI_1IN) { src = I.f1wi + (size_t)l * DM * 2 * DFF; dst = (bf16*)(wl + WO_1IN); K = DM; N = 2 * DFF; pairNh = DFF; gk = I.f1n + (size_t)l * DM; }
        else if ((r -= CI_1IN) < CI_1IN) { src = I.f2wi + (size_t)l * DM * 2 * DFF; dst = (bf16*)(wl + WO_2IN); K = DM; N = 2 * DFF; pairNh = DFF; gk = I.f2n + (size_t)l * DM; }
        else if ((r -= CI_1IN) < CI_1OUT) { src = I.f1wo + (size_t)l * DFF * DM; dst = (bf16*)(wl + WO_1OUT); K = DFF; N = DM; }
        else if ((r -= CI_1OUT) < CI_1OUT) { src = I.f2wo + (size_t)l * DFF * DM; dst = (bf16*)(wl + WO_2OUT); K = DFF; N = DM; }
        else if ((r -= CI_1OUT) < CI_IN) { src = I.win + (size_t)l * DM * INW; dst = (bf16*)(wl + WO_IN); K = DM; N = INW; gk = I.mixn + (size_t)l * DM; }
        else if ((r -= CI_IN) < CI_MKV) { src = I.wmkv + (size_t)l * DM * 2048; dst = (bf16*)(wl + WO_MKV); K = DM; N = 2048; }
        else if ((r -= CI_MKV) < CI_GLU) { src = I.wglu + (size_t)l * 1024 * 4096; dst = (bf16*)(wl + WO_GLU); K = 1024; N = 4096; pairNh = 2048; }
        else if ((r -= CI_GLU) < CI_SWA) { src = I.wswa + (size_t)l * 1024 * DM; dst = (bf16*)(wl + WO_SWA); K = 1024; N = DM; }
        else if ((r -= CI_SWA) < CI_MEM) { src = I.wmem + (size_t)l * 1024 * DM; dst = (bf16*)(wl + WO_MEM); K = 1024; N = DM; }
        else { r -= CI_MEM; src = I.wout + (size_t)l * DM * DM; dst = (bf16*)(wl + WO_OUT); K = DM; N = DM; }
        const int nblk = N / 64, r8 = r >> 3, wv = r & 7, kb = 8 * (r8 / nblk) + wv, nb = r8 % nblk, n0 = nb * 64, k0 = kb * 64;
        float sc = 1.f; if (N == INW) sc = n0 < COL_K ? 0.125f * LOG2E : ((n0 >= COL_MQ && n0 < COL_G) ? 0.0625f * LOG2E : 1.f);
        int row0 = n0; if (pairNh) { const int j = n0 < pairNh ? n0 : n0 - pairNh; row0 = (j >> 7) * 256 + (j & 127) + (n0 < pairNh ? 0 : 128); }
        c.src = src + (size_t)k0 * N + n0 + lane; c.gk = gk ? gk + k0 : nullptr; c.dst = dst + (size_t)(row0 + (lane >> 3)) * K + k0 + 8 * (lane & 7); c.K = K; c.N = N; c.scale = sc;
    };
    {
        LAS unsigned char* scr = F.lds + F.wave * 9216; constexpr int NIT = DEPTH * CI_LAYER;
        float va[64], vb[64]; ConvItem ca, cb; int it = gw;
        if (it < NIT) { item(it, ca); conv_load(ca, va); }
        while (it < NIT) {
            const int it1 = it + NGW; if (it1 < NIT) { item(it1, cb); conv_load(cb, vb); }
            conv_store(ca, va, lane, scr);
            if (it1 >= NIT) break;
            const int it2 = it1 + NGW; if (it2 < NIT) { item(it2, ca); conv_load(ca, va); }
            conv_store(cb, vb, lane, scr);
            it = it2;
        }
    }
    for (int m = gw; m < T; m += NGW) {
        const f32x4* xr = (const f32x4*)(I.x + (size_t)m * DM) + lane; v2u* o8 = (v2u*)(wsb(F, WS_XN) + (size_t)m * DM) + lane; float s = 0.f;
#pragma unroll
        for (int j = 0; j < 8; ++j) { const f32x4 v = xr[64 * j]; s += (v.x * v.x + v.y * v.y) + (v.z * v.z + v.w * v.w); v2u o; o.x = cvt_pk_bf16(v.x, v.y); o.y = cvt_pk_bf16(v.z, v.w); o8[64 * j] = o; }
        s = wave_sum(s); if (lane < 32) ((float*)(F.ws + WS_SSQ))[(size_t)m * 32 + lane] = lane == 0 ? s : 0.f;
    }
    for (int it = gw; it < DEPTH * 512; it += NGW) {
        const int l = it / 512, row = it % 512;
        const f32x4* xr = (const f32x4*)(I.mem + (size_t)row * DM) + lane; const f32x4* gr = (const f32x4*)(I.memn + (size_t)l * DM) + lane;
        f32x4 v[8]; float s = 0.f;
#pragma unroll
        for (int j = 0; j < 8; ++j) { v[j] = xr[64 * j]; s += (v[j].x * v[j].x + v[j].y * v[j].y) + (v[j].z * v[j].z + v[j].w * v[j].w); }
        const float rstd = 1.0f / sqrtf(wave_sum(s) * (1.f / DM) + RMS_EPS);
        v2u* o8 = (v2u*)(wsb(F, WS_MEMN) + ((size_t)l * 512 + row) * DM) + lane;
#pragma unroll
        for (int j = 0; j < 8; ++j) { const f32x4 g = gr[64 * j]; v2u o; o.x = cvt_pk_bf16(v[j].x * rstd * g.x, v[j].y * rstd * g.y); o.y = cvt_pk_bf16(v[j].z * rstd * g.z, v[j].w * rstd * g.w); o8[64 * j] = o; }
    }
}
constexpr int RSTD_OFF = LDSCTL_OFF + 1024;
__device__ __forceinline__ void rstd_table(Frame& F, int pm) {
    LAS float* tab = (LAS float*)(F.lds + RSTD_OFF);
    if (F.tid < 256) { const f32x4* q = (const f32x4*)((const float*)(F.ws + WS_SSQ) + ((size_t)pm * 256 + F.tid) * 32); float s = 0.f;
#pragma unroll
        for (int j = 0; j < 8; ++j) { const f32x4 a = q[j]; s += (a[0] + a[1]) + (a[2] + a[3]); }
        tab[F.tid] = 1.0f / sqrtf(s * (1.0f / DM) + RMS_EPS); }
    __syncthreads();
}
template <bool OUTF32>
__device__ __forceinline__ void norm_phase(Frame& F, const float* hin, const float* gain, void* outp) {
    const int gw = blockIdx.x * NWAVES + F.wave, NGW = F.G * NWAVES, lane = F.lane;
    f32x4 g[8];
#pragma unroll
    for (int j = 0; j < 8; ++j) g[j] = ((const f32x4*)gain)[lane + 64 * j];
    for (int m = gw; m < T; m += NGW) {
        const f32x4* xr = (const f32x4*)(hin + (size_t)m * DM) + lane;
        f32x4 v[8]; float s = 0.f;
#pragma unroll
        for (int j = 0; j < 8; ++j) { v[j] = xr[64 * j]; s += (v[j].x * v[j].x + v[j].y * v[j].y) + (v[j].z * v[j].z + v[j].w * v[j].w); }
        const float rstd = 1.0f / sqrtf(wave_sum(s) * (1.f / DM) + RMS_EPS);
        if (OUTF32) { f32x4* o = (f32x4*)((float*)outp + (size_t)m * DM) + lane;
#pragma unroll
            for (int j = 0; j < 8; ++j) o[64 * j] = v[j] * rstd * g[j];
        } else { v2u* o8 = (v2u*)((bf16*)outp + (size_t)m * DM) + lane;
#pragma unroll
            for (int j = 0; j < 8; ++j) { v2u o; o.x = cvt_pk_bf16(v[j].x * rstd * g[j].x, v[j].y * rstd * g[j].y); o.y = cvt_pk_bf16(v[j].z * rstd * g[j].z, v[j].w * rstd * g[j].w); o8[64 * j] = o; } }
    }
}
__device__ __forceinline__ void final_norm(Frame& F, const bf16* hb, const float* gain, float* outp) {
    const int gw = blockIdx.x * NWAVES + F.wave, NGW = F.G * NWAVES, lane = F.lane;
    for (int m = gw; m < T; m += NGW) {
        const v4u* xr = (const v4u*)(hb + (size_t)m * DM) + lane; float v[4][8]; float s = 0.f;
#pragma unroll
        for (int j = 0; j < 4; ++j) { const v4u w = xr[64 * j]; v[j][0] = bf_lo(w.x); v[j][1] = bf_hi(w.x); v[j][2] = bf_lo(w.y); v[j][3] = bf_hi(w.y); v[j][4] = bf_lo(w.z); v[j][5] = bf_hi(w.z); v[j][6] = bf_lo(w.w); v[j][7] = bf_hi(w.w);
#pragma unroll
            for (int e = 0; e < 8; ++e) s += v[j][e] * v[j][e]; }
        const float rstd = 1.0f / sqrtf(wave_sum(s) * (1.f / DM) + RMS_EPS);
#pragma unroll
        for (int j = 0; j < 4; ++j) { const f32x4* g = (const f32x4*)(gain + (lane + 64 * j) * 8); f32x4* o = (f32x4*)(outp + (size_t)m * DM + (lane + 64 * j) * 8); const f32x4 g0 = g[0], g1 = g[1];
            o[0] = (f32x4){v[j][0] * rstd * g0[0], v[j][1] * rstd * g0[1], v[j][2] * rstd * g0[2], v[j][3] * rstd * g0[3]}; o[1] = (f32x4){v[j][4] * rstd * g1[0], v[j][5] * rstd * g1[1], v[j][6] * rstd * g1[2], v[j][7] * rstd * g1[3]}; }
    }
}
__device__ __forceinline__ void unpack8(const v4u w, float* f) { f[0] = bf_lo(w.x); f[1] = bf_hi(w.x); f[2] = bf_lo(w.y); f[3] = bf_hi(w.y); f[4] = bf_lo(w.z); f[5] = bf_hi(w.z); f[6] = bf_lo(w.w); f[7] = bf_hi(w.w); }

__device__ __forceinline__ void swa_naive(Frame& F, const float* sinks) {
    const bf16* P = wsb(F, WS_PROJ); bf16* O = wsb(F, WS_OSWA);
    for (int idx = blockIdx.x * 512 + F.tid; idx < T * 16; idx += F.G * 512) {
        const int hq = idx / T, m = idx % T, b = m / SEQ, t = m % SEQ, g = hq >> 2;
        float q[64];
        { const v4u* qp = (const v4u*)(P + (size_t)m * INW + COL_Q + hq * 64);
#pragma unroll
          for (int j = 0; j < 8; ++j) unpack8(qp[j], q + 8 * j); }
        float mrun = sinks[hq] * LOG2E, lrun = 1.f, o[64];
#pragma unroll
        for (int j = 0; j < 64; ++j) o[j] = 0.f;
        const int k0 = t >= 127 ? t - 127 : 0;
        for (int kp = k0; kp <= t; ++kp) {
            const bf16* kr = P + (size_t)(b * SEQ + kp) * INW + COL_K + g * 64; const bf16* vr = kr + (COL_V - COL_K);
            float s0 = 0.f, s1 = 0.f;
#pragma unroll
            for (int j = 0; j < 8; ++j) { float kf[8]; unpack8(((const v4u*)kr)[j], kf);
#pragma unroll
                for (int e = 0; e < 8; e += 2) { s0 += q[8 * j + e] * kf[e]; s1 += q[8 * j + e + 1] * kf[e + 1]; } }
            const float s = s0 + s1, mnew = fmaxf(mrun, s), corr = __builtin_amdgcn_exp2f(mrun - mnew), p = __builtin_amdgcn_exp2f(s - mnew);
            lrun = lrun * corr + p; mrun = mnew;
#pragma unroll
            for (int j = 0; j < 8; ++j) { float vf[8]; unpack8(((const v4u*)vr)[j], vf);
#pragma unroll
                for (int e = 0; e < 8; ++e) o[8 * j + e] = o[8 * j + e] * corr + p * vf[e]; }
        }
        const float inv = 1.0f / lrun; v4u* op = (v4u*)(O + (size_t)m * 1024 + hq * 64);
#pragma unroll
        for (int j = 0; j < 8; ++j) { v4u w; w.x = cvt_pk_bf16(o[8 * j] * inv, o[8 * j + 1] * inv); w.y = cvt_pk_bf16(o[8 * j + 2] * inv, o[8 * j + 3] * inv);
            w.z = cvt_pk_bf16(o[8 * j + 4] * inv, o[8 * j + 5] * inv); w.w = cvt_pk_bf16(o[8 * j + 6] * inv, o[8 * j + 7] * inv); op[j] = w; }
    }
}
__device__ __forceinline__ void memattn_naive(Frame& F) {
    const bf16* P = wsb(F, WS_PROJ); const bf16* KV = wsb(F, WS_MKV); bf16* O = wsb(F, WS_OMEM);
    LAS float* qs = (LAS float*)F.lds;
    LAS float* ss = qs + 32 * 260;
    const int tid = F.tid, ti = tid >> 4, kg = tid & 15;
    for (int unit = blockIdx.x; unit < 1024; unit += F.G) {
        const int b = unit >> 9, hd = (unit >> 7) & 3, tb = unit & 127, m0 = b * SEQ + tb * 32;
        { const v4u* src = (const v4u*)(P + (size_t)(m0 + ti) * INW + COL_MQ + hd * 256 + kg * 16); float f[16]; unpack8(src[0], f); unpack8(src[1], f + 8);
#pragma unroll
          for (int e = 0; e < 16; ++e) qs[ti * 260 + kg * 16 + e] = f[e]; }
        __syncthreads();
        float sc[16];
#pragma unroll 1
        for (int i = 0; i < 16; ++i) { const int key = kg + 16 * i; const v4u* kr = (const v4u*)(KV + (size_t)(b * NMEM + key) * 2048 + hd * 256);
            float a0 = 0.f, a1 = 0.f;
#pragma unroll 8
            for (int d8 = 0; d8 < 32; ++d8) { float kf[8]; unpack8(kr[d8], kf); const LAS f32x4* qp = (const LAS f32x4*)(qs + ti * 260 + d8 * 8); const f32x4 qa = qp[0], qb = qp[1];
                a0 += qa.x * kf[0] + qa.y * kf[1] + qa.z * kf[2] + qa.w * kf[3]; a1 += qb.x * kf[4] + qb.y * kf[5] + qb.z * kf[6] + qb.w * kf[7]; }
            ss[ti * 257 + key] = a0 + a1; }
        __syncthreads();
        float mx = -3.0e38f;
#pragma unroll
        for (int i = 0; i < 16; ++i) { sc[i] = ss[ti * 257 + kg + 16 * i]; mx = fmaxf(mx, sc[i]); }
#pragma unroll
        for (int o = 1; o < 16; o <<= 1) mx = fmaxf(mx, __shfl_xor(mx, o));
        float sum = 0.f;
#pragma unroll
        for (int i = 0; i < 16; ++i) { sc[i] = __builtin_amdgcn_exp2f(sc[i] - mx); sum += sc[i]; }
#pragma unroll
        for (int o = 1; o < 16; o <<= 1) sum += __shfl_xor(sum, o);
        const float inv = 1.0f / sum;
#pragma unroll
        for (int i = 0; i < 16; ++i) ss[ti * 257 + kg + 16 * i] = sc[i] * inv;
        __syncthreads();
        float o[16];
#pragma unroll
        for (int e = 0; e < 16; ++e) o[e] = 0.f;
#pragma unroll 4
        for (int key = 0; key < NMEM; ++key) { const float p = ss[ti * 257 + key]; const v4u* vr = (const v4u*)(KV + (size_t)(b * NMEM + key) * 2048 + 1024 + hd * 256 + kg * 16);
            float vf[16]; unpack8(vr[0], vf); unpack8(vr[1], vf + 8);
#pragma unroll
            for (int e = 0; e < 16; ++e) o[e] += p * vf[e]; }
        v4u* op = (v4u*)(O + (size_t)(m0 + ti) * 1024 + hd * 256 + kg * 16);
        v4u w; w.x = cvt_pk_bf16(o[0], o[1]); w.y = cvt_pk_bf16(o[2], o[3]); w.z = cvt_pk_bf16(o[4], o[5]); w.w = cvt_pk_bf16(o[6], o[7]); op[0] = w;
        w.x = cvt_pk_bf16(o[8], o[9]); w.y = cvt_pk_bf16(o[10], o[11]); w.z = cvt_pk_bf16(o[12], o[13]); w.w = cvt_pk_bf16(o[14], o[15]); op[1] = w;
        __syncthreads();
    }
}
__device__ __forceinline__ void sincos_red(double x, float& s, float& c) {
    const double k = __builtin_rint(x * 0.63661977236758134308); const double r = (x - k * 1.57079632679489655800) - k * 6.123233995736766036e-17; const double r2 = r * r;
    double sp = -7.6471637318198164759e-13; sp = sp * r2 + 1.6059043836821614599e-10; sp = sp * r2 - 2.5052108385441718775e-8; sp = sp * r2 + 2.7557319223985890653e-6; sp = sp * r2 - 1.9841269841269841270e-4; sp = sp * r2 + 8.3333333333333333333e-3; sp = sp * r2 - 1.6666666666666666667e-1;
    const double sr = r + r * r2 * sp;
    double cp = -1.1470745597729724714e-11; cp = cp * r2 + 2.0876756987868098979e-9; cp = cp * r2 - 2.7557319223985890653e-7; cp = cp * r2 + 2.4801587301587301587e-5; cp = cp * r2 - 1.3888888888888888889e-3; cp = cp * r2 + 4.1666666666666666667e-2; cp = cp * r2 - 0.5;
    const double cr = 1.0 + r2 * cp;
    const int q = ((int)k) & 3;
    const double ss = (q & 1) ? cr : sr, cc = (q & 1) ? sr : cr;
    s = (float)((q & 2) ? -ss : ss); c = (float)(((q == 1) || (q == 2)) ? -cc : cc);
}
struct SsmState { float ar, ai, a64r, a64i; float bbr[16], bbi[16]; };
struct SsmIn { const float *lre, *lim, *ldt, *bre, *bim, *cre, *cim, *dsk; };
__device__ __forceinline__ void ssm_params(const SsmIn& I, int g, int p, SsmState& S) {
    const int gp = g * 64 + p;
    const float lr = fminf(I.lre[gp], -1e-4f), li = I.lim[gp], dt = expf(I.ldt[g]);
    const float mag = expf(lr * dt); float sn, cs; const double th = (double)li * (double)dt; sincos_red(th, sn, cs);
    S.ar = mag * cs; S.ai = mag * sn;
    const float mag64 = expf(lr * dt * 64.f); sincos_red(th * 64.0, sn, cs); S.a64r = mag64 * cs; S.a64i = mag64 * sn;
    const float nr = S.ar - 1.f, ni = S.ai, den = lr * lr + li * li, kr = (nr * lr + ni * li) / den, ki = (ni * lr - nr * li) / den;
    const float* br = I.bre + (size_t)gp * 16; const float* bi = I.bim + (size_t)gp * 16;
#pragma unroll
    for (int c = 0; c < 16; ++c) { S.bbr[c] = kr * br[c] - ki * bi[c]; S.bbi[c] = kr * bi[c] + ki * br[c]; }
}
__device__ __forceinline__ void ssm_step(const SsmState& S, const bf16* up, float& sr, float& si) {
    const v4u* u4 = (const v4u*)up; float uf[16]; unpack8(u4[0], uf); unpack8(u4[1], uf + 8);
    float xr = 0.f, xi = 0.f;
#pragma unroll
    for (int c = 0; c < 16; ++c) { xr += S.bbr[c] * uf[c]; xi += S.bbi[c] * uf[c]; }
    const float nr = S.ar * sr - S.ai * si + xr, ni = S.ar * si + S.ai * sr + xi; sr = nr; si = ni;
}
__device__ __forceinline__ void ssm_local(Frame& F, const SsmIn& I) {
    const bf16* P = wsb(F, WS_PROJ); f32x2* SE = (f32x2*)(F.ws + WS_SEND);
    const int gw = blockIdx.x * NWAVES + F.wave, NGW = F.G * NWAVES, p = F.lane;
    for (int u = gw; u < 2 * 64 * 64; u += NGW) {
        const int g = u & 63, ch = (u >> 6) & 63, b = u >> 12;
        SsmState S; ssm_params(I, g, p, S);
        float sr = 0.f, si = 0.f; const bf16* up = P + (size_t)(b * SEQ + ch * 64) * INW + COL_S + g * 16;
#pragma unroll 4
        for (int j = 0; j < 64; ++j) ssm_step(S, up + (size_t)j * INW, sr, si);
        SE[((size_t)(b * 64 + ch) * 64 + g) * 64 + p] = (f32x2){sr, si};
    }
}
__device__ __forceinline__ void ssm_replay(Frame& F, const SsmIn& I) {
    const bf16* P = wsb(F, WS_PROJ); const f32x2* SE = (const f32x2*)(F.ws + WS_SEND); bf16* Y = wsb(F, WS_YS);
    LAS f32x2* Cs = (LAS f32x2*)F.lds;
    LAS float* Ds = (LAS float*)(F.lds + 16 * 65 * 8);
    LAS f32x2* Sw = (LAS f32x2*)(F.lds + 16384) + F.wave * (16 * 65);
    const int p = F.lane, jj = F.lane >> 2, cq = F.lane & 3;
    for (int unit = blockIdx.x; unit < 1024; unit += F.G) {
        const int oct = unit & 7, g = (unit >> 3) & 63, b = unit >> 9, ch = oct * 8 + F.wave;
        for (int e = F.tid; e < 1024; e += 512) { const int c = e >> 6, pp = e & 63; const size_t gi = ((size_t)g * 16 + c) * 64 + pp; Cs[c * 65 + pp] = (f32x2){I.cre[gi], I.cim[gi]}; }
        if (F.tid < 16) Ds[F.tid] = I.dsk[g * 16 + F.tid];
        __syncthreads();
        SsmState S; ssm_params(I, g, p, S);
        float sr = 0.f, si = 0.f;
        for (int j = 0; j < ch; ++j) { const f32x2 e = SE[((size_t)(b * 64 + j) * 64 + g) * 64 + p]; const float nr = S.a64r * sr - S.a64i * si + e.x, ni = S.a64r * si + S.a64i * sr + e.y; sr = nr; si = ni; }
        const size_t tok0 = (size_t)b * SEQ + ch * 64;
#pragma unroll 1
        for (int sub = 0; sub < 4; ++sub) {
#pragma unroll 4
            for (int j = 0; j < 16; ++j) { ssm_step(S, P + (tok0 + sub * 16 + j) * INW + COL_S + g * 16, sr, si); Sw[j * 65 + p] = (f32x2){sr, si}; }
            asm volatile("s_waitcnt lgkmcnt(0)" ::: "memory");
            float acc[4] = {0.f, 0.f, 0.f, 0.f};
#pragma unroll 4
            for (int pp = 0; pp < 64; ++pp) { const f32x2 sv = Sw[jj * 65 + pp];
#pragma unroll
                for (int ci = 0; ci < 4; ++ci) { const f32x2 cv = Cs[(cq * 4 + ci) * 65 + pp]; acc[ci] += cv.x * sv.x - cv.y * sv.y; } }
            const size_t tok = tok0 + sub * 16 + jj; const v2u uw = *(const v2u*)(P + tok * INW + COL_S + g * 16 + cq * 4);
            const float u0 = bf_lo(uw.x), u1 = bf_hi(uw.x), u2 = bf_lo(uw.y), u3 = bf_hi(uw.y);
            v2u o; o.x = cvt_pk_bf16(acc[0] + Ds[cq * 4] * u0, acc[1] + Ds[cq * 4 + 1] * u1); o.y = cvt_pk_bf16(acc[2] + Ds[cq * 4 + 2] * u2, acc[3] + Ds[cq * 4 + 3] * u3);
            *(v2u*)(Y + tok * 1024 + g * 16 + cq * 4) = o;
            asm volatile("s_waitcnt lgkmcnt(0)" ::: "memory");
        }
        __syncthreads();
    }
}

typedef short bf16x8 __attribute__((ext_vector_type(8)));
typedef short s16x4 __attribute__((ext_vector_type(4)));
typedef float f32x16 __attribute__((ext_vector_type(16)));
__device__ __forceinline__ s16x4 lds_tr16(const LAS unsigned char* p) { return __builtin_bit_cast(s16x4, __builtin_amdgcn_ds_read_tr16_b64_v4i16((LAS s16x4*)p)); }
__device__ __forceinline__ bf16x8 cat8(s16x4 lo, s16x4 hi) { return (bf16x8){lo[0], lo[1], lo[2], lo[3], hi[0], hi[1], hi[2], hi[3]}; }
__device__ __forceinline__ bf16x8 pack8(float a0, float a1, float a2, float a3, float a4, float a5, float a6, float a7) {
    v4u w; w.x = cvt_pk_bf16(a0, a1); w.y = cvt_pk_bf16(a2, a3); w.z = cvt_pk_bf16(a4, a5); w.w = cvt_pk_bf16(a6, a7); return __builtin_bit_cast(bf16x8, w); }

__device__ __forceinline__ void swa_mfma(Frame& F, const float* sinks) {
    const bf16* P = wsb(F, WS_PROJ); bf16* O = wsb(F, WS_OSWA);
    LAS unsigned char* Kl = F.lds;
    LAS unsigned char* Vl = F.lds + 36864;
    const int tid = F.tid, lane = F.lane, w = F.wave, r = w >> 1, qh = w & 1, l31 = lane & 31, h = lane >> 5;
    for (int ub_ = blockIdx.x; ub_ < 256; ub_ += F.G) { const int unit = (F.G == 256) ? ((ub_ & 7) * 32 + (ub_ >> 3)) : ub_;
        const int n = unit & 31, g = (unit >> 5) & 3, b = unit >> 7;
#pragma unroll
        for (int i = 0; i < 4; ++i) { const int c = tid + 512 * i, key = c >> 3, part = c & 7, pos = (n - 1) * 128 + key;
            v4u kv = {0u, 0u, 0u, 0u}, vv = {0u, 0u, 0u, 0u};
            if (pos >= 0) { const bf16* src = P + (size_t)(b * SEQ + pos) * INW + COL_K + g * 64 + part * 8; kv = *(const v4u*)src; vv = *(const v4u*)(src + (COL_V - COL_K)); }
            *(LAS v4u*)(Kl + key * 144 + part * 16) = kv;
            *(LAS v4u*)(Vl + (part >> 2) * 16384 + key * 64 + (part & 3) * 16) = vv; }
        __syncthreads();
        const int hq = g * 4 + r; const float sink2 = sinks[hq] * LOG2E;
#pragma unroll 1
        for (int qt = 0; qt < 2; ++qt) {
            const int a = qh * 2 + qt, qi = a * 32 + l31; const size_t m = (size_t)b * SEQ + n * 128 + qi;
            bf16x8 qf[4];
#pragma unroll
            for (int ds = 0; ds < 4; ++ds) qf[ds] = *(const bf16x8*)(P + m * INW + COL_Q + hq * 64 + ds * 16 + h * 8);
            f32x16 s[5];
#pragma unroll
            for (int k5 = 0; k5 < 5; ++k5) { f32x16 acc;
#pragma unroll
                for (int e = 0; e < 16; ++e) acc[e] = 0.f;
#pragma unroll
                for (int ds = 0; ds < 4; ++ds) { const bf16x8 kf = *(const LAS bf16x8*)(Kl + (32 * (a + k5) + l31) * 144 + ds * 32 + h * 16); acc = __builtin_amdgcn_mfma_f32_32x32x16_bf16(kf, qf[ds], acc, 0, 0, 0); }
                s[k5] = acc; }
            float mx = sink2;
#pragma unroll
            for (int k5 = 0; k5 < 5; ++k5)
#pragma unroll
                for (int e = 0; e < 16; ++e) { const int kl = 32 * (a + k5) + (e & 3) + 8 * (e >> 2) + 4 * h; const bool ok = (kl > qi) && (kl <= qi + 128) && (n > 0 || kl >= 128);
                    const float v = ok ? s[k5][e] : -1.0e30f; s[k5][e] = v; mx = fmaxf(mx, v); }
            mx = fmaxf(mx, __shfl_xor(mx, 32));
            float sum = 0.f;
#pragma unroll
            for (int k5 = 0; k5 < 5; ++k5)
#pragma unroll
                for (int e = 0; e < 16; ++e) { const float p = __builtin_amdgcn_exp2f(s[k5][e] - mx); s[k5][e] = p; sum += p; }
            sum += __shfl_xor(sum, 32); sum += __builtin_amdgcn_exp2f(sink2 - mx);
            f32x16 o[2];
#pragma unroll
            for (int e = 0; e < 16; ++e) { o[0][e] = 0.f; o[1][e] = 0.f; }
#pragma unroll
            for (int k5 = 0; k5 < 5; ++k5)
#pragma unroll
                for (int s2 = 0; s2 < 2; ++s2) { const bf16x8 pf = pack8(s[k5][8 * s2], s[k5][8 * s2 + 1], s[k5][8 * s2 + 2], s[k5][8 * s2 + 3], s[k5][8 * s2 + 4], s[k5][8 * s2 + 5], s[k5][8 * s2 + 6], s[k5][8 * s2 + 7]);
                    const int base0 = 32 * (a + k5) + 16 * s2 + 4 * h;
#pragma unroll
                    for (int db = 0; db < 2; ++db) { const LAS unsigned char* vp = Vl + db * 16384 + (base0 + ((lane & 15) >> 2)) * 64 + (16 * ((lane >> 4) & 1) + 4 * (lane & 3)) * 2;
                        const bf16x8 vf = cat8(lds_tr16(vp), lds_tr16(vp + 8 * 64)); o[db] = __builtin_amdgcn_mfma_f32_32x32x16_bf16(vf, pf, o[db], 0, 0, 0); } }
            const float inv = 1.0f / sum;
#pragma unroll
            for (int db = 0; db < 2; ++db)
#pragma unroll
                for (int g4 = 0; g4 < 4; ++g4) { v2u wv; wv.x = cvt_pk_bf16(o[db][4 * g4] * inv, o[db][4 * g4 + 1] * inv); wv.y = cvt_pk_bf16(o[db][4 * g4 + 2] * inv, o[db][4 * g4 + 3] * inv);
                    *(v2u*)(O + m * 1024 + hq * 64 + db * 32 + 8 * g4 + 4 * h) = wv; }
        }
        __syncthreads();
    }
}
__device__ __forceinline__ void memattn_mfma(Frame& F) {
    const bf16* P = wsb(F, WS_PROJ); const bf16* KV = wsb(F, WS_MKV); bf16* O = wsb(F, WS_OMEM);
    constexpr int RS = 544, SLOT = 64 * RS;
    const int tid = F.tid, lane = F.lane, w = F.wave, l15 = lane & 15, kq = lane >> 4;
    for (int ub_ = blockIdx.x; ub_ < 256; ub_ += F.G) { const int unit = (F.G == 256) ? ((ub_ & 7) * 32 + (ub_ >> 3)) : ub_;
        const int tb = unit & 31, hd = (unit >> 5) & 3, b = unit >> 7; const size_t m = (size_t)b * SEQ + tb * 128 + w * 16 + l15;
        bf16x8 qf[8];
#pragma unroll
        for (int ds = 0; ds < 8; ++ds) qf[ds] = *(const bf16x8*)(P + m * INW + COL_MQ + hd * 256 + ds * 32 + kq * 8);
        v4u st[4];
#define MA_LOAD(t) do { _Pragma("unroll") for (int i_ = 0; i_ < 4; ++i_) { const int c_ = tid + 512 * i_, row_ = c_ >> 5, part_ = c_ & 31; \
            st[i_] = *(const v4u*)(KV + (size_t)(b * NMEM + 64 * ((t) & 3) + row_) * 2048 + ((t) >> 2) * 1024 + hd * 256 + part_ * 8); } } while (0)
#define MA_STORE(buf) do { _Pragma("unroll") for (int i_ = 0; i_ < 4; ++i_) { const int c_ = tid + 512 * i_, row_ = c_ >> 5, part_ = c_ & 31; *(LAS v4u*)((buf) + row_ * RS + part_ * 16) = st[i_]; } } while (0)
        MA_LOAD(0); MA_STORE(F.lds); __syncthreads();
        f32x4 s[16]; f32x4 o[16]; float inv = 0.f;
#pragma unroll
        for (int t = 0; t < 8; ++t) {
            if (t < 7) MA_LOAD(t + 1);
            const LAS unsigned char* cur = F.lds + (t & 1) * SLOT;
            if (t < 4) {
#pragma unroll
                for (int k4 = 0; k4 < 4; ++k4) { f32x4 acc = {0.f, 0.f, 0.f, 0.f};
#pragma unroll
                    for (int ds = 0; ds < 8; ++ds) { const bf16x8 kf = *(const LAS bf16x8*)(cur + (16 * k4 + l15) * RS + ds * 64 + kq * 16); acc = __builtin_amdgcn_mfma_f32_16x16x32_bf16(kf, qf[ds], acc, 0, 0, 0); }
                    s[4 * t + k4] = acc; }
                if (t == 3) {
                    float mx = -3.0e38f;
#pragma unroll
                    for (int i = 0; i < 16; ++i) mx = fmaxf(mx, fmaxf(fmaxf(s[i][0], s[i][1]), fmaxf(s[i][2], s[i][3])));
                    mx = fmaxf(mx, __shfl_xor(mx, 16)); mx = fmaxf(mx, __shfl_xor(mx, 32));
                    float sum = 0.f;
#pragma unroll
                    for (int i = 0; i < 16; ++i)
#pragma unroll
                        for (int e = 0; e < 4; ++e) { const float p = __builtin_amdgcn_exp2f(s[i][e] - mx); s[i][e] = p; sum += p; }
                    sum += __shfl_xor(sum, 16); sum += __shfl_xor(sum, 32); inv = 1.0f / sum;
#pragma unroll
                    for (int i = 0; i < 16; ++i) o[i] = (f32x4){0.f, 0.f, 0.f, 0.f};
                }
            } else {
                const int tv = t - 4;
#pragma unroll
                for (int s2 = 0; s2 < 2; ++s2) { const f32x4 p0 = s[4 * tv + 2 * s2], p1 = s[4 * tv + 2 * s2 + 1]; const bf16x8 pf = pack8(p0[0], p0[1], p0[2], p0[3], p1[0], p1[1], p1[2], p1[3]);
#pragma unroll
                    for (int db = 0; db < 16; ++db) { const LAS unsigned char* vp = cur + (32 * s2 + 4 * kq + (l15 >> 2)) * RS + (16 * db + 4 * (lane & 3)) * 2;
                        const bf16x8 vf = cat8(lds_tr16(vp), lds_tr16(vp + 16 * RS)); o[db] = __builtin_amdgcn_mfma_f32_16x16x32_bf16(vf, pf, o[db], 0, 0, 0); } }
            }
            if (t < 7) MA_STORE(F.lds + ((t + 1) & 1) * SLOT);
            __syncthreads();
        }
#undef MA_LOAD
#undef MA_STORE
#pragma unroll
        for (int db = 0; db < 16; ++db) { v2u wv; wv.x = cvt_pk_bf16(o[db][0] * inv, o[db][1] * inv); wv.y = cvt_pk_bf16(o[db][2] * inv, o[db][3] * inv); *(v2u*)(O + m * 1024 + hd * 256 + 16 * db + 4 * kq) = wv; }
    }
}

__device__ __forceinline__ void cmul(float ar, float ai, float br, float bi, float& cr, float& ci) { cr = ar * br - ai * bi; ci = ar * bi + ai * br; }
__device__ __forceinline__ void ssm_tables(Frame& F, const SsmIn& I0) {
    LAS f32x2* AP = (LAS f32x2*)F.lds;
    LAS f32x2* BB = (LAS f32x2*)(F.lds + 33280);
    LAS f32x2* CC = (LAS f32x2*)(F.lds + 33280 + 8192);
    LAS f32x2* KC = (LAS f32x2*)(F.lds + 33280 + 16384);
    const int t = F.tid;
    for (int unit = blockIdx.x; unit < DEPTH * 64; unit += F.G) {
        const int l = unit >> 6, g = unit & 63, gp0 = unit * 64;
        const float dt = expf(I0.ldt[unit]);
        for (int e = t; e < 65 * 64; e += 512) { const int ee = e >> 6, p = e & 63; const float lr = fminf(I0.lre[gp0 + p], -1e-4f), li = I0.lim[gp0 + p];
            const float mag = expf(lr * dt * (float)ee); float sn, cs; sincos_red((double)li * (double)dt * (double)ee, sn, cs); AP[e] = (f32x2){mag * cs, mag * sn}; }
        __syncthreads();
        if (t < 64) { ((f32x2*)(F.ws + WS_A64))[gp0 + t] = AP[64 * 64 + t];
            const float lr = fminf(I0.lre[gp0 + t], -1e-4f), li = I0.lim[gp0 + t]; const f32x2 a = AP[64 + t]; const float nr = a.x - 1.f, ni = a.y, den = lr * lr + li * li;
            KC[t] = (f32x2){(nr * lr + ni * li) / den, (ni * lr - nr * li) / den}; }
        __syncthreads();
        for (int e = t; e < 1024; e += 512) { const int p = e >> 4; const f32x2 k = KC[p]; const float br = I0.bre[(size_t)gp0 * 16 + e], bi = I0.bim[(size_t)gp0 * 16 + e];
            BB[e] = (f32x2){k.x * br - k.y * bi, k.x * bi + k.y * br}; CC[e] = (f32x2){I0.cre[(size_t)gp0 * 16 + e], I0.cim[(size_t)gp0 * 16 + e]}; }
        __syncthreads();
        bf16* WinT = wsb(F, WS_WINT) + (size_t)unit * 131072; bf16* WoutT = wsb(F, WS_WOUTT) + (size_t)unit * 131072; bf16* LB = (bf16*)(F.ws + WS_LB + (size_t)unit * LB_BYTES);
        for (int q = t; q < 16384; q += 512) { const int n = q >> 7, ck = q & 127, j = ck >> 1, half = ck & 1, p = 16 * (n >> 5) + (n & 15), isim = (n >> 4) & 1; const f32x2 a = AP[(63 - j) * 64 + p]; float v[8];
#pragma unroll
            for (int e = 0; e < 8; ++e) { const f32x2 bb = BB[p * 16 + 8 * half + e]; float zr, zi; cmul(a.x, a.y, bb.x, bb.y, zr, zi); v[e] = isim ? zi : zr; }
            *(bf16x8*)(WinT + (size_t)n * 1024 + ck * 8) = pack8(v[0], v[1], v[2], v[3], v[4], v[5], v[6], v[7]); }
        for (int q = t; q < 16384; q += 512) { const int row = q >> 4, ck = q & 15, tau = row >> 4, c = row & 15, isim = ck >> 3, p0 = (8 * ck) & 63; float v[8];
#pragma unroll
            for (int e = 0; e < 8; ++e) { const f32x2 cc = CC[c * 64 + p0 + e], a = AP[(tau + 1) * 64 + p0 + e]; float zr, zi; cmul(cc.x, cc.y, a.x, a.y, zr, zi); v[e] = isim ? -zi : zr; }
            *(bf16x8*)(WoutT + (size_t)row * 128 + ck * 8) = pack8(v[0], v[1], v[2], v[3], v[4], v[5], v[6], v[7]); }
        { const int c = (t >> 4) & 15, c2 = t & 15, lh = t >> 8; float acc[32];
#pragma unroll
          for (int d = 0; d < 32; ++d) acc[d] = 0.f;
#pragma unroll 2
          for (int p = 0; p < 64; ++p) { const f32x2 cc = CC[c * 64 + p], bb = BB[p * 16 + c2]; float zr, zi; cmul(cc.x, cc.y, bb.x, bb.y, zr, zi);
#pragma unroll
              for (int d = 0; d < 32; ++d) { const f32x2 a = AP[(32 * lh + d) * 64 + p]; acc[d] += zr * a.x - zi * a.y; } }
          if (lh == 0 && c == c2) acc[0] += I0.dsk[l * 1024 + g * 16 + c];
#pragma unroll
          for (int d = 0; d < 32; ++d) LB[(((32 * lh + d + 1) * 2 + (c2 >> 3)) * 16 + c) * 8 + (c2 & 7)] = (bf16)(cvt_pk_bf16(acc[d], 0.f) & 0xffffu);
          if (t < 256) LB[t] = 0; }
        __syncthreads();
    }
}
__device__ __forceinline__ void ssm_s1(Frame& F, const SsmIn& I, int l) {
    const bf16* P = wsb(F, WS_PROJ); bf16* SST = wsb(F, WS_SST);
    LAS float* E = (LAS float*)F.lds;
    const int lane = F.lane, w = F.wave, l31 = lane & 31, h = lane >> 5, mi = w & 3, kh = w >> 2;
    for (int ub_ = blockIdx.x; ub_ < 256; ub_ += F.G) { const int unit = (F.G == 256) ? ((ub_ & 7) * 32 + (ub_ >> 3)) : ub_;
        const int g = unit >> 2, pq = unit & 3;
        const bf16* WinT = wsb(F, WS_WINT) + (size_t)(l * 64 + g) * 131072 + (size_t)(pq * 32 + l31) * 1024 + 8 * h;
        const int mrow = 32 * mi + l31, bb = mrow >> 6, kk = mrow & 63;
        const bf16* up = wsb(F, WS_SIN) + ((size_t)g * T + bb * SEQ + kk * 64) * 16 + 8 * h;
        f32x16 acc;
#pragma unroll
        for (int e = 0; e < 16; ++e) acc[e] = 0.f;
#pragma unroll 16
        for (int jj = 0; jj < 32; ++jj) { const int j = 32 * kh + jj; const bf16x8 af = *(const bf16x8*)(up + (size_t)j * 16), bf = *(const bf16x8*)(WinT + 16 * j);
            acc = __builtin_amdgcn_mfma_f32_32x32x16_bf16(af, bf, acc, 0, 0, 0); }
#pragma unroll
        for (int e = 0; e < 16; ++e) E[(kh * 128 + 32 * mi + (e & 3) + 8 * (e >> 2) + 4 * h) * 33 + l31] = acc[e];
        __syncthreads();
#pragma unroll 1
        for (int tk = 0; tk < 4; ++tk) { const int task = w * 4 + tk, b = task >> 4, st = task & 15, p = 16 * pq + st, k = lane;
            float xr = E[(b * 64 + k) * 33 + st] + E[(128 + b * 64 + k) * 33 + st], xi = E[(b * 64 + k) * 33 + 16 + st] + E[(128 + b * 64 + k) * 33 + 16 + st];
            float ar, ai; { const f32x2 a64 = ((const f32x2*)(F.ws + WS_A64))[(l * 64 + g) * 64 + p]; ar = a64.x; ai = a64.y; }
#pragma unroll
            for (int d = 1; d < 64; d <<= 1) { const float yr = __shfl_up(xr, d), yi = __shfl_up(xi, d); if (k >= d) { xr += ar * yr - ai * yi; xi += ar * yi + ai * yr; } const float nr = ar * ar - ai * ai, ni = 2.f * ar * ai; ar = nr; ai = ni; }
            float sr = __shfl_up(xr, 1), si = __shfl_up(xi, 1); if (k == 0) { sr = 0.f; si = 0.f; }
            bf16* dst = SST + ((size_t)(g * 128 + b * 64 + k)) * 128 + p; dst[0] = (bf16)(cvt_pk_bf16(sr, 0.f) & 0xffffu); dst[64] = (bf16)(cvt_pk_bf16(si, 0.f) & 0xffffu); }
        __syncthreads();
    }
}
__device__ __forceinline__ void ssm_s2(Frame& F, int l) {
    const bf16* P = wsb(F, WS_PROJ); const bf16* SST = wsb(F, WS_SST); bf16* Y = wsb(F, WS_YS);
    LAS unsigned char* Ul = F.lds;
    LAS unsigned char* Ll = F.lds + 66048;
    LAS unsigned char* Sl = F.lds + 66048 + 33280;
    const int t = F.tid, lane = F.lane, w = F.wave, l31 = lane & 31, h = lane >> 5;
    for (int ub_ = blockIdx.x; ub_ < 256; ub_ += F.G) { const int unit = (F.G == 256) ? ((ub_ & 7) * 32 + (ub_ >> 3)) : ub_;
        const int mt = unit & 1, b = (unit >> 1) & 1, g = unit >> 2;
        const bf16* WoutT = wsb(F, WS_WOUTT) + (size_t)(l * 64 + g) * 131072;
        bf16x8 wfr[4][8];
#pragma unroll
        for (int q = 0; q < 4; ++q) { const int n = (q == 0) ? w : (q == 1) ? 15 - w : (q == 2) ? 16 + w : 31 - w;
#pragma unroll
            for (int ks = 0; ks < 8; ++ks) wfr[q][ks] = *(const bf16x8*)(WoutT + (size_t)(32 * n + l31) * 128 + 16 * ks + 8 * h); }
#pragma unroll
        for (int i = 0; i < 8; ++i) { const int q = t + 512 * i, half = q & 1, ti = q >> 1, ir = ti >> 6, j = ti & 63;
            *(LAS v4u*)(Ul + ir * 2064 + j * 32 + half * 16) = *(const v4u*)(wsb(F, WS_SIN) + ((size_t)g * T + b * SEQ + (32 * mt) * 64) * 16 + (size_t)q * 8); }
        { const v4u* src = (const v4u*)(F.ws + WS_LB + (size_t)(l * 64 + g) * LB_BYTES);
          for (int q = t; q < (int)(LB_BYTES / 16); q += 512) *(LAS v4u*)(Ll + q * 16) = src[q]; }
        { const int row = t >> 4, part = t & 15; *(LAS v4u*)(Sl + row * 272 + part * 16) = *(const v4u*)(SST + ((size_t)(g * 128 + b * 64 + 32 * mt + row)) * 128 + part * 8); }
        __syncthreads();
#pragma unroll
        for (int q = 0; q < 4; ++q) { const int n = (q == 0) ? w : (q == 1) ? 15 - w : (q == 2) ? 16 + w : 31 - w;
            f32x16 acc;
#pragma unroll
            for (int e = 0; e < 16; ++e) acc[e] = 0.f;
#pragma unroll
            for (int ks = 0; ks < 8; ++ks) { const bf16x8 sf = *(const LAS bf16x8*)(Sl + l31 * 272 + ks * 32 + h * 16);
                acc = __builtin_amdgcn_mfma_f32_32x32x16_bf16(wfr[q][ks], sf, acc, 0, 0, 0); }
            const LAS unsigned char* lbp = Ll + ((2 * n + 1 + (l31 >> 4)) * 2 + h) * 256 + (l31 & 15) * 16; const LAS unsigned char* ubp = Ul + l31 * 2064 + h * 16;
#pragma unroll 4
            for (int j = 0; j < 2 * n + 2; ++j) { const bf16x8 kf = *(const LAS bf16x8*)(lbp - j * 512), uf = *(const LAS bf16x8*)(ubp + j * 32); acc = __builtin_amdgcn_mfma_f32_32x32x16_bf16(kf, uf, acc, 0, 0, 0); }
#pragma unroll
            for (int q4 = 0; q4 < 4; ++q4) { const int c0 = 8 * (q4 & 1) + 4 * h, tau = 2 * n + (q4 >> 1); const size_t tok = (size_t)b * SEQ + (32 * mt + l31) * 64 + tau;
                v2u wv; wv.x = cvt_pk_bf16(acc[4 * q4], acc[4 * q4 + 1]); wv.y = cvt_pk_bf16(acc[4 * q4 + 2], acc[4 * q4 + 3]); *(v2u*)(Y + tok * 1024 + g * 16 + c0) = wv; }
        }
        __syncthreads();
    }
}

constexpr int PH_PRO = 0, PH_SB0 = 1, PH_PER_SB = 6, N_SB = 3 * DEPTH, PH_FINAL = PH_SB0 + N_SB * PH_PER_SB, N_PH = PH_FINAL + 1;
struct Args { const float* in[N_IN]; float* out; unsigned char* ws; int ph_lo, ph_hi; };
static_assert(sizeof(Args) == N_IN * 8 + 8 + 8 + 8, "Args has no padding");

typedef __attribute__((address_space(4))) const Args* KArgs;
__device__ __forceinline__ KArgs kargs() { KArgs p = (KArgs)__builtin_amdgcn_kernarg_segment_ptr(); asm volatile("" : "+s"(p)); return p; }
#define AIN(i) (kargs()->in[i])
__global__ void __launch_bounds__(NWAVES * 64, 2) fwd(Args args_unused) {
    extern __shared__ __attribute__((aligned(16))) unsigned char lds[];
    Frame F;
    F.lds = (LAS unsigned char*)lds;
    F.tid = threadIdx.x; F.lane = F.tid & 63; F.wave = __builtin_amdgcn_readfirstlane(F.tid >> 6); F.G = gridDim.x;
    F.ws = kargs()->ws;
    volatile LAS unsigned* MISC = (volatile LAS unsigned*)(F.lds + MISC_OFF);
    for (int u = F.tid; u < (LDS_BYTES - LDSCTL_OFF) / 4; u += NWAVES * 64) ((LAS unsigned*)(F.lds + LDSCTL_OFF))[u] = 0u;
    __syncthreads();
    unsigned* barw = (unsigned*)(F.ws + WS_CTL) + CW_BAR;
    XcdBarrier bar; bar.bar = barw; bar.x = 0; bar.st = nullptr;
    if (kargs()->ph_hi - kargs()->ph_lo > 1) (void)xcd_barrier_post(barw, MISC + 8);
#define IN(p) (kargs()->ph_lo <= (p) && (p) < kargs()->ph_hi)
#define hi (kargs()->ph_hi)
#define BARNOW() XcdBarrier{(unsigned*)(kargs()->ws + WS_CTL) + CW_BAR, xb_xcc_id(), (volatile LAS unsigned*)((LAS unsigned char*)lds + MISC_OFF) + 8}
#define FRESH() do { int t_ = threadIdx.x; asm volatile("" : "+v"(t_)); F.tid = t_; F.lane = t_ & 63; F.wave = __builtin_amdgcn_readfirstlane(t_ >> 6); unsigned char* w_ = kargs()->ws; F.ws = w_; } while (0)
#if DIAG
#define SEAM(p, q) do { if (IN(p) && (q) < hi) { xcd_barrier(BARNOW()); if ((q) == PH_FINAL && threadIdx.x == 0) { const unsigned dwt = MISC[16]; unsigned* dw = (unsigned*)(kargs()->ws + WS_CTL) + 2048; atomicMax(dw, dwt); atomicAdd(dw + 128, dwt >> 8); } } } while (0)
#else
#define SEAM(p, q) do { if (IN(p) && (q) < hi) xcd_barrier(BARNOW()); } while (0)
#endif

    if (IN(PH_PRO) && EN_PRO) for (int rep_ = 0; rep_ < REP_PRO; ++rep_) { FRESH(); const ProIn I{AIN(I_F1WI), AIN(I_F2WI), AIN(I_F1WO), AIN(I_F2WO), AIN(I_WIN), AIN(I_WMKV), AIN(I_WGLU), AIN(I_WSWA), AIN(I_WMEMUP), AIN(I_WOUT), AIN(I_MEM), AIN(I_MEMN), AIN(I_F1N), AIN(I_F2N), AIN(I_MIXN), AIN(I_X)}; prologue(F, I);
        const SsmIn I0{AIN(I_LRE), AIN(I_LIM), AIN(I_LDT), AIN(I_BRE), AIN(I_BIM), AIN(I_CRE), AIN(I_CIM), AIN(I_DSK)}; ssm_tables(F, I0); }
    SEAM(PH_PRO, PH_SB0);

    for (int sb = 0; sb < N_SB; ++sb) {
        const int l = sb / 3, ty = sb % 3, pb = PH_SB0 + sb * PH_PER_SB;
        if (pb + PH_PER_SB <= kargs()->ph_lo || pb >= hi) continue;
#define HIN() ((sb == 0) ? AIN(I_X) : (const float*)(F.ws + WS_H))
#define WL() (F.ws + WS_W + (size_t)l * W_LAYER)
        if (ty != 1) {
            if (IN(pb + 1) && EN_G1) for (int rep_ = 0; rep_ < REP_G1; ++rep_) { FRESH();
                pg8::SchedG1 S{(const char*)(F.ws + WS_XN), (const char*)(WL() + (ty == 0 ? WO_1IN : WO_2IN)), (size_t)256 * DM * 2, T / 256, 2 * DFF / 256, F.G, (int)blockIdx.x};
                pg8::Unit u0; int pm0 = -1; if (S.next(0, u0)) { pm0 = u0.pm; rstd_table(F, pm0); }
                pg8::EpiSwiGLU E{wsb(F, WS_HID), DFF, pg8::RstdTab{(const LAS float*)(F.lds + RSTD_OFF), pm0, (const float*)(F.ws + WS_SSQ)}};
                pg8::gemm_phase<pg8::EpiSwiGLU, pg8::SchedG1, true, true>(F.lds + RING_OFF, DM, S, E);
            }
            SEAM(pb + 1, pb + 5);
        } else {
            if (IN(pb + 1) && EN_G3) for (int rep_ = 0; rep_ < REP_G3; ++rep_) { FRESH();
                pg8::SchedProj S{(const char*)(F.ws + WS_XN), (const char*)(WL() + WO_IN), (const char*)(F.ws + WS_MEMN + (size_t)l * 512 * DM * 2), (const char*)(WL() + WO_MKV), (size_t)256 * DM * 2, T / 256, INW / 256, F.G, (int)blockIdx.x};
                pg8::Unit u0; int pm0 = -1; if (S.next(0, u0)) { pm0 = u0.pm; rstd_table(F, pm0); }
                pg8::EpiProj E{wsb(F, WS_PROJ), INW, COL_G / 256, wsb(F, WS_MKV), 2048, pg8::RstdTab{(const LAS float*)(F.lds + RSTD_OFF), pm0, (const float*)(F.ws + WS_SSQ)}, wsb(F, WS_SIN)};
                pg8::gemm_phase<pg8::EpiProj, pg8::SchedProj, true, true>(F.lds + RING_OFF, DM, S, E);
            }
            SEAM(pb + 1, pb + 2);
            if (IN(pb + 2) && EN_M1) for (int rep_ = 0; rep_ < REP_M; ++rep_) { FRESH(); for (int r2_ = 0; r2_ < REP_SWA; ++r2_) swa_mfma(F, AIN(I_SINK) + l * 16); for (int r2_ = 0; r2_ < REP_MA; ++r2_) memattn_mfma(F);
                const SsmIn I{AIN(I_LRE) + l * 4096, AIN(I_LIM) + l * 4096, AIN(I_LDT) + l * 64, AIN(I_BRE) + l * 65536, AIN(I_BIM) + l * 65536, AIN(I_CRE) + l * 65536, AIN(I_CIM) + l * 65536, AIN(I_DSK) + l * 1024}; for (int r2_ = 0; r2_ < REP_S1; ++r2_) ssm_s1(F, I, l); }
            SEAM(pb + 2, pb + 3);
            if (IN(pb + 3) && EN_M2) for (int rep_ = 0; rep_ < REP_M; ++rep_) { FRESH(); const SsmIn I{AIN(I_LRE) + l * 4096, AIN(I_LIM) + l * 4096, AIN(I_LDT) + l * 64, AIN(I_BRE) + l * 65536, AIN(I_BIM) + l * 65536, AIN(I_CRE) + l * 65536, AIN(I_CIM) + l * 65536, AIN(I_DSK) + l * 1024}; (void)I; for (int r2_ = 0; r2_ < REP_S2; ++r2_) ssm_s2(F, l); }
            SEAM(pb + 3, pb + 4);
            if (IN(pb + 4) && EN_G4) for (int rep_ = 0; rep_ < REP_G4; ++rep_) { FRESH();
                pg8::SchedMix S{(const char*)(F.ws + WS_OSWA), (const char*)(F.ws + WS_OMEM), (const char*)(F.ws + WS_YS), (const char*)(WL() + WO_SWA), (const char*)(WL() + WO_MEM), (const char*)(WL() + WO_GLU), (size_t)256 * 1024 * 2, T / 256, DM / 256, F.G, (int)blockIdx.x};
                pg8::EpiMix E{wsb(F, WS_MG), wsb(F, WS_PROJ) + COL_G, INW};
                pg8::gemm_phase<pg8::EpiMix, pg8::SchedMix, true, true>(F.lds + RING_OFF, 1024, S, E);
            }
            SEAM(pb + 4, pb + 5);
        }
        if (IN(pb + 5) && EN_GR) for (int rep_ = 0; rep_ < REP_GR; ++rep_) { FRESH();
            const int K = (ty == 1) ? DM : DFF;
            pg8::SchedTiles S{(const char*)(F.ws + (ty == 1 ? WS_MG : WS_HID)), (const char*)(WL() + (ty == 0 ? WO_1OUT : ty == 1 ? WO_OUT : WO_2OUT)), (size_t)256 * K * 2, T / 256, DM / 256, F.G, (int)blockIdx.x};
            pg8::EpiResid E{(sb == 0) ? AIN(I_X) : nullptr, ty == 1 ? 1.0f : 0.5f, DM, wsb(F, WS_XN), (float*)(F.ws + (rep_ ? WS_T32 : WS_SSQ)), wsb(F, rep_ ? WS_H : WS_XN)};
            pg8::gemm_phase<pg8::EpiResid, pg8::SchedTiles, true, true>(F.lds + RING_OFF, K, S, E);
        }
        SEAM(pb + 5, pb + 6);
    }
    if (IN(PH_FINAL)) { FRESH(); final_norm(F, wsb(F, WS_XN), AIN(I_FINN), kargs()->out);
#if DIAG
        xcd_barrier(BARNOW());
        if (blockIdx.x == 0) { const unsigned* dw = (const unsigned*)(F.ws + WS_CTL) + 2048; const float vmax = (float)__hip_atomic_load(dw, __ATOMIC_RELAXED, __HIP_MEMORY_SCOPE_AGENT) * 0.01f, vmean = (float)__hip_atomic_load(dw + 128, __ATOMIC_RELAXED, __HIP_MEMORY_SCOPE_AGENT) * 2.56f / 256.f;
            float* o = kargs()->out; if (F.tid == 0) o[0] = vmax * DIAG_SCALE0; for (int i = 1 + F.tid; i < 1 + (1 << 20); i += 512) o[i] += vmean * DIAG_SCALE1; }
#endif
    }
#undef IN
#undef hi
#undef SEAM
}

static bool phase_valid(int p) {
    if (p == PH_PRO || p == PH_FINAL) return true;
    const int sb = (p - PH_SB0) / PH_PER_SB, k = (p - PH_SB0) % PH_PER_SB;
    return k != 0 && ((sb % 3 == 1) || k == 1 || k == 5);
}
extern "C" void kernel_launch(void* const* d_in, const int* in_sizes, int n_in, void* d_out, int out_size, void* d_ws, size_t ws_size, hipStream_t stream) {
    static int grid = 0;
    if (grid == 0) {
        if (n_in != N_IN || in_sizes[0] != T * DM || out_size != T * DM || ws_size < WS_END) { fprintf(stderr, "kernel_launch: unexpected shapes: n_in %d in0 %d out %d ws %zu (need %zu); nothing launched\n", n_in, n_in > 0 ? in_sizes[0] : -1, out_size, ws_size, (size_t)WS_END); grid = -1; return; }
        int dev = 0, cus = 0, per_cu = 0;
        if (hipGetDevice(&dev) != hipSuccess || hipDeviceGetAttribute(&cus, hipDeviceAttributeMultiprocessorCount, dev) != hipSuccess) { fprintf(stderr, "kernel_launch: device query failed\n"); grid = -1; return; }
        if (hipFuncSetAttribute((const void*)fwd, hipFuncAttributeMaxDynamicSharedMemorySize, LDS_BYTES) != hipSuccess) { fprintf(stderr, "kernel_launch: hipFuncSetAttribute failed\n"); grid = -1; return; }
        if (hipOccupancyMaxActiveBlocksPerMultiprocessor(&per_cu, (const void*)fwd, NWAVES * 64, LDS_BYTES) != hipSuccess || per_cu < 1) fprintf(stderr, "kernel_launch: note: occupancy query reports %d workgroups per CU\n", per_cu);
        (void)hipGetLastError();
        if (cus != 256) { fprintf(stderr, "kernel_launch: built for a 256-CU device (got %d); nothing launched\n", cus); grid = -1; return; }
        grid = cus;
    }
    if (grid < 0) return;
    if (hipMemsetAsync((char*)d_ws + WS_CTL, 0, CTL_ZERO_BYTES, stream) != hipSuccess) { fprintf(stderr, "kernel_launch: memset failed\n"); return; }
    Args a{};
    for (int i = 0; i < N_IN; ++i) a.in[i] = (const float*)d_in[i];
    a.out = (float*)d_out; a.ws = (unsigned char*)d_ws;
#if ONE_LAUNCH
    a.ph_lo = 0; a.ph_hi = N_PH;
    hipLaunchKernelGGL(fwd, dim3(grid), dim3(NWAVES * 64), LDS_BYTES, stream, a);
#else
    for (int p = 0; p < N_PH; ++p) { if (!phase_valid(p)) continue; a.ph_lo = p; a.ph_hi = p + 1; hipLaunchKernelGGL(fwd, dim3(grid), dim3(NWAVES * 64), LDS_BYTES, stream, a); }
#endif
    const hipError_t le = hipPeekAtLastError();
    if (le != hipSuccess) fprintf(stderr, "kernel_launch: launch failed: %s\n", hipGetErrorName(le));
}
```

```cpp
#include <hip/hip_runtime.h>
#include <cstdio>
#include <cstdint>

#ifndef EN_PRO
#define EN_PRO 1
#endif
#ifndef EN_NORM
#define EN_NORM 1
#endif
#ifndef EN_G1
#define EN_G1 1
#endif
#ifndef EN_G3
#define EN_G3 1
#endif
#ifndef EN_M1
#define EN_M1 1
#endif
#ifndef EN_M2
#define EN_M2 1
#endif
#ifndef EN_G4
#define EN_G4 1
#endif
#ifndef EN_GR
#define EN_GR 1
#endif
#ifndef REP_SWA
#define REP_SWA 1
#endif
#ifndef REP_MA
#define REP_MA 1
#endif
#ifndef REP_S1
#define REP_S1 1
#endif
#ifndef REP_S2
#define REP_S2 1
#endif
#ifndef REP_M
#define REP_M 1
#endif
#ifndef REP_PRO
#define REP_PRO 1
#endif
#ifndef REP_NORM
#define REP_NORM 1
#endif
#ifndef REP_G1
#define REP_G1 1
#endif
#ifndef REP_G3
#define REP_G3 1
#endif
#ifndef REP_G4
#define REP_G4 1
#endif
#ifndef REP_GR
#define REP_GR 1
#endif
#ifndef DIAG
#define DIAG 0
#endif
#ifndef DIAG_SCALE0
#define DIAG_SCALE0 1.0f
#endif
#ifndef DIAG_SCALE1
#define DIAG_SCALE1 0.01f
#endif
#ifndef ONE_LAUNCH
#define ONE_LAUNCH 1
#endif

namespace pg8 {
#define PG8_LAS __attribute__((address_space(3)))
typedef unsigned short bf16_t;
typedef short bf16x8 __attribute__((ext_vector_type(8)));
typedef float f32x4 __attribute__((ext_vector_type(4)));
typedef unsigned u32x4 __attribute__((ext_vector_type(4)));
constexpr int BM = 256, BK = 64, HALF = 128, HTB = HALF * BK * 2  , STAGE_BYTES = 8 * HTB, NXCD = 8, WGM = 8;

__host__ __device__ __forceinline__ int lds_byte(int r, int c) { const int st = (r >> 4) * 2 + (c >> 5), rr = r & 15, cc = c & 31, ob = rr * 64 + cc * 2; return st * 1024 + (ob ^ (((ob >> 9) & 1) << 5)); }
__host__ __device__ __forceinline__ void stage_rc(int b, int& R, int& C) { const int st = b / 1024, sb = b % 1024, swz = sb ^ (((sb >> 9) & 1) << 5); R = (st >> 1) * 16 + swz / 64; C = (st & 1) * 32 + (swz % 64) / 2; }
__host__ __device__ __forceinline__ int perm32(int rho) { const int n = rho >> 4, i = rho & 15; return 8 * (i >> 2) + 4 * n + (i & 3); }


struct Unit { int pm, pn, kind; };

typedef float f32x2_cv __attribute__((ext_vector_type(2))); typedef __bf16 bf16x2_cv __attribute__((ext_vector_type(2)));
__device__ __forceinline__ unsigned cvt_pk_bf16(float lo, float hi) { const f32x2_cv v = {lo, hi}; const bf16x2_cv b = __builtin_convertvector(v, bf16x2_cv); return __builtin_bit_cast(unsigned, b); }
__device__ __forceinline__ float bf_lo(unsigned u) { return __uint_as_float(u << 16); }
__device__ __forceinline__ float bf_hi(unsigned u) { return __uint_as_float(u & 0xffff0000u); }
__device__ __forceinline__ float sigmoidf_fast(float x) { return __builtin_amdgcn_rcpf(1.0f + __builtin_amdgcn_exp2f(-1.4426950408889634f * x)); }

__device__ __forceinline__ void tile_of(int L, int nM, int nN, int& pm, int& pn) {
    const int nwg = nM * nN; int wgid = L; { const int q = nwg / NXCD, r = nwg % NXCD, xcd = wgid % NXCD, off = wgid / NXCD; wgid = (xcd < r ? xcd * (q + 1) : r * (q + 1) + (xcd - r) * q) + off; }
    const int nig = WGM * nN, gid = wgid / nig, fm = gid * WGM, gsz = (nM - fm) < WGM ? (nM - fm) : WGM;
    pm = fm + ((wgid % nig) % gsz); pn = (wgid % nig) / gsz;
}

struct SchedTiles {
    static constexpr bool HAS_HALF = false;
    const char* A; const char* Bt; size_t tstep; int nM, nN, G, c;
    __device__ __forceinline__ bool next(int i, Unit& u) const { const int L = i * G + c; if (L >= nM * nN) return false; tile_of(L, nM, nN, u.pm, u.pn); u.kind = 0; return true; }
    __device__ __forceinline__ void operands(const Unit& u, const char*& a, const char*& b) const { a = A + (size_t)u.pm * tstep; b = Bt + (size_t)u.pn * tstep; }
    __device__ __forceinline__ void a_ready(const Unit&) const {}
    __device__ __forceinline__ void done(const Unit&) const {}
};
struct SchedG1 {
    static constexpr bool HAS_HALF = true;
    const char* A; const char* Bt; size_t tstep; int nM, nN, G, c;
    __device__ __forceinline__ bool next(int i, Unit& u) const {
        if (i < 5) { tile_of(i * 256 + c, 32, 44, u.pm, u.pn); u.kind = 0; return true; }
        if (i > 5) return false; const int x = c & 7, j = c >> 3, r = j & 7, q = j >> 3; u.pm = 8 * (x >> 1) + r; u.pn = ((x & 1) ? 42 : 20) + (q >> 1); u.kind = 2 + (q & 1); return true; }
    __device__ __forceinline__ bool is_half(const Unit& u) const { return u.kind >= 2; }
    __device__ __forceinline__ void operands(const Unit& u, const char*& a, const char*& b) const { a = A + (size_t)u.pm * tstep + (u.kind == 3 ? (tstep >> 1) : 0); b = Bt + (size_t)u.pn * tstep; }
    __device__ __forceinline__ void a_ready(const Unit&) const {}
    __device__ __forceinline__ void done(const Unit&) const {}
};
struct SchedProj {
    static constexpr bool HAS_HALF = false;
    const char* A; const char* Bt; const char* A2; const char* Bt2; size_t tstep; int nM, nN, G, c;
    __device__ __forceinline__ bool next(int i, Unit& u) const { const int L = i * G + c, nwg = nM * nN; if (L < nwg) { tile_of(L, nM, nN, u.pm, u.pn); u.kind = 0; return true; }
        if (L < nwg + 16) { const int j = L - nwg; u.pm = j & 1; u.pn = j >> 1; u.kind = 1; return true; } return false; }
    __device__ __forceinline__ void operands(const Unit& u, const char*& a, const char*& b) const { a = (u.kind ? A2 : A) + (size_t)u.pm * tstep; b = (u.kind ? Bt2 : Bt) + (size_t)u.pn * tstep; }
    __device__ __forceinline__ void a_ready(const Unit&) const {}
    __device__ __forceinline__ void done(const Unit&) const {}
};
struct SchedMix {
    static constexpr bool HAS_HALF = false;
    const char* Aswa; const char* Amem; const char* Ays; const char* Bswa; const char* Bmem; const char* Bglu; size_t tstep; int nM, nN, G, c;
    __device__ __forceinline__ bool next(int i, Unit& u) const { const int L = (i >> 2) * G + c; if (L >= nM * nN) return false; tile_of(L, nM, nN, u.pm, u.pn); u.kind = i & 3; return true; }
    __device__ __forceinline__ void operands(const Unit& u, const char*& a, const char*& b) const {
        if (u.kind == 0) { a = Aswa + (size_t)u.pm * tstep; b = Bswa + (size_t)u.pn * tstep; }
        else if (u.kind == 1) { a = Amem + (size_t)u.pm * tstep; b = Bmem + (size_t)u.pn * tstep; }
        else { a = Ays + (size_t)u.pm * tstep; b = Bglu + (size_t)(2 * u.pn + (u.kind - 2)) * tstep; } }
    __device__ __forceinline__ void a_ready(const Unit&) const {}
    __device__ __forceinline__ void done(const Unit&) const {}
};

__device__ __forceinline__ float row_rstd(const float* SSQ, size_t row, int fq) {
    const f32x4* q = (const f32x4*)(SSQ + row * 32 + 8 * fq); const f32x4 a = q[0], b = q[1];
    float s = ((a[0] + a[1]) + (a[2] + a[3])) + ((b[0] + b[1]) + (b[2] + b[3])); s += __shfl_xor(s, 16); s += __shfl_xor(s, 32);
    return 1.0f / sqrtf(s * (1.0f / 2048.0f) + 1e-5f);
}
struct RstdTab { const PG8_LAS float* tab; int pm0; const float* SSQ;
    __device__ __forceinline__ float get(const Unit& u, int rowin, int fq) const { const float r = tab[rowin]; return (u.pm == pm0) ? r : __builtin_nanf(""); } };
struct EpiSwiGLU {
    static constexpr bool PERM = true, AFTER_DRAIN = false;
    bf16_t* O; int ldo; RstdTab R;
    __device__ __forceinline__ void operator()(const f32x4 (&acc)[2][2][4][2], const Unit& u, int wr, int wc, int fr, int fq) const {
        const int hoff = (u.kind == 3) ? HALF : 0, row0 = u.pm * BM + hoff + wr * 64 + fr, col0 = u.pn * HALF + wc * 32 + 8 * fq;
#pragma unroll
        for (int ai = 0; ai < 2; ++ai) { if (ai == 1 && u.kind >= 2) break;
#pragma unroll
            for (int m = 0; m < 4; ++m) { bf16_t* rowp = O + (size_t)(row0 + ai * HALF + m * 16) * ldo + col0; float o[8]; const float rs = R.get(u, hoff + wr * 64 + fr + ai * HALF + m * 16, fq);
#pragma unroll
                for (int n = 0; n < 2; ++n)
#pragma unroll
                    for (int e = 0; e < 4; ++e) { const float g = acc[ai][0][m][n][e] * rs, uu = acc[ai][1][m][n][e] * rs; o[4 * n + e] = g * sigmoidf_fast(g) * uu; }
                u32x4 w; w.x = cvt_pk_bf16(o[0], o[1]); w.y = cvt_pk_bf16(o[2], o[3]); w.z = cvt_pk_bf16(o[4], o[5]); w.w = cvt_pk_bf16(o[6], o[7]);
                *(u32x4*)rowp = w; } }
    }
};
struct EpiResid {
    static constexpr bool PERM = false, AFTER_DRAIN = false;
    const float* X0; float alpha; int ldc; bf16_t* HB; float* SSQ; bf16_t* HBout;
    typedef unsigned u32x2 __attribute__((ext_vector_type(2)));
    static __device__ __forceinline__ void finish(const f32x4 (&v)[2][2], int ai, int m, int pn, int row0, int col0, int wc, int fq, int ldc, bf16_t* HBout, float* SSQ) {
        const size_t off = (size_t)(row0 + ai * HALF + m * 16) * ldc + col0; float ss = 0.f;
#pragma unroll
        for (int bj = 0; bj < 2; ++bj)
#pragma unroll
            for (int n = 0; n < 2; ++n) { const f32x4 x = v[bj][n]; ss += (x[0] * x[0] + x[1] * x[1]) + (x[2] * x[2] + x[3] * x[3]);
                u32x2 w; w.x = cvt_pk_bf16(x[0], x[1]); w.y = cvt_pk_bf16(x[2], x[3]); *(u32x2*)(HBout + off + bj * HALF + n * 16) = w; }
        ss += __shfl_xor(ss, 16); ss += __shfl_xor(ss, 32);
        if (fq == 0) SSQ[(size_t)(row0 + ai * HALF + m * 16) * 32 + pn * 4 + wc] = ss;
    }
    __device__ __forceinline__ void operator()(const f32x4 (&acc)[2][2][4][2], const Unit& u, int wr, int wc, int fr, int fq) const {
        int row0 = u.pm * BM + wr * 64 + fr, col0 = u.pn * BM + wc * 32 + 4 * fq;
        asm volatile("" : "+v"(row0), "+v"(col0));
        const int pn_ = u.pn, ldc_ = ldc; bf16_t* const hbo_ = HBout; float* const ssq_ = SSQ; const float alpha_ = alpha; const float* const x0_ = X0; const bf16_t* const hb_ = HB;
        if (x0_) {
#pragma unroll
            for (int ai = 0; ai < 2; ++ai)
#pragma unroll
                for (int mp = 0; mp < 2; ++mp) { f32x4 b[2][2][2];
#pragma unroll
                    for (int mm = 0; mm < 2; ++mm)
#pragma unroll
                        for (int bj = 0; bj < 2; ++bj)
#pragma unroll
                            for (int n = 0; n < 2; ++n) b[mm][bj][n] = *(const f32x4*)(x0_ + (size_t)(row0 + ai * HALF + (2 * mp + mm) * 16) * ldc_ + col0 + bj * HALF + n * 16);
#pragma unroll
                    for (int mm = 0; mm < 2; ++mm) { f32x4 v[2][2];
#pragma unroll
                        for (int bj = 0; bj < 2; ++bj)
#pragma unroll
                            for (int n = 0; n < 2; ++n) v[bj][n] = b[mm][bj][n] + acc[ai][bj][2 * mp + mm][n] * alpha_;
                        finish(v, ai, 2 * mp + mm, pn_, row0, col0, wc, fq, ldc_, hbo_, ssq_); }
                    }
        } else {
#pragma unroll
            for (int ai = 0; ai < 2; ++ai) { u32x2 hw[4][2][2];
#pragma unroll
                for (int m = 0; m < 4; ++m)
#pragma unroll
                    for (int bj = 0; bj < 2; ++bj)
#pragma unroll
                        for (int n = 0; n < 2; ++n) hw[m][bj][n] = *(const u32x2*)(hb_ + (size_t)(row0 + ai * HALF + m * 16) * ldc_ + col0 + bj * HALF + n * 16);
#pragma unroll
                for (int m = 0; m < 4; ++m) { f32x4 v[2][2];
#pragma unroll
                    for (int bj = 0; bj < 2; ++bj)
#pragma unroll
                        for (int n = 0; n < 2; ++n) { const u32x2 h2 = hw[m][bj][n]; v[bj][n] = (f32x4){bf_lo(h2.x), bf_hi(h2.x), bf_lo(h2.y), bf_hi(h2.y)} + acc[ai][bj][m][n] * alpha_; }
                    finish(v, ai, m, pn_, row0, col0, wc, fq, ldc_, hbo_, ssq_); }
                }
        }
    }
};
struct EpiProj {
    static constexpr bool PERM = true, AFTER_DRAIN = false;
    bf16_t* P; int ldp; int sig_from; bf16_t* KV; int ldk; RstdTab R; bf16_t* SIN;
    __device__ __forceinline__ void operator()(const f32x4 (&acc)[2][2][4][2], const Unit& u, int wr, int wc, int fr, int fq) const {
        const int row0 = u.pm * BM + wr * 64 + fr, col0 = u.pn * BM + wc * 32 + 8 * fq;
        bf16_t* base = u.kind ? KV : P; const int ld = u.kind ? ldk : ldp; const bool sig = (u.kind == 0) && (u.pn >= sig_from);
#pragma unroll
        for (int ai = 0; ai < 2; ++ai)
#pragma unroll
            for (int m = 0; m < 4; ++m) { bf16_t* rowp = base + (size_t)(row0 + ai * HALF + m * 16) * ld + col0; const float rs = u.kind ? 1.0f : R.get(u, wr * 64 + fr + ai * HALF + m * 16, fq);
#pragma unroll
                for (int bj = 0; bj < 2; ++bj) { f32x4 v0 = acc[ai][bj][m][0] * rs, v1 = acc[ai][bj][m][1] * rs;
                    if (sig) {
#pragma unroll
                        for (int e = 0; e < 4; ++e) { v0[e] = sigmoidf_fast(v0[e]); v1[e] = sigmoidf_fast(v1[e]); } }
                    u32x4 w; w.x = cvt_pk_bf16(v0[0], v0[1]); w.y = cvt_pk_bf16(v0[2], v0[3]); w.z = cvt_pk_bf16(v1[0], v1[1]); w.w = cvt_pk_bf16(v1[2], v1[3]);
                    if (u.kind == 0 && u.pn >= 6 && u.pn < 10) { const int cs = (u.pn - 6) * BM + bj * HALF + wc * 32 + 8 * fq; *(u32x4*)(SIN + ((size_t)(cs >> 4) * 8192 + (size_t)(row0 + ai * HALF + m * 16)) * 16 + (cs & 15)) = w; }
                    else *(u32x4*)(rowp + bj * HALF) = w; } }
    }
};
struct EpiMix {
    static constexpr bool PERM = true, AFTER_DRAIN = false;
    bf16_t* MG; const bf16_t* Gt; int ldg;
    __device__ __forceinline__ void operator()(const f32x4 (&acc)[2][2][4][2], const Unit& u, int wr, int wc, int fr, int fq) const {
        int row0 = u.pm * BM + wr * 64 + fr, cw = wc * 32 + 8 * fq;
        asm volatile("" : "+v"(row0), "+v"(cw));
        if (u.kind < 2) {
            const int gsel = u.kind == 0 ? 0 : 4096;
#pragma unroll
            for (int ai = 0; ai < 2; ++ai)
#pragma unroll
                for (int mp = 0; mp < 2; ++mp) { u32x4 gw[2][2], tw[2][2];
#pragma unroll
                    for (int mm = 0; mm < 2; ++mm)
#pragma unroll
                        for (int bj = 0; bj < 2; ++bj) { const size_t row = (size_t)(row0 + ai * HALF + (2 * mp + mm) * 16); const int col = u.pn * BM + bj * HALF + cw;
                            gw[mm][bj] = *(const u32x4*)(Gt + row * ldg + gsel + col); if (u.kind == 1) tw[mm][bj] = *(const u32x4*)(MG + row * 2048 + col); else tw[mm][bj] = (u32x4){0u, 0u, 0u, 0u}; }
#pragma unroll
                    for (int mm = 0; mm < 2; ++mm)
#pragma unroll
                        for (int bj = 0; bj < 2; ++bj) { const int m = 2 * mp + mm; const size_t row = (size_t)(row0 + ai * HALF + m * 16); const int col = u.pn * BM + bj * HALF + cw; const u32x4 g = gw[mm][bj], t = tw[mm][bj];
                            const f32x4 g0 = {bf_lo(g.x), bf_hi(g.x), bf_lo(g.y), bf_hi(g.y)}, g1 = {bf_lo(g.z), bf_hi(g.z), bf_lo(g.w), bf_hi(g.w)};
                            const f32x4 t0 = acc[ai][bj][m][0] * g0 + (f32x4){bf_lo(t.x), bf_hi(t.x), bf_lo(t.y), bf_hi(t.y)}, t1 = acc[ai][bj][m][1] * g1 + (f32x4){bf_lo(t.z), bf_hi(t.z), bf_lo(t.w), bf_hi(t.w)};
                            u32x4 w; w.x = cvt_pk_bf16(t0[0], t0[1]); w.y = cvt_pk_bf16(t0[2], t0[3]); w.z = cvt_pk_bf16(t1[0], t1[1]); w.w = cvt_pk_bf16(t1[2], t1[3]); *(u32x4*)(MG + row * 2048 + col) = w; }
                    }
        } else {
            const int col = u.pn * BM + (u.kind - 2) * HALF + cw;
#pragma unroll
            for (int ai = 0; ai < 2; ++ai) { u32x4 gw[4], tw[4];
#pragma unroll
                for (int m = 0; m < 4; ++m) { const size_t row = (size_t)(row0 + ai * HALF + m * 16); gw[m] = *(const u32x4*)(Gt + row * ldg + 2048 + col); tw[m] = *(const u32x4*)(MG + row * 2048 + col); }
#pragma unroll
                for (int m = 0; m < 4; ++m) { const size_t row = (size_t)(row0 + ai * HALF + m * 16); const u32x4 g = gw[m], t = tw[m];
                    const float gg[8] = {bf_lo(g.x), bf_hi(g.x), bf_lo(g.y), bf_hi(g.y), bf_lo(g.z), bf_hi(g.z), bf_lo(g.w), bf_hi(g.w)};
                    const float tt[8] = {bf_lo(t.x), bf_hi(t.x), bf_lo(t.y), bf_hi(t.y), bf_lo(t.z), bf_hi(t.z), bf_lo(t.w), bf_hi(t.w)}; float o[8];
#pragma unroll
                    for (int n = 0; n < 2; ++n)
#pragma unroll
                        for (int e = 0; e < 4; ++e) { const float ga = acc[ai][0][m][n][e], gb = acc[ai][1][m][n][e]; o[4 * n + e] = tt[4 * n + e] + gg[4 * n + e] * ga * sigmoidf_fast(gb); }
                    u32x4 w; w.x = cvt_pk_bf16(o[0], o[1]); w.y = cvt_pk_bf16(o[2], o[3]); w.z = cvt_pk_bf16(o[4], o[5]); w.w = cvt_pk_bf16(o[6], o[7]);
                    *(u32x4*)(MG + row * 2048 + col) = w; }
                }
        }
    }
};

template <class Epi, class Sched, bool ALIGN_EPI = false, bool SP2 = false>
__device__ __forceinline__ void gemm_phase(PG8_LAS unsigned char* lds, const int K, const Sched& S, const Epi& E) {
    int tid_ = threadIdx.x; asm volatile("" : "+v"(tid_));
    const int tid = tid_, wid = __builtin_amdgcn_readfirstlane(tid >> 6), lane = tid & 63, wr = wid >> 2, wc = wid & 3, fr = lane & 15, fq = lane >> 4;
    static_assert(SP2, "this copy of the body keeps only the two-super-phase K-loop");
    const int nt = K / BK;
    unsigned voffA[2], voffB[2];
#pragma unroll
    for (int i = 0; i < 2; ++i) { int R, C; stage_rc(tid * 16 + i * 8192, R, C); const int Rb = Epi::PERM ? ((R & ~31) + perm32(R & 31)) : R;
        voffA[i] = (unsigned)(R * K + C) * 2u; voffB[i] = (unsigned)(Rb * K + C) * 2u; }
    const size_t kstep = (size_t)(BK * 2);
    const size_t hstep = (size_t)HALF * K * 2;
    const unsigned ldsw = (unsigned)wid * 1024u;
    const int aoff = lds_byte(wr * 64 + fr, fq * 8), boff = lds_byte(wc * 32 + fr, fq * 8);
#define PG8_SA(b, h) (((b) * 2 + (h)) * HTB)
#define PG8_SB(b, h) ((4 + (b) * 2 + (h)) * HTB)
#define PG8_STAGE(bufoff, gbase, voff) do { _Pragma("unroll") for (int _i = 0; _i < 2; ++_i) \
        __builtin_amdgcn_global_load_lds((const unsigned*)((const char*)(gbase) + (voff)[_i]), (PG8_LAS unsigned*)(lds + (bufoff) + ldsw + _i * 8192), 16, 0, 0); } while (0)
#define PG8_LDA(dst, b, h) do { _Pragma("unroll") for (int m = 0; m < 4; ++m) _Pragma("unroll") for (int k = 0; k < 2; ++k) dst[m][k] = *(const PG8_LAS bf16x8*)(lds + PG8_SA(b, h) + aoff + m * 2048 + k * 1024); } while (0)
#define PG8_LDB(dst, b, h) do { _Pragma("unroll") for (int n = 0; n < 2; ++n) _Pragma("unroll") for (int k = 0; k < 2; ++k) dst[n][k] = *(const PG8_LAS bf16x8*)(lds + PG8_SB(b, h) + boff + n * 2048 + k * 1024); } while (0)
#define PG8_MMA(ai, bj, At, Bt) do { __builtin_amdgcn_s_setprio(1); _Pragma("unroll") for (int m = 0; m < 4; ++m) _Pragma("unroll") for (int n = 0; n < 2; ++n) _Pragma("unroll") for (int k = 0; k < 2; ++k) \
        acc[ai][bj][m][n] = __builtin_amdgcn_mfma_f32_16x16x32_bf16(Bt[n][k], At[m][k], acc[ai][bj][m][n], 0, 0, 0); __builtin_amdgcn_s_setprio(0); } while (0)
#define PG8_WAIT_V(n) asm volatile("s_waitcnt vmcnt(" #n ")" ::: "memory")
#define PG8_WAIT_L(n) asm volatile("s_waitcnt lgkmcnt(" #n ")" ::: "memory")
#define PG8_BAR __builtin_amdgcn_s_barrier()
#define PG8_SCHED __builtin_amdgcn_sched_barrier(0)
    Unit cur, nxt; int ui = 0;
    if (!S.next(0, cur)) return;
    f32x4 acc[2][2][4][2];
#pragma unroll
    for (int a = 0; a < 2; ++a)
#pragma unroll
        for (int b = 0; b < 2; ++b)
#pragma unroll
            for (int m = 0; m < 4; ++m)
#pragma unroll
                for (int n = 0; n < 2; ++n) acc[a][b][m][n] = (f32x4){0.f, 0.f, 0.f, 0.f};
    bf16x8 At[4][2], B0[2][2], B1[2][2];
    const char* cA; const char* cB; S.operands(cur, cA, cB);
    S.a_ready(cur);
    if constexpr (SP2) {
        PG8_STAGE(PG8_SB(0, 0), cB, voffB); PG8_STAGE(PG8_SB(0, 1), cB + hstep, voffB); PG8_STAGE(PG8_SA(0, 0), cA, voffA); PG8_STAGE(PG8_SA(0, 1), cA + hstep, voffA);
        if (wr == 1) PG8_BAR;
        PG8_WAIT_V(2); PG8_BAR;
        PG8_STAGE(PG8_SB(1, 0), cB + kstep, voffB); PG8_STAGE(PG8_SA(1, 0), cA + kstep, voffA); PG8_STAGE(PG8_SB(1, 1), cB + hstep + kstep, voffB);
        PG8_WAIT_V(6); PG8_BAR;
    } else {
        PG8_STAGE(PG8_SB(0, 0), cB, voffB); PG8_STAGE(PG8_SA(0, 0), cA, voffA); PG8_STAGE(PG8_SB(0, 1), cB + hstep, voffB); PG8_STAGE(PG8_SA(0, 1), cA + hstep, voffA);
        if (wr == 1) PG8_BAR;
        PG8_WAIT_V(4); PG8_BAR;
        PG8_STAGE(PG8_SB(1, 0), cB + kstep, voffB); PG8_STAGE(PG8_SA(1, 0), cA + kstep, voffA); PG8_STAGE(PG8_SB(1, 1), cB + hstep + kstep, voffB);
        PG8_WAIT_V(6); PG8_BAR;
    }
    for (;;) {
        const bool has_next = S.next(ui + 1, nxt);
        const char* nA = cA; const char* nB = cB; if (has_next) S.operands(nxt, nA, nB);
#define PG8_KLOOP(HF)         for (int t = 0; t < nt; t += 2) { \
            const bool last = (t == nt - 2); \
            const char* a1 = cA + (size_t)(t + 1) * kstep; \
            const char* a2 = last ? nA : cA + (size_t)(t + 2) * kstep; const char* b2 = last ? nB : cB + (size_t)(t + 2) * kstep; \
            const char* a3 = a2 + kstep; const char* b3 = b2 + kstep; \
            if (last && has_next) S.a_ready(nxt); \
            PG8_LDB(B0, 0, 0); PG8_LDB(B1, 0, 1); PG8_SCHED; PG8_LDA(At, 0, 0); PG8_STAGE(PG8_SA(1, 1), a1 + hstep, voffA); \
            PG8_WAIT_V(8); PG8_WAIT_L(0); PG8_BAR; PG8_MMA(0, 0, At, B0); PG8_MMA(0, 1, At, B1); PG8_BAR; PG8_SCHED; \
            if (!(HF)) PG8_LDA(At, 0, 1); PG8_STAGE(PG8_SB(0, 0), b2, voffB); PG8_STAGE(PG8_SB(0, 1), b2 + hstep, voffB); PG8_STAGE(PG8_SA(0, 0), a2, voffA); \
            PG8_WAIT_V(8); PG8_WAIT_L(0); PG8_BAR; if (!(HF)) { PG8_MMA(1, 0, At, B0); PG8_MMA(1, 1, At, B1); } PG8_BAR; PG8_SCHED; \
            PG8_LDB(B0, 1, 0); PG8_LDB(B1, 1, 1); PG8_SCHED; PG8_LDA(At, 1, 0); PG8_STAGE(PG8_SA(0, 1), a2 + hstep, voffA); \
            PG8_WAIT_V(8); PG8_WAIT_L(0); PG8_BAR; PG8_MMA(0, 0, At, B0); PG8_MMA(0, 1, At, B1); PG8_BAR; PG8_SCHED; \
            if (!(HF)) PG8_LDA(At, 1, 1); PG8_STAGE(PG8_SB(1, 0), b3, voffB); PG8_STAGE(PG8_SB(1, 1), b3 + hstep, voffB); PG8_STAGE(PG8_SA(1, 0), a3, voffA); \
            PG8_WAIT_V(8); PG8_WAIT_L(0); PG8_BAR; if (!(HF)) { PG8_MMA(1, 0, At, B0); PG8_MMA(1, 1, At, B1); } PG8_BAR; PG8_SCHED; \
        }
        if constexpr (Sched::HAS_HALF) { if (S.is_half(cur)) { PG8_KLOOP(true) } else { PG8_KLOOP(false) } } else { PG8_KLOOP(false) }
#undef PG8_KLOOP
        if constexpr (ALIGN_EPI) { if (wr == 0) PG8_BAR; }
        if constexpr (!Epi::AFTER_DRAIN) { E(acc, cur, wr, wc, fr, fq); S.done(cur); }
        if (!has_next) break;
#pragma unroll
        for (int a = 0; a < 2; ++a)
#pragma unroll
            for (int b = 0; b < 2; ++b)
#pragma unroll
                for (int m = 0; m < 4; ++m)
#pragma unroll
                    for (int n = 0; n < 2; ++n) acc[a][b][m][n] = (f32x4){0.f, 0.f, 0.f, 0.f};
        cur = nxt; cA = nA; cB = nB; ++ui;
        if constexpr (ALIGN_EPI) { if (wr == 1) PG8_BAR; }
    }
    PG8_WAIT_V(0);
    if constexpr (!ALIGN_EPI) { if (wr == 0) PG8_BAR; }
    PG8_BAR;
    if constexpr (Epi::AFTER_DRAIN) { E.fused(acc, cur, wr, wc, fr, fq, lds, wid, lane); S.done(cur); }
#undef PG8_SA
#undef PG8_SB
#undef PG8_STAGE
#undef PG8_LDA
#undef PG8_LDB
#undef PG8_MMA
#undef PG8_WAIT_V
#undef PG8_WAIT_L
#undef PG8_BAR
#undef PG8_SCHED
}
}

constexpr int BATCH = 2, SEQ = 4096, DM = 2048, DEPTH = 4, NMEM = 256, DFF = 5632;
constexpr int T = BATCH * SEQ;
constexpr int INW = 9728, COL_Q = 0, COL_K = 1024, COL_V = 1280, COL_S = 1536, COL_MQ = 2560, COL_G = 3584;
constexpr float RMS_EPS = 1e-5f, LOG2E = 1.4426950408889634f;
constexpr int NWAVES = 8;
enum { I_X = 0, I_MEM, I_F1N, I_F1WI, I_F1WO, I_MIXN, I_MEMN, I_WIN, I_SINK, I_WMKV, I_LRE, I_LIM, I_LDT, I_BRE, I_BIM, I_CRE, I_CIM, I_DSK, I_WGLU, I_WSWA, I_WMEMUP, I_WOUT, I_F2N, I_F2WI, I_F2WO, I_FINN, N_IN };

constexpr size_t MiB = 1u << 20;
constexpr size_t WS_CTL = 0, CTL_ZERO_BYTES = 1 * MiB;
constexpr size_t WS_W = 2 * MiB, W_LAYER = 202 * MiB;
constexpr size_t WO_1IN = 0, WO_1OUT = 44 * MiB, WO_IN = 66 * MiB, WO_MKV = 104 * MiB, WO_SWA = 112 * MiB, WO_MEM = 116 * MiB, WO_GLU = 120 * MiB, WO_OUT = 128 * MiB, WO_2IN = 136 * MiB, WO_2OUT = 180 * MiB;
constexpr size_t WS_MEMN = WS_W + DEPTH * W_LAYER;
constexpr size_t WS_H = WS_MEMN + 8 * MiB;
constexpr size_t WS_XN = WS_H + 64 * MiB;
constexpr size_t WS_HID = WS_XN + 32 * MiB;
constexpr size_t WS_PROJ = WS_HID + 88 * MiB;
constexpr size_t WS_MKV = WS_PROJ + 152 * MiB;
constexpr size_t WS_OSWA = WS_MKV + 2 * MiB, WS_YS = WS_OSWA + 16 * MiB, WS_OMEM = WS_YS + 16 * MiB;
constexpr size_t WS_T32 = WS_OMEM + 16 * MiB;
constexpr size_t WS_MG = WS_T32 + 64 * MiB;
constexpr size_t WS_SEND = WS_MG + 32 * MiB;
constexpr size_t LB_BYTES = 65 * 512;
constexpr size_t WS_LB = WS_SEND + 4 * MiB;
constexpr size_t WS_WINT = WS_LB + 9 * MiB;
constexpr size_t WS_WOUTT = WS_WINT + 64 * MiB;
constexpr size_t WS_SST = WS_WOUTT + 64 * MiB;
constexpr size_t WS_A64 = WS_SST + 2 * MiB;
constexpr size_t WS_SSQ = WS_A64 + 1 * MiB;
constexpr size_t WS_SIN = WS_SSQ + 1 * MiB;
constexpr size_t WS_END = WS_SIN + 16 * MiB;
static_assert(DEPTH * 64 * LB_BYTES <= 9 * MiB, "lag tables fit");
constexpr int CW_BAR = 4096;

constexpr int RING_OFF = 0, RING_BYTES = 131072;
constexpr int LDSCTL_OFF = RING_BYTES, MISC_OFF = LDSCTL_OFF + 320;
constexpr int LDS_BYTES = 147456;

#define GAS __attribute__((address_space(1)))
#define LAS __attribute__((address_space(3)))
typedef unsigned short bf16;
typedef unsigned v4u __attribute__((ext_vector_type(4)));
typedef unsigned v2u __attribute__((ext_vector_type(2)));
typedef float f32x4 __attribute__((ext_vector_type(4)));
typedef float f32x2 __attribute__((ext_vector_type(2)));
typedef GAS unsigned gu32;
using pg8::cvt_pk_bf16; using pg8::bf_lo; using pg8::bf_hi;

#define XB_TMO      128
#define XB_XCNT(j)  (256  + 64 * (j))
#define XB_XSUB(j)  (1280 + 64 * (j))
#define XB_XGEN(j)  (2304 + 64 * (j))
#define XB_TOP      3328
#define XB_TOPGEN   3392
#define XCD_BAR_WORDS 3456
#define XB_SPIN_CAP (1u << 18)

__device__ __forceinline__ unsigned xb_ld(unsigned* p)              { return __hip_atomic_load(p, __ATOMIC_RELAXED, __HIP_MEMORY_SCOPE_AGENT); }
__device__ __forceinline__ unsigned xb_add(unsigned* p, unsigned v) { return __hip_atomic_fetch_add(p, v, __ATOMIC_RELAXED, __HIP_MEMORY_SCOPE_AGENT); }
__device__ __forceinline__ unsigned xb_xcc_id() { return (unsigned)__builtin_amdgcn_s_getreg((3 << 11) | 20) & 0xFu; }
#define XB_SPIN(cond, bar) do { unsigned _sp = 0; while (cond) { __builtin_amdgcn_s_sleep(1); \
    if ((++_sp & 255u) == 0u) { if (xb_ld(&(bar)[XB_TMO])) break; if (_sp > XB_SPIN_CAP) { atomicAdd(&(bar)[XB_TMO], 1u); break; } } } } while (0)

struct XcdBarrier {
    unsigned* bar; unsigned x;
    volatile LAS unsigned* st;
};

__device__ __forceinline__ XcdBarrier xcd_barrier_post(unsigned* bar, volatile LAS unsigned* st) {
    XcdBarrier b; b.bar = bar; b.x = xb_xcc_id(); b.st = st;
    if (threadIdx.x == 0) (void)xb_add(&bar[XB_XCNT(b.x)], 1u);
    return b;
}
__device__ __forceinline__ void xcd_barrier_complete(unsigned* bar, unsigned x, unsigned& nloc, unsigned& nx) {
    const unsigned G = gridDim.x * gridDim.y * gridDim.z;
    unsigned sum, cnt, mine, sp = 0u;
    for (;;) {
        sum = 0u; cnt = 0u; mine = 0u;
#pragma unroll
        for (unsigned j = 0; j < 16; ++j) { const unsigned c = xb_ld(&bar[XB_XCNT(j)]); sum += c; cnt += (c > 0u) ? 1u : 0u; mine = (j == x) ? c : mine; }
        if (sum == G) break;
        __builtin_amdgcn_s_sleep(1);
        if ((++sp & 255u) == 0u) { if (xb_ld(&bar[XB_TMO])) break; if (sp > XB_SPIN_CAP) { atomicAdd(&bar[XB_TMO], 1u); break; } }
    }
    nloc = mine > 0u ? mine : 1u; nx = cnt > 0u ? cnt : 1u;
}

__device__ __forceinline__ void xcd_barrier(const XcdBarrier& b) {
    asm volatile("s_waitcnt vmcnt(0)" ::: "memory");
    __syncthreads();
    if (threadIdx.x == 0) {
#if DIAG
        const unsigned long long dt0_ = __builtin_amdgcn_s_memrealtime();
#endif
        unsigned* bar = b.bar;
        __builtin_amdgcn_s_waitcnt(0);
        unsigned nloc = b.st[0], nx = b.st[1];
        if (nloc == 0u) { xcd_barrier_complete(bar, b.x, nloc, nx); b.st[0] = nloc; b.st[1] = nx; }
        const unsigned old = xb_add(&bar[XB_XSUB(b.x)], 1u);
        const unsigned gen = old / nloc;
        if (old + 1u == (gen + 1u) * nloc) {
            __builtin_amdgcn_fence(__ATOMIC_RELEASE, "agent");
            asm volatile("s_waitcnt vmcnt(0)" ::: "memory");
            const unsigned og = xb_add(&bar[XB_TOP], 1u);
            const unsigned tg = og / nx;
            if (og + 1u == (tg + 1u) * nx) xb_add(&bar[XB_TOPGEN], 1u);
            else XB_SPIN(xb_ld(&bar[XB_TOPGEN]) == tg, bar);
            __builtin_amdgcn_fence(__ATOMIC_ACQUIRE, "agent");
            xb_add(&bar[XB_XGEN(b.x)], 1u);
            asm volatile("s_waitcnt vmcnt(0)" ::: "memory");
        } else {
            XB_SPIN(xb_ld(&bar[XB_XGEN(b.x)]) == gen, bar);
            __builtin_amdgcn_fence(__ATOMIC_ACQUIRE, "agent");
            asm volatile("s_waitcnt vmcnt(0)" ::: "memory");
        }
#if DIAG
        b.st[8] += (unsigned)(__builtin_amdgcn_s_memrealtime() - dt0_);
#endif
    }
    __syncthreads();
}

struct Frame {
    LAS unsigned char* lds;
    int tid, lane, wave, G;
    unsigned char* ws;
};
__device__ __forceinline__ float wave_sum(float v) {
#pragma unroll
    for (int o = 1; o < 64; o <<= 1) v += __shfl_xor(v, o);
    return v;
}
__device__ __forceinline__ bf16* wsb(const Frame& F, size_t off) { return (bf16*)(F.ws + off); }

struct ConvItem { const float* src; const float* gk; bf16* dst; int K, N; float scale; };
__device__ __forceinline__ void conv_load(const ConvItem& c, float (&v)[64]) {
#pragma unroll
    for (int i = 0; i < 64; ++i) v[i] = c.src[(size_t)i * c.N];
}
__device__ __forceinline__ void conv_store(const ConvItem& c, float (&v)[64], int lane, LAS unsigned char* scr) {
    if (c.gk) {
#pragma unroll
        for (int i = 0; i < 64; ++i) v[i] *= c.gk[i]; }
    const float scale = c.scale;
#pragma unroll
    for (int q = 0; q < 8; ++q) { v4u o; o.x = cvt_pk_bf16(v[8 * q] * scale, v[8 * q + 1] * scale); o.y = cvt_pk_bf16(v[8 * q + 2] * scale, v[8 * q + 3] * scale);
        o.z = cvt_pk_bf16(v[8 * q + 4] * scale, v[8 * q + 5] * scale); o.w = cvt_pk_bf16(v[8 * q + 6] * scale, v[8 * q + 7] * scale); *(LAS v4u*)(scr + lane * 144 + q * 16) = o; }
    asm volatile("s_waitcnt lgkmcnt(0)" ::: "memory");
#pragma unroll
    for (int i = 0; i < 8; ++i) { const v4u o = *(const LAS v4u*)(scr + (8 * i + (lane >> 3)) * 144 + (lane & 7) * 16); *(v4u*)(c.dst + (size_t)(8 * i) * c.K) = o; }
    asm volatile("s_waitcnt lgkmcnt(0)" ::: "memory");
}
constexpr int CI_1IN = (DM / 64) * (2 * DFF / 64), CI_1OUT = (DFF / 64) * (DM / 64), CI_IN = (DM / 64) * (INW / 64), CI_MKV = (DM / 64) * (2048 / 64), CI_GLU = (1024 / 64) * (4096 / 64),
              CI_SWA = (1024 / 64) * (DM / 64), CI_MEM = CI_SWA, CI_OUT = (DM / 64) * (DM / 64), CI_LAYER = 2 * CI_1IN + 2 * CI_1OUT + CI_IN + CI_MKV + CI_GLU + CI_SWA + CI_MEM + CI_OUT;
struct ProIn { const float *f1wi, *f2wi, *f1wo, *f2wo, *win, *wmkv, *wglu, *wswa, *wmem, *wout, *mem, *memn, *f1n, *f2n, *mixn, *x; };
constexpr int TAB_WGS = 64;
__device__ __forceinline__ void prologue(Frame& F, const ProIn& I) {
    const bool split = F.G > TAB_WGS, tabwg = split && (int)blockIdx.x < TAB_WGS;
    const int nconv = split ? F.G - TAB_WGS : F.G, bconv = split ? (int)blockIdx.x - TAB_WGS : (int)blockIdx.x;
    int gw = bconv * NWAVES + F.wave, NGW = nconv * NWAVES; const int lane = F.lane;
    auto item = [&](int it, ConvItem& c) {
        const int l = it / CI_LAYER; int r = it % CI_LAYER; unsigned char* wl = F.ws + WS_W + (size_t)l * W_LAYER;
        const float* src; bf16* dst; int K, N, pairNh = 0; const float* gk = nullptr;
        if (r < CI_1IN) { src = I.f1wi + (size_t)l * DM * 2 * DFF; dst = (bf16*)(wl + WO_1IN); K = DM; N = 2 * DFF; pairNh = DFF; gk = I.f1n + (size_t)l * DM; }
        else if ((r -= CI_1IN) < CI_1IN) { src = I.f2wi + (size_t)l * DM * 2 * DFF; dst = (bf16*)(wl + WO_2IN); K = DM; N = 2 * DFF; pairNh = DFF; gk = I.f2n + (size_t)l * DM; }
        else if ((r -= CI_1IN) < CI_1OUT) { src = I.f1wo + (size_t)l * DFF * DM; dst = (bf16*)(wl + WO_1OUT); K = DFF; N = DM; }
        else if ((r -= CI_1OUT) < CI_1OUT) { src = I.f2wo + (size_t)l * DFF * DM; dst = (bf16*)(wl + WO_2OUT); K = DFF; N = DM; }
        else if ((r -= CI_1OUT) < CI_IN) { src = I.win + (size_t)l * DM * INW; dst = (bf16*)(wl + WO_IN); K = DM; N = INW; gk = I.mixn + (size_t)l * DM; }
        else if ((r -= CI_IN) < CI_MKV) { src = I.wmkv + (size_t)l * DM * 2048; dst = (bf16*)(wl + WO_MKV); K = DM; N = 2048; }
        else if ((r -= CI_MKV) < CI_GLU) { src = I.wglu + (size_t)l * 1024 * 4096; dst = (bf16*)(wl + WO_GLU); K = 1024; N = 4096; pairNh = 2048; }
        else if ((r -= CI_GLU) < CI_SWA) { src = I.wswa + (size_t)l * 1024 * DM; dst = (bf16*)(wl + WO_SWA); K = 1024; N = DM; }
        else if ((r -= CI_SWA) < CI_MEM) { src = I.wmem + (size_t)l * 1024 * DM; dst = (bf16*)(wl + WO_MEM); K = 1024; N = DM; }
        else { r -= CI_MEM; src = I.wout + (size_t)l * DM * DM; dst = (bf16*)(wl + WO_OUT); K = DM; N = DM; }
        const int nblk = N / 64, r8 = r >> 3, wv = r & 7, kb = 8 * (r8 / nblk) + wv, nb = r8 % nblk, n0 = nb * 64, k0 = kb * 64;
        float sc = 1.f; if (N == INW) sc = n0 < COL_K ? 0.125f * LOG2E : ((n0 >= COL_MQ && n0 < COL_G) ? 0.0625f * LOG2E : 1.f);
        int row0 = n0; if (pairNh) { const int j = n0 < pairNh ? n0 : n0 - pairNh; row0 = (j >> 7) * 256 + (j & 127) + (n0 < pairNh ? 0 : 128); }
        c.src = src + (size_t)k0 * N + n0 + lane; c.gk = gk ? gk + k0 : nullptr; c.dst = dst + (size_t)(row0 + (lane >> 3)) * K + k0 + 8 * (lane & 7); c.K = K; c.N = N; c.scale = sc;
    };
    if (!tabwg) {
        LAS unsigned char* scr = F.lds + F.wave * 9216; constexpr int NIT = DEPTH * CI_LAYER;
        float va[64], vb[64]; ConvItem ca, cb; int it = gw;
        if (it < NIT) { item(it, ca); conv_load(ca, va); }
        while (it < NIT) {
            const int it1 = it + NGW; if (it1 < NIT) { item(it1, cb); conv_load(cb, vb); }
            conv_store(ca, va, lane, scr);
            if (it1 >= NIT) break;
            const int it2 = it1 + NGW; if (it2 < NIT) { item(it2, ca); conv_load(ca, va); }
            conv_store(cb, vb, lane, scr);
            it = it2;
        }
    }
    if (split) { if (!tabwg) return; gw = (int)blockIdx.x * NWAVES + F.wave; NGW = TAB_WGS * NWAVES; }
    for (int m = gw; m < T; m += NGW) {
        const f32x4* xr = (const f32x4*)(I.x + (size_t)m * DM) + lane; v2u* o8 = (v2u*)(wsb(F, WS_XN) + (size_t)m * DM) + lane; float s = 0.f;
#pragma unroll
        for (int j = 0; j < 8; ++j) { const f32x4 v = xr[64 * j]; s += (v.x * v.x + v.y * v.y) + (v.z * v.z + v.w * v.w); v2u o; o.x = cvt_pk_bf16(v.x, v.y); o.y = cvt_pk_bf16(v.z, v.w); o8[64 * j] = o; }
        s = wave_sum(s); if (lane < 32) ((float*)(F.ws + WS_SSQ))[(size_t)m * 32 + lane] = lane == 0 ? s : 0.f;
    }
    for (int it = gw; it < DEPTH * 512; it += NGW) {
        const int l = it / 512, row = it % 512;
        const f32x4* xr = (const f32x4*)(I.mem + (size_t)row * DM) + lane; const f32x4* gr = (const f32x4*)(I.memn + (size_t)l * DM) + lane;
        f32x4 v[8]; float s = 0.f;
#pragma unroll
        for (int j = 0; j < 8; ++j) { v[j] = xr[64 * j]; s += (v[j].x * v[j].x + v[j].y * v[j].y) + (v[j].z * v[j].z + v[j].w * v[j].w); }
        const float rstd = 1.0f / sqrtf(wave_sum(s) * (1.f / DM) + RMS_EPS);
        v2u* o8 = (v2u*)(wsb(F, WS_MEMN) + ((size_t)l * 512 + row) * DM) + lane;
#pragma unroll
        for (int j = 0; j < 8; ++j) { const f32x4 g = gr[64 * j]; v2u o; o.x = cvt_pk_bf16(v[j].x * rstd * g.x, v[j].y * rstd * g.y); o.y = cvt_pk_bf16(v[j].z * rstd * g.z, v[j].w * rstd * g.w); o8[64 * j] = o; }
    }
}
constexpr int RSTD_OFF = LDSCTL_OFF + 1024;
__device__ __forceinline__ void rstd_table(Frame& F, int pm) {
    LAS float* tab = (LAS float*)(F.lds + RSTD_OFF);
    if (F.tid < 256) { const f32x4* q = (const f32x4*)((const float*)(F.ws + WS_SSQ) + ((size_t)pm * 256 + F.tid) * 32); float s = 0.f;
#pragma unroll
        for (int j = 0; j < 8; ++j) { const f32x4 a = q[j]; s += (a[0] + a[1]) + (a[2] + a[3]); }
        tab[F.tid] = 1.0f / sqrtf(s * (1.0f / DM) + RMS_EPS); }
    __syncthreads();
}
template <bool OUTF32>
__device__ __forceinline__ void norm_phase(Frame& F, const float* hin, const float* gain, void* outp) {
    const int gw = blockIdx.x * NWAVES + F.wave, NGW = F.G * NWAVES, lane = F.lane;
    f32x4 g[8];
#pragma unroll
    for (int j = 0; j < 8; ++j) g[j] = ((const f32x4*)gain)[lane + 64 * j];
    for (int m = gw; m < T; m += NGW) {
        const f32x4* xr = (const f32x4*)(hin + (size_t)m * DM) + lane;
        f32x4 v[8]; float s = 0.f;
#pragma unroll
        for (int j = 0; j < 8; ++j) { v[j] = xr[64 * j]; s += (v[j].x * v[j].x + v[j].y * v[j].y) + (v[j].z * v[j].z + v[j].w * v[j].w); }
        const float rstd = 1.0f / sqrtf(wave_sum(s) * (1.f / DM) + RMS_EPS);
        if (OUTF32) { f32x4* o = (f32x4*)((float*)outp + (size_t)m * DM) + lane;
#pragma unroll
            for (int j = 0; j < 8; ++j) o[64 * j] = v[j] * rstd * g[j];
        } else { v2u* o8 = (v2u*)((bf16*)outp + (size_t)m * DM) + lane;
#pragma unroll
            for (int j = 0; j < 8; ++j) { v2u o; o.x = cvt_pk_bf16(v[j].x * rstd * g[j].x, v[j].y * rstd * g[j].y); o.y = cvt_pk_bf16(v[j].z * rstd * g[j].z, v[j].w * rstd * g[j].w); o8[64 * j] = o; } }
    }
}
__device__ __forceinline__ void final_norm(Frame& F, const bf16* hb, const float* gain, float* outp) {
    const int gw = blockIdx.x * NWAVES + F.wave, NGW = F.G * NWAVES, lane = F.lane;
    for (int m = gw; m < T; m += NGW) {
        const v4u* xr = (const v4u*)(hb + (size_t)m * DM) + lane; float v[4][8]; float s = 0.f;
#pragma unroll
        for (int j = 0; j < 4; ++j) { const v4u w = xr[64 * j]; v[j][0] = bf_lo(w.x); v[j][1] = bf_hi(w.x); v[j][2] = bf_lo(w.y); v[j][3] = bf_hi(w.y); v[j][4] = bf_lo(w.z); v[j][5] = bf_hi(w.z); v[j][6] = bf_lo(w.w); v[j][7] = bf_hi(w.w);
#pragma unroll
            for (int e = 0; e < 8; ++e) s += v[j][e] * v[j][e]; }
        const float rstd = 1.0f / sqrtf(wave_sum(s) * (1.f / DM) + RMS_EPS);
#pragma unroll
        for (int j = 0; j < 4; ++j) { const f32x4* g = (const f32x4*)(gain + (lane + 64 * j) * 8); f32x4* o = (f32x4*)(outp + (size_t)m * DM + (lane + 64 * j) * 8); const f32x4 g0 = g[0], g1 = g[1];
            o[0] = (f32x4){v[j][0] * rstd * g0[0], v[j][1] * rstd * g0[1], v[j][2] * rstd * g0[2], v[j][3] * rstd * g0[3]}; o[1] = (f32x4){v[j][4] * rstd * g1[0], v[j][5] * rstd * g1[1], v[j][6] * rstd * g1[2], v[j][7] * rstd * g1[3]}; }
    }
}
__device__ __forceinline__ void unpack8(const v4u w, float* f) { f[0] = bf_lo(w.x); f[1] = bf_hi(w.x); f[2] = bf_lo(w.y); f[3] = bf_hi(w.y); f[4] = bf_lo(w.z); f[5] = bf_hi(w.z); f[6] = bf_lo(w.w); f[7] = bf_hi(w.w); }

__device__ __forceinline__ void swa_naive(Frame& F, const float* sinks) {
    const bf16* P = wsb(F, WS_PROJ); bf16* O = wsb(F, WS_OSWA);
    for (int idx = blockIdx.x * 512 + F.tid; idx < T * 16; idx += F.G * 512) {
        const int hq = idx / T, m = idx % T, b = m / SEQ, t = m % SEQ, g = hq >> 2;
        float q[64];
        { const v4u* qp = (const v4u*)(P + (size_t)m * INW + COL_Q + hq * 64);
#pragma unroll
          for (int j = 0; j < 8; ++j) unpack8(qp[j], q + 8 * j); }
        float mrun = sinks[hq] * LOG2E, lrun = 1.f, o[64];
#pragma unroll
        for (int j = 0; j < 64; ++j) o[j] = 0.f;
        const int k0 = t >= 127 ? t - 127 : 0;
        for (int kp = k0; kp <= t; ++kp) {
            const bf16* kr = P + (size_t)(b * SEQ + kp) * INW + COL_K + g * 64; const bf16* vr = kr + (COL_V - COL_K);
            float s0 = 0.f, s1 = 0.f;
#pragma unroll
            for (int j = 0; j < 8; ++j) { float kf[8]; unpack8(((const v4u*)kr)[j], kf);
#pragma unroll
                for (int e = 0; e < 8; e += 2) { s0 += q[8 * j + e] * kf[e]; s1 += q[8 * j + e + 1] * kf[e + 1]; } }
            const float s = s0 + s1, mnew = fmaxf(mrun, s), corr = __builtin_amdgcn_exp2f(mrun - mnew), p = __builtin_amdgcn_exp2f(s - mnew);
            lrun = lrun * corr + p; mrun = mnew;
#pragma unroll
            for (int j = 0; j < 8; ++j) { float vf[8]; unpack8(((const v4u*)vr)[j], vf);
#pragma unroll
                for (int e = 0; e < 8; ++e) o[8 * j + e] = o[8 * j + e] * corr + p * vf[e]; }
        }
        const float inv = 1.0f / lrun; v4u* op = (v4u*)(O + (size_t)m * 1024 + hq * 64);
#pragma unroll
        for (int j = 0; j < 8; ++j) { v4u w; w.x = cvt_pk_bf16(o[8 * j] * inv, o[8 * j + 1] * inv); w.y = cvt_pk_bf16(o[8 * j + 2] * inv, o[8 * j + 3] * inv);
            w.z = cvt_pk_bf16(o[8 * j + 4] * inv, o[8 * j + 5] * inv); w.w = cvt_pk_bf16(o[8 * j + 6] * inv, o[8 * j + 7] * inv); op[j] = w; }
    }
}
__device__ __forceinline__ void memattn_naive(Frame& F) {
    const bf16* P = wsb(F, WS_PROJ); const bf16* KV = wsb(F, WS_MKV); bf16* O = wsb(F, WS_OMEM);
    LAS float* qs = (LAS float*)F.lds;
    LAS float* ss = qs + 32 * 260;
    const int tid = F.tid, ti = tid >> 4, kg = tid & 15;
    for (int unit = blockIdx.x; unit < 1024; unit += F.G) {
        const int b = unit >> 9, hd = (unit >> 7) & 3, tb = unit & 127, m0 = b * SEQ + tb * 32;
        { const v4u* src = (const v4u*)(P + (size_t)(m0 + ti) * INW + COL_MQ + hd * 256 + kg * 16); float f[16]; unpack8(src[0], f); unpack8(src[1], f + 8);
#pragma unroll
          for (int e = 0; e < 16; ++e) qs[ti * 260 + kg * 16 + e] = f[e]; }
        __syncthreads();
        float sc[16];
#pragma unroll 1
        for (int i = 0; i < 16; ++i) { const int key = kg + 16 * i; const v4u* kr = (const v4u*)(KV + (size_t)(b * NMEM + key) * 2048 + hd * 256);
            float a0 = 0.f, a1 = 0.f;
#pragma unroll 8
            for (int d8 = 0; d8 < 32; ++d8) { float kf[8]; unpack8(kr[d8], kf); const LAS f32x4* qp = (const LAS f32x4*)(qs + ti * 260 + d8 * 8); const f32x4 qa = qp[0], qb = qp[1];
                a0 += qa.x * kf[0] + qa.y * kf[1] + qa.z * kf[2] + qa.w * kf[3]; a1 += qb.x * kf[4] + qb.y * kf[5] + qb.z * kf[6] + qb.w * kf[7]; }
            ss[ti * 257 + key] = a0 + a1; }
        __syncthreads();
        float mx = -3.0e38f;
#pragma unroll
        for (int i = 0; i < 16; ++i) { sc[i] = ss[ti * 257 + kg + 16 * i]; mx = fmaxf(mx, sc[i]); }
#pragma unroll
        for (int o = 1; o < 16; o <<= 1) mx = fmaxf(mx, __shfl_xor(mx, o));
        float sum = 0.f;
#pragma unroll
        for (int i = 0; i < 16; ++i) { sc[i] = __builtin_amdgcn_exp2f(sc[i] - mx); sum += sc[i]; }
#pragma unroll
        for (int o = 1; o < 16; o <<= 1) sum += __shfl_xor(sum, o);
        const float inv = 1.0f / sum;
#pragma unroll
        for (int i = 0; i < 16; ++i) ss[ti * 257 + kg + 16 * i] = sc[i] * inv;
        __syncthreads();
        float o[16];
#pragma unroll
        for (int e = 0; e < 16; ++e) o[e] = 0.f;
#pragma unroll 4
        for (int key = 0; key < NMEM; ++key) { const float p = ss[ti * 257 + key]; const v4u* vr = (const v4u*)(KV + (size_t)(b * NMEM + key) * 2048 + 1024 + hd * 256 + kg * 16);
            float vf[16]; unpack8(vr[0], vf); unpack8(vr[1], vf + 8);
#pragma unroll
            for (int e = 0; e < 16; ++e) o[e] += p * vf[e]; }
        v4u* op = (v4u*)(O + (size_t)(m0 + ti) * 1024 + hd * 256 + kg * 16);
        v4u w; w.x = cvt_pk_bf16(o[0], o[1]); w.y = cvt_pk_bf16(o[2], o[3]); w.z = cvt_pk_bf16(o[4], o[5]); w.w = cvt_pk_bf16(o[6], o[7]); op[0] = w;
        w.x = cvt_pk_bf16(o[8], o[9]); w.y = cvt_pk_bf16(o[10], o[11]); w.z = cvt_pk_bf16(o[12], o[13]); w.w = cvt_pk_bf16(o[14], o[15]); op[1] = w;
        __syncthreads();
    }
}
__device__ __forceinline__ void sincos_red(double x, float& s, float& c) {
    const double k = __builtin_rint(x * 0.63661977236758134308); const double r = (x - k * 1.57079632679489655800) - k * 6.123233995736766036e-17; const double r2 = r * r;
    double sp = -7.6471637318198164759e-13; sp = sp * r2 + 1.6059043836821614599e-10; sp = sp * r2 - 2.5052108385441718775e-8; sp = sp * r2 + 2.7557319223985890653e-6; sp = sp * r2 - 1.9841269841269841270e-4; sp = sp * r2 + 8.3333333333333333333e-3; sp = sp * r2 - 1.6666666666666666667e-1;
    const double sr = r + r * r2 * sp;
    double cp = -1.1470745597729724714e-11; cp = cp * r2 + 2.0876756987868098979e-9; cp = cp * r2 - 2.7557319223985890653e-7; cp = cp * r2 + 2.4801587301587301587e-5; cp = cp * r2 - 1.3888888888888888889e-3; cp = cp * r2 + 4.1666666666666666667e-2; cp = cp * r2 - 0.5;
    const double cr = 1.0 + r2 * cp;
    const int q = ((int)k) & 3;
    const double ss = (q & 1) ? cr : sr, cc = (q & 1) ? sr : cr;
    s = (float)((q & 2) ? -ss : ss); c = (float)(((q == 1) || (q == 2)) ? -cc : cc);
}
struct SsmState { float ar, ai, a64r, a64i; float bbr[16], bbi[16]; };
struct SsmIn { const float *lre, *lim, *ldt, *bre, *bim, *cre, *cim, *dsk; };
__device__ __forceinline__ void ssm_params(const SsmIn& I, int g, int p, SsmState& S) {
    const int gp = g * 64 + p;
    const float lr = fminf(I.lre[gp], -1e-4f), li = I.lim[gp], dt = expf(I.ldt[g]);
    const float mag = expf(lr * dt); float sn, cs; const double th = (double)li * (double)dt; sincos_red(th, sn, cs);
    S.ar = mag * cs; S.ai = mag * sn;
    const float mag64 = expf(lr * dt * 64.f); sincos_red(th * 64.0, sn, cs); S.a64r = mag64 * cs; S.a64i = mag64 * sn;
    const float nr = S.ar - 1.f, ni = S.ai, den = lr * lr + li * li, kr = (nr * lr + ni * li) / den, ki = (ni * lr - nr * li) / den;
    const float* br = I.bre + (size_t)gp * 16; const float* bi = I.bim + (size_t)gp * 16;
#pragma unroll
    for (int c = 0; c < 16; ++c) { S.bbr[c] = kr * br[c] - ki * bi[c]; S.bbi[c] = kr * bi[c] + ki * br[c]; }
}
__device__ __forceinline__ void ssm_step(const SsmState& S, const bf16* up, float& sr, float& si) {
    const v4u* u4 = (const v4u*)up; float uf[16]; unpack8(u4[0], uf); unpack8(u4[1], uf + 8);
    float xr = 0.f, xi = 0.f;
#pragma unroll
    for (int c = 0; c < 16; ++c) { xr += S.bbr[c] * uf[c]; xi += S.bbi[c] * uf[c]; }
    const float nr = S.ar * sr - S.ai * si + xr, ni = S.ar * si + S.ai * sr + xi; sr = nr; si = ni;
}
__device__ __forceinline__ void ssm_local(Frame& F, const SsmIn& I) {
    const bf16* P = wsb(F, WS_PROJ); f32x2* SE = (f32x2*)(F.ws + WS_SEND);
    const int gw = blockIdx.x * NWAVES + F.wave, NGW = F.G * NWAVES, p = F.lane;
    for (int u = gw; u < 2 * 64 * 64; u += NGW) {
        const int g = u & 63, ch = (u >> 6) & 63, b = u >> 12;
        SsmState S; ssm_params(I, g, p, S);
        float sr = 0.f, si = 0.f; const bf16* up = P + (size_t)(b * SEQ + ch * 64) * INW + COL_S + g * 16;
#pragma unroll 4
        for (int j = 0; j < 64; ++j) ssm_step(S, up + (size_t)j * INW, sr, si);
        SE[((size_t)(b * 64 + ch) * 64 + g) * 64 + p] = (f32x2){sr, si};
    }
}
__device__ __forceinline__ void ssm_replay(Frame& F, const SsmIn& I) {
    const bf16* P = wsb(F, WS_PROJ); const f32x2* SE = (const f32x2*)(F.ws + WS_SEND); bf16* Y = wsb(F, WS_YS);
    LAS f32x2* Cs = (LAS f32x2*)F.lds;
    LAS float* Ds = (LAS float*)(F.lds + 16 * 65 * 8);
    LAS f32x2* Sw = (LAS f32x2*)(F.lds + 16384) + F.wave * (16 * 65);
    const int p = F.lane, jj = F.lane >> 2, cq = F.lane & 3;
    for (int unit = blockIdx.x; unit < 1024; unit += F.G) {
        const int oct = unit & 7, g = (unit >> 3) & 63, b = unit >> 9, ch = oct * 8 + F.wave;
        for (int e = F.tid; e < 1024; e += 512) { const int c = e >> 6, pp = e & 63; const size_t gi = ((size_t)g * 16 + c) * 64 + pp; Cs[c * 65 + pp] = (f32x2){I.cre[gi], I.cim[gi]}; }
        if (F.tid < 16) Ds[F.tid] = I.dsk[g * 16 + F.tid];
        __syncthreads();
        SsmState S; ssm_params(I, g, p, S);
        float sr = 0.f, si = 0.f;
        for (int j = 0; j < ch; ++j) { const f32x2 e = SE[((size_t)(b * 64 + j) * 64 + g) * 64 + p]; const float nr = S.a64r * sr - S.a64i * si + e.x, ni = S.a64r * si + S.a64i * sr + e.y; sr = nr; si = ni; }
        const size_t tok0 = (size_t)b * SEQ + ch * 64;
#pragma unroll 1
        for (int sub = 0; sub < 4; ++sub) {
#pragma unroll 4
            for (int j = 0; j < 16; ++j) { ssm_step(S, P + (tok0 + sub * 16 + j) * INW + COL_S + g * 16, sr, si); Sw[j * 65 + p] = (f32x2){sr, si}; }
            asm volatile("s_waitcnt lgkmcnt(0)" ::: "memory");
            float acc[4] = {0.f, 0.f, 0.f, 0.f};
#pragma unroll 4
            for (int pp = 0; pp < 64; ++pp) { const f32x2 sv = Sw[jj * 65 + pp];
#pragma unroll
                for (int ci = 0; ci < 4; ++ci) { const f32x2 cv = Cs[(cq * 4 + ci) * 65 + pp]; acc[ci] += cv.x * sv.x - cv.y * sv.y; } }
            const size_t tok = tok0 + sub * 16 + jj; const v2u uw = *(const v2u*)(P + tok * INW + COL_S + g * 16 + cq * 4);
            const float u0 = bf_lo(uw.x), u1 = bf_hi(uw.x), u2 = bf_lo(uw.y), u3 = bf_hi(uw.y);
            v2u o; o.x = cvt_pk_bf16(acc[0] + Ds[cq * 4] * u0, acc[1] + Ds[cq * 4 + 1] * u1); o.y = cvt_pk_bf16(acc[2] + Ds[cq * 4 + 2] * u2, acc[3] + Ds[cq * 4 + 3] * u3);
            *(v2u*)(Y + tok * 1024 + g * 16 + cq * 4) = o;
            asm volatile("s_waitcnt lgkmcnt(0)" ::: "memory");
        }
        __syncthreads();
    }
}

typedef short bf16x8 __attribute__((ext_vector_type(8)));
typedef short s16x4 __attribute__((ext_vector_type(4)));
typedef float f32x16 __attribute__((ext_vector_type(16)));
__device__ __forceinline__ s16x4 lds_tr16(const LAS unsigned char* p) { return __builtin_bit_cast(s16x4, __builtin_amdgcn_ds_read_tr16_b64_v4i16((LAS s16x4*)p)); }
__device__ __forceinline__ bf16x8 cat8(s16x4 lo, s16x4 hi) { return (bf16x8){lo[0], lo[1], lo[2], lo[3], hi[0], hi[1], hi[2], hi[3]}; }
__device__ __forceinline__ bf16x8 pack8(float a0, float a1, float a2, float a3, float a4, float a5, float a6, float a7) {
    v4u w; w.x = cvt_pk_bf16(a0, a1); w.y = cvt_pk_bf16(a2, a3); w.z = cvt_pk_bf16(a4, a5); w.w = cvt_pk_bf16(a6, a7); return __builtin_bit_cast(bf16x8, w); }

__device__ __forceinline__ void swa_mfma(Frame& F, const float* sinks) {
    const bf16* P = wsb(F, WS_PROJ); bf16* O = wsb(F, WS_OSWA);
    LAS unsigned char* Kl = F.lds;
    LAS unsigned char* Vl = F.lds + 36864;
    const int tid = F.tid, lane = F.lane, w = F.wave, r = w >> 1, qh = w & 1, l31 = lane & 31, h = lane >> 5;
    for (int ub_ = blockIdx.x; ub_ < 256; ub_ += F.G) { const int unit = (F.G == 256) ? ((ub_ & 7) * 32 + (ub_ >> 3)) : ub_;
        const int n = unit & 31, g = (unit >> 5) & 3, b = unit >> 7;
#pragma unroll
        for (int i = 0; i < 4; ++i) { const int c = tid + 512 * i, key = c >> 3, part = c & 7, pos = (n - 1) * 128 + key;
            v4u kv = {0u, 0u, 0u, 0u}, vv = {0u, 0u, 0u, 0u};
            if (pos >= 0) { const bf16* src = P + (size_t)(b * SEQ + pos) * INW + COL_K + g * 64 + part * 8; kv = *(const v4u*)src; vv = *(const v4u*)(src + (COL_V - COL_K)); }
            *(LAS v4u*)(Kl + key * 144 + part * 16) = kv;
            *(LAS v4u*)(Vl + (part >> 2) * 16384 + key * 64 + (part & 3) * 16) = vv; }
        __syncthreads();
        const int hq = g * 4 + r; const float sink2 = sinks[hq] * LOG2E;
#pragma unroll 1
        for (int qt = 0; qt < 2; ++qt) {
            const int a = qh * 2 + qt, qi = a * 32 + l31; const size_t m = (size_t)b * SEQ + n * 128 + qi;
            bf16x8 qf[4];
#pragma unroll
            for (int ds = 0; ds < 4; ++ds) qf[ds] = *(const bf16x8*)(P + m * INW + COL_Q + hq * 64 + ds * 16 + h * 8);
            f32x16 s[5];
#pragma unroll
            for (int k5 = 0; k5 < 5; ++k5) { f32x16 acc;
#pragma unroll
                for (int e = 0; e < 16; ++e) acc[e] = 0.f;
#pragma unroll
                for (int ds = 0; ds < 4; ++ds) { const bf16x8 kf = *(const LAS bf16x8*)(Kl + (32 * (a + k5) + l31) * 144 + ds * 32 + h * 16); acc = __builtin_amdgcn_mfma_f32_32x32x16_bf16(kf, qf[ds], acc, 0, 0, 0); }
                s[k5] = acc; }
            float mx = sink2;
#pragma unroll
            for (int k5 = 0; k5 < 5; ++k5)
#pragma unroll
                for (int e = 0; e < 16; ++e) { const int kl = 32 * (a + k5) + (e & 3) + 8 * (e >> 2) + 4 * h; const bool ok = (kl > qi) && (kl <= qi + 128) && (n > 0 || kl >= 128);
                    const float v = ok ? s[k5][e] : -1.0e30f; s[k5][e] = v; mx = fmaxf(mx, v); }
            mx = fmaxf(mx, __shfl_xor(mx, 32));
            float sum = 0.f;
#pragma unroll
            for (int k5 = 0; k5 < 5; ++k5)
#pragma unroll
                for (int e = 0; e < 16; ++e) { const float p = __builtin_amdgcn_exp2f(s[k5][e] - mx); s[k5][e] = p; sum += p; }
            sum += __shfl_xor(sum, 32); sum += __builtin_amdgcn_exp2f(sink2 - mx);
            f32x16 o[2];
#pragma unroll
            for (int e = 0; e < 16; ++e) { o[0][e] = 0.f; o[1][e] = 0.f; }
#pragma unroll
            for (int k5 = 0; k5 < 5; ++k5)
#pragma unroll
                for (int s2 = 0; s2 < 2; ++s2) { const bf16x8 pf = pack8(s[k5][8 * s2], s[k5][8 * s2 + 1], s[k5][8 * s2 + 2], s[k5][8 * s2 + 3], s[k5][8 * s2 + 4], s[k5][8 * s2 + 5], s[k5][8 * s2 + 6], s[k5][8 * s2 + 7]);
                    const int base0 = 32 * (a + k5) + 16 * s2 + 4 * h;
#pragma unroll
                    for (int db = 0; db < 2; ++db) { const LAS unsigned char* vp = Vl + db * 16384 + (base0 + ((lane & 15) >> 2)) * 64 + (16 * ((lane >> 4) & 1) + 4 * (lane & 3)) * 2;
                        const bf16x8 vf = cat8(lds_tr16(vp), lds_tr16(vp + 8 * 64)); o[db] = __builtin_amdgcn_mfma_f32_32x32x16_bf16(vf, pf, o[db], 0, 0, 0); } }
            const float inv = 1.0f / sum;
#pragma unroll
            for (int db = 0; db < 2; ++db)
#pragma unroll
                for (int g4 = 0; g4 < 4; ++g4) { v2u wv; wv.x = cvt_pk_bf16(o[db][4 * g4] * inv, o[db][4 * g4 + 1] * inv); wv.y = cvt_pk_bf16(o[db][4 * g4 + 2] * inv, o[db][4 * g4 + 3] * inv);
                    *(v2u*)(O + m * 1024 + hq * 64 + db * 32 + 8 * g4 + 4 * h) = wv; }
        }
        __syncthreads();
    }
}
__device__ __forceinline__ void memattn_mfma(Frame& F) {
    const bf16* P = wsb(F, WS_PROJ); const bf16* KV = wsb(F, WS_MKV); bf16* O = wsb(F, WS_OMEM);
    constexpr int RS = 544, SLOT = 64 * RS;
    const int tid = F.tid, lane = F.lane, w = F.wave, l15 = lane & 15, kq = lane >> 4;
    for (int ub_ = blockIdx.x; ub_ < 256; ub_ += F.G) { const int unit = (F.G == 256) ? ((ub_ & 7) * 32 + (ub_ >> 3)) : ub_;
        const int tb = unit & 31, hd = (unit >> 5) & 3, b = unit >> 7; const size_t m = (size_t)b * SEQ + tb * 128 + w * 16 + l15;
        bf16x8 qf[8];
#pragma unroll
        for (int ds = 0; ds < 8; ++ds) qf[ds] = *(const bf16x8*)(P + m * INW + COL_MQ + hd * 256 + ds * 32 + kq * 8);
        v4u st[4];
#define MA_LOAD(t) do { _Pragma("unroll") for (int i_ = 0; i_ < 4; ++i_) { const int c_ = tid + 512 * i_, row_ = c_ >> 5, part_ = c_ & 31; \
            st[i_] = *(const v4u*)(KV + (size_t)(b * NMEM + 64 * ((t) & 3) + row_) * 2048 + ((t) >> 2) * 1024 + hd * 256 + part_ * 8); } } while (0)
#define MA_STORE(buf) do { _Pragma("unroll") for (int i_ = 0; i_ < 4; ++i_) { const int c_ = tid + 512 * i_, row_ = c_ >> 5, part_ = c_ & 31; *(LAS v4u*)((buf) + row_ * RS + part_ * 16) = st[i_]; } } while (0)
        MA_LOAD(0); MA_STORE(F.lds); __syncthreads();
        f32x4 s[16]; f32x4 o[16]; float inv = 0.f;
#pragma unroll
        for (int t = 0; t < 8; ++t) {
            if (t < 7) MA_LOAD(t + 1);
            const LAS unsigned char* cur = F.lds + (t & 1) * SLOT;
            if (t < 4) {
#pragma unroll
                for (int k4 = 0; k4 < 4; ++k4) { f32x4 acc = {0.f, 0.f, 0.f, 0.f};
#pragma unroll
                    for (int ds = 0; ds < 8; ++ds) { const bf16x8 kf = *(const LAS bf16x8*)(cur + (16 * k4 + l15) * RS + ds * 64 + kq * 16); acc = __builtin_amdgcn_mfma_f32_16x16x32_bf16(kf, qf[ds], acc, 0, 0, 0); }
                    s[4 * t + k4] = acc; }
                if (t == 3) {
                    float mx = -3.0e38f;
#pragma unroll
                    for (int i = 0; i < 16; ++i) mx = fmaxf(mx, fmaxf(fmaxf(s[i][0], s[i][1]), fmaxf(s[i][2], s[i][3])));
                    mx = fmaxf(mx, __shfl_xor(mx, 16)); mx = fmaxf(mx, __shfl_xor(mx, 32));
                    float sum = 0.f;
#pragma unroll
                    for (int i = 0; i < 16; ++i)
#pragma unroll
                        for (int e = 0; e < 4; ++e) { const float p = __builtin_amdgcn_exp2f(s[i][e] - mx); s[i][e] = p; sum += p; }
                    sum += __shfl_xor(sum, 16); sum += __shfl_xor(sum, 32); inv = 1.0f / sum;
#pragma unroll
                    for (int i = 0; i < 16; ++i) o[i] = (f32x4){0.f, 0.f, 0.f, 0.f};
                }
            } else {
                const int tv = t - 4;
#pragma unroll
                for (int s2 = 0; s2 < 2; ++s2) { const f32x4 p0 = s[4 * tv + 2 * s2], p1 = s[4 * tv + 2 * s2 + 1]; const bf16x8 pf = pack8(p0[0], p0[1], p0[2], p0[3], p1[0], p1[1], p1[2], p1[3]);
#pragma unroll
                    for (int db = 0; db < 16; ++db) { const LAS unsigned char* vp = cur + (32 * s2 + 4 * kq + (l15 >> 2)) * RS + (16 * db + 4 * (lane & 3)) * 2;
                        const bf16x8 vf = cat8(lds_tr16(vp), lds_tr16(vp + 16 * RS)); o[db] = __builtin_amdgcn_mfma_f32_16x16x32_bf16(vf, pf, o[db], 0, 0, 0); } }
            }
            if (t < 7) MA_STORE(F.lds + ((t + 1) & 1) * SLOT);
            __syncthreads();
        }
#undef MA_LOAD
#undef MA_STORE
#pragma unroll
        for (int db = 0; db < 16; ++db) { v2u wv; wv.x = cvt_pk_bf16(o[db][0] * inv, o[db][1] * inv); wv.y = cvt_pk_bf16(o[db][2] * inv, o[db][3] * inv); *(v2u*)(O + m * 1024 + hd * 256 + 16 * db + 4 * kq) = wv; }
    }
}

__device__ __forceinline__ void cmul(float ar, float ai, float br, float bi, float& cr, float& ci) { cr = ar * br - ai * bi; ci = ar * bi + ai * br; }
__device__ __forceinline__ void ssm_tables(Frame& F, const SsmIn& I0) {
    LAS f32x2* AP = (LAS f32x2*)F.lds;
    LAS f32x2* BB = (LAS f32x2*)(F.lds + 33280);
    LAS f32x2* CC = (LAS f32x2*)(F.lds + 33280 + 8192);
    LAS f32x2* KC = (LAS f32x2*)(F.lds + 33280 + 16384);
    const int t = F.tid;
    if ((int)blockIdx.x >= TAB_WGS && F.G > TAB_WGS) return;
    for (int unit = blockIdx.x; unit < DEPTH * 64; unit += (F.G > TAB_WGS ? TAB_WGS : F.G)) {
        const int l = unit >> 6, g = unit & 63, gp0 = unit * 64;
        const float dt = expf(I0.ldt[unit]);
        for (int e = t; e < 65 * 64; e += 512) { const int ee = e >> 6, p = e & 63; const float lr = fminf(I0.lre[gp0 + p], -1e-4f), li = I0.lim[gp0 + p];
            const float mag = expf(lr * dt * (float)ee); float sn, cs; sincos_red((double)li * (double)dt * (double)ee, sn, cs); AP[e] = (f32x2){mag * cs, mag * sn}; }
        __syncthreads();
        if (t < 64) { ((f32x2*)(F.ws + WS_A64))[gp0 + t] = AP[64 * 64 + t];
            const float lr = fminf(I0.lre[gp0 + t], -1e-4f), li = I0.lim[gp0 + t]; const f32x2 a = AP[64 + t]; const float nr = a.x - 1.f, ni = a.y, den = lr * lr + li * li;
            KC[t] = (f32x2){(nr * lr + ni * li) / den, (ni * lr - nr * li) / den}; }
        __syncthreads();
        for (int e = t; e < 1024; e += 512) { const int p = e >> 4; const f32x2 k = KC[p]; const float br = I0.bre[(size_t)gp0 * 16 + e], bi = I0.bim[(size_t)gp0 * 16 + e];
            BB[e] = (f32x2){k.x * br - k.y * bi, k.x * bi + k.y * br}; CC[e] = (f32x2){I0.cre[(size_t)gp0 * 16 + e], I0.cim[(size_t)gp0 * 16 + e]}; }
        __syncthreads();
        bf16* WinT = wsb(F, WS_WINT) + (size_t)unit * 131072; bf16* WoutT = wsb(F, WS_WOUTT) + (size_t)unit * 131072; bf16* LB = (bf16*)(F.ws + WS_LB + (size_t)unit * LB_BYTES);
        for (int q = t; q < 16384; q += 512) { const int n = q >> 7, ck = q & 127, j = ck >> 1, half = ck & 1, p = 16 * (n >> 5) + (n & 15), isim = (n >> 4) & 1; const f32x2 a = AP[(63 - j) * 64 + p]; float v[8];
#pragma unroll
            for (int e = 0; e < 8; ++e) { const f32x2 bb = BB[p * 16 + 8 * half + e]; float zr, zi; cmul(a.x, a.y, bb.x, bb.y, zr, zi); v[e] = isim ? zi : zr; }
            *(bf16x8*)(WinT + (size_t)n * 1024 + ck * 8) = pack8(v[0], v[1], v[2], v[3], v[4], v[5], v[6], v[7]); }
        for (int q = t; q < 16384; q += 512) { const int row = q >> 4, ck = q & 15, tau = row >> 4, c = row & 15, isim = ck >> 3, p0 = (8 * ck) & 63; float v[8];
#pragma unroll
            for (int e = 0; e < 8; ++e) { const f32x2 cc = CC[c * 64 + p0 + e], a = AP[(tau + 1) * 64 + p0 + e]; float zr, zi; cmul(cc.x, cc.y, a.x, a.y, zr, zi); v[e] = isim ? -zi : zr; }
            *(bf16x8*)(WoutT + (size_t)row * 128 + ck * 8) = pack8(v[0], v[1], v[2], v[3], v[4], v[5], v[6], v[7]); }
        { const int c = (t >> 4) & 15, c2 = t & 15, lh = t >> 8; float acc[32];
#pragma unroll
          for (int d = 0; d < 32; ++d) acc[d] = 0.f;
#pragma unroll 2
          for (int p = 0; p < 64; ++p) { const f32x2 cc = CC[c * 64 + p], bb = BB[p * 16 + c2]; float zr, zi; cmul(cc.x, cc.y, bb.x, bb.y, zr, zi);
#pragma unroll
              for (int d = 0; d < 32; ++d) { const f32x2 a = AP[(32 * lh + d) * 64 + p]; acc[d] += zr * a.x - zi * a.y; } }
          if (lh == 0 && c == c2) acc[0] += I0.dsk[l * 1024 + g * 16 + c];
#pragma unroll
          for (int d = 0; d < 32; ++d) LB[(((32 * lh + d + 1) * 2 + (c2 >> 3)) * 16 + c) * 8 + (c2 & 7)] = (bf16)(cvt_pk_bf16(acc[d], 0.f) & 0xffffu);
          if (t < 256) LB[t] = 0; }
        __syncthreads();
    }
}
__device__ __forceinline__ void ssm_s1(Frame& F, const SsmIn& I, int l) {
    const bf16* P = wsb(F, WS_PROJ); bf16* SST = wsb(F, WS_SST);
    LAS float* E = (LAS float*)F.lds;
    const int lane = F.lane, w = F.wave, l31 = lane & 31, h = lane >> 5, mi = w & 3, kh = w >> 2;
    for (int ub_ = blockIdx.x; ub_ < 256; ub_ += F.G) { const int unit = (F.G == 256) ? ((ub_ & 7) * 32 + (ub_ >> 3)) : ub_;
        const int g = unit >> 2, pq = unit & 3;
        const bf16* WinT = wsb(F, WS_WINT) + (size_t)(l * 64 + g) * 131072 + (size_t)(pq * 32 + l31) * 1024 + 8 * h;
        const int mrow = 32 * mi + l31, bb = mrow >> 6, kk = mrow & 63;
        const bf16* up = wsb(F, WS_SIN) + ((size_t)g * T + bb * SEQ + kk * 64) * 16 + 8 * h;
        f32x16 acc;
#pragma unroll
        for (int e = 0; e < 16; ++e) acc[e] = 0.f;
#pragma unroll 16
        for (int jj = 0; jj < 32; ++jj) { const int j = 32 * kh + jj; const bf16x8 af = *(const bf16x8*)(up + (size_t)j * 16), bf = *(const bf16x8*)(WinT + 16 * j);
            acc = __builtin_amdgcn_mfma_f32_32x32x16_bf16(af, bf, acc, 0, 0, 0); }
#pragma unroll
        for (int e = 0; e < 16; ++e) E[(kh * 128 + 32 * mi + (e & 3) + 8 * (e >> 2) + 4 * h) * 33 + l31] = acc[e];
        __syncthreads();
#pragma unroll 1
        for (int tk = 0; tk < 4; ++tk) { const int task = w * 4 + tk, b = task >> 4, st = task & 15, p = 16 * pq + st, k = lane;
            float xr = E[(b * 64 + k) * 33 + st] + E[(128 + b * 64 + k) * 33 + st], xi = E[(b * 64 + k) * 33 + 16 + st] + E[(128 + b * 64 + k) * 33 + 16 + st];
            float ar, ai; { const f32x2 a64 = ((const f32x2*)(F.ws + WS_A64))[(l * 64 + g) * 64 + p]; ar = a64.x; ai = a64.y; }
#pragma unroll
            for (int d = 1; d < 64; d <<= 1) { const float yr = __shfl_up(xr, d), yi = __shfl_up(xi, d); if (k >= d) { xr += ar * yr - ai * yi; xi += ar * yi + ai * yr; } const float nr = ar * ar - ai * ai, ni = 2.f * ar * ai; ar = nr; ai = ni; }
            float sr = __shfl_up(xr, 1), si = __shfl_up(xi, 1); if (k == 0) { sr = 0.f; si = 0.f; }
            bf16* dst = SST + ((size_t)(g * 128 + b * 64 + k)) * 128 + p; dst[0] = (bf16)(cvt_pk_bf16(sr, 0.f) & 0xffffu); dst[64] = (bf16)(cvt_pk_bf16(si, 0.f) & 0xffffu); }
        __syncthreads();
    }
}
__device__ __forceinline__ void ssm_s2(Frame& F, int l) {
    const bf16* P = wsb(F, WS_PROJ); const bf16* SST = wsb(F, WS_SST); bf16* Y = wsb(F, WS_YS);
    LAS unsigned char* Ul = F.lds;
    LAS unsigned char* Ll = F.lds + 66048;
    LAS unsigned char* Sl = F.lds + 66048 + 33280;
    const int t = F.tid, lane = F.lane, w = F.wave, l31 = lane & 31, h = lane >> 5;
    for (int ub_ = blockIdx.x; ub_ < 256; ub_ += F.G) { const int unit = (F.G == 256) ? ((ub_ & 7) * 32 + (ub_ >> 3)) : ub_;
        const int mt = unit & 1, b = (unit >> 1) & 1, g = unit >> 2;
        const bf16* WoutT = wsb(F, WS_WOUTT) + (size_t)(l * 64 + g) * 131072;
        bf16x8 wfr[4][8];
#pragma unroll
        for (int q = 0; q < 4; ++q) { const int n = (q == 0) ? w : (q == 1) ? 15 - w : (q == 2) ? 16 + w : 31 - w;
#pragma unroll
            for (int ks = 0; ks < 8; ++ks) wfr[q][ks] = *(const bf16x8*)(WoutT + (size_t)(32 * n + l31) * 128 + 16 * ks + 8 * h); }
#pragma unroll
        for (int i = 0; i < 8; ++i) { const int q = t + 512 * i, half = q & 1, ti = q >> 1, ir = ti >> 6, j = ti & 63;
            *(LAS v4u*)(Ul + ir * 2064 + j * 32 + half * 16) = *(const v4u*)(wsb(F, WS_SIN) + ((size_t)g * T + b * SEQ + (32 * mt) * 64) * 16 + (size_t)q * 8); }
        { const v4u* src = (const v4u*)(F.ws + WS_LB + (size_t)(l * 64 + g) * LB_BYTES);
          for (int q = t; q < (int)(LB_BYTES / 16); q += 512) *(LAS v4u*)(Ll + q * 16) = src[q]; }
        { const int row = t >> 4, part = t & 15; *(LAS v4u*)(Sl + row * 272 + part * 16) = *(const v4u*)(SST + ((size_t)(g * 128 + b * 64 + 32 * mt + row)) * 128 + part * 8); }
        __syncthreads();
#pragma unroll
        for (int q = 0; q < 4; ++q) { const int n = (q == 0) ? w : (q == 1) ? 15 - w : (q == 2) ? 16 + w : 31 - w;
            f32x16 acc;
#pragma unroll
            for (int e = 0; e < 16; ++e) acc[e] = 0.f;
#pragma unroll
            for (int ks = 0; ks < 8; ++ks) { const bf16x8 sf = *(const LAS bf16x8*)(Sl + l31 * 272 + ks * 32 + h * 16);
                acc = __builtin_amdgcn_mfma_f32_32x32x16_bf16(wfr[q][ks], sf, acc, 0, 0, 0); }
            const LAS unsigned char* lbp = Ll + ((2 * n + 1 + (l31 >> 4)) * 2 + h) * 256 + (l31 & 15) * 16; const LAS unsigned char* ubp = Ul + l31 * 2064 + h * 16;
#pragma unroll 4
            for (int j = 0; j < 2 * n + 2; ++j) { const bf16x8 kf = *(const LAS bf16x8*)(lbp - j * 512), uf = *(const LAS bf16x8*)(ubp + j * 32); acc = __builtin_amdgcn_mfma_f32_32x32x16_bf16(kf, uf, acc, 0, 0, 0); }
#pragma unroll
            for (int q4 = 0; q4 < 4; ++q4) { const int c0 = 8 * (q4 & 1) + 4 * h, tau = 2 * n + (q4 >> 1); const size_t tok = (size_t)b * SEQ + (32 * mt + l31) * 64 + tau;
                v2u wv; wv.x = cvt_pk_bf16(acc[4 * q4], acc[4 * q4 + 1]); wv.y = cvt_pk_bf16(acc[4 * q4 + 2], acc[4 * q4 + 3]); *(v2u*)(Y + tok * 1024 + g * 16 + c0) = wv; }
        }
        __syncthreads();
    }
}

constexpr int PH_PRO = 0, PH_SB0 = 1, PH_PER_SB = 6, N_SB = 3 * DEPTH, PH_FINAL = PH_SB0 + N_SB * PH_PER_SB, N_PH = PH_FINAL + 1;
struct Args { const float* in[N_IN]; float* out; unsigned char* ws; int ph_lo, ph_hi; };
static_assert(sizeof(Args) == N_IN * 8 + 8 + 8 + 8, "Args has no padding");

typedef __attribute__((address_space(4))) const Args* KArgs;
__device__ __forceinline__ KArgs kargs() { KArgs p = (KArgs)__builtin_amdgcn_kernarg_segment_ptr(); asm volatile("" : "+s"(p)); return p; }
#define AIN(i) (kargs()->in[i])
__global__ void __launch_bounds__(NWAVES * 64, 2) fwd(Args args_unused) {
    extern __shared__ __attribute__((aligned(16))) unsigned char lds[];
    Frame F;
    F.lds = (LAS unsigned char*)lds;
    F.tid = threadIdx.x; F.lane = F.tid & 63; F.wave = __builtin_amdgcn_readfirstlane(F.tid >> 6); F.G = gridDim.x;
    F.ws = kargs()->ws;
    volatile LAS unsigned* MISC = (volatile LAS unsigned*)(F.lds + MISC_OFF);
    for (int u = F.tid; u < (LDS_BYTES - LDSCTL_OFF) / 4; u += NWAVES * 64) ((LAS unsigned*)(F.lds + LDSCTL_OFF))[u] = 0u;
    __syncthreads();
    unsigned* barw = (unsigned*)(F.ws + WS_CTL) + CW_BAR;
    XcdBarrier bar; bar.bar = barw; bar.x = 0; bar.st = nullptr;
    if (kargs()->ph_hi - kargs()->ph_lo > 1) (void)xcd_barrier_post(barw, MISC + 8);
#define IN(p) (kargs()->ph_lo <= (p) && (p) < kargs()->ph_hi)
#define hi (kargs()->ph_hi)
#define BARNOW() XcdBarrier{(unsigned*)(kargs()->ws + WS_CTL) + CW_BAR, xb_xcc_id(), (volatile LAS unsigned*)((LAS unsigned char*)lds + MISC_OFF) + 8}
#define FRESH() do { int t_ = threadIdx.x; asm volatile("" : "+v"(t_)); F.tid = t_; F.lane = t_ & 63; F.wave = __builtin_amdgcn_readfirstlane(t_ >> 6); unsigned char* w_ = kargs()->ws; F.ws = w_; } while (0)
#if DIAG
#define SEAM(p, q) do { if (IN(p) && (q) < hi) { xcd_barrier(BARNOW()); if ((q) == PH_FINAL && threadIdx.x == 0) { const unsigned dwt = MISC[16]; unsigned* dw = (unsigned*)(kargs()->ws + WS_CTL) + 2048; atomicMax(dw, dwt); atomicAdd(dw + 128, dwt >> 8); } } } while (0)
#else
#define SEAM(p, q) do { if (IN(p) && (q) < hi) xcd_barrier(BARNOW()); } while (0)
#endif

    if (IN(PH_PRO) && EN_PRO) for (int rep_ = 0; rep_ < REP_PRO; ++rep_) { FRESH(); const ProIn I{AIN(I_F1WI), AIN(I_F2WI), AIN(I_F1WO), AIN(I_F2WO), AIN(I_WIN), AIN(I_WMKV), AIN(I_WGLU), AIN(I_WSWA), AIN(I_WMEMUP), AIN(I_WOUT), AIN(I_MEM), AIN(I_MEMN), AIN(I_F1N), AIN(I_F2N), AIN(I_MIXN), AIN(I_X)}; prologue(F, I);
        const SsmIn I0{AIN(I_LRE), AIN(I_LIM), AIN(I_LDT), AIN(I_BRE), AIN(I_BIM), AIN(I_CRE), AIN(I_CIM), AIN(I_DSK)}; ssm_tables(F, I0); }
    SEAM(PH_PRO, PH_SB0);

    for (int sb = 0; sb < N_SB; ++sb) {
        const int l = sb / 3, ty = sb % 3, pb = PH_SB0 + sb * PH_PER_SB;
        if (pb + PH_PER_SB <= kargs()->ph_lo || pb >= hi) continue;
#define HIN() ((sb == 0) ? AIN(I_X) : (const float*)(F.ws + WS_H))
#define WL() (F.ws + WS_W + (size_t)l * W_LAYER)
        if (ty != 1) {
            if (IN(pb + 1) && EN_G1) for (int rep_ = 0; rep_ < REP_G1; ++rep_) { FRESH();
                pg8::SchedG1 S{(const char*)(F.ws + WS_XN), (const char*)(WL() + (ty == 0 ? WO_1IN : WO_2IN)), (size_t)256 * DM * 2, T / 256, 2 * DFF / 256, F.G, (int)blockIdx.x};
                pg8::Unit u0; int pm0 = -1; if (S.next(0, u0)) { pm0 = u0.pm; rstd_table(F, pm0); }
                pg8::EpiSwiGLU E{wsb(F, WS_HID), DFF, pg8::RstdTab{(const LAS float*)(F.lds + RSTD_OFF), pm0, (const float*)(F.ws + WS_SSQ)}};
                pg8::gemm_phase<pg8::EpiSwiGLU, pg8::SchedG1, true, true>(F.lds + RING_OFF, DM, S, E);
            }
            SEAM(pb + 1, pb + 5);
        } else {
            if (IN(pb + 1) && EN_G3) for (int rep_ = 0; rep_ < REP_G3; ++rep_) { FRESH();
                pg8::SchedProj S{(const char*)(F.ws + WS_XN), (const char*)(WL() + WO_IN), (const char*)(F.ws + WS_MEMN + (size_t)l * 512 * DM * 2), (const char*)(WL() + WO_MKV), (size_t)256 * DM * 2, T / 256, INW / 256, F.G, (int)blockIdx.x};
                pg8::Unit u0; int pm0 = -1; if (S.next(0, u0)) { pm0 = u0.pm; rstd_table(F, pm0); }
                pg8::EpiProj E{wsb(F, WS_PROJ), INW, COL_G / 256, wsb(F, WS_MKV), 2048, pg8::RstdTab{(const LAS float*)(F.lds + RSTD_OFF), pm0, (const float*)(F.ws + WS_SSQ)}, wsb(F, WS_SIN)};
                pg8::gemm_phase<pg8::EpiProj, pg8::SchedProj, true, true>(F.lds + RING_OFF, DM, S, E);
            }
            SEAM(pb + 1, pb + 2);
            if (IN(pb + 2) && EN_M1) for (int rep_ = 0; rep_ < REP_M; ++rep_) { FRESH(); for (int r2_ = 0; r2_ < REP_SWA; ++r2_) swa_mfma(F, AIN(I_SINK) + l * 16); for (int r2_ = 0; r2_ < REP_MA; ++r2_) memattn_mfma(F);
                const SsmIn I{AIN(I_LRE) + l * 4096, AIN(I_LIM) + l * 4096, AIN(I_LDT) + l * 64, AIN(I_BRE) + l * 65536, AIN(I_BIM) + l * 65536, AIN(I_CRE) + l * 65536, AIN(I_CIM) + l * 65536, AIN(I_DSK) + l * 1024}; for (int r2_ = 0; r2_ < REP_S1; ++r2_) ssm_s1(F, I, l); }
            SEAM(pb + 2, pb + 3);
            if (IN(pb + 3) && EN_M2) for (int rep_ = 0; rep_ < REP_M; ++rep_) { FRESH(); const SsmIn I{AIN(I_LRE) + l * 4096, AIN(I_LIM) + l * 4096, AIN(I_LDT) + l * 64, AIN(I_BRE) + l * 65536, AIN(I_BIM) + l * 65536, AIN(I_CRE) + l * 65536, AIN(I_CIM) + l * 65536, AIN(I_DSK) + l * 1024}; (void)I; for (int r2_ = 0; r2_ < REP_S2; ++r2_) ssm_s2(F, l); }
            SEAM(pb + 3, pb + 4);
            if (IN(pb + 4) && EN_G4) for (int rep_ = 0; rep_ < REP_G4; ++rep_) { FRESH();
                pg8::SchedMix S{(const char*)(F.ws + WS_OSWA), (const char*)(F.ws + WS_OMEM), (const char*)(F.ws + WS_YS), (const char*)(WL() + WO_SWA), (const char*)(WL() + WO_MEM), (const char*)(WL() + WO_GLU), (size_t)256 * 1024 * 2, T / 256, DM / 256, F.G, (int)blockIdx.x};
                pg8::EpiMix E{wsb(F, WS_MG), wsb(F, WS_PROJ) + COL_G, INW};
                pg8::gemm_phase<pg8::EpiMix, pg8::SchedMix, true, true>(F.lds + RING_OFF, 1024, S, E);
            }
            SEAM(pb + 4, pb + 5);
        }
        if (IN(pb + 5) && EN_GR) for (int rep_ = 0; rep_ < REP_GR; ++rep_) { FRESH();
            const int K = (ty == 1) ? DM : DFF;
            pg8::SchedTiles S{(const char*)(F.ws + (ty == 1 ? WS_MG : WS_HID)), (const char*)(WL() + (ty == 0 ? WO_1OUT : ty == 1 ? WO_OUT : WO_2OUT)), (size_t)256 * K * 2, T / 256, DM / 256, F.G, (int)blockIdx.x};
            pg8::EpiResid E{(sb == 0) ? AIN(I_X) : nullptr, ty == 1 ? 1.0f : 0.5f, DM, wsb(F, WS_XN), (float*)(F.ws + (rep_ ? WS_T32 : WS_SSQ)), wsb(F, rep_ ? WS_H : WS_XN)};
            pg8::gemm_phase<pg8::EpiResid, pg8::SchedTiles, true, true>(F.lds + RING_OFF, K, S, E);
        }
        SEAM(pb + 5, pb + 6);
    }
    if (IN(PH_FINAL)) { FRESH(); final_norm(F, wsb(F, WS_XN), AIN(I_FINN), kargs()->out);
#if DIAG
        xcd_barrier(BARNOW());
        if (blockIdx.x == 0) { const unsigned* dw = (const unsigned*)(F.ws + WS_CTL) + 2048; const float vmax = (float)__hip_atomic_load(dw, __ATOMIC_RELAXED, __HIP_MEMORY_SCOPE_AGENT) * 0.01f, vmean = (float)__hip_atomic_load(dw + 128, __ATOMIC_RELAXED, __HIP_MEMORY_SCOPE_AGENT) * 2.56f / 256.f;
            float* o = kargs()->out; if (F.tid == 0) o[0] = vmax * DIAG_SCALE0; for (int i = 1 + F.tid; i < 1 + (1 << 20); i += 512) o[i] += vmean * DIAG_SCALE1; }
#endif
    }
#undef IN
#undef hi
#undef SEAM
}

static bool phase_valid(int p) {
    if (p == PH_PRO || p == PH_FINAL) return true;
    const int sb = (p - PH_SB0) / PH_PER_SB, k = (p - PH_SB0) % PH_PER_SB;
    return k != 0 && ((sb % 3 == 1) || k == 1 || k == 5);
}
extern "C" void kernel_launch(void* const* d_in, const int* in_sizes, int n_in, void* d_out, int out_size, void* d_ws, size_t ws_size, hipStream_t stream) {
    static int grid = 0;
    if (grid == 0) {
        if (n_in != N_IN || in_sizes[0] != T * DM || out_size != T * DM || ws_size < WS_END) { fprintf(stderr, "kernel_launch: unexpected shapes: n_in %d in0 %d out %d ws %zu (need %zu); nothing launched\n", n_in, n_in > 0 ? in_sizes[0] : -1, out_size, ws_size, (size_t)WS_END); grid = -1; return; }
        int dev = 0, cus = 0, per_cu = 0;
        if (hipGetDevice(&dev) != hipSuccess || hipDeviceGetAttribute(&cus, hipDeviceAttributeMultiprocessorCount, dev) != hipSuccess) { fprintf(stderr, "kernel_launch: device query failed\n"); grid = -1; return; }
        if (hipFuncSetAttribute((const void*)fwd, hipFuncAttributeMaxDynamicSharedMemorySize, LDS_BYTES) != hipSuccess) { fprintf(stderr, "kernel_launch: hipFuncSetAttribute failed\n"); grid = -1; return; }
        if (hipOccupancyMaxActiveBlocksPerMultiprocessor(&per_cu, (const void*)fwd, NWAVES * 64, LDS_BYTES) != hipSuccess || per_cu < 1) fprintf(stderr, "kernel_launch: note: occupancy query reports %d workgroups per CU\n", per_cu);
        (void)hipGetLastError();
        if (cus != 256) { fprintf(stderr, "kernel_launch: built for a 256-CU device (got %d); nothing launched\n", cus); grid = -1; return; }
        grid = cus;
    }
    if (grid < 0) return;
    if (hipMemsetAsync((char*)d_ws + WS_CTL, 0, CTL_ZERO_BYTES, stream) != hipSuccess) { fprintf(stderr, "kernel_launch: memset failed\n"); return; }
    Args a{};
    for (int i = 0; i < N_IN; ++i) a.in[i] = (const float*)d_in[i];
    a.out = (float*)d_out; a.ws = (unsigned char*)d_ws;
#if ONE_LAUNCH
    a.ph_lo = 0; a.ph_hi = N_PH;
    hipLaunchKernelGGL(fwd, dim3(grid), dim3(NWAVES * 64), LDS_BYTES, stream, a);
#else
    for (int p = 0; p < N_PH; ++p) { if (!phase_valid(p)) continue; a.ph_lo = p; a.ph_hi = p + 1; hipLaunchKernelGGL(fwd, dim3(grid), dim3(NWAVES * 64), LDS_BYTES, stream, a); }
#endif
    const hipError_t le = hipPeekAtLastError();
    if (le != hipSuccess) fprintf(stderr, "kernel_launch: launch failed: %s\n", hipGetErrorName(le));
}
```

```cpp
#include <hip/hip_runtime.h>
#include <cstdio>
#include <cstdint>

#ifndef EN_PRO
#define EN_PRO 1
#endif
#ifndef EN_NORM
#define EN_NORM 1
#endif
#ifndef EN_G1
#define EN_G1 1
#endif
#ifndef EN_G3
#define EN_G3 1
#endif
#ifndef EN_M1
#define EN_M1 1
#endif
#ifndef EN_M2
#define EN_M2 1
#endif
#ifndef EN_G4
#define EN_G4 1
#endif
#ifndef EN_GR
#define EN_GR 1
#endif
#ifndef REP_SWA
#define REP_SWA 1
#endif
#ifndef REP_MA
#define REP_MA 1
#endif
#ifndef REP_S1
#define REP_S1 1
#endif
#ifndef REP_S2
#define REP_S2 1
#endif
#ifndef REP_M
#define REP_M 1
#endif
#ifndef REP_PRO
#define REP_PRO 1
#endif
#ifndef REP_NORM
#define REP_NORM 1
#endif
#ifndef REP_G1
#define REP_G1 1
#endif
#ifndef REP_G3
#define REP_G3 1
#endif
#ifndef REP_G4
#define REP_G4 1
#endif
#ifndef REP_GR
#define REP_GR 1
#endif
#ifndef DIAG
#define DIAG 0
#endif
#ifndef DIAG_SCALE0
#define DIAG_SCALE0 1.0f
#endif
#ifndef DIAG_SCALE1
#define DIAG_SCALE1 0.01f
#endif
#ifndef ONE_LAUNCH
#define ONE_LAUNCH 1
#endif

namespace pg8 {
#define PG8_LAS __attribute__((address_space(3)))
typedef unsigned short bf16_t;
typedef short bf16x8 __attribute__((ext_vector_type(8)));
typedef float f32x4 __attribute__((ext_vector_type(4)));
typedef unsigned u32x4 __attribute__((ext_vector_type(4)));
constexpr int BM = 256, BK = 64, HALF = 128, HTB = HALF * BK * 2  , STAGE_BYTES = 8 * HTB, NXCD = 8, WGM = 8;

__host__ __device__ __forceinline__ int lds_byte(int r, int c) { const int st = (r >> 4) * 2 + (c >> 5), rr = r & 15, cc = c & 31, ob = rr * 64 + cc * 2; return st * 1024 + (ob ^ (((ob >> 9) & 1) << 5)); }
__host__ __device__ __forceinline__ void stage_rc(int b, int& R, int& C) { const int st = b / 1024, sb = b % 1024, swz = sb ^ (((sb >> 9) & 1) << 5); R = (st >> 1) * 16 + swz / 64; C = (st & 1) * 32 + (swz % 64) / 2; }
__host__ __device__ __forceinline__ int perm32(int rho) { const int n = rho >> 4, i = rho & 15; return 8 * (i >> 2) + 4 * n + (i & 3); }


struct Unit { int pm, pn, kind; };

typedef float f32x2_cv __attribute__((ext_vector_type(2))); typedef __bf16 bf16x2_cv __attribute__((ext_vector_type(2)));
__device__ __forceinline__ unsigned cvt_pk_bf16(float lo, float hi) { const f32x2_cv v = {lo, hi}; const bf16x2_cv b = __builtin_convertvector(v, bf16x2_cv); return __builtin_bit_cast(unsigned, b); }
__device__ __forceinline__ float bf_lo(unsigned u) { return __uint_as_float(u << 16); }
__device__ __forceinline__ float bf_hi(unsigned u) { return __uint_as_float(u & 0xffff0000u); }
__device__ __forceinline__ float sigmoidf_fast(float x) { return __builtin_amdgcn_rcpf(1.0f + __builtin_amdgcn_exp2f(-1.4426950408889634f * x)); }

__device__ __forceinline__ void tile_of(int L, int nM, int nN, int& pm, int& pn) {
    const int nwg = nM * nN; int wgid = L; { const int q = nwg / NXCD, r = nwg % NXCD, xcd = wgid % NXCD, off = wgid / NXCD; wgid = (xcd < r ? xcd * (q + 1) : r * (q + 1) + (xcd - r) * q) + off; }
    const int nig = WGM * nN, gid = wgid / nig, fm = gid * WGM, gsz = (nM - fm) < WGM ? (nM - fm) : WGM;
    pm = fm + ((wgid % nig) % gsz); pn = (wgid % nig) / gsz;
}

struct SchedTiles {
    static constexpr bool HAS_HALF = false;
    const char* A; const char* Bt; size_t tstep; int nM, nN, G, c;
    __device__ __forceinline__ bool next(int i, Unit& u) const { const int L = i * G + c; if (L >= nM * nN) return false; tile_of(L, nM, nN, u.pm, u.pn); u.kind = 0; return true; }
    __device__ __forceinline__ void operands(const Unit& u, const char*& a, const char*& b) const { a = A + (size_t)u.pm * tstep; b = Bt + (size_t)u.pn * tstep; }
    __device__ __forceinline__ void a_ready(const Unit&) const {}
    __device__ __forceinline__ void done(const Unit&) const {}
};
struct SchedG1 {
    static constexpr bool HAS_HALF = true;
    const char* A; const char* Bt; size_t tstep; int nM, nN, G, c;
    __device__ __forceinline__ bool next(int i, Unit& u) const {
        if (i < 5) { tile_of(i * 256 + c, 32, 44, u.pm, u.pn); u.kind = 0; return true; }
        if (i > 5) return false; const int x = c & 7, j = c >> 3, r = j & 7, q = j >> 3; u.pm = 8 * (x >> 1) + r; u.pn = ((x & 1) ? 42 : 20) + (q >> 1); u.kind = 2 + (q & 1); return true; }
    __device__ __forceinline__ bool is_half(const Unit& u) const { return u.kind >= 2; }
    __device__ __forceinline__ void operands(const Unit& u, const char*& a, const char*& b) const { a = A + (size_t)u.pm * tstep + (u.kind == 3 ? (tstep >> 1) : 0); b = Bt + (size_t)u.pn * tstep; }
    __device__ __forceinline__ void a_ready(const Unit&) const {}
    __device__ __forceinline__ void done(const Unit&) const {}
};
struct SchedProj {
    static constexpr bool HAS_HALF = false;
    const char* A; const char* Bt; const char* A2; const char* Bt2; size_t tstep; int nM, nN, G, c;
    __device__ __forceinline__ bool next(int i, Unit& u) const { const int L = i * G + c, nwg = nM * nN; if (L < nwg) { tile_of(L, nM, nN, u.pm, u.pn); u.kind = 0; return true; }
        if (L < nwg + 16) { const int j = L - nwg; u.pm = j & 1; u.pn = j >> 1; u.kind = 1; return true; } return false; }
    __device__ __forceinline__ void operands(const Unit& u, const char*& a, const char*& b) const { a = (u.kind ? A2 : A) + (size_t)u.pm * tstep; b = (u.kind ? Bt2 : Bt) + (size_t)u.pn * tstep; }
    __device__ __forceinline__ void a_ready(const Unit&) const {}
    __device__ __forceinline__ void done(const Unit&) const {}
};
struct SchedMix {
    static constexpr bool HAS_HALF = false;
    const char* Aswa; const char* Amem; const char* Ays; const char* Bswa; const char* Bmem; const char* Bglu; size_t tstep; int nM, nN, G, c;
    __device__ __forceinline__ bool next(int i, Unit& u) const { const int L = (i >> 2) * G + c; if (L >= nM * nN) return false; tile_of(L, nM, nN, u.pm, u.pn); u.kind = i & 3; return true; }
    __device__ __forceinline__ void operands(const Unit& u, const char*& a, const char*& b) const {
        if (u.kind == 0) { a = Aswa + (size_t)u.pm * tstep; b = Bswa + (size_t)u.pn * tstep; }
        else if (u.kind == 1) { a = Amem + (size_t)u.pm * tstep; b = Bmem + (size_t)u.pn * tstep; }
        else { a = Ays + (size_t)u.pm * tstep; b = Bglu + (size_t)(2 * u.pn + (u.kind - 2)) * tstep; } }
    __device__ __forceinline__ void a_ready(const Unit&) const {}
    __device__ __forceinline__ void done(const Unit&) const {}
};

__device__ __forceinline__ float row_rstd(const float* SSQ, size_t row, int fq) {
    const f32x4* q = (const f32x4*)(SSQ + row * 32 + 8 * fq); const f32x4 a = q[0], b = q[1];
    float s = ((a[0] + a[1]) + (a[2] + a[3])) + ((b[0] + b[1]) + (b[2] + b[3])); s += __shfl_xor(s, 16); s += __shfl_xor(s, 32);
    return 1.0f / sqrtf(s * (1.0f / 2048.0f) + 1e-5f);
}
struct RstdTab { const PG8_LAS float* tab; int pm0; const float* SSQ;
    __device__ __forceinline__ float get(const Unit& u, int rowin, int fq) const { const float r = tab[rowin]; return (u.pm == pm0) ? r : __builtin_nanf(""); } };
struct EpiSwiGLU {
    static constexpr bool PERM = true, AFTER_DRAIN = false;
    bf16_t* O; int ldo; RstdTab R;
    __device__ __forceinline__ void operator()(const f32x4 (&acc)[2][2][4][2], const Unit& u, int wr, int wc, int fr, int fq) const {
        const int hoff = (u.kind == 3) ? HALF : 0, row0 = u.pm * BM + hoff + wr * 64 + fr, col0 = u.pn * HALF + wc * 32 + 8 * fq;
#pragma unroll
        for (int ai = 0; ai < 2; ++ai) { if (ai == 1 && u.kind >= 2) break;
#pragma unroll
            for (int m = 0; m < 4; ++m) { bf16_t* rowp = O + (size_t)(row0 + ai * HALF + m * 16) * ldo + col0; float o[8]; const float rs = R.get(u, hoff + wr * 64 + fr + ai * HALF + m * 16, fq);
#pragma unroll
                for (int n = 0; n < 2; ++n)
#pragma unroll
                    for (int e = 0; e < 4; ++e) { const float g = acc[ai][0][m][n][e] * rs, uu = acc[ai][1][m][n][e] * rs; o[4 * n + e] = g * sigmoidf_fast(g) * uu; }
                u32x4 w; w.x = cvt_pk_bf16(o[0], o[1]); w.y = cvt_pk_bf16(o[2], o[3]); w.z = cvt_pk_bf16(o[4], o[5]); w.w = cvt_pk_bf16(o[6], o[7]);
                *(u32x4*)rowp = w; } }
    }
};
struct EpiResid {
    static constexpr bool PERM = true, AFTER_DRAIN = false;
    const float* X0; float alpha; int ldc; bf16_t* HB; float* SSQ; bf16_t* HBout;
    static __device__ __forceinline__ void finish(const f32x4 (&v)[2][2], int ai, int m, int pn, int row0, int col0, int wc, int fq, int ldc, bf16_t* HBout, float* SSQ) {
        const size_t off = (size_t)(row0 + ai * HALF + m * 16) * ldc + col0; float ss = 0.f;
#pragma unroll
        for (int bj = 0; bj < 2; ++bj) { const f32x4 x0 = v[bj][0], x1 = v[bj][1];
            ss += ((x0[0] * x0[0] + x0[1] * x0[1]) + (x0[2] * x0[2] + x0[3] * x0[3])) + ((x1[0] * x1[0] + x1[1] * x1[1]) + (x1[2] * x1[2] + x1[3] * x1[3]));
            u32x4 w; w.x = cvt_pk_bf16(x0[0], x0[1]); w.y = cvt_pk_bf16(x0[2], x0[3]); w.z = cvt_pk_bf16(x1[0], x1[1]); w.w = cvt_pk_bf16(x1[2], x1[3]); *(u32x4*)(HBout + off + bj * HALF) = w; }
        ss += __shfl_xor(ss, 16); ss += __shfl_xor(ss, 32);
        if (fq == 0) SSQ[(size_t)(row0 + ai * HALF + m * 16) * 32 + pn * 4 + wc] = ss;
    }
    __device__ __forceinline__ void operator()(const f32x4 (&acc)[2][2][4][2], const Unit& u, int wr, int wc, int fr, int fq) const {
        int row0 = u.pm * BM + wr * 64 + fr, col0 = u.pn * BM + wc * 32 + 8 * fq;
        asm volatile("" : "+v"(row0), "+v"(col0));
        const int pn_ = u.pn, ldc_ = ldc; bf16_t* const hbo_ = HBout; float* const ssq_ = SSQ; const float alpha_ = alpha; const float* const x0_ = X0; const bf16_t* const hb_ = HB;
        if (x0_) {
#pragma unroll
            for (int ai = 0; ai < 2; ++ai)
#pragma unroll
                for (int mp = 0; mp < 2; ++mp) { f32x4 b[2][2][2];
#pragma unroll
                    for (int mm = 0; mm < 2; ++mm)
#pragma unroll
                        for (int bj = 0; bj < 2; ++bj)
#pragma unroll
                            for (int n = 0; n < 2; ++n) b[mm][bj][n] = *(const f32x4*)(x0_ + (size_t)(row0 + ai * HALF + (2 * mp + mm) * 16) * ldc_ + col0 + bj * HALF + n * 4);
#pragma unroll
                    for (int mm = 0; mm < 2; ++mm) { f32x4 v[2][2];
#pragma unroll
                        for (int bj = 0; bj < 2; ++bj)
#pragma unroll
                            for (int n = 0; n < 2; ++n) v[bj][n] = b[mm][bj][n] + acc[ai][bj][2 * mp + mm][n] * alpha_;
                        finish(v, ai, 2 * mp + mm, pn_, row0, col0, wc, fq, ldc_, hbo_, ssq_); }
                }
        } else {
#pragma unroll
            for (int ai = 0; ai < 2; ++ai) { u32x4 hw[4][2];
#pragma unroll
                for (int m = 0; m < 4; ++m)
#pragma unroll
                    for (int bj = 0; bj < 2; ++bj) hw[m][bj] = *(const u32x4*)(hb_ + (size_t)(row0 + ai * HALF + m * 16) * ldc_ + col0 + bj * HALF);
#pragma unroll
                for (int m = 0; m < 4; ++m) { f32x4 v[2][2];
#pragma unroll
                    for (int bj = 0; bj < 2; ++bj) { const u32x4 h4 = hw[m][bj];
                        v[bj][0] = (f32x4){bf_lo(h4.x), bf_hi(h4.x), bf_lo(h4.y), bf_hi(h4.y)} + acc[ai][bj][m][0] * alpha_; v[bj][1] = (f32x4){bf_lo(h4.z), bf_hi(h4.z), bf_lo(h4.w), bf_hi(h4.w)} + acc[ai][bj][m][1] * alpha_; }
                    finish(v, ai, m, pn_, row0, col0, wc, fq, ldc_, hbo_, ssq_); }
            }
        }
    }
};
struct EpiProj {
    static constexpr bool PERM = true, AFTER_DRAIN = false;
    bf16_t* P; int ldp; int sig_from; bf16_t* KV; int ldk; RstdTab R; bf16_t* SIN;
    __device__ __forceinline__ void operator()(const f32x4 (&acc)[2][2][4][2], const Unit& u, int wr, int wc, int fr, int fq) const {
        const int row0 = u.pm * BM + wr * 64 + fr, col0 = u.pn * BM + wc * 32 + 8 * fq;
        bf16_t* base = u.kind ? KV : P; const int ld = u.kind ? ldk : ldp; const bool sig = (u.kind == 0) && (u.pn >= sig_from);
#pragma unroll
        for (int ai = 0; ai < 2; ++ai)
#pragma unroll
            for (int m = 0; m < 4; ++m) { bf16_t* rowp = base + (size_t)(row0 + ai * HALF + m * 16) * ld + col0; const float rs = u.kind ? 1.0f : R.get(u, wr * 64 + fr + ai * HALF + m * 16, fq);
#pragma unroll
                for (int bj = 0; bj < 2; ++bj) { f32x4 v0 = acc[ai][bj][m][0] * rs, v1 = acc[ai][bj][m][1] * rs;
                    if (sig) {
#pragma unroll
                        for (int e = 0; e < 4; ++e) { v0[e] = sigmoidf_fast(v0[e]); v1[e] = sigmoidf_fast(v1[e]); } }
                    u32x4 w; w.x = cvt_pk_bf16(v0[0], v0[1]); w.y = cvt_pk_bf16(v0[2], v0[3]); w.z = cvt_pk_bf16(v1[0], v1[1]); w.w = cvt_pk_bf16(v1[2], v1[3]);
                    if (u.kind == 0 && u.pn >= 6 && u.pn < 10) { const int cs = (u.pn - 6) * BM + bj * HALF + wc * 32 + 8 * fq; *(u32x4*)(SIN + ((size_t)(cs >> 4) * 8192 + (size_t)(row0 + ai * HALF + m * 16)) * 16 + (cs & 15)) = w; }
                    else *(u32x4*)(rowp + bj * HALF) = w; } }
    }
};
struct EpiMix {
    static constexpr bool PERM = true, AFTER_DRAIN = false;
    bf16_t* MG; const bf16_t* Gt; int ldg;
    __device__ __forceinline__ void operator()(const f32x4 (&acc)[2][2][4][2], const Unit& u, int wr, int wc, int fr, int fq) const {
        int row0 = u.pm * BM + wr * 64 + fr, cw = wc * 32 + 8 * fq;
        asm volatile("" : "+v"(row0), "+v"(cw));
        if (u.kind < 2) {
            const int gsel = u.kind == 0 ? 0 : 4096;
#pragma unroll
            for (int ai = 0; ai < 2; ++ai)
#pragma unroll
                for (int mp = 0; mp < 2; ++mp) { u32x4 gw[2][2], tw[2][2];
#pragma unroll
                    for (int mm = 0; mm < 2; ++mm)
#pragma unroll
                        for (int bj = 0; bj < 2; ++bj) { const size_t row = (size_t)(row0 + ai * HALF + (2 * mp + mm) * 16); const int col = u.pn * BM + bj * HALF + cw;
                            gw[mm][bj] = *(const u32x4*)(Gt + row * ldg + gsel + col); if (u.kind == 1) tw[mm][bj] = *(const u32x4*)(MG + row * 2048 + col); else tw[mm][bj] = (u32x4){0u, 0u, 0u, 0u}; }
#pragma unroll
                    for (int mm = 0; mm < 2; ++mm)
#pragma unroll
                        for (int bj = 0; bj < 2; ++bj) { const int m = 2 * mp + mm; const size_t row = (size_t)(row0 + ai * HALF + m * 16); const int col = u.pn * BM + bj * HALF + cw; const u32x4 g = gw[mm][bj], t = tw[mm][bj];
                            const f32x4 g0 = {bf_lo(g.x), bf_hi(g.x), bf_lo(g.y), bf_hi(g.y)}, g1 = {bf_lo(g.z), bf_hi(g.z), bf_lo(g.w), bf_hi(g.w)};
                            const f32x4 t0 = acc[ai][bj][m][0] * g0 + (f32x4){bf_lo(t.x), bf_hi(t.x), bf_lo(t.y), bf_hi(t.y)}, t1 = acc[ai][bj][m][1] * g1 + (f32x4){bf_lo(t.z), bf_hi(t.z), bf_lo(t.w), bf_hi(t.w)};
                            u32x4 w; w.x = cvt_pk_bf16(t0[0], t0[1]); w.y = cvt_pk_bf16(t0[2], t0[3]); w.z = cvt_pk_bf16(t1[0], t1[1]); w.w = cvt_pk_bf16(t1[2], t1[3]); *(u32x4*)(MG + row * 2048 + col) = w; }
                    }
        } else {
            const int col = u.pn * BM + (u.kind - 2) * HALF + cw;
#pragma unroll
            for (int ai = 0; ai < 2; ++ai) { u32x4 gw[4], tw[4];
#pragma unroll
                for (int m = 0; m < 4; ++m) { const size_t row = (size_t)(row0 + ai * HALF + m * 16); gw[m] = *(const u32x4*)(Gt + row * ldg + 2048 + col); tw[m] = *(const u32x4*)(MG + row * 2048 + col); }
#pragma unroll
                for (int m = 0; m < 4; ++m) { const size_t row = (size_t)(row0 + ai * HALF + m * 16); const u32x4 g = gw[m], t = tw[m];
                    const float gg[8] = {bf_lo(g.x), bf_hi(g.x), bf_lo(g.y), bf_hi(g.y), bf_lo(g.z), bf_hi(g.z), bf_lo(g.w), bf_hi(g.w)};
                    const float tt[8] = {bf_lo(t.x), bf_hi(t.x), bf_lo(t.y), bf_hi(t.y), bf_lo(t.z), bf_hi(t.z), bf_lo(t.w), bf_hi(t.w)}; float o[8];
#pragma unroll
                    for (int n = 0; n < 2; ++n)
#pragma unroll
                        for (int e = 0; e < 4; ++e) { const float ga = acc[ai][0][m][n][e], gb = acc[ai][1][m][n][e]; o[4 * n + e] = tt[4 * n + e] + gg[4 * n + e] * ga * sigmoidf_fast(gb); }
                    u32x4 w; w.x = cvt_pk_bf16(o[0], o[1]); w.y = cvt_pk_bf16(o[2], o[3]); w.z = cvt_pk_bf16(o[4], o[5]); w.w = cvt_pk_bf16(o[6], o[7]);
                    *(u32x4*)(MG + row * 2048 + col) = w; }
                }
        }
    }
};

template <class Epi, class Sched, bool ALIGN_EPI = false, bool SP2 = false>
__device__ __forceinline__ void gemm_phase(PG8_LAS unsigned char* lds, const int K, const Sched& S, const Epi& E) {
    int tid_ = threadIdx.x; asm volatile("" : "+v"(tid_));
    const int tid = tid_, wid = __builtin_amdgcn_readfirstlane(tid >> 6), lane = tid & 63, wr = wid >> 2, wc = wid & 3, fr = lane & 15, fq = lane >> 4;
    static_assert(SP2, "this copy of the body keeps only the two-super-phase K-loop");
    const int nt = K / BK;
    unsigned voffA[2], voffB[2];
#pragma unroll
    for (int i = 0; i < 2; ++i) { int R, C; stage_rc(tid * 16 + i * 8192, R, C); const int Rb = Epi::PERM ? ((R & ~31) + perm32(R & 31)) : R;
        voffA[i] = (unsigned)(R * K + C) * 2u; voffB[i] = (unsigned)(Rb * K + C) * 2u; }
    const size_t kstep = (size_t)(BK * 2);
    const size_t hstep = (size_t)HALF * K * 2;
    const unsigned ldsw = (unsigned)wid * 1024u;
    const int aoff = lds_byte(wr * 64 + fr, fq * 8), boff = lds_byte(wc * 32 + fr, fq * 8);
#define PG8_SA(b, h) (((b) * 2 + (h)) * HTB)
#define PG8_SB(b, h) ((4 + (b) * 2 + (h)) * HTB)
#define PG8_STAGE(bufoff, gbase, voff) do { _Pragma("unroll") for (int _i = 0; _i < 2; ++_i) \
        __builtin_amdgcn_global_load_lds((const unsigned*)((const char*)(gbase) + (voff)[_i]), (PG8_LAS unsigned*)(lds + (bufoff) + ldsw + _i * 8192), 16, 0, 0); } while (0)
#define PG8_LDA(dst, b, h) do { _Pragma("unroll") for (int m = 0; m < 4; ++m) _Pragma("unroll") for (int k = 0; k < 2; ++k) dst[m][k] = *(const PG8_LAS bf16x8*)(lds + PG8_SA(b, h) + aoff + m * 2048 + k * 1024); } while (0)
#define PG8_LDB(dst, b, h) do { _Pragma("unroll") for (int n = 0; n < 2; ++n) _Pragma("unroll") for (int k = 0; k < 2; ++k) dst[n][k] = *(const PG8_LAS bf16x8*)(lds + PG8_SB(b, h) + boff + n * 2048 + k * 1024); } while (0)
#define PG8_MMA(ai, bj, At, Bt) do { __builtin_amdgcn_s_setprio(1); _Pragma("unroll") for (int m = 0; m < 4; ++m) _Pragma("unroll") for (int n = 0; n < 2; ++n) _Pragma("unroll") for (int k = 0; k < 2; ++k) \
        acc[ai][bj][m][n] = __builtin_amdgcn_mfma_f32_16x16x32_bf16(Bt[n][k], At[m][k], acc[ai][bj][m][n], 0, 0, 0); __builtin_amdgcn_s_setprio(0); } while (0)
#define PG8_WAIT_V(n) asm volatile("s_waitcnt vmcnt(" #n ")" ::: "memory")
#define PG8_WAIT_L(n) asm volatile("s_waitcnt lgkmcnt(" #n ")" ::: "memory")
#define PG8_BAR __builtin_amdgcn_s_barrier()
#define PG8_SCHED __builtin_amdgcn_sched_barrier(0)
    Unit cur, nxt; int ui = 0;
    if (!S.next(0, cur)) return;
    f32x4 acc[2][2][4][2];
#pragma unroll
    for (int a = 0; a < 2; ++a)
#pragma unroll
        for (int b = 0; b < 2; ++b)
#pragma unroll
            for (int m = 0; m < 4; ++m)
#pragma unroll
                for (int n = 0; n < 2; ++n) acc[a][b][m][n] = (f32x4){0.f, 0.f, 0.f, 0.f};
    bf16x8 At[4][2], B0[2][2], B1[2][2];
    const char* cA; const char* cB; S.operands(cur, cA, cB);
    S.a_ready(cur);
    if constexpr (SP2) {
        PG8_STAGE(PG8_SB(0, 0), cB, voffB); PG8_STAGE(PG8_SB(0, 1), cB + hstep, voffB); PG8_STAGE(PG8_SA(0, 0), cA, voffA); PG8_STAGE(PG8_SA(0, 1), cA + hstep, voffA);
        if (wr == 1) PG8_BAR;
        PG8_WAIT_V(2); PG8_BAR;
        PG8_STAGE(PG8_SB(1, 0), cB + kstep, voffB); PG8_STAGE(PG8_SA(1, 0), cA + kstep, voffA); PG8_STAGE(PG8_SB(1, 1), cB + hstep + kstep, voffB);
        PG8_WAIT_V(6); PG8_BAR;
    } else {
        PG8_STAGE(PG8_SB(0, 0), cB, voffB); PG8_STAGE(PG8_SA(0, 0), cA, voffA); PG8_STAGE(PG8_SB(0, 1), cB + hstep, voffB); PG8_STAGE(PG8_SA(0, 1), cA + hstep, voffA);
        if (wr == 1) PG8_BAR;
        PG8_WAIT_V(4); PG8_BAR;
        PG8_STAGE(PG8_SB(1, 0), cB + kstep, voffB); PG8_STAGE(PG8_SA(1, 0), cA + kstep, voffA); PG8_STAGE(PG8_SB(1, 1), cB + hstep + kstep, voffB);
        PG8_WAIT_V(6); PG8_BAR;
    }
    for (;;) {
        const bool has_next = S.next(ui + 1, nxt);
        const char* nA = cA; const char* nB = cB; if (has_next) S.operands(nxt, nA, nB);
#define PG8_KLOOP(HF)         for (int t = 0; t < nt; t += 2) { \
            const bool last = (t == nt - 2); \
            const char* a1 = cA + (size_t)(t + 1) * kstep; \
            const char* a2 = last ? nA : cA + (size_t)(t + 2) * kstep; const char* b2 = last ? nB : cB + (size_t)(t + 2) * kstep; \
            const char* a3 = a2 + kstep; const char* b3 = b2 + kstep; \
            if (last && has_next) S.a_ready(nxt); \
            PG8_LDB(B0, 0, 0); PG8_LDB(B1, 0, 1); PG8_SCHED; PG8_LDA(At, 0, 0); PG8_STAGE(PG8_SA(1, 1), a1 + hstep, voffA); \
            PG8_WAIT_V(8); PG8_WAIT_L(0); PG8_BAR; PG8_MMA(0, 0, At, B0); PG8_MMA(0, 1, At, B1); PG8_BAR; PG8_SCHED; \
            if (!(HF)) PG8_LDA(At, 0, 1); PG8_STAGE(PG8_SB(0, 0), b2, voffB); PG8_STAGE(PG8_SB(0, 1), b2 + hstep, voffB); PG8_STAGE(PG8_SA(0, 0), a2, voffA); \
            PG8_WAIT_V(8); PG8_WAIT_L(0); PG8_BAR; if (!(HF)) { PG8_MMA(1, 0, At, B0); PG8_MMA(1, 1, At, B1); } PG8_BAR; PG8_SCHED; \
            PG8_LDB(B0, 1, 0); PG8_LDB(B1, 1, 1); PG8_SCHED; PG8_LDA(At, 1, 0); PG8_STAGE(PG8_SA(0, 1), a2 + hstep, voffA); \
            PG8_WAIT_V(8); PG8_WAIT_L(0); PG8_BAR; PG8_MMA(0, 0, At, B0); PG8_MMA(0, 1, At, B1); PG8_BAR; PG8_SCHED; \
            if (!(HF)) PG8_LDA(At, 1, 1); PG8_STAGE(PG8_SB(1, 0), b3, voffB); PG8_STAGE(PG8_SB(1, 1), b3 + hstep, voffB); PG8_STAGE(PG8_SA(1, 0), a3, voffA); \
            PG8_WAIT_V(8); PG8_WAIT_L(0); PG8_BAR; if (!(HF)) { PG8_MMA(1, 0, At, B0); PG8_MMA(1, 1, At, B1); } PG8_BAR; PG8_SCHED; \
        }
        if constexpr (Sched::HAS_HALF) { if (S.is_half(cur)) { PG8_KLOOP(true) } else { PG8_KLOOP(false) } } else { PG8_KLOOP(false) }
#undef PG8_KLOOP
        if constexpr (ALIGN_EPI) { if (wr == 0) PG8_BAR; }
        if constexpr (!Epi::AFTER_DRAIN) { E(acc, cur, wr, wc, fr, fq); S.done(cur); }
        if (!has_next) break;
#pragma unroll
        for (int a = 0; a < 2; ++a)
#pragma unroll
            for (int b = 0; b < 2; ++b)
#pragma unroll
                for (int m = 0; m < 4; ++m)
#pragma unroll
                    for (int n = 0; n < 2; ++n) acc[a][b][m][n] = (f32x4){0.f, 0.f, 0.f, 0.f};
        cur = nxt; cA = nA; cB = nB; ++ui;
        if constexpr (ALIGN_EPI) { if (wr == 1) PG8_BAR; }
    }
    PG8_WAIT_V(0);
    if constexpr (!ALIGN_EPI) { if (wr == 0) PG8_BAR; }
    PG8_BAR;
    if constexpr (Epi::AFTER_DRAIN) { E.fused(acc, cur, wr, wc, fr, fq, lds, wid, lane); S.done(cur); }
#undef PG8_SA
#undef PG8_SB
#undef PG8_STAGE
#undef PG8_LDA
#undef PG8_LDB
#undef PG8_MMA
#undef PG8_WAIT_V
#undef PG8_WAIT_L
#undef PG8_BAR
#undef PG8_SCHED
}
}

constexpr int BATCH = 2, SEQ = 4096, DM = 2048, DEPTH = 4, NMEM = 256, DFF = 5632;
constexpr int T = BATCH * SEQ;
constexpr int INW = 9728, COL_Q = 0, COL_K = 1024, COL_V = 1280, COL_S = 1536, COL_MQ = 2560, COL_G = 3584;
constexpr float RMS_EPS = 1e-5f, LOG2E = 1.4426950408889634f;
constexpr int NWAVES = 8;
enum { I_X = 0, I_MEM, I_F1N, I_F1WI, I_F1WO, I_MIXN, I_MEMN, I_WIN, I_SINK, I_WMKV, I_LRE, I_LIM, I_LDT, I_BRE, I_BIM, I_CRE, I_CIM, I_DSK, I_WGLU, I_WSWA, I_WMEMUP, I_WOUT, I_F2N, I_F2WI, I_F2WO, I_FINN, N_IN };

constexpr size_t MiB = 1u << 20;
constexpr size_t WS_CTL = 0, CTL_ZERO_BYTES = 1 * MiB;
constexpr size_t WS_W = 2 * MiB, W_LAYER = 202 * MiB;
constexpr size_t WO_1IN = 0, WO_1OUT = 44 * MiB, WO_IN = 66 * MiB, WO_MKV = 104 * MiB, WO_SWA = 112 * MiB, WO_MEM = 116 * MiB, WO_GLU = 120 * MiB, WO_OUT = 128 * MiB, WO_2IN = 136 * MiB, WO_2OUT = 180 * MiB;
constexpr size_t WS_MEMN = WS_W + DEPTH * W_LAYER;
constexpr size_t WS_H = WS_MEMN + 8 * MiB;
constexpr size_t WS_XN = WS_H + 64 * MiB;
constexpr size_t WS_HID = WS_XN + 32 * MiB;
constexpr size_t WS_PROJ = WS_HID + 88 * MiB;
constexpr size_t WS_MKV = WS_PROJ + 152 * MiB;
constexpr size_t WS_OSWA = WS_MKV + 2 * MiB, WS_YS = WS_OSWA + 16 * MiB, WS_OMEM = WS_YS + 16 * MiB;
constexpr size_t WS_T32 = WS_OMEM + 16 * MiB;
constexpr size_t WS_MG = WS_T32 + 64 * MiB;
constexpr size_t WS_SEND = WS_MG + 32 * MiB;
constexpr size_t LB_BYTES = 65 * 512;
constexpr size_t WS_LB = WS_SEND + 4 * MiB;
constexpr size_t WS_WINT = WS_LB + 9 * MiB;
constexpr size_t WS_WOUTT = WS_WINT + 64 * MiB;
constexpr size_t WS_SST = WS_WOUTT + 64 * MiB;
constexpr size_t WS_A64 = WS_SST + 2 * MiB;
constexpr size_t WS_SSQ = WS_A64 + 1 * MiB;
constexpr size_t WS_SIN = WS_SSQ + 1 * MiB;
constexpr size_t WS_END = WS_SIN + 16 * MiB;
static_assert(DEPTH * 64 * LB_BYTES <= 9 * MiB, "lag tables fit");
constexpr int CW_BAR = 4096;

constexpr int RING_OFF = 0, RING_BYTES = 131072;
constexpr int LDSCTL_OFF = RING_BYTES, MISC_OFF = LDSCTL_OFF + 320;
constexpr int LDS_BYTES = 147456;

#define GAS __attribute__((address_space(1)))
#define LAS __attribute__((address_space(3)))
typedef unsigned short bf16;
typedef unsigned v4u __attribute__((ext_vector_type(4)));
typedef unsigned v2u __attribute__((ext_vector_type(2)));
typedef float f32x4 __attribute__((ext_vector_type(4)));
typedef float f32x2 __attribute__((ext_vector_type(2)));
typedef GAS unsigned gu32;
using pg8::cvt_pk_bf16; using pg8::bf_lo; using pg8::bf_hi;

#define XB_TMO      128
#define XB_XCNT(j)  (256  + 64 * (j))
#define XB_XSUB(j)  (1280 + 64 * (j))
#define XB_XGEN(j)  (2304 + 64 * (j))
#define XB_TOP      3328
#define XB_TOPGEN   3392
#define XCD_BAR_WORDS 3456
#define XB_SPIN_CAP (1u << 18)

__device__ __forceinline__ unsigned xb_ld(unsigned* p)              { return __hip_atomic_load(p, __ATOMIC_RELAXED, __HIP_MEMORY_SCOPE_AGENT); }
__device__ __forceinline__ unsigned xb_add(unsigned* p, unsigned v) { return __hip_atomic_fetch_add(p, v, __ATOMIC_RELAXED, __HIP_MEMORY_SCOPE_AGENT); }
__device__ __forceinline__ unsigned xb_xcc_id() { return (unsigned)__builtin_amdgcn_s_getreg((3 << 11) | 20) & 0xFu; }
#define XB_SPIN(cond, bar) do { unsigned _sp = 0; while (cond) { __builtin_amdgcn_s_sleep(1); \
    if ((++_sp & 255u) == 0u) { if (xb_ld(&(bar)[XB_TMO])) break; if (_sp > XB_SPIN_CAP) { atomicAdd(&(bar)[XB_TMO], 1u); break; } } } } while (0)

struct XcdBarrier {
    unsigned* bar; unsigned x;
    volatile LAS unsigned* st;
};

__device__ __forceinline__ XcdBarrier xcd_barrier_post(unsigned* bar, volatile LAS unsigned* st) {
    XcdBarrier b; b.bar = bar; b.x = xb_xcc_id(); b.st = st;
    if (threadIdx.x == 0) (void)xb_add(&bar[XB_XCNT(b.x)], 1u);
    return b;
}
__device__ __forceinline__ void xcd_barrier_complete(unsigned* bar, unsigned x, unsigned& nloc, unsigned& nx) {
    const unsigned G = gridDim.x * gridDim.y * gridDim.z;
    unsigned sum, cnt, mine, sp = 0u;
    for (;;) {
        sum = 0u; cnt = 0u; mine = 0u;
#pragma unroll
        for (unsigned j = 0; j < 16; ++j) { const unsigned c = xb_ld(&bar[XB_XCNT(j)]); sum += c; cnt += (c > 0u) ? 1u : 0u; mine = (j == x) ? c : mine; }
        if (sum == G) break;
        __builtin_amdgcn_s_sleep(1);
        if ((++sp & 255u) == 0u) { if (xb_ld(&bar[XB_TMO])) break; if (sp > XB_SPIN_CAP) { atomicAdd(&bar[XB_TMO], 1u); break; } }
    }
    nloc = mine > 0u ? mine : 1u; nx = cnt > 0u ? cnt : 1u;
}

__device__ __forceinline__ void xcd_barrier(const XcdBarrier& b) {
    asm volatile("s_waitcnt vmcnt(0)" ::: "memory");
    __syncthreads();
    if (threadIdx.x == 0) {
#if DIAG
        const unsigned long long dt0_ = __builtin_amdgcn_s_memrealtime();
#endif
        unsigned* bar = b.bar;
        __builtin_amdgcn_s_waitcnt(0);
        unsigned nloc = b.st[0], nx = b.st[1];
        if (nloc == 0u) { xcd_barrier_complete(bar, b.x, nloc, nx); b.st[0] = nloc; b.st[1] = nx; }
        const unsigned old = xb_add(&bar[XB_XSUB(b.x)], 1u);
        const unsigned gen = old / nloc;
        if (old + 1u == (gen + 1u) * nloc) {
            __builtin_amdgcn_fence(__ATOMIC_RELEASE, "agent");
            asm volatile("s_waitcnt vmcnt(0)" ::: "memory");
            const unsigned og = xb_add(&bar[XB_TOP], 1u);
            const unsigned tg = og / nx;
            if (og + 1u == (tg + 1u) * nx) xb_add(&bar[XB_TOPGEN], 1u);
            else XB_SPIN(xb_ld(&bar[XB_TOPGEN]) == tg, bar);
            __builtin_amdgcn_fence(__ATOMIC_ACQUIRE, "agent");
            xb_add(&bar[XB_XGEN(b.x)], 1u);
            asm volatile("s_waitcnt vmcnt(0)" ::: "memory");
        } else {
            XB_SPIN(xb_ld(&bar[XB_XGEN(b.x)]) == gen, bar);
            __builtin_amdgcn_fence(__ATOMIC_ACQUIRE, "agent");
            asm volatile("s_waitcnt vmcnt(0)" ::: "memory");
        }
#if DIAG
        b.st[8] += (unsigned)(__builtin_amdgcn_s_memrealtime() - dt0_);
#endif
    }
    __syncthreads();
}

struct Frame {
    LAS unsigned char* lds;
    int tid, lane, wave, G;
    unsigned char* ws;
};
__device__ __forceinline__ float wave_sum(float v) {
#pragma unroll
    for (int o = 1; o < 64; o <<= 1) v += __shfl_xor(v, o);
    return v;
}
__device__ __forceinline__ bf16* wsb(const Frame& F, size_t off) { return (bf16*)(F.ws + off); }

struct ConvItem { const float* src; const float* gk; bf16* dst; int K, N; float scale; };
__device__ __forceinline__ void conv_load(const ConvItem& c, float (&v)[64]) {
#pragma unroll
    for (int i = 0; i < 64; ++i) v[i] = c.src[(size_t)i * c.N];
}
__device__ __forceinline__ void conv_store(const ConvItem& c, float (&v)[64], int lane, LAS unsigned char* scr) {
    if (c.gk) {
#pragma unroll
        for (int i = 0; i < 64; ++i) v[i] *= c.gk[i]; }
    const float scale = c.scale;
#pragma unroll
    for (int q = 0; q < 8; ++q) { v4u o; o.x = cvt_pk_bf16(v[8 * q] * scale, v[8 * q + 1] * scale); o.y = cvt_pk_bf16(v[8 * q + 2] * scale, v[8 * q + 3] * scale);
        o.z = cvt_pk_bf16(v[8 * q + 4] * scale, v[8 * q + 5] * scale); o.w = cvt_pk_bf16(v[8 * q + 6] * scale, v[8 * q + 7] * scale); *(LAS v4u*)(scr + lane * 144 + q * 16) = o; }
    asm volatile("s_waitcnt lgkmcnt(0)" ::: "memory");
#pragma unroll
    for (int i = 0; i < 8; ++i) { const v4u o = *(const LAS v4u*)(scr + (8 * i + (lane >> 3)) * 144 + (lane & 7) * 16); *(v4u*)(c.dst + (size_t)(8 * i) * c.K) = o; }
    asm volatile("s_waitcnt lgkmcnt(0)" ::: "memory");
}
constexpr int CI_1IN = (DM / 64) * (2 * DFF / 64), CI_1OUT = (DFF / 64) * (DM / 64), CI_IN = (DM / 64) * (INW / 64), CI_MKV = (DM / 64) * (2048 / 64), CI_GLU = (1024 / 64) * (4096 / 64),
              CI_SWA = (1024 / 64) * (DM / 64), CI_MEM = CI_SWA, CI_OUT = (DM / 64) * (DM / 64), CI_LAYER = 2 * CI_1IN + 2 * CI_1OUT + CI_IN + CI_MKV + CI_GLU + CI_SWA + CI_MEM + CI_OUT;
struct ProIn { const float *f1wi, *f2wi, *f1wo, *f2wo, *win, *wmkv, *wglu, *wswa, *wmem, *wout, *mem, *memn, *f1n, *f2n, *mixn, *x; };
constexpr int TAB_WGS = 64;
__device__ __forceinline__ void prologue(Frame& F, const ProIn& I) {
    const bool split = F.G > TAB_WGS, tabwg = split && (int)blockIdx.x < TAB_WGS;
    const int nconv = split ? F.G - TAB_WGS : F.G, bconv = split ? (int)blockIdx.x - TAB_WGS : (int)blockIdx.x;
    int gw = bconv * NWAVES + F.wave, NGW = nconv * NWAVES; const int lane = F.lane;
    auto item = [&](int it, ConvItem& c) {
        const int l = it / CI_LAYER; int r = it % CI_LAYER; unsigned char* wl = F.ws + WS_W + (size_t)l * W_LAYER;
        const float* src; bf16* dst; int K, N, pairNh = 0; const float* gk = nullptr;
        if (r < CI_1IN) { src = I.f1wi + (size_t)l * DM * 2 * DFF; dst = (bf16*)(wl + WO_1IN); K = DM; N = 2 * DFF; pairNh = DFF; gk = I.f1n + (size_t)l * DM; }
        else if ((r -= CI_1IN) < CI_1IN) { src = I.f2wi + (size_t)l * DM * 2 * DFF; dst = (bf16*)(wl + WO_2IN); K = DM; N = 2 * DFF; pairNh = DFF; gk = I.f2n + (size_t)l * DM; }
        else if ((r -= CI_1IN) < CI_1OUT) { src = I.f1wo + (size_t)l * DFF * DM; dst = (bf16*)(wl + WO_1OUT); K = DFF; N = DM; }
        else if ((r -= CI_1OUT) < CI_1OUT) { src = I.f2wo + (size_t)l * DFF * DM; dst = (bf16*)(wl + WO_2OUT); K = DFF; N = DM; }
        else if ((r -= CI_1OUT) < CI_IN) { src = I.win + (size_t)l * DM * INW; dst = (bf16*)(wl + WO_IN); K = DM; N = INW; gk = I.mixn + (size_t)l * DM; }
        else if ((r -= CI_IN) < CI_MKV) { src = I.wmkv + (size_t)l * DM * 2048; dst = (bf16*)(wl + WO_MKV); K = DM; N = 2048; }
        else if ((r -= CI_MKV) < CI_GLU) { src = I.wglu + (size_t)l * 1024 * 4096; dst = (bf16*)(wl + WO_GLU); K = 1024; N = 4096; pairNh = 2048; }
        else if ((r -= CI_GLU) < CI_SWA) { src = I.wswa + (size_t)l * 1024 * DM; dst = (bf16*)(wl + WO_SWA); K = 1024; N = DM; }
        else if ((r -= CI_SWA) < CI_MEM) { src = I.wmem + (size_t)l * 1024 * DM; dst = (bf16*)(wl + WO_MEM); K = 1024; N = DM; }
        else { r -= CI_MEM; src = I.wout + (size_t)l * DM * DM; dst = (bf16*)(wl + WO_OUT); K = DM; N = DM; }
        const int nblk = N / 64, r8 = r >> 3, wv = r & 7, kb = 8 * (r8 / nblk) + wv, nb = r8 % nblk, n0 = nb * 64, k0 = kb * 64;
        float sc = 1.f; if (N == INW) sc = n0 < COL_K ? 0.125f * LOG2E : ((n0 >= COL_MQ && n0 < COL_G) ? 0.0625f * LOG2E : 1.f);
        int row0 = n0; if (pairNh) { const int j = n0 < pairNh ? n0 : n0 - pairNh; row0 = (j >> 7) * 256 + (j & 127) + (n0 < pairNh ? 0 : 128); }
        c.src = src + (size_t)k0 * N + n0 + lane; c.gk = gk ? gk + k0 : nullptr; c.dst = dst + (size_t)(row0 + (lane >> 3)) * K + k0 + 8 * (lane & 7); c.K = K; c.N = N; c.scale = sc;
    };
    if (!tabwg) {
        LAS unsigned char* scr = F.lds + F.wave * 9216; constexpr int NIT = DEPTH * CI_LAYER;
        float va[64], vb[64]; ConvItem ca, cb; int it = gw;
        if (it < NIT) { item(it, ca); conv_load(ca, va); }
        while (it < NIT) {
            const int it1 = it + NGW; if (it1 < NIT) { item(it1, cb); conv_load(cb, vb); }
            conv_store(ca, va, lane, scr);
            if (it1 >= NIT) break;
            const int it2 = it1 + NGW; if (it2 < NIT) { item(it2, ca); conv_load(ca, va); }
            conv_store(cb, vb, lane, scr);
            it = it2;
        }
    }
    if (split) { if (!tabwg) return; gw = (int)blockIdx.x * NWAVES + F.wave; NGW = TAB_WGS * NWAVES; }
    for (int m = gw; m < T; m += NGW) {
        const f32x4* xr = (const f32x4*)(I.x + (size_t)m * DM) + lane; v2u* o8 = (v2u*)(wsb(F, WS_XN) + (size_t)m * DM) + lane; float s = 0.f;
#pragma unroll
        for (int j = 0; j < 8; ++j) { const f32x4 v = xr[64 * j]; s += (v.x * v.x + v.y * v.y) + (v.z * v.z + v.w * v.w); v2u o; o.x = cvt_pk_bf16(v.x, v.y); o.y = cvt_pk_bf16(v.z, v.w); o8[64 * j] = o; }
        s = wave_sum(s); if (lane < 32) ((float*)(F.ws + WS_SSQ))[(size_t)m * 32 + lane] = lane == 0 ? s : 0.f;
    }
    for (int it = gw; it < DEPTH * 512; it += NGW) {
        const int l = it / 512, row = it % 512;
        const f32x4* xr = (const f32x4*)(I.mem + (size_t)row * DM) + lane; const f32x4* gr = (const f32x4*)(I.memn + (size_t)l * DM) + lane;
        f32x4 v[8]; float s = 0.f;
#pragma unroll
        for (int j = 0; j < 8; ++j) { v[j] = xr[64 * j]; s += (v[j].x * v[j].x + v[j].y * v[j].y) + (v[j].z * v[j].z + v[j].w * v[j].w); }
        const float rstd = 1.0f / sqrtf(wave_sum(s) * (1.f / DM) + RMS_EPS);
        v2u* o8 = (v2u*)(wsb(F, WS_MEMN) + ((size_t)l * 512 + row) * DM) + lane;
#pragma unroll
        for (int j = 0; j < 8; ++j) { const f32x4 g = gr[64 * j]; v2u o; o.x = cvt_pk_bf16(v[j].x * rstd * g.x, v[j].y * rstd * g.y); o.y = cvt_pk_bf16(v[j].z * rstd * g.z, v[j].w * rstd * g.w); o8[64 * j] = o; }
    }
}
constexpr int RSTD_OFF = LDSCTL_OFF + 1024;
__device__ __forceinline__ void rstd_table(Frame& F, int pm) {
    LAS float* tab = (LAS float*)(F.lds + RSTD_OFF);
    if (F.tid < 256) { const f32x4* q = (const f32x4*)((const float*)(F.ws + WS_SSQ) + ((size_t)pm * 256 + F.tid) * 32); float s = 0.f;
#pragma unroll
        for (int j = 0; j < 8; ++j) { const f32x4 a = q[j]; s += (a[0] + a[1]) + (a[2] + a[3]); }
        tab[F.tid] = 1.0f / sqrtf(s * (1.0f / DM) + RMS_EPS); }
    __syncthreads();
}
template <bool OUTF32>
__device__ __forceinline__ void norm_phase(Frame& F, const float* hin, const float* gain, void* outp) {
    const int gw = blockIdx.x * NWAVES + F.wave, NGW = F.G * NWAVES, lane = F.lane;
    f32x4 g[8];
#pragma unroll
    for (int j = 0; j < 8; ++j) g[j] = ((const f32x4*)gain)[lane + 64 * j];
    for (int m = gw; m < T; m += NGW) {
        const f32x4* xr = (const f32x4*)(hin + (size_t)m * DM) + lane;
        f32x4 v[8]; float s = 0.f;
#pragma unroll
        for (int j = 0; j < 8; ++j) { v[j] = xr[64 * j]; s += (v[j].x * v[j].x + v[j].y * v[j].y) + (v[j].z * v[j].z + v[j].w * v[j].w); }
        const float rstd = 1.0f / sqrtf(wave_sum(s) * (1.f / DM) + RMS_EPS);
        if (OUTF32) { f32x4* o = (f32x4*)((float*)outp + (size_t)m * DM) + lane;
#pragma unroll
            for (int j = 0; j < 8; ++j) o[64 * j] = v[j] * rstd * g[j];
        } else { v2u* o8 = (v2u*)((bf16*)outp + (size_t)m * DM) + lane;
#pragma unroll
            for (int j = 0; j < 8; ++j) { v2u o; o.x = cvt_pk_bf16(v[j].x * rstd * g[j].x, v[j].y * rstd * g[j].y); o.y = cvt_pk_bf16(v[j].z * rstd * g[j].z, v[j].w * rstd * g[j].w); o8[64 * j] = o; } }
    }
}
__device__ __forceinline__ void final_norm(Frame& F, const bf16* hb, const float* gain, float* outp) {
    const int gw = blockIdx.x * NWAVES + F.wave, NGW = F.G * NWAVES, lane = F.lane;
    for (int m = gw; m < T; m += NGW) {
        const v4u* xr = (const v4u*)(hb + (size_t)m * DM) + lane; float v[4][8]; float s = 0.f;
#pragma unroll
        for (int j = 0; j < 4; ++j) { const v4u w = xr[64 * j]; v[j][0] = bf_lo(w.x); v[j][1] = bf_hi(w.x); v[j][2] = bf_lo(w.y); v[j][3] = bf_hi(w.y); v[j][4] = bf_lo(w.z); v[j][5] = bf_hi(w.z); v[j][6] = bf_lo(w.w); v[j][7] = bf_hi(w.w);
#pragma unroll
            for (int e = 0; e < 8; ++e) s += v[j][e] * v[j][e]; }
        const float rstd = 1.0f / sqrtf(wave_sum(s) * (1.f / DM) + RMS_EPS);
#pragma unroll
        for (int j = 0; j < 4; ++j) { const f32x4* g = (const f32x4*)(gain + (lane + 64 * j) * 8); f32x4* o = (f32x4*)(outp + (size_t)m * DM + (lane + 64 * j) * 8); const f32x4 g0 = g[0], g1 = g[1];
            o[0] = (f32x4){v[j][0] * rstd * g0[0], v[j][1] * rstd * g0[1], v[j][2] * rstd * g0[2], v[j][3] * rstd * g0[3]}; o[1] = (f32x4){v[j][4] * rstd * g1[0], v[j][5] * rstd * g1[1], v[j][6] * rstd * g1[2], v[j][7] * rstd * g1[3]}; }
    }
}
__device__ __forceinline__ void unpack8(const v4u w, float* f) { f[0] = bf_lo(w.x); f[1] = bf_hi(w.x); f[2] = bf_lo(w.y); f[3] = bf_hi(w.y); f[4] = bf_lo(w.z); f[5] = bf_hi(w.z); f[6] = bf_lo(w.w); f[7] = bf_hi(w.w); }

__device__ __forceinline__ void swa_naive(Frame& F, const float* sinks) {
    const bf16* P = wsb(F, WS_PROJ); bf16* O = wsb(F, WS_OSWA);
    for (int idx = blockIdx.x * 512 + F.tid; idx < T * 16; idx += F.G * 512) {
        const int hq = idx / T, m = idx % T, b = m / SEQ, t = m % SEQ, g = hq >> 2;
        float q[64];
        { const v4u* qp = (const v4u*)(P + (size_t)m * INW + COL_Q + hq * 64);
#pragma unroll
          for (int j = 0; j < 8; ++j) unpack8(qp[j], q + 8 * j); }
        float mrun = sinks[hq] * LOG2E, lrun = 1.f, o[64];
#pragma unroll
        for (int j = 0; j < 64; ++j) o[j] = 0.f;
        const int k0 = t >= 127 ? t - 127 : 0;
        for (int kp = k0; kp <= t; ++kp) {
            const bf16* kr = P + (size_t)(b * SEQ + kp) * INW + COL_K + g * 64; const bf16* vr = kr + (COL_V - COL_K);
            float s0 = 0.f, s1 = 0.f;
#pragma unroll
            for (int j = 0; j < 8; ++j) { float kf[8]; unpack8(((const v4u*)kr)[j], kf);
#pragma unroll
                for (int e = 0; e < 8; e += 2) { s0 += q[8 * j + e] * kf[e]; s1 += q[8 * j + e + 1] * kf[e + 1]; } }
            const float s = s0 + s1, mnew = fmaxf(mrun, s), corr = __builtin_amdgcn_exp2f(mrun - mnew), p = __builtin_amdgcn_exp2f(s - mnew);
            lrun = lrun * corr + p; mrun = mnew;
#pragma unroll
            for (int j = 0; j < 8; ++j) { float vf[8]; unpack8(((const v4u*)vr)[j], vf);
#pragma unroll
                for (int e = 0; e < 8; ++e) o[8 * j + e] = o[8 * j + e] * corr + p * vf[e]; }
        }
        const float inv = 1.0f / lrun; v4u* op = (v4u*)(O + (size_t)m * 1024 + hq * 64);
#pragma unroll
        for (int j = 0; j < 8; ++j) { v4u w; w.x = cvt_pk_bf16(o[8 * j] * inv, o[8 * j + 1] * inv); w.y = cvt_pk_bf16(o[8 * j + 2] * inv, o[8 * j + 3] * inv);
            w.z = cvt_pk_bf16(o[8 * j + 4] * inv, o[8 * j + 5] * inv); w.w = cvt_pk_bf16(o[8 * j + 6] * inv, o[8 * j + 7] * inv); op[j] = w; }
    }
}
__device__ __forceinline__ void memattn_naive(Frame& F) {
    const bf16* P = wsb(F, WS_PROJ); const bf16* KV = wsb(F, WS_MKV); bf16* O = wsb(F, WS_OMEM);
    LAS float* qs = (LAS float*)F.lds;
    LAS float* ss = qs + 32 * 260;
    const int tid = F.tid, ti = tid >> 4, kg = tid & 15;
    for (int unit = blockIdx.x; unit < 1024; unit += F.G) {
        const int b = unit >> 9, hd = (unit >> 7) & 3, tb = unit & 127, m0 = b * SEQ + tb * 32;
        { const v4u* src = (const v4u*)(P + (size_t)(m0 + ti) * INW + COL_MQ + hd * 256 + kg * 16); float f[16]; unpack8(src[0], f); unpack8(src[1], f + 8);
#pragma unroll
          for (int e = 0; e < 16; ++e) qs[ti * 260 + kg * 16 + e] = f[e]; }
        __syncthreads();
        float sc[16];
#pragma unroll 1
        for (int i = 0; i < 16; ++i) { const int key = kg + 16 * i; const v4u* kr = (const v4u*)(KV + (size_t)(b * NMEM + key) * 2048 + hd * 256);
            float a0 = 0.f, a1 = 0.f;
#pragma unroll 8
            for (int d8 = 0; d8 < 32; ++d8) { float kf[8]; unpack8(kr[d8], kf); const LAS f32x4* qp = (const LAS f32x4*)(qs + ti * 260 + d8 * 8); const f32x4 qa = qp[0], qb = qp[1];
                a0 += qa.x * kf[0] + qa.y * kf[1] + qa.z * kf[2] + qa.w * kf[3]; a1 += qb.x * kf[4] + qb.y * kf[5] + qb.z * kf[6] + qb.w * kf[7]; }
            ss[ti * 257 + key] = a0 + a1; }
        __syncthreads();
        float mx = -3.0e38f;
#pragma unroll
        for (int i = 0; i < 16; ++i) { sc[i] = ss[ti * 257 + kg + 16 * i]; mx = fmaxf(mx, sc[i]); }
#pragma unroll
        for (int o = 1; o < 16; o <<= 1) mx = fmaxf(mx, __shfl_xor(mx, o));
        float sum = 0.f;
#pragma unroll
        for (int i = 0; i < 16; ++i) { sc[i] = __builtin_amdgcn_exp2f(sc[i] - mx); sum += sc[i]; }
#pragma unroll
        for (int o = 1; o < 16; o <<= 1) sum += __shfl_xor(sum, o);
        const float inv = 1.0f / sum;
#pragma unroll
        for (int i = 0; i < 16; ++i) ss[ti * 257 + kg + 16 * i] = sc[i] * inv;
        __syncthreads();
        float o[16];
#pragma unroll
        for (int e = 0; e < 16; ++e) o[e] = 0.f;
#pragma unroll 4
        for (int key = 0; key < NMEM; ++key) { const float p = ss[ti * 257 + key]; const v4u* vr = (const v4u*)(KV + (size_t)(b * NMEM + key) * 2048 + 1024 + hd * 256 + kg * 16);
            float vf[16]; unpack8(vr[0], vf); unpack8(vr[1], vf + 8);
#pragma unroll
            for (int e = 0; e < 16; ++e) o[e] += p * vf[e]; }
        v4u* op = (v4u*)(O + (size_t)(m0 + ti) * 1024 + hd * 256 + kg * 16);
        v4u w; w.x = cvt_pk_bf16(o[0], o[1]); w.y = cvt_pk_bf16(o[2], o[3]); w.z = cvt_pk_bf16(o[4], o[5]); w.w = cvt_pk_bf16(o[6], o[7]); op[0] = w;
        w.x = cvt_pk_bf16(o[8], o[9]); w.y = cvt_pk_bf16(o[10], o[11]); w.z = cvt_pk_bf16(o[12], o[13]); w.w = cvt_pk_bf16(o[14], o[15]); op[1] = w;
        __syncthreads();
    }
}
__device__ __forceinline__ void sincos_red(double x, float& s, float& c) {
    const double k = __builtin_rint(x * 0.63661977236758134308); const double r = (x - k * 1.57079632679489655800) - k * 6.123233995736766036e-17; const double r2 = r * r;
    double sp = -7.6471637318198164759e-13; sp = sp * r2 + 1.6059043836821614599e-10; sp = sp * r2 - 2.5052108385441718775e-8; sp = sp * r2 + 2.7557319223985890653e-6; sp = sp * r2 - 1.9841269841269841270e-4; sp = sp * r2 + 8.3333333333333333333e-3; sp = sp * r2 - 1.6666666666666666667e-1;
    const double sr = r + r * r2 * sp;
    double cp = -1.1470745597729724714e-11; cp = cp * r2 + 2.0876756987868098979e-9; cp = cp * r2 - 2.7557319223985890653e-7; cp = cp * r2 + 2.4801587301587301587e-5; cp = cp * r2 - 1.3888888888888888889e-3; cp = cp * r2 + 4.1666666666666666667e-2; cp = cp * r2 - 0.5;
    const double cr = 1.0 + r2 * cp;
    const int q = ((int)k) & 3;
    const double ss = (q & 1) ? cr : sr, cc = (q & 1) ? sr : cr;
    s = (float)((q & 2) ? -ss : ss); c = (float)(((q == 1) || (q == 2)) ? -cc : cc);
}
struct SsmState { float ar, ai, a64r, a64i; float bbr[16], bbi[16]; };
struct SsmIn { const float *lre, *lim, *ldt, *bre, *bim, *cre, *cim, *dsk; };
__device__ __forceinline__ void ssm_params(const SsmIn& I, int g, int p, SsmState& S) {
    const int gp = g * 64 + p;
    const float lr = fminf(I.lre[gp], -1e-4f), li = I.lim[gp], dt = expf(I.ldt[g]);
    const float mag = expf(lr * dt); float sn, cs; const double th = (double)li * (double)dt; sincos_red(th, sn, cs);
    S.ar = mag * cs; S.ai = mag * sn;
    const float mag64 = expf(lr * dt * 64.f); sincos_red(th * 64.0, sn, cs); S.a64r = mag64 * cs; S.a64i = mag64 * sn;
    const float nr = S.ar - 1.f, ni = S.ai, den = lr * lr + li * li, kr = (nr * lr + ni * li) / den, ki = (ni * lr - nr * li) / den;
    const float* br = I.bre + (size_t)gp * 16; const float* bi = I.bim + (size_t)gp * 16;
#pragma unroll
    for (int c = 0; c < 16; ++c) { S.bbr[c] = kr * br[c] - ki * bi[c]; S.bbi[c] = kr * bi[c] + ki * br[c]; }
}
__device__ __forceinline__ void ssm_step(const SsmState& S, const bf16* up, float& sr, float& si) {
    const v4u* u4 = (const v4u*)up; float uf[16]; unpack8(u4[0], uf); unpack8(u4[1], uf + 8);
    float xr = 0.f, xi = 0.f;
#pragma unroll
    for (int c = 0; c < 16; ++c) { xr += S.bbr[c] * uf[c]; xi += S.bbi[c] * uf[c]; }
    const float nr = S.ar * sr - S.ai * si + xr, ni = S.ar * si + S.ai * sr + xi; sr = nr; si = ni;
}
__device__ __forceinline__ void ssm_local(Frame& F, const SsmIn& I) {
    const bf16* P = wsb(F, WS_PROJ); f32x2* SE = (f32x2*)(F.ws + WS_SEND);
    const int gw = blockIdx.x * NWAVES + F.wave, NGW = F.G * NWAVES, p = F.lane;
    for (int u = gw; u < 2 * 64 * 64; u += NGW) {
        const int g = u & 63, ch = (u >> 6) & 63, b = u >> 12;
        SsmState S; ssm_params(I, g, p, S);
        float sr = 0.f, si = 0.f; const bf16* up = P + (size_t)(b * SEQ + ch * 64) * INW + COL_S + g * 16;
#pragma unroll 4
        for (int j = 0; j < 64; ++j) ssm_step(S, up + (size_t)j * INW, sr, si);
        SE[((size_t)(b * 64 + ch) * 64 + g) * 64 + p] = (f32x2){sr, si};
    }
}
__device__ __forceinline__ void ssm_replay(Frame& F, const SsmIn& I) {
    const bf16* P = wsb(F, WS_PROJ); const f32x2* SE = (const f32x2*)(F.ws + WS_SEND); bf16* Y = wsb(F, WS_YS);
    LAS f32x2* Cs = (LAS f32x2*)F.lds;
    LAS float* Ds = (LAS float*)(F.lds + 16 * 65 * 8);
    LAS f32x2* Sw = (LAS f32x2*)(F.lds + 16384) + F.wave * (16 * 65);
    const int p = F.lane, jj = F.lane >> 2, cq = F.lane & 3;
    for (int unit = blockIdx.x; unit < 1024; unit += F.G) {
        const int oct = unit & 7, g = (unit >> 3) & 63, b = unit >> 9, ch = oct * 8 + F.wave;
        for (int e = F.tid; e < 1024; e += 512) { const int c = e >> 6, pp = e & 63; const size_t gi = ((size_t)g * 16 + c) * 64 + pp; Cs[c * 65 + pp] = (f32x2){I.cre[gi], I.cim[gi]}; }
        if (F.tid < 16) Ds[F.tid] = I.dsk[g * 16 + F.tid];
        __syncthreads();
        SsmState S; ssm_params(I, g, p, S);
        float sr = 0.f, si = 0.f;
        for (int j = 0; j < ch; ++j) { const f32x2 e = SE[((size_t)(b * 64 + j) * 64 + g) * 64 + p]; const float nr = S.a64r * sr - S.a64i * si + e.x, ni = S.a64r * si + S.a64i * sr + e.y; sr = nr; si = ni; }
        const size_t tok0 = (size_t)b * SEQ + ch * 64;
#pragma unroll 1
        for (int sub = 0; sub < 4; ++sub) {
#pragma unroll 4
            for (int j = 0; j < 16; ++j) { ssm_step(S, P + (tok0 + sub * 16 + j) * INW + COL_S + g * 16, sr, si); Sw[j * 65 + p] = (f32x2){sr, si}; }
            asm volatile("s_waitcnt lgkmcnt(0)" ::: "memory");
            float acc[4] = {0.f, 0.f, 0.f, 0.f};
#pragma unroll 4
            for (int pp = 0; pp < 64; ++pp) { const f32x2 sv = Sw[jj * 65 + pp];
#pragma unroll
                for (int ci = 0; ci < 4; ++ci) { const f32x2 cv = Cs[(cq * 4 + ci) * 65 + pp]; acc[ci] += cv.x * sv.x - cv.y * sv.y; } }
            const size_t tok = tok0 + sub * 16 + jj; const v2u uw = *(const v2u*)(P + tok * INW + COL_S + g * 16 + cq * 4);
            const float u0 = bf_lo(uw.x), u1 = bf_hi(uw.x), u2 = bf_lo(uw.y), u3 = bf_hi(uw.y);
            v2u o; o.x = cvt_pk_bf16(acc[0] + Ds[cq * 4] * u0, acc[1] + Ds[cq * 4 + 1] * u1); o.y = cvt_pk_bf16(acc[2] + Ds[cq * 4 + 2] * u2, acc[3] + Ds[cq * 4 + 3] * u3);
            *(v2u*)(Y + tok * 1024 + g * 16 + cq * 4) = o;
            asm volatile("s_waitcnt lgkmcnt(0)" ::: "memory");
        }
        __syncthreads();
    }
}

typedef short bf16x8 __attribute__((ext_vector_type(8)));
typedef short s16x4 __attribute__((ext_vector_type(4)));
typedef float f32x16 __attribute__((ext_vector_type(16)));
__device__ __forceinline__ s16x4 lds_tr16(const LAS unsigned char* p) { return __builtin_bit_cast(s16x4, __builtin_amdgcn_ds_read_tr16_b64_v4i16((LAS s16x4*)p)); }
__device__ __forceinline__ bf16x8 cat8(s16x4 lo, s16x4 hi) { return (bf16x8){lo[0], lo[1], lo[2], lo[3], hi[0], hi[1], hi[2], hi[3]}; }
__device__ __forceinline__ bf16x8 pack8(float a0, float a1, float a2, float a3, float a4, float a5, float a6, float a7) {
    v4u w; w.x = cvt_pk_bf16(a0, a1); w.y = cvt_pk_bf16(a2, a3); w.z = cvt_pk_bf16(a4, a5); w.w = cvt_pk_bf16(a6, a7); return __builtin_bit_cast(bf16x8, w); }

__device__ __forceinline__ void swa_mfma(Frame& F, const float* sinks) {
    const bf16* P = wsb(F, WS_PROJ); bf16* O = wsb(F, WS_OSWA);
    LAS unsigned char* Kl = F.lds;
    LAS unsigned char* Vl = F.lds + 36864;
    const int tid = F.tid, lane = F.lane, w = F.wave, r = w >> 1, qh = w & 1, l31 = lane & 31, h = lane >> 5;
    for (int ub_ = blockIdx.x; ub_ < 256; ub_ += F.G) { const int unit = (F.G == 256) ? ((ub_ & 7) * 32 + (ub_ >> 3)) : ub_;
        const int n = unit & 31, g = (unit >> 5) & 3, b = unit >> 7;
        const int hq = g * 4 + r; bf16x8 qfa[2][4];
#pragma unroll
        for (int qt = 0; qt < 2; ++qt)
#pragma unroll
            for (int ds = 0; ds < 4; ++ds) qfa[qt][ds] = *(const bf16x8*)(P + ((size_t)b * SEQ + n * 128 + (qh * 2 + qt) * 32 + l31) * INW + COL_Q + hq * 64 + ds * 16 + h * 8);
#pragma unroll
        for (int i = 0; i < 4; ++i) { const int c = tid + 512 * i, key = c >> 3, part = c & 7, pos = (n - 1) * 128 + key;
            v4u kv = {0u, 0u, 0u, 0u}, vv = {0u, 0u, 0u, 0u};
            if (pos >= 0) { const bf16* src = P + (size_t)(b * SEQ + pos) * INW + COL_K + g * 64 + part * 8; kv = *(const v4u*)src; vv = *(const v4u*)(src + (COL_V - COL_K)); }
            *(LAS v4u*)(Kl + key * 144 + part * 16) = kv;
            *(LAS v4u*)(Vl + (part >> 2) * 16384 + key * 64 + (part & 3) * 16) = vv; }
        __syncthreads();
        const float sink2 = sinks[hq] * LOG2E;
#pragma unroll 1
        for (int qt = 0; qt < 2; ++qt) {
            bf16x8 qf[4];
#pragma unroll
            for (int ds = 0; ds < 4; ++ds) qf[ds] = qt ? qfa[1][ds] : qfa[0][ds];
            const int a = qh * 2 + qt, qi = a * 32 + l31; const size_t m = (size_t)b * SEQ + n * 128 + qi;
            f32x16 s[5];
#pragma unroll
            for (int k5 = 0; k5 < 5; ++k5) { f32x16 acc;
#pragma unroll
                for (int e = 0; e < 16; ++e) acc[e] = 0.f;
                bf16x8 kf[4];
#pragma unroll
                for (int ds = 0; ds < 4; ++ds) kf[ds] = *(const LAS bf16x8*)(Kl + (32 * (a + k5) + l31) * 144 + ds * 32 + h * 16);
#pragma unroll
                for (int ds = 0; ds < 4; ++ds) acc = __builtin_amdgcn_mfma_f32_32x32x16_bf16(kf[ds], qf[ds], acc, 0, 0, 0);
                s[k5] = acc; }
            float mx = sink2;
#pragma unroll
            for (int k5 = 0; k5 < 5; ++k5)
#pragma unroll
                for (int e = 0; e < 16; ++e) { const int kl = 32 * (a + k5) + (e & 3) + 8 * (e >> 2) + 4 * h; const bool ok = (kl > qi) && (kl <= qi + 128) && (n > 0 || kl >= 128);
                    const float v = ok ? s[k5][e] : -1.0e30f; s[k5][e] = v; mx = fmaxf(mx, v); }
            mx = fmaxf(mx, __shfl_xor(mx, 32));
            float sum = 0.f;
#pragma unroll
            for (int k5 = 0; k5 < 5; ++k5)
#pragma unroll
                for (int e = 0; e < 16; ++e) { const float p = __builtin_amdgcn_exp2f(s[k5][e] - mx); s[k5][e] = p; sum += p; }
            sum += __shfl_xor(sum, 32); sum += __builtin_amdgcn_exp2f(sink2 - mx);
            f32x16 o[2];
#pragma unroll
            for (int e = 0; e < 16; ++e) { o[0][e] = 0.f; o[1][e] = 0.f; }
#pragma unroll
            for (int k5 = 0; k5 < 5; ++k5) { s16x4 vlo[2][2], vhi[2][2];
#pragma unroll
                for (int s2 = 0; s2 < 2; ++s2)
#pragma unroll
                    for (int db = 0; db < 2; ++db) { const LAS unsigned char* vp = Vl + db * 16384 + (32 * (a + k5) + 16 * s2 + 4 * h + ((lane & 15) >> 2)) * 64 + (16 * ((lane >> 4) & 1) + 4 * (lane & 3)) * 2;
                        vlo[s2][db] = lds_tr16(vp); vhi[s2][db] = lds_tr16(vp + 8 * 64); }
#pragma unroll
                for (int s2 = 0; s2 < 2; ++s2) { const bf16x8 pf = pack8(s[k5][8 * s2], s[k5][8 * s2 + 1], s[k5][8 * s2 + 2], s[k5][8 * s2 + 3], s[k5][8 * s2 + 4], s[k5][8 * s2 + 5], s[k5][8 * s2 + 6], s[k5][8 * s2 + 7]);
#pragma unroll
                    for (int db = 0; db < 2; ++db) o[db] = __builtin_amdgcn_mfma_f32_32x32x16_bf16(cat8(vlo[s2][db], vhi[s2][db]), pf, o[db], 0, 0, 0); } }
            const float inv = 1.0f / sum;
#pragma unroll
            for (int db = 0; db < 2; ++db)
#pragma unroll
                for (int g4 = 0; g4 < 4; ++g4) { v2u wv; wv.x = cvt_pk_bf16(o[db][4 * g4] * inv, o[db][4 * g4 + 1] * inv); wv.y = cvt_pk_bf16(o[db][4 * g4 + 2] * inv, o[db][4 * g4 + 3] * inv);
                    *(v2u*)(O + m * 1024 + hq * 64 + db * 32 + 8 * g4 + 4 * h) = wv; }
        }
        __syncthreads();
    }
}
__device__ __forceinline__ void memattn_mfma(Frame& F) {
    const bf16* P = wsb(F, WS_PROJ); const bf16* KV = wsb(F, WS_MKV); bf16* O = wsb(F, WS_OMEM);
    constexpr int RS = 544, SLOT = 64 * RS;
    const int tid = F.tid, lane = F.lane, w = F.wave, l15 = lane & 15, kq = lane >> 4;
    for (int ub_ = blockIdx.x; ub_ < 256; ub_ += F.G) { const int unit = (F.G == 256) ? ((ub_ & 7) * 32 + (ub_ >> 3)) : ub_;
        const int tb = unit & 31, hd = (unit >> 5) & 3, b = unit >> 7; const size_t m = (size_t)b * SEQ + tb * 128 + w * 16 + l15;
        bf16x8 qf[8];
#pragma unroll
        for (int ds = 0; ds < 8; ++ds) qf[ds] = *(const bf16x8*)(P + m * INW + COL_MQ + hd * 256 + ds * 32 + kq * 8);
        v4u st[2][4];
#define MA_LOAD(t) do { _Pragma("unroll") for (int i_ = 0; i_ < 4; ++i_) { const int c_ = tid + 512 * i_, row_ = c_ >> 5, part_ = c_ & 31; \
            st[(t) & 1][i_] = *(const v4u*)(KV + (size_t)(b * NMEM + 64 * ((t) & 3) + row_) * 2048 + ((t) >> 2) * 1024 + hd * 256 + part_ * 8); } } while (0)
#define MA_STORE(t) do { _Pragma("unroll") for (int i_ = 0; i_ < 4; ++i_) { const int c_ = tid + 512 * i_, row_ = c_ >> 5, part_ = c_ & 31; *(LAS v4u*)(F.lds + ((t) % 3) * SLOT + row_ * RS + part_ * 16) = st[(t) & 1][i_]; } } while (0)
        MA_LOAD(0); MA_LOAD(1); MA_STORE(0); __syncthreads();
        f32x4 s[16]; f32x4 o[16]; float inv = 0.f;
#pragma unroll
        for (int t = 0; t < 8; ++t) {
            if (t < 6) MA_LOAD(t + 2);
            const LAS unsigned char* cur = F.lds + (t % 3) * SLOT;
            if (t < 4) {
#pragma unroll
                for (int k4 = 0; k4 < 4; ++k4) { f32x4 acc = {0.f, 0.f, 0.f, 0.f}; bf16x8 kf[8];
#pragma unroll
                    for (int ds = 0; ds < 8; ++ds) kf[ds] = *(const LAS bf16x8*)(cur + (16 * k4 + l15) * RS + ds * 64 + kq * 16);
#pragma unroll
                    for (int ds = 0; ds < 8; ++ds) acc = __builtin_amdgcn_mfma_f32_16x16x32_bf16(kf[ds], qf[ds], acc, 0, 0, 0);
                    s[4 * t + k4] = acc; }
                if (t == 3) {
                    float mx = -3.0e38f;
#pragma unroll
                    for (int i = 0; i < 16; ++i) mx = fmaxf(mx, fmaxf(fmaxf(s[i][0], s[i][1]), fmaxf(s[i][2], s[i][3])));
                    mx = fmaxf(mx, __shfl_xor(mx, 16)); mx = fmaxf(mx, __shfl_xor(mx, 32));
                    float sum = 0.f;
#pragma unroll
                    for (int i = 0; i < 16; ++i)
#pragma unroll
                        for (int e = 0; e < 4; ++e) { const float p = __builtin_amdgcn_exp2f(s[i][e] - mx); s[i][e] = p; sum += p; }
                    sum += __shfl_xor(sum, 16); sum += __shfl_xor(sum, 32); inv = 1.0f / sum;
#pragma unroll
                    for (int i = 0; i < 16; ++i) o[i] = (f32x4){0.f, 0.f, 0.f, 0.f};
                }
            } else {
                const int tv = t - 4;
#pragma unroll
                for (int s2 = 0; s2 < 2; ++s2) { const f32x4 p0 = s[4 * tv + 2 * s2], p1 = s[4 * tv + 2 * s2 + 1]; const bf16x8 pf = pack8(p0[0], p0[1], p0[2], p0[3], p1[0], p1[1], p1[2], p1[3]);
#pragma unroll
                    for (int dh = 0; dh < 2; ++dh) { s16x4 vlo[8], vhi[8];
#pragma unroll
                        for (int d8 = 0; d8 < 8; ++d8) { const LAS unsigned char* vp = cur + (32 * s2 + 4 * kq + (l15 >> 2)) * RS + (16 * (8 * dh + d8) + 4 * (lane & 3)) * 2; vlo[d8] = lds_tr16(vp); vhi[d8] = lds_tr16(vp + 16 * RS); }
#pragma unroll
                        for (int d8 = 0; d8 < 8; ++d8) o[8 * dh + d8] = __builtin_amdgcn_mfma_f32_16x16x32_bf16(cat8(vlo[d8], vhi[d8]), pf, o[8 * dh + d8], 0, 0, 0); } }
            }
            if (t < 7) MA_STORE(t + 1);
            asm volatile("s_waitcnt lgkmcnt(0)" ::: "memory"); __builtin_amdgcn_s_barrier(); asm volatile("" ::: "memory");
        }
#undef MA_LOAD
#undef MA_STORE
#pragma unroll
        for (int db = 0; db < 16; ++db) { v2u wv; wv.x = cvt_pk_bf16(o[db][0] * inv, o[db][1] * inv); wv.y = cvt_pk_bf16(o[db][2] * inv, o[db][3] * inv); *(v2u*)(O + m * 1024 + hd * 256 + 16 * db + 4 * kq) = wv; }
    }
}

__device__ __forceinline__ void cmul(float ar, float ai, float br, float bi, float& cr, float& ci) { cr = ar * br - ai * bi; ci = ar * bi + ai * br; }
__device__ __forceinline__ void ssm_tables(Frame& F, const SsmIn& I0) {
    LAS f32x2* AP = (LAS f32x2*)F.lds;
    LAS f32x2* BB = (LAS f32x2*)(F.lds + 33280);
    LAS f32x2* CC = (LAS f32x2*)(F.lds + 33280 + 8192);
    LAS f32x2* KC = (LAS f32x2*)(F.lds + 33280 + 16384);
    const int t = F.tid;
    if ((int)blockIdx.x >= TAB_WGS && F.G > TAB_WGS) return;
    for (int unit = blockIdx.x; unit < DEPTH * 64; unit += (F.G > TAB_WGS ? TAB_WGS : F.G)) {
        const int l = unit >> 6, g = unit & 63, gp0 = unit * 64;
        const float dt = expf(I0.ldt[unit]);
        for (int e = t; e < 65 * 64; e += 512) { const int ee = e >> 6, p = e & 63; const float lr = fminf(I0.lre[gp0 + p], -1e-4f), li = I0.lim[gp0 + p];
            const float mag = expf(lr * dt * (float)ee); float sn, cs; sincos_red((double)li * (double)dt * (double)ee, sn, cs); AP[e] = (f32x2){mag * cs, mag * sn}; }
        __syncthreads();
        if (t < 64) { ((f32x2*)(F.ws + WS_A64))[gp0 + t] = AP[64 * 64 + t];
            const float lr = fminf(I0.lre[gp0 + t], -1e-4f), li = I0.lim[gp0 + t]; const f32x2 a = AP[64 + t]; const float nr = a.x - 1.f, ni = a.y, den = lr * lr + li * li;
            KC[t] = (f32x2){(nr * lr + ni * li) / den, (ni * lr - nr * li) / den}; }
        __syncthreads();
        for (int e = t; e < 1024; e += 512) { const int p = e >> 4; const f32x2 k = KC[p]; const float br = I0.bre[(size_t)gp0 * 16 + e], bi = I0.bim[(size_t)gp0 * 16 + e];
            BB[e] = (f32x2){k.x * br - k.y * bi, k.x * bi + k.y * br}; CC[e] = (f32x2){I0.cre[(size_t)gp0 * 16 + e], I0.cim[(size_t)gp0 * 16 + e]}; }
        __syncthreads();
        bf16* WinT = wsb(F, WS_WINT) + (size_t)unit * 131072; bf16* WoutT = wsb(F, WS_WOUTT) + (size_t)unit * 131072; bf16* LB = (bf16*)(F.ws + WS_LB + (size_t)unit * LB_BYTES);
        for (int q = t; q < 16384; q += 512) { const int n = q >> 7, ck = q & 127, j = ck >> 1, half = ck & 1, p = 16 * (n >> 5) + (n & 15), isim = (n >> 4) & 1; const f32x2 a = AP[(63 - j) * 64 + p]; float v[8];
#pragma unroll
            for (int e = 0; e < 8; ++e) { const f32x2 bb = BB[p * 16 + 8 * half + e]; float zr, zi; cmul(a.x, a.y, bb.x, bb.y, zr, zi); v[e] = isim ? zi : zr; }
            *(bf16x8*)(WinT + (size_t)n * 1024 + ck * 8) = pack8(v[0], v[1], v[2], v[3], v[4], v[5], v[6], v[7]); }
        for (int q = t; q < 16384; q += 512) { const int row = q >> 4, ck = q & 15, tau = row >> 4, c = row & 15, isim = ck >> 3, p0 = (8 * ck) & 63; float v[8];
#pragma unroll
            for (int e = 0; e < 8; ++e) { const f32x2 cc = CC[c * 64 + p0 + e], a = AP[(tau + 1) * 64 + p0 + e]; float zr, zi; cmul(cc.x, cc.y, a.x, a.y, zr, zi); v[e] = isim ? -zi : zr; }
            *(bf16x8*)(WoutT + (size_t)row * 128 + ck * 8) = pack8(v[0], v[1], v[2], v[3], v[4], v[5], v[6], v[7]); }
        { const int c = (t >> 4) & 15, c2 = t & 15, lh = t >> 8; float acc[32];
#pragma unroll
          for (int d = 0; d < 32; ++d) acc[d] = 0.f;
#pragma unroll 2
          for (int p = 0; p < 64; ++p) { const f32x2 cc = CC[c * 64 + p], bb = BB[p * 16 + c2]; float zr, zi; cmul(cc.x, cc.y, bb.x, bb.y, zr, zi);
#pragma unroll
              for (int d = 0; d < 32; ++d) { const f32x2 a = AP[(32 * lh + d) * 64 + p]; acc[d] += zr * a.x - zi * a.y; } }
          if (lh == 0 && c == c2) acc[0] += I0.dsk[l * 1024 + g * 16 + c];
#pragma unroll
          for (int d = 0; d < 32; ++d) LB[(((32 * lh + d + 1) * 2 + (c2 >> 3)) * 16 + c) * 8 + (c2 & 7)] = (bf16)(cvt_pk_bf16(acc[d], 0.f) & 0xffffu);
          if (t < 256) LB[t] = 0; }
        __syncthreads();
    }
}
__device__ __forceinline__ void ssm_s1(Frame& F, const SsmIn& I, int l) {
    const bf16* P = wsb(F, WS_PROJ); bf16* SST = wsb(F, WS_SST);
    LAS float* E = (LAS float*)F.lds;
    const int lane = F.lane, w = F.wave, l31 = lane & 31, h = lane >> 5, mi = w & 3, kh = w >> 2;
    for (int ub_ = blockIdx.x; ub_ < 256; ub_ += F.G) { const int unit = (F.G == 256) ? ((ub_ & 7) * 32 + (ub_ >> 3)) : ub_;
        const int g = unit >> 2, pq = unit & 3;
        const bf16* WinT = wsb(F, WS_WINT) + (size_t)(l * 64 + g) * 131072 + (size_t)(pq * 32 + l31) * 1024 + 8 * h;
        const int mrow = 32 * mi + l31, bb = mrow >> 6, kk = mrow & 63;
        const bf16* up = wsb(F, WS_SIN) + ((size_t)g * T + bb * SEQ + kk * 64) * 16 + 8 * h;
        f32x16 acc;
#pragma unroll
        for (int e = 0; e < 16; ++e) acc[e] = 0.f;
#pragma unroll 16
        for (int jj = 0; jj < 32; ++jj) { const int j = 32 * kh + jj; const bf16x8 af = *(const bf16x8*)(up + (size_t)j * 16), bf = *(const bf16x8*)(WinT + 16 * j);
            acc = __builtin_amdgcn_mfma_f32_32x32x16_bf16(af, bf, acc, 0, 0, 0); }
#pragma unroll
        for (int e = 0; e < 16; ++e) E[(kh * 128 + 32 * mi + (e & 3) + 8 * (e >> 2) + 4 * h) * 33 + l31] = acc[e];
        __syncthreads();
#pragma unroll 1
        for (int tk = 0; tk < 4; ++tk) { const int task = w * 4 + tk, b = task >> 4, st = task & 15, p = 16 * pq + st, k = lane;
            float xr = E[(b * 64 + k) * 33 + st] + E[(128 + b * 64 + k) * 33 + st], xi = E[(b * 64 + k) * 33 + 16 + st] + E[(128 + b * 64 + k) * 33 + 16 + st];
            float ar, ai; { const f32x2 a64 = ((const f32x2*)(F.ws + WS_A64))[(l * 64 + g) * 64 + p]; ar = a64.x; ai = a64.y; }
#pragma unroll
            for (int d = 1; d < 64; d <<= 1) { const float yr = __shfl_up(xr, d), yi = __shfl_up(xi, d); if (k >= d) { xr += ar * yr - ai * yi; xi += ar * yi + ai * yr; } const float nr = ar * ar - ai * ai, ni = 2.f * ar * ai; ar = nr; ai = ni; }
            float sr = __shfl_up(xr, 1), si = __shfl_up(xi, 1); if (k == 0) { sr = 0.f; si = 0.f; }
            bf16* dst = SST + ((size_t)(g * 128 + b * 64 + k)) * 128 + p; dst[0] = (bf16)(cvt_pk_bf16(sr, 0.f) & 0xffffu); dst[64] = (bf16)(cvt_pk_bf16(si, 0.f) & 0xffffu); }
        __syncthreads();
    }
}
__device__ __forceinline__ void ssm_s2(Frame& F, int l) {
    const bf16* P = wsb(F, WS_PROJ); const bf16* SST = wsb(F, WS_SST); bf16* Y = wsb(F, WS_YS);
    LAS unsigned char* Ul = F.lds;
    LAS unsigned char* Ll = F.lds + 66048;
    LAS unsigned char* Sl = F.lds + 66048 + 33280;
    const int t = F.tid, lane = F.lane, w = F.wave, l31 = lane & 31, h = lane >> 5;
    for (int ub_ = blockIdx.x; ub_ < 256; ub_ += F.G) { const int unit = (F.G == 256) ? ((ub_ & 7) * 32 + (ub_ >> 3)) : ub_;
        const int mt = unit & 1, b = (unit >> 1) & 1, g = unit >> 2;
        const bf16* WoutT = wsb(F, WS_WOUTT) + (size_t)(l * 64 + g) * 131072;
        bf16x8 wfr[4][8];
#pragma unroll
        for (int q = 0; q < 4; ++q) { const int n = (q == 0) ? w : (q == 1) ? 15 - w : (q == 2) ? 16 + w : 31 - w;
#pragma unroll
            for (int ks = 0; ks < 8; ++ks) wfr[q][ks] = *(const bf16x8*)(WoutT + (size_t)(32 * n + l31) * 128 + 16 * ks + 8 * h); }
#pragma unroll
        for (int i = 0; i < 8; ++i) { const int q = t + 512 * i, half = q & 1, ti = q >> 1, ir = ti >> 6, j = ti & 63;
            *(LAS v4u*)(Ul + ir * 2064 + j * 32 + half * 16) = *(const v4u*)(wsb(F, WS_SIN) + ((size_t)g * T + b * SEQ + (32 * mt) * 64) * 16 + (size_t)q * 8); }
        { const v4u* src = (const v4u*)(F.ws + WS_LB + (size_t)(l * 64 + g) * LB_BYTES);
          for (int q = t; q < (int)(LB_BYTES / 16); q += 512) *(LAS v4u*)(Ll + q * 16) = src[q]; }
        { const int row = t >> 4, part = t & 15; *(LAS v4u*)(Sl + row * 272 + part * 16) = *(const v4u*)(SST + ((size_t)(g * 128 + b * 64 + 32 * mt + row)) * 128 + part * 8); }
        __syncthreads();
#pragma unroll
        for (int q = 0; q < 4; ++q) { const int n = (q == 0) ? w : (q == 1) ? 15 - w : (q == 2) ? 16 + w : 31 - w;
            f32x16 acc;
#pragma unroll
            for (int e = 0; e < 16; ++e) acc[e] = 0.f;
#pragma unroll
            for (int ks = 0; ks < 8; ++ks) { const bf16x8 sf = *(const LAS bf16x8*)(Sl + l31 * 272 + ks * 32 + h * 16);
                acc = __builtin_amdgcn_mfma_f32_32x32x16_bf16(wfr[q][ks], sf, acc, 0, 0, 0); }
            const LAS unsigned char* lbp = Ll + ((2 * n + 1 + (l31 >> 4)) * 2 + h) * 256 + (l31 & 15) * 16; const LAS unsigned char* ubp = Ul + l31 * 2064 + h * 16;
#pragma unroll 4
            for (int j = 0; j < 2 * n + 2; ++j) { const bf16x8 kf = *(const LAS bf16x8*)(lbp - j * 512), uf = *(const LAS bf16x8*)(ubp + j * 32); acc = __builtin_amdgcn_mfma_f32_32x32x16_bf16(kf, uf, acc, 0, 0, 0); }
#pragma unroll
            for (int q4 = 0; q4 < 4; ++q4) { const int c0 = 8 * (q4 & 1) + 4 * h, tau = 2 * n + (q4 >> 1); const size_t tok = (size_t)b * SEQ + (32 * mt + l31) * 64 + tau;
                v2u wv; wv.x = cvt_pk_bf16(acc[4 * q4], acc[4 * q4 + 1]); wv.y = cvt_pk_bf16(acc[4 * q4 + 2], acc[4 * q4 + 3]); *(v2u*)(Y + tok * 1024 + g * 16 + c0) = wv; }
        }
        __syncthreads();
    }
}

constexpr int PH_PRO = 0, PH_SB0 = 1, PH_PER_SB = 6, N_SB = 3 * DEPTH, PH_FINAL = PH_SB0 + N_SB * PH_PER_SB, N_PH = PH_FINAL + 1;
struct Args { const float* in[N_IN]; float* out; unsigned char* ws; int ph_lo, ph_hi; };
static_assert(sizeof(Args) == N_IN * 8 + 8 + 8 + 8, "Args has no padding");

typedef __attribute__((address_space(4))) const Args* KArgs;
__device__ __forceinline__ KArgs kargs() { KArgs p = (KArgs)__builtin_amdgcn_kernarg_segment_ptr(); asm volatile("" : "+s"(p)); return p; }
#define AIN(i) (kargs()->in[i])
__global__ void __launch_bounds__(NWAVES * 64, 2) fwd(Args args_unused) {
    extern __shared__ __attribute__((aligned(16))) unsigned char lds[];
    Frame F;
    F.lds = (LAS unsigned char*)lds;
    F.tid = threadIdx.x; F.lane = F.tid & 63; F.wave = __builtin_amdgcn_readfirstlane(F.tid >> 6); F.G = gridDim.x;
    F.ws = kargs()->ws;
    volatile LAS unsigned* MISC = (volatile LAS unsigned*)(F.lds + MISC_OFF);
    for (int u = F.tid; u < (LDS_BYTES - LDSCTL_OFF) / 4; u += NWAVES * 64) ((LAS unsigned*)(F.lds + LDSCTL_OFF))[u] = 0u;
    __syncthreads();
    unsigned* barw = (unsigned*)(F.ws + WS_CTL) + CW_BAR;
    XcdBarrier bar; bar.bar = barw; bar.x = 0; bar.st = nullptr;
    if (kargs()->ph_hi - kargs()->ph_lo > 1) (void)xcd_barrier_post(barw, MISC + 8);
#define IN(p) (kargs()->ph_lo <= (p) && (p) < kargs()->ph_hi)
#define hi (kargs()->ph_hi)
#define BARNOW() XcdBarrier{(unsigned*)(kargs()->ws + WS_CTL) + CW_BAR, xb_xcc_id(), (volatile LAS unsigned*)((LAS unsigned char*)lds + MISC_OFF) + 8}
#define FRESH() do { int t_ = threadIdx.x; asm volatile("" : "+v"(t_)); F.tid = t_; F.lane = t_ & 63; F.wave = __builtin_amdgcn_readfirstlane(t_ >> 6); unsigned char* w_ = kargs()->ws; F.ws = w_; } while (0)
#if DIAG
#define SEAM(p, q) do { if (IN(p) && (q) < hi) { xcd_barrier(BARNOW()); if ((q) == PH_FINAL && threadIdx.x == 0) { const unsigned dwt = MISC[16]; unsigned* dw = (unsigned*)(kargs()->ws + WS_CTL) + 2048; atomicMax(dw, dwt); atomicAdd(dw + 128, dwt >> 8); } } } while (0)
#else
#define SEAM(p, q) do { if (IN(p) && (q) < hi) xcd_barrier(BARNOW()); } while (0)
#endif

    if (IN(PH_PRO) && EN_PRO) for (int rep_ = 0; rep_ < REP_PRO; ++rep_) { FRESH(); const ProIn I{AIN(I_F1WI), AIN(I_F2WI), AIN(I_F1WO), AIN(I_F2WO), AIN(I_WIN), AIN(I_WMKV), AIN(I_WGLU), AIN(I_WSWA), AIN(I_WMEMUP), AIN(I_WOUT), AIN(I_MEM), AIN(I_MEMN), AIN(I_F1N), AIN(I_F2N), AIN(I_MIXN), AIN(I_X)}; prologue(F, I);
        const SsmIn I0{AIN(I_LRE), AIN(I_LIM), AIN(I_LDT), AIN(I_BRE), AIN(I_BIM), AIN(I_CRE), AIN(I_CIM), AIN(I_DSK)}; ssm_tables(F, I0); }
    SEAM(PH_PRO, PH_SB0);

    for (int sb = 0; sb < N_SB; ++sb) {
        const int l = sb / 3, ty = sb % 3, pb = PH_SB0 + sb * PH_PER_SB;
        if (pb + PH_PER_SB <= kargs()->ph_lo || pb >= hi) continue;
#define HIN() ((sb == 0) ? AIN(I_X) : (const float*)(F.ws + WS_H))
#define WL() (F.ws + WS_W + (size_t)l * W_LAYER)
        if (ty != 1) {
            if (IN(pb + 1) && EN_G1) for (int rep_ = 0; rep_ < REP_G1; ++rep_) { FRESH();
                pg8::SchedG1 S{(const char*)(F.ws + WS_XN), (const char*)(WL() + (ty == 0 ? WO_1IN : WO_2IN)), (size_t)256 * DM * 2, T / 256, 2 * DFF / 256, F.G, (int)blockIdx.x};
                pg8::Unit u0; int pm0 = -1; if (S.next(0, u0)) { pm0 = u0.pm; rstd_table(F, pm0); }
                pg8::EpiSwiGLU E{wsb(F, WS_HID), DFF, pg8::RstdTab{(const LAS float*)(F.lds + RSTD_OFF), pm0, (const float*)(F.ws + WS_SSQ)}};
                pg8::gemm_phase<pg8::EpiSwiGLU, pg8::SchedG1, true, true>(F.lds + RING_OFF, DM, S, E);
            }
            SEAM(pb + 1, pb + 5);
        } else {
            if (IN(pb + 1) && EN_G3) for (int rep_ = 0; rep_ < REP_G3; ++rep_) { FRESH();
                pg8::SchedProj S{(const char*)(F.ws + WS_XN), (const char*)(WL() + WO_IN), (const char*)(F.ws + WS_MEMN + (size_t)l * 512 * DM * 2), (const char*)(WL() + WO_MKV), (size_t)256 * DM * 2, T / 256, INW / 256, F.G, (int)blockIdx.x};
                pg8::Unit u0; int pm0 = -1; if (S.next(0, u0)) { pm0 = u0.pm; rstd_table(F, pm0); }
                pg8::EpiProj E{wsb(F, WS_PROJ), INW, COL_G / 256, wsb(F, WS_MKV), 2048, pg8::RstdTab{(const LAS float*)(F.lds + RSTD_OFF), pm0, (const float*)(F.ws + WS_SSQ)}, wsb(F, WS_SIN)};
                pg8::gemm_phase<pg8::EpiProj, pg8::SchedProj, true, true>(F.lds + RING_OFF, DM, S, E);
            }
            SEAM(pb + 1, pb + 2);
            if (IN(pb + 2) && EN_M1) for (int rep_ = 0; rep_ < REP_M; ++rep_) { FRESH(); for (int r2_ = 0; r2_ < REP_SWA; ++r2_) swa_mfma(F, AIN(I_SINK) + l * 16); for (int r2_ = 0; r2_ < REP_MA; ++r2_) memattn_mfma(F);
                const SsmIn I{AIN(I_LRE) + l * 4096, AIN(I_LIM) + l * 4096, AIN(I_LDT) + l * 64, AIN(I_BRE) + l * 65536, AIN(I_BIM) + l * 65536, AIN(I_CRE) + l * 65536, AIN(I_CIM) + l * 65536, AIN(I_DSK) + l * 1024}; for (int r2_ = 0; r2_ < REP_S1; ++r2_) ssm_s1(F, I, l); }
            SEAM(pb + 2, pb + 3);
            if (IN(pb + 3) && EN_M2) for (int rep_ = 0; rep_ < REP_M; ++rep_) { FRESH(); const SsmIn I{AIN(I_LRE) + l * 4096, AIN(I_LIM) + l * 4096, AIN(I_LDT) + l * 64, AIN(I_BRE) + l * 65536, AIN(I_BIM) + l * 65536, AIN(I_CRE) + l * 65536, AIN(I_CIM) + l * 65536, AIN(I_DSK) + l * 1024}; (void)I; for (int r2_ = 0; r2_ < REP_S2; ++r2_) ssm_s2(F, l); }
            SEAM(pb + 3, pb + 4);
            if (IN(pb + 4) && EN_G4) for (int rep_ = 0; rep_ < REP_G4; ++rep_) { FRESH();
                pg8::SchedMix S{(const char*)(F.ws + WS_OSWA), (const char*)(F.ws + WS_OMEM), (const char*)(F.ws + WS_YS), (const char*)(WL() + WO_SWA), (const char*)(WL() + WO_MEM), (const char*)(WL() + WO_GLU), (size_t)256 * 1024 * 2, T / 256, DM / 256, F.G, (int)blockIdx.x};
                pg8::EpiMix E{wsb(F, WS_MG), wsb(F, WS_PROJ) + COL_G, INW};
                pg8::gemm_phase<pg8::EpiMix, pg8::SchedMix, true, true>(F.lds + RING_OFF, 1024, S, E);
            }
            SEAM(pb + 4, pb + 5);
        }
        if (IN(pb + 5) && EN_GR) for (int rep_ = 0; rep_ < REP_GR; ++rep_) { FRESH();
            const int K = (ty == 1) ? DM : DFF;
            pg8::SchedTiles S{(const char*)(F.ws + (ty == 1 ? WS_MG : WS_HID)), (const char*)(WL() + (ty == 0 ? WO_1OUT : ty == 1 ? WO_OUT : WO_2OUT)), (size_t)256 * K * 2, T / 256, DM / 256, F.G, (int)blockIdx.x};
            pg8::EpiResid E{(sb == 0) ? AIN(I_X) : nullptr, ty == 1 ? 1.0f : 0.5f, DM, wsb(F, WS_XN), (float*)(F.ws + (rep_ ? WS_T32 : WS_SSQ)), wsb(F, rep_ ? WS_H : WS_XN)};
            pg8::gemm_phase<pg8::EpiResid, pg8::SchedTiles, true, true>(F.lds + RING_OFF, K, S, E);
        }
        SEAM(pb + 5, pb + 6);
    }
    if (IN(PH_FINAL)) { FRESH(); final_norm(F, wsb(F, WS_XN), AIN(I_FINN), kargs()->out);
#if DIAG
        xcd_barrier(BARNOW());
        if (blockIdx.x == 0) { const unsigned* dw = (const unsigned*)(F.ws + WS_CTL) + 2048; const float vmax = (float)__hip_atomic_load(dw, __ATOMIC_RELAXED, __HIP_MEMORY_SCOPE_AGENT) * 0.01f, vmean = (float)__hip_atomic_load(dw + 128, __ATOMIC_RELAXED, __HIP_MEMORY_SCOPE_AGENT) * 2.56f / 256.f;
            float* o = kargs()->out; if (F.tid == 0) o[0] = vmax * DIAG_SCALE0; for (int i = 1 + F.tid; i < 1 + (1 << 20); i += 512) o[i] += vmean * DIAG_SCALE1; }
#endif
    }
#undef IN
#undef hi
#undef SEAM
}

static bool phase_valid(int p) {
    if (p == PH_PRO || p == PH_FINAL) return true;
    const int sb = (p - PH_SB0) / PH_PER_SB, k = (p - PH_SB0) % PH_PER_SB;
    return k != 0 && ((sb % 3 == 1) || k == 1 || k == 5);
}
extern "C" void kernel_launch(void* const* d_in, const int* in_sizes, int n_in, void* d_out, int out_size, void* d_ws, size_t ws_size, hipStream_t stream) {
    static int grid = 0;
    if (grid == 0) {
        if (n_in != N_IN || in_sizes[0] != T * DM || out_size != T * DM || ws_size < WS_END) { fprintf(stderr, "kernel_launch: unexpected shapes: n_in %d in0 %d out %d ws %zu (need %zu); nothing launched\n", n_in, n_in > 0 ? in_sizes[0] : -1, out_size, ws_size, (size_t)WS_END); grid = -1; return; }
        int dev = 0, cus = 0, per_cu = 0;
        if (hipGetDevice(&dev) != hipSuccess || hipDeviceGetAttribute(&cus, hipDeviceAttributeMultiprocessorCount, dev) != hipSuccess) { fprintf(stderr, "kernel_launch: device query failed\n"); grid = -1; return; }
        if (hipFuncSetAttribute((const void*)fwd, hipFuncAttributeMaxDynamicSharedMemorySize, LDS_BYTES) != hipSuccess) { fprintf(stderr, "kernel_launch: hipFuncSetAttribute failed\n"); grid = -1; return; }
        if (hipOccupancyMaxActiveBlocksPerMultiprocessor(&per_cu, (const void*)fwd, NWAVES * 64, LDS_BYTES) != hipSuccess || per_cu < 1) fprintf(stderr, "kernel_launch: note: occupancy query reports %d workgroups per CU\n", per_cu);
        (void)hipGetLastError();
        if (cus != 256) { fprintf(stderr, "kernel_launch: built for a 256-CU device (got %d); nothing launched\n", cus); grid = -1; return; }
        grid = cus;
    }
    if (grid < 0) return;
    if (hipMemsetAsync((char*)d_ws + WS_CTL, 0, CTL_ZERO_BYTES, stream) != hipSuccess) { fprintf(stderr, "kernel_launch: memset failed\n"); return; }
    Args a{};
    for (int i = 0; i < N_IN; ++i) a.in[i] = (const float*)d_in[i];
    a.out = (float*)d_out; a.ws = (unsigned char*)d_ws;
#if ONE_LAUNCH
    a.ph_lo = 0; a.ph_hi = N_PH;
    hipLaunchKernelGGL(fwd, dim3(grid), dim3(NWAVES * 64), LDS_BYTES, stream, a);
#else
    for (int p = 0; p < N_PH; ++p) { if (!phase_valid(p)) continue; a.ph_lo = p; a.ph_hi = p + 1; hipLaunchKernelGGL(fwd, dim3(grid), dim3(NWAVES * 64), LDS_BYTES, stream, a); }
#endif
    const hipError_t le = hipPeekAtLastError();
    if (le != hipSuccess) fprintf(stderr, "kernel_launch: launch failed: %s\n", hipGetErrorName(le));
}
```

```cpp
#include <hip/hip_runtime.h>
#include <cstdio>
#include <cstdint>

#ifndef EN_PRO
#define EN_PRO 1
#endif
#ifndef EN_NORM
#define EN_NORM 1
#endif
#ifndef EN_G1
#define EN_G1 1
#endif
#ifndef EN_G3
#define EN_G3 1
#endif
#ifndef EN_M1
#define EN_M1 1
#endif
#ifndef EN_M2
#define EN_M2 1
#endif
#ifndef EN_G4
#define EN_G4 1
#endif
#ifndef EN_GR
#define EN_GR 1
#endif
#ifndef REP_SWA
#define REP_SWA 1
#endif
#ifndef REP_MA
#define REP_MA 1
#endif
#ifndef REP_S1
#define REP_S1 1
#endif
#ifndef REP_S2
#define REP_S2 1
#endif
#ifndef REP_M
#define REP_M 1
#endif
#ifndef REP_PRO
#define REP_PRO 1
#endif
#ifndef REP_NORM
#define REP_NORM 1
#endif
#ifndef REP_G1
#define REP_G1 1
#endif
#ifndef REP_G3
#define REP_G3 1
#endif
#ifndef REP_G4
#define REP_G4 1
#endif
#ifndef REP_GR
#define REP_GR 1
#endif
#ifndef DIAG
#define DIAG 0
#endif
#ifndef DIAG_SCALE0
#define DIAG_SCALE0 1.0f
#endif
#ifndef DIAG_SCALE1
#define DIAG_SCALE1 0.01f
#endif
#ifndef ONE_LAUNCH
#define ONE_LAUNCH 1
#endif

namespace pg8 {
#define PG8_LAS __attribute__((address_space(3)))
typedef unsigned short bf16_t;
typedef short bf16x8 __attribute__((ext_vector_type(8)));
typedef float f32x4 __attribute__((ext_vector_type(4)));
typedef unsigned u32x4 __attribute__((ext_vector_type(4)));
constexpr int BM = 256, BK = 64, HALF = 128, HTB = HALF * BK * 2  , STAGE_BYTES = 8 * HTB, NXCD = 8, WGM = 8;

__host__ __device__ __forceinline__ int lds_byte(int r, int c) { const int st = (r >> 4) * 2 + (c >> 5), rr = r & 15, cc = c & 31, ob = rr * 64 + cc * 2; return st * 1024 + (ob ^ (((ob >> 9) & 1) << 5)); }
__host__ __device__ __forceinline__ void stage_rc(int b, int& R, int& C) { const int st = b / 1024, sb = b % 1024, swz = sb ^ (((sb >> 9) & 1) << 5); R = (st >> 1) * 16 + swz / 64; C = (st & 1) * 32 + (swz % 64) / 2; }
__host__ __device__ __forceinline__ int perm32(int rho) { const int n = rho >> 4, i = rho & 15; return 8 * (i >> 2) + 4 * n + (i & 3); }


struct Unit { int pm, pn, kind; };

typedef float f32x2_cv __attribute__((ext_vector_type(2))); typedef __bf16 bf16x2_cv __attribute__((ext_vector_type(2)));
__device__ __forceinline__ unsigned cvt_pk_bf16(float lo, float hi) { const f32x2_cv v = {lo, hi}; const bf16x2_cv b = __builtin_convertvector(v, bf16x2_cv); return __builtin_bit_cast(unsigned, b); }
__device__ __forceinline__ float bf_lo(unsigned u) { return __uint_as_float(u << 16); }
__device__ __forceinline__ float bf_hi(unsigned u) { return __uint_as_float(u & 0xffff0000u); }
__device__ __forceinline__ float sigmoidf_fast(float x) { return __builtin_amdgcn_rcpf(1.0f + __builtin_amdgcn_exp2f(-1.4426950408889634f * x)); }

__device__ __forceinline__ void tile_of(int L, int nM, int nN, int& pm, int& pn) {
    const int nwg = nM * nN; int wgid = L; { const int q = nwg / NXCD, r = nwg % NXCD, xcd = wgid % NXCD, off = wgid / NXCD; wgid = (xcd < r ? xcd * (q + 1) : r * (q + 1) + (xcd - r) * q) + off; }
    const int nig = WGM * nN, gid = wgid / nig, fm = gid * WGM, gsz = (nM - fm) < WGM ? (nM - fm) : WGM;
    pm = fm + ((wgid % nig) % gsz); pn = (wgid % nig) / gsz;
}

struct SchedTiles {
    static constexpr bool HAS_HALF = false;
    const char* A; const char* Bt; size_t tstep; int nM, nN, G, c;
    __device__ __forceinline__ bool next(int i, Unit& u) const { const int L = i * G + c; if (L >= nM * nN) return false; tile_of(L, nM, nN, u.pm, u.pn); u.kind = 0; return true; }
    __device__ __forceinline__ void operands(const Unit& u, const char*& a, const char*& b) const { a = A + (size_t)u.pm * tstep; b = Bt + (size_t)u.pn * tstep; }
    __device__ __forceinline__ void a_ready(const Unit&) const {}
    __device__ __forceinline__ void done(const Unit&) const {}
};
struct SchedG1 {
    static constexpr bool HAS_HALF = true;
    const char* A; const char* Bt; size_t tstep; int nM, nN, G, c;
    __device__ __forceinline__ bool next(int i, Unit& u) const {
        if (i < 5) { tile_of(i * 256 + c, 32, 44, u.pm, u.pn); u.kind = 0; return true; }
        if (i > 5) return false; const int x = c & 7, j = c >> 3, r = j & 7, q = j >> 3; u.pm = 8 * (x >> 1) + r; u.pn = ((x & 1) ? 42 : 20) + (q >> 1); u.kind = 2 + (q & 1); return true; }
    __device__ __forceinline__ bool is_half(const Unit& u) const { return u.kind >= 2; }
    __device__ __forceinline__ void operands(const Unit& u, const char*& a, const char*& b) const { a = A + (size_t)u.pm * tstep + (u.kind == 3 ? (tstep >> 1) : 0); b = Bt + (size_t)u.pn * tstep; }
    __device__ __forceinline__ void a_ready(const Unit&) const {}
    __device__ __forceinline__ void done(const Unit&) const {}
};
struct SchedProj {
    static constexpr bool HAS_HALF = false;
    const char* A; const char* Bt; const char* A2; const char* Bt2; size_t tstep; int nM, nN, G, c;
    __device__ __forceinline__ bool next(int i, Unit& u) const { const int L = i * G + c, nwg = nM * nN; if (L < nwg) { tile_of(L, nM, nN, u.pm, u.pn); u.kind = 0; return true; }
        if (L < nwg + 16) { const int j = L - nwg; u.pm = j & 1; u.pn = j >> 1; u.kind = 1; return true; } return false; }
    __device__ __forceinline__ void operands(const Unit& u, const char*& a, const char*& b) const { a = (u.kind ? A2 : A) + (size_t)u.pm * tstep; b = (u.kind ? Bt2 : Bt) + (size_t)u.pn * tstep; }
    __device__ __forceinline__ void a_ready(const Unit&) const {}
    __device__ __forceinline__ void done(const Unit&) const {}
};
struct SchedMix {
    static constexpr bool HAS_HALF = false;
    const char* Aswa; const char* Amem; const char* Ays; const char* Bswa; const char* Bmem; const char* Bglu; size_t tstep; int nM, nN, G, c;
    __device__ __forceinline__ bool next(int i, Unit& u) const { const int L = (i >> 2) * G + c; if (L >= nM * nN) return false; tile_of(L, nM, nN, u.pm, u.pn); u.kind = i & 3; return true; }
    __device__ __forceinline__ void operands(const Unit& u, const char*& a, const char*& b) const {
        if (u.kind == 0) { a = Aswa + (size_t)u.pm * tstep; b = Bswa + (size_t)u.pn * tstep; }
        else if (u.kind == 1) { a = Amem + (size_t)u.pm * tstep; b = Bmem + (size_t)u.pn * tstep; }
        else { a = Ays + (size_t)u.pm * tstep; b = Bglu + (size_t)(2 * u.pn + (u.kind - 2)) * tstep; } }
    __device__ __forceinline__ void a_ready(const Unit&) const {}
    __device__ __forceinline__ void done(const Unit&) const {}
};

__device__ __forceinline__ float row_rstd(const float* SSQ, size_t row, int fq) {
    const f32x4* q = (const f32x4*)(SSQ + row * 32 + 8 * fq); const f32x4 a = q[0], b = q[1];
    float s = ((a[0] + a[1]) + (a[2] + a[3])) + ((b[0] + b[1]) + (b[2] + b[3])); s += __shfl_xor(s, 16); s += __shfl_xor(s, 32);
    return 1.0f / sqrtf(s * (1.0f / 2048.0f) + 1e-5f);
}
struct RstdTab { const PG8_LAS float* tab; int pm0; const float* SSQ;
    __device__ __forceinline__ float get(const Unit& u, int rowin, int fq) const { const float r = tab[rowin]; return (u.pm == pm0) ? r : __builtin_nanf(""); } };
struct EpiSwiGLU {
    static constexpr bool PERM = true, AFTER_DRAIN = false;
    bf16_t* O; int ldo; RstdTab R;
    __device__ __forceinline__ void operator()(const f32x4 (&acc)[2][2][4][2], const Unit& u, int wr, int wc, int fr, int fq) const {
        const int hoff = (u.kind == 3) ? HALF : 0, row0 = u.pm * BM + hoff + wr * 64 + fr, col0 = u.pn * HALF + wc * 32 + 8 * fq;
#pragma unroll
        for (int ai = 0; ai < 2; ++ai) { if (ai == 1 && u.kind >= 2) break;
#pragma unroll
            for (int m = 0; m < 4; ++m) { bf16_t* rowp = O + (size_t)(row0 + ai * HALF + m * 16) * ldo + col0; float o[8]; const float rs = R.get(u, hoff + wr * 64 + fr + ai * HALF + m * 16, fq);
#pragma unroll
                for (int n = 0; n < 2; ++n)
#pragma unroll
                    for (int e = 0; e < 4; ++e) { const float g = acc[ai][0][m][n][e] * rs, uu = acc[ai][1][m][n][e] * rs; o[4 * n + e] = g * sigmoidf_fast(g) * uu; }
                u32x4 w; w.x = cvt_pk_bf16(o[0], o[1]); w.y = cvt_pk_bf16(o[2], o[3]); w.z = cvt_pk_bf16(o[4], o[5]); w.w = cvt_pk_bf16(o[6], o[7]);
                *(u32x4*)rowp = w; } }
    }
};
struct EpiResid {
    static constexpr bool PERM = true, AFTER_DRAIN = false;
    const float* X0; float alpha; int ldc; bf16_t* HB; float* SSQ; bf16_t* HBout;
    static __device__ __forceinline__ void finish(const f32x4 (&v)[2][2], int ai, int m, int pn, int row0, int col0, int wc, int fq, int ldc, bf16_t* HBout, float* SSQ) {
        const size_t off = (size_t)(row0 + ai * HALF + m * 16) * ldc + col0; float ss = 0.f;
#pragma unroll
        for (int bj = 0; bj < 2; ++bj) { const f32x4 x0 = v[bj][0], x1 = v[bj][1];
            ss += ((x0[0] * x0[0] + x0[1] * x0[1]) + (x0[2] * x0[2] + x0[3] * x0[3])) + ((x1[0] * x1[0] + x1[1] * x1[1]) + (x1[2] * x1[2] + x1[3] * x1[3]));
            u32x4 w; w.x = cvt_pk_bf16(x0[0], x0[1]); w.y = cvt_pk_bf16(x0[2], x0[3]); w.z = cvt_pk_bf16(x1[0], x1[1]); w.w = cvt_pk_bf16(x1[2], x1[3]); *(u32x4*)(HBout + off + bj * HALF) = w; }
        ss += __shfl_xor(ss, 16); ss += __shfl_xor(ss, 32);
        if (fq == 0) SSQ[(size_t)(row0 + ai * HALF + m * 16) * 32 + pn * 4 + wc] = ss;
    }
    __device__ __forceinline__ void operator()(const f32x4 (&acc)[2][2][4][2], const Unit& u, int wr, int wc, int fr, int fq) const {
        int row0 = u.pm * BM + wr * 64 + fr, col0 = u.pn * BM + wc * 32 + 8 * fq;
        asm volatile("" : "+v"(row0), "+v"(col0));
        const int pn_ = u.pn, ldc_ = ldc; bf16_t* const hbo_ = HBout; float* const ssq_ = SSQ; const float alpha_ = alpha; const float* const x0_ = X0; const bf16_t* const hb_ = HB;
        if (x0_) {
#pragma unroll
            for (int ai = 0; ai < 2; ++ai)
#pragma unroll
                for (int mp = 0; mp < 2; ++mp) { f32x4 b[2][2][2];
#pragma unroll
                    for (int mm = 0; mm < 2; ++mm)
#pragma unroll
                        for (int bj = 0; bj < 2; ++bj)
#pragma unroll
                            for (int n = 0; n < 2; ++n) b[mm][bj][n] = *(const f32x4*)(x0_ + (size_t)(row0 + ai * HALF + (2 * mp + mm) * 16) * ldc_ + col0 + bj * HALF + n * 4);
#pragma unroll
                    for (int mm = 0; mm < 2; ++mm) { f32x4 v[2][2];
#pragma unroll
                        for (int bj = 0; bj < 2; ++bj)
#pragma unroll
                            for (int n = 0; n < 2; ++n) v[bj][n] = b[mm][bj][n] + acc[ai][bj][2 * mp + mm][n] * alpha_;
                        finish(v, ai, 2 * mp + mm, pn_, row0, col0, wc, fq, ldc_, hbo_, ssq_); }
                }
        } else {
#pragma unroll
            for (int ai = 0; ai < 2; ++ai) { u32x4 hw[4][2];
#pragma unroll
                for (int m = 0; m < 4; ++m)
#pragma unroll
                    for (int bj = 0; bj < 2; ++bj) hw[m][bj] = *(const u32x4*)(hb_ + (size_t)(row0 + ai * HALF + m * 16) * ldc_ + col0 + bj * HALF);
#pragma unroll
                for (int m = 0; m < 4; ++m) { f32x4 v[2][2];
#pragma unroll
                    for (int bj = 0; bj < 2; ++bj) { const u32x4 h4 = hw[m][bj];
                        v[bj][0] = (f32x4){bf_lo(h4.x), bf_hi(h4.x), bf_lo(h4.y), bf_hi(h4.y)} + acc[ai][bj][m][0] * alpha_; v[bj][1] = (f32x4){bf_lo(h4.z), bf_hi(h4.z), bf_lo(h4.w), bf_hi(h4.w)} + acc[ai][bj][m][1] * alpha_; }
                    finish(v, ai, m, pn_, row0, col0, wc, fq, ldc_, hbo_, ssq_); }
            }
        }
    }
};
struct EpiProj {
    static constexpr bool PERM = true, AFTER_DRAIN = false;
    bf16_t* P; int ldp; int sig_from; bf16_t* KV; int ldk; RstdTab R; bf16_t* SIN;
    __device__ __forceinline__ void operator()(const f32x4 (&acc)[2][2][4][2], const Unit& u, int wr, int wc, int fr, int fq) const {
        const int row0 = u.pm * BM + wr * 64 + fr, col0 = u.pn * BM + wc * 32 + 8 * fq;
        bf16_t* base = u.kind ? KV : P; const int ld = u.kind ? ldk : ldp; const bool sig = (u.kind == 0) && (u.pn >= sig_from);
#pragma unroll
        for (int ai = 0; ai < 2; ++ai)
#pragma unroll
            for (int m = 0; m < 4; ++m) { bf16_t* rowp = base + (size_t)(row0 + ai * HALF + m * 16) * ld + col0; const float rs = u.kind ? 1.0f : R.get(u, wr * 64 + fr + ai * HALF + m * 16, fq);
#pragma unroll
                for (int bj = 0; bj < 2; ++bj) { f32x4 v0 = acc[ai][bj][m][0] * rs, v1 = acc[ai][bj][m][1] * rs;
                    if (sig) {
#pragma unroll
                        for (int e = 0; e < 4; ++e) { v0[e] = sigmoidf_fast(v0[e]); v1[e] = sigmoidf_fast(v1[e]); } }
                    u32x4 w; w.x = cvt_pk_bf16(v0[0], v0[1]); w.y = cvt_pk_bf16(v0[2], v0[3]); w.z = cvt_pk_bf16(v1[0], v1[1]); w.w = cvt_pk_bf16(v1[2], v1[3]);
                    if (u.kind == 0 && u.pn >= 6 && u.pn < 10) { const int cs = (u.pn - 6) * BM + bj * HALF + wc * 32 + 8 * fq; *(u32x4*)(SIN + ((size_t)(cs >> 4) * 8192 + (size_t)(row0 + ai * HALF + m * 16)) * 16 + (cs & 15)) = w; }
                    else *(u32x4*)(rowp + bj * HALF) = w; } }
    }
};
struct EpiMix {
    static constexpr bool PERM = true, AFTER_DRAIN = false;
    bf16_t* MG; const bf16_t* Gt; int ldg;
    __device__ __forceinline__ void operator()(const f32x4 (&acc)[2][2][4][2], const Unit& u, int wr, int wc, int fr, int fq) const {
        int row0 = u.pm * BM + wr * 64 + fr, cw = wc * 32 + 8 * fq;
        asm volatile("" : "+v"(row0), "+v"(cw));
        if (u.kind < 2) {
            const int gsel = u.kind == 0 ? 0 : 4096;
#pragma unroll
            for (int ai = 0; ai < 2; ++ai)
#pragma unroll
                for (int mp = 0; mp < 2; ++mp) { u32x4 gw[2][2], tw[2][2];
#pragma unroll
                    for (int mm = 0; mm < 2; ++mm)
#pragma unroll
                        for (int bj = 0; bj < 2; ++bj) { const size_t row = (size_t)(row0 + ai * HALF + (2 * mp + mm) * 16); const int col = u.pn * BM + bj * HALF + cw;
                            gw[mm][bj] = *(const u32x4*)(Gt + row * ldg + gsel + col); if (u.kind == 1) tw[mm][bj] = *(const u32x4*)(MG + row * 2048 + col); else tw[mm][bj] = (u32x4){0u, 0u, 0u, 0u}; }
#pragma unroll
                    for (int mm = 0; mm < 2; ++mm)
#pragma unroll
                        for (int bj = 0; bj < 2; ++bj) { const int m = 2 * mp + mm; const size_t row = (size_t)(row0 + ai * HALF + m * 16); const int col = u.pn * BM + bj * HALF + cw; const u32x4 g = gw[mm][bj], t = tw[mm][bj];
                            const f32x4 g0 = {bf_lo(g.x), bf_hi(g.x), bf_lo(g.y), bf_hi(g.y)}, g1 = {bf_lo(g.z), bf_hi(g.z), bf_lo(g.w), bf_hi(g.w)};
                            const f32x4 t0 = acc[ai][bj][m][0] * g0 + (f32x4){bf_lo(t.x), bf_hi(t.x), bf_lo(t.y), bf_hi(t.y)}, t1 = acc[ai][bj][m][1] * g1 + (f32x4){bf_lo(t.z), bf_hi(t.z), bf_lo(t.w), bf_hi(t.w)};
                            u32x4 w; w.x = cvt_pk_bf16(t0[0], t0[1]); w.y = cvt_pk_bf16(t0[2], t0[3]); w.z = cvt_pk_bf16(t1[0], t1[1]); w.w = cvt_pk_bf16(t1[2], t1[3]); *(u32x4*)(MG + row * 2048 + col) = w; }
                    }
        } else {
            const int col = u.pn * BM + (u.kind - 2) * HALF + cw;
#pragma unroll
            for (int ai = 0; ai < 2; ++ai) { u32x4 gw[4], tw[4];
#pragma unroll
                for (int m = 0; m < 4; ++m) { const size_t row = (size_t)(row0 + ai * HALF + m * 16); gw[m] = *(const u32x4*)(Gt + row * ldg + 2048 + col); tw[m] = *(const u32x4*)(MG + row * 2048 + col); }
#pragma unroll
                for (int m = 0; m < 4; ++m) { const size_t row = (size_t)(row0 + ai * HALF + m * 16); const u32x4 g = gw[m], t = tw[m];
                    const float gg[8] = {bf_lo(g.x), bf_hi(g.x), bf_lo(g.y), bf_hi(g.y), bf_lo(g.z), bf_hi(g.z), bf_lo(g.w), bf_hi(g.w)};
                    const float tt[8] = {bf_lo(t.x), bf_hi(t.x), bf_lo(t.y), bf_hi(t.y), bf_lo(t.z), bf_hi(t.z), bf_lo(t.w), bf_hi(t.w)}; float o[8];
#pragma unroll
                    for (int n = 0; n < 2; ++n)
#pragma unroll
                        for (int e = 0; e < 4; ++e) { const float ga = acc[ai][0][m][n][e], gb = acc[ai][1][m][n][e]; o[4 * n + e] = tt[4 * n + e] + gg[4 * n + e] * ga * sigmoidf_fast(gb); }
                    u32x4 w; w.x = cvt_pk_bf16(o[0], o[1]); w.y = cvt_pk_bf16(o[2], o[3]); w.z = cvt_pk_bf16(o[4], o[5]); w.w = cvt_pk_bf16(o[6], o[7]);
                    *(u32x4*)(MG + row * 2048 + col) = w; }
                }
        }
    }
};

template <class Epi, class Sched, bool ALIGN_EPI = false, bool SP2 = false>
__device__ __forceinline__ void gemm_phase(PG8_LAS unsigned char* lds, const int K, const Sched& S, const Epi& E) {
    int tid_ = threadIdx.x; asm volatile("" : "+v"(tid_));
    const int tid = tid_, wid = __builtin_amdgcn_readfirstlane(tid >> 6), lane = tid & 63, wr = wid >> 2, wc = wid & 3, fr = lane & 15, fq = lane >> 4;
    static_assert(SP2, "this copy of the body keeps only the two-super-phase K-loop");
    const int nt = K / BK;
    unsigned voffA[2], voffB[2];
#pragma unroll
    for (int i = 0; i < 2; ++i) { int R, C; stage_rc(tid * 16 + i * 8192, R, C); const int Rb = Epi::PERM ? ((R & ~31) + perm32(R & 31)) : R;
        voffA[i] = (unsigned)(R * K + C) * 2u; voffB[i] = (unsigned)(Rb * K + C) * 2u; }
    const size_t kstep = (size_t)(BK * 2);
    const size_t hstep = (size_t)HALF * K * 2;
    const unsigned ldsw = (unsigned)wid * 1024u;
    const int aoff = lds_byte(wr * 64 + fr, fq * 8), boff = lds_byte(wc * 32 + fr, fq * 8);
#define PG8_SA(b, h) (((b) * 2 + (h)) * HTB)
#define PG8_SB(b, h) ((4 + (b) * 2 + (h)) * HTB)
#define PG8_STAGE(bufoff, gbase, voff) do { _Pragma("unroll") for (int _i = 0; _i < 2; ++_i) \
        __builtin_amdgcn_global_load_lds((const unsigned*)((const char*)(gbase) + (voff)[_i]), (PG8_LAS unsigned*)(lds + (bufoff) + ldsw + _i * 8192), 16, 0, 0); } while (0)
#define PG8_LDA(dst, b, h) do { _Pragma("unroll") for (int m = 0; m < 4; ++m) _Pragma("unroll") for (int k = 0; k < 2; ++k) dst[m][k] = *(const PG8_LAS bf16x8*)(lds + PG8_SA(b, h) + aoff + m * 2048 + k * 1024); } while (0)
#define PG8_LDB(dst, b, h) do { _Pragma("unroll") for (int n = 0; n < 2; ++n) _Pragma("unroll") for (int k = 0; k < 2; ++k) dst[n][k] = *(const PG8_LAS bf16x8*)(lds + PG8_SB(b, h) + boff + n * 2048 + k * 1024); } while (0)
#define PG8_MMA(ai, bj, At, Bt) do { __builtin_amdgcn_s_setprio(1); _Pragma("unroll") for (int m = 0; m < 4; ++m) _Pragma("unroll") for (int n = 0; n < 2; ++n) _Pragma("unroll") for (int k = 0; k < 2; ++k) \
        acc[ai][bj][m][n] = __builtin_amdgcn_mfma_f32_16x16x32_bf16(Bt[n][k], At[m][k], acc[ai][bj][m][n], 0, 0, 0); __builtin_amdgcn_s_setprio(0); } while (0)
#define PG8_WAIT_V(n) asm volatile("s_waitcnt vmcnt(" #n ")" ::: "memory")
#define PG8_WAIT_L(n) asm volatile("s_waitcnt lgkmcnt(" #n ")" ::: "memory")
#define PG8_BAR __builtin_amdgcn_s_barrier()
#define PG8_SCHED __builtin_amdgcn_sched_barrier(0)
    Unit cur, nxt; int ui = 0;
    if (!S.next(0, cur)) return;
    f32x4 acc[2][2][4][2];
#pragma unroll
    for (int a = 0; a < 2; ++a)
#pragma unroll
        for (int b = 0; b < 2; ++b)
#pragma unroll
            for (int m = 0; m < 4; ++m)
#pragma unroll
                for (int n = 0; n < 2; ++n) acc[a][b][m][n] = (f32x4){0.f, 0.f, 0.f, 0.f};
    bf16x8 At[4][2], B0[2][2], B1[2][2];
    const char* cA; const char* cB; S.operands(cur, cA, cB);
    S.a_ready(cur);
    if constexpr (SP2) {
        PG8_STAGE(PG8_SB(0, 0), cB, voffB); PG8_STAGE(PG8_SB(0, 1), cB + hstep, voffB); PG8_STAGE(PG8_SA(0, 0), cA, voffA); PG8_STAGE(PG8_SA(0, 1), cA + hstep, voffA);
        if (wr == 1) PG8_BAR;
        PG8_WAIT_V(2); PG8_BAR;
        PG8_STAGE(PG8_SB(1, 0), cB + kstep, voffB); PG8_STAGE(PG8_SA(1, 0), cA + kstep, voffA); PG8_STAGE(PG8_SB(1, 1), cB + hstep + kstep, voffB);
        PG8_WAIT_V(6); PG8_BAR;
    } else {
        PG8_STAGE(PG8_SB(0, 0), cB, voffB); PG8_STAGE(PG8_SA(0, 0), cA, voffA); PG8_STAGE(PG8_SB(0, 1), cB + hstep, voffB); PG8_STAGE(PG8_SA(0, 1), cA + hstep, voffA);
        if (wr == 1) PG8_BAR;
        PG8_WAIT_V(4); PG8_BAR;
        PG8_STAGE(PG8_SB(1, 0), cB + kstep, voffB); PG8_STAGE(PG8_SA(1, 0), cA + kstep, voffA); PG8_STAGE(PG8_SB(1, 1), cB + hstep + kstep, voffB);
        PG8_WAIT_V(6); PG8_BAR;
    }
    for (;;) {
        const bool has_next = S.next(ui + 1, nxt);
        const char* nA = cA; const char* nB = cB; if (has_next) S.operands(nxt, nA, nB);
#define PG8_KLOOP(HF)         for (int t = 0; t < nt; t += 2) { \
            const bool last = (t == nt - 2); \
            const char* a1 = cA + (size_t)(t + 1) * kstep; \
            const char* a2 = last ? nA : cA + (size_t)(t + 2) * kstep; const char* b2 = last ? nB : cB + (size_t)(t + 2) * kstep; \
            const char* a3 = a2 + kstep; const char* b3 = b2 + kstep; \
            if (last && has_next) S.a_ready(nxt); \
            PG8_LDB(B0, 0, 0); PG8_LDB(B1, 0, 1); PG8_SCHED; PG8_LDA(At, 0, 0); if (!(HF)) PG8_STAGE(PG8_SA(1, 1), a1 + hstep, voffA); \
            if (HF) PG8_WAIT_V(6); else PG8_WAIT_V(8); PG8_WAIT_L(0); PG8_BAR; PG8_MMA(0, 0, At, B0); PG8_MMA(0, 1, At, B1); PG8_BAR; PG8_SCHED; \
            if (!(HF)) PG8_LDA(At, 0, 1); PG8_STAGE(PG8_SB(0, 0), b2, voffB); PG8_STAGE(PG8_SB(0, 1), b2 + hstep, voffB); PG8_STAGE(PG8_SA(0, 0), a2, voffA); \
            if (HF) PG8_WAIT_V(6); else PG8_WAIT_V(8); PG8_WAIT_L(0); PG8_BAR; if (!(HF)) { PG8_MMA(1, 0, At, B0); PG8_MMA(1, 1, At, B1); } PG8_BAR; PG8_SCHED; \
            PG8_LDB(B0, 1, 0); PG8_LDB(B1, 1, 1); PG8_SCHED; PG8_LDA(At, 1, 0); if (!(HF)) PG8_STAGE(PG8_SA(0, 1), a2 + hstep, voffA); \
            if (HF) PG8_WAIT_V(6); else PG8_WAIT_V(8); PG8_WAIT_L(0); PG8_BAR; PG8_MMA(0, 0, At, B0); PG8_MMA(0, 1, At, B1); PG8_BAR; PG8_SCHED; \
            if (!(HF)) PG8_LDA(At, 1, 1); PG8_STAGE(PG8_SB(1, 0), b3, voffB); PG8_STAGE(PG8_SB(1, 1), b3 + hstep, voffB); PG8_STAGE(PG8_SA(1, 0), a3, voffA); \
            if (HF) PG8_WAIT_V(6); else PG8_WAIT_V(8); PG8_WAIT_L(0); PG8_BAR; if (!(HF)) { PG8_MMA(1, 0, At, B0); PG8_MMA(1, 1, At, B1); } PG8_BAR; PG8_SCHED; \
        }
        if constexpr (Sched::HAS_HALF) { if (S.is_half(cur)) { PG8_KLOOP(true) } else { PG8_KLOOP(false) } } else { PG8_KLOOP(false) }
#undef PG8_KLOOP
        if constexpr (ALIGN_EPI) { if (wr == 0) PG8_BAR; }
        if constexpr (!Epi::AFTER_DRAIN) { E(acc, cur, wr, wc, fr, fq); S.done(cur); }
        if (!has_next) break;
#pragma unroll
        for (int a = 0; a < 2; ++a)
#pragma unroll
            for (int b = 0; b < 2; ++b)
#pragma unroll
                for (int m = 0; m < 4; ++m)
#pragma unroll
                    for (int n = 0; n < 2; ++n) acc[a][b][m][n] = (f32x4){0.f, 0.f, 0.f, 0.f};
        cur = nxt; cA = nA; cB = nB; ++ui;
        if constexpr (ALIGN_EPI) { if (wr == 1) PG8_BAR; }
    }
    PG8_WAIT_V(0);
    if constexpr (!ALIGN_EPI) { if (wr == 0) PG8_BAR; }
    PG8_BAR;
    if constexpr (Epi::AFTER_DRAIN) { E.fused(acc, cur, wr, wc, fr, fq, lds, wid, lane); S.done(cur); }
#undef PG8_SA
#undef PG8_SB
#undef PG8_STAGE
#undef PG8_LDA
#undef PG8_LDB
#undef PG8_MMA
#undef PG8_WAIT_V
#undef PG8_WAIT_L
#undef PG8_BAR
#undef PG8_SCHED
}
}

constexpr int BATCH = 2, SEQ = 4096, DM = 2048, DEPTH = 4, NMEM = 256, DFF = 5632;
constexpr int T = BATCH * SEQ;
constexpr int INW = 9728, COL_Q = 0, COL_K = 1024, COL_V = 1280, COL_S = 1536, COL_MQ = 2560, COL_G = 3584;
constexpr float RMS_EPS = 1e-5f, LOG2E = 1.4426950408889634f;
constexpr int NWAVES = 8;
enum { I_X = 0, I_MEM, I_F1N, I_F1WI, I_F1WO, I_MIXN, I_MEMN, I_WIN, I_SINK, I_WMKV, I_LRE, I_LIM, I_LDT, I_BRE, I_BIM, I_CRE, I_CIM, I_DSK, I_WGLU, I_WSWA, I_WMEMUP, I_WOUT, I_F2N, I_F2WI, I_F2WO, I_FINN, N_IN };

constexpr size_t MiB = 1u << 20;
constexpr size_t WS_CTL = 0, CTL_ZERO_BYTES = 1 * MiB;
constexpr size_t WS_W = 2 * MiB, W_LAYER = 202 * MiB;
constexpr size_t WO_1IN = 0, WO_1OUT = 44 * MiB, WO_IN = 66 * MiB, WO_MKV = 104 * MiB, WO_SWA = 112 * MiB, WO_MEM = 116 * MiB, WO_GLU = 120 * MiB, WO_OUT = 128 * MiB, WO_2IN = 136 * MiB, WO_2OUT = 180 * MiB;
constexpr size_t WS_MEMN = WS_W + DEPTH * W_LAYER;
constexpr size_t WS_H = WS_MEMN + 8 * MiB;
constexpr size_t WS_XN = WS_H + 64 * MiB;
constexpr size_t WS_HID = WS_XN + 32 * MiB;
constexpr size_t WS_PROJ = WS_HID + 88 * MiB;
constexpr size_t WS_MKV = WS_PROJ + 152 * MiB;
constexpr size_t WS_OSWA = WS_MKV + 2 * MiB, WS_YS = WS_OSWA + 16 * MiB, WS_OMEM = WS_YS + 16 * MiB;
constexpr size_t WS_T32 = WS_OMEM + 16 * MiB;
constexpr size_t WS_MG = WS_T32 + 64 * MiB;
constexpr size_t WS_SEND = WS_MG + 32 * MiB;
constexpr size_t LB_BYTES = 65 * 512;
constexpr size_t WS_LB = WS_SEND + 4 * MiB;
constexpr size_t WS_WINT = WS_LB + 9 * MiB;
constexpr size_t WS_WOUTT = WS_WINT + 64 * MiB;
constexpr size_t WS_SST = WS_WOUTT + 64 * MiB;
constexpr size_t WS_A64 = WS_SST + 2 * MiB;
constexpr size_t WS_SSQ = WS_A64 + 1 * MiB;
constexpr size_t WS_SIN = WS_SSQ + 1 * MiB;
constexpr size_t WS_END = WS_SIN + 16 * MiB;
static_assert(DEPTH * 64 * LB_BYTES <= 9 * MiB, "lag tables fit");
constexpr int CW_BAR = 4096;

constexpr int RING_OFF = 0, RING_BYTES = 131072;
constexpr int LDSCTL_OFF = RING_BYTES, MISC_OFF = LDSCTL_OFF + 320;
constexpr int LDS_BYTES = 147456;

#define GAS __attribute__((address_space(1)))
#define LAS __attribute__((address_space(3)))
typedef unsigned short bf16;
typedef unsigned v4u __attribute__((ext_vector_type(4)));
typedef unsigned v2u __attribute__((ext_vector_type(2)));
typedef float f32x4 __attribute__((ext_vector_type(4)));
typedef float f32x2 __attribute__((ext_vector_type(2)));
typedef GAS unsigned gu32;
using pg8::cvt_pk_bf16; using pg8::bf_lo; using pg8::bf_hi;

#define XB_TMO      128
#define XB_XCNT(j)  (256  + 64 * (j))
#define XB_XSUB(j)  (1280 + 64 * (j))
#define XB_XGEN(j)  (2304 + 64 * (j))
#define XB_TOP      3328
#define XB_TOPGEN   3392
#define XCD_BAR_WORDS 3456
#define XB_SPIN_CAP (1u << 18)

__device__ __forceinline__ unsigned xb_ld(unsigned* p)              { return __hip_atomic_load(p, __ATOMIC_RELAXED, __HIP_MEMORY_SCOPE_AGENT); }
__device__ __forceinline__ unsigned xb_add(unsigned* p, unsigned v) { return __hip_atomic_fetch_add(p, v, __ATOMIC_RELAXED, __HIP_MEMORY_SCOPE_AGENT); }
__device__ __forceinline__ unsigned xb_xcc_id() { return (unsigned)__builtin_amdgcn_s_getreg((3 << 11) | 20) & 0xFu; }
#define XB_SPIN(cond, bar) do { unsigned _sp = 0; while (cond) { __builtin_amdgcn_s_sleep(1); \
    if ((++_sp & 255u) == 0u) { if (xb_ld(&(bar)[XB_TMO])) break; if (_sp > XB_SPIN_CAP) { atomicAdd(&(bar)[XB_TMO], 1u); break; } } } } while (0)

struct XcdBarrier {
    unsigned* bar; unsigned x;
    volatile LAS unsigned* st;
};

__device__ __forceinline__ XcdBarrier xcd_barrier_post(unsigned* bar, volatile LAS unsigned* st) {
    XcdBarrier b; b.bar = bar; b.x = xb_xcc_id(); b.st = st;
    if (threadIdx.x == 0) (void)xb_add(&bar[XB_XCNT(b.x)], 1u);
    return b;
}
__device__ __forceinline__ void xcd_barrier_complete(unsigned* bar, unsigned x, unsigned& nloc, unsigned& nx) {
    const unsigned G = gridDim.x * gridDim.y * gridDim.z;
    unsigned sum, cnt, mine, sp = 0u;
    for (;;) {
        sum = 0u; cnt = 0u; mine = 0u;
#pragma unroll
        for (unsigned j = 0; j < 16; ++j) { const unsigned c = xb_ld(&bar[XB_XCNT(j)]); sum += c; cnt += (c > 0u) ? 1u : 0u; mine = (j == x) ? c : mine; }
        if (sum == G) break;
        __builtin_amdgcn_s_sleep(1);
        if ((++sp & 255u) == 0u) { if (xb_ld(&bar[XB_TMO])) break; if (sp > XB_SPIN_CAP) { atomicAdd(&bar[XB_TMO], 1u); break; } }
    }
    nloc = mine > 0u ? mine : 1u; nx = cnt > 0u ? cnt : 1u;
}

__device__ __forceinline__ void xcd_barrier(const XcdBarrier& b) {
    asm volatile("s_waitcnt vmcnt(0)" ::: "memory");
    __syncthreads();
    if (threadIdx.x == 0) {
#if DIAG
        const unsigned long long dt0_ = __builtin_amdgcn_s_memrealtime();
#endif
        unsigned* bar = b.bar;
        __builtin_amdgcn_s_waitcnt(0);
        unsigned nloc = b.st[0], nx = b.st[1];
        if (nloc == 0u) { xcd_barrier_complete(bar, b.x, nloc, nx); b.st[0] = nloc; b.st[1] = nx; }
        const unsigned old = xb_add(&bar[XB_XSUB(b.x)], 1u);
        const unsigned gen = old / nloc;
        if (old + 1u == (gen + 1u) * nloc) {
            __builtin_amdgcn_fence(__ATOMIC_RELEASE, "agent");
            asm volatile("s_waitcnt vmcnt(0)" ::: "memory");
            const unsigned og = xb_add(&bar[XB_TOP], 1u);
            const unsigned tg = og / nx;
            if (og + 1u == (tg + 1u) * nx) xb_add(&bar[XB_TOPGEN], 1u);
            else XB_SPIN(xb_ld(&bar[XB_TOPGEN]) == tg, bar);
            __builtin_amdgcn_fence(__ATOMIC_ACQUIRE, "agent");
            xb_add(&bar[XB_XGEN(b.x)], 1u);
            asm volatile("s_waitcnt vmcnt(0)" ::: "memory");
        } else {
            XB_SPIN(xb_ld(&bar[XB_XGEN(b.x)]) == gen, bar);
            __builtin_amdgcn_fence(__ATOMIC_ACQUIRE, "agent");
            asm volatile("s_waitcnt vmcnt(0)" ::: "memory");
        }
#if DIAG
        b.st[8] += (unsigned)(__builtin_amdgcn_s_memrealtime() - dt0_);
#endif
    }
    __syncthreads();
}

struct Frame {
    LAS unsigned char* lds;
    int tid, lane, wave, G;
    unsigned char* ws;
};
__device__ __forceinline__ float wave_sum(float v) {
#pragma unroll
    for (int o = 1; o < 64; o <<= 1) v += __shfl_xor(v, o);
    return v;
}
__device__ __forceinline__ bf16* wsb(const Frame& F, size_t off) { return (bf16*)(F.ws + off); }

struct ConvItem { const float* src; const float* gk; bf16* dst; int K, N; float scale; };
__device__ __forceinline__ void conv_load(const ConvItem& c, float (&v)[64]) {
#pragma unroll
    for (int i = 0; i < 64; ++i) v[i] = c.src[(size_t)i * c.N];
}
__device__ __forceinline__ void conv_store(const ConvItem& c, float (&v)[64], int lane, LAS unsigned char* scr) {
    if (c.gk) {
#pragma unroll
        for (int i = 0; i < 64; ++i) v[i] *= c.gk[i]; }
    const float scale = c.scale;
#pragma unroll
    for (int q = 0; q < 8; ++q) { v4u o; o.x = cvt_pk_bf16(v[8 * q] * scale, v[8 * q + 1] * scale); o.y = cvt_pk_bf16(v[8 * q + 2] * scale, v[8 * q + 3] * scale);
        o.z = cvt_pk_bf16(v[8 * q + 4] * scale, v[8 * q + 5] * scale); o.w = cvt_pk_bf16(v[8 * q + 6] * scale, v[8 * q + 7] * scale); *(LAS v4u*)(scr + lane * 144 + q * 16) = o; }
    asm volatile("s_waitcnt lgkmcnt(0)" ::: "memory");
#pragma unroll
    for (int i = 0; i < 8; ++i) { const v4u o = *(const LAS v4u*)(scr + (8 * i + (lane >> 3)) * 144 + (lane & 7) * 16); *(v4u*)(c.dst + (size_t)(8 * i) * c.K) = o; }
    asm volatile("s_waitcnt lgkmcnt(0)" ::: "memory");
}
constexpr int CI_1IN = (DM / 64) * (2 * DFF / 64), CI_1OUT = (DFF / 64) * (DM / 64), CI_IN = (DM / 64) * (INW / 64), CI_MKV = (DM / 64) * (2048 / 64), CI_GLU = (1024 / 64) * (4096 / 64),
              CI_SWA = (1024 / 64) * (DM / 64), CI_MEM = CI_SWA, CI_OUT = (DM / 64) * (DM / 64), CI_LAYER = 2 * CI_1IN + 2 * CI_1OUT + CI_IN + CI_MKV + CI_GLU + CI_SWA + CI_MEM + CI_OUT;
struct ProIn { const float *f1wi, *f2wi, *f1wo, *f2wo, *win, *wmkv, *wglu, *wswa, *wmem, *wout, *mem, *memn, *f1n, *f2n, *mixn, *x; };
constexpr int TAB_WGS = 64;
__device__ __forceinline__ void prologue(Frame& F, const ProIn& I) {
    const bool split = F.G > TAB_WGS, tabwg = split && (int)blockIdx.x < TAB_WGS;
    const int nconv = split ? F.G - TAB_WGS : F.G, bconv = split ? (int)blockIdx.x - TAB_WGS : (int)blockIdx.x;
    int gw = bconv * NWAVES + F.wave, NGW = nconv * NWAVES; const int lane = F.lane;
    auto item = [&](int it, ConvItem& c) {
        const int l = it / CI_LAYER; int r = it % CI_LAYER; unsigned char* wl = F.ws + WS_W + (size_t)l * W_LAYER;
        const float* src; bf16* dst; int K, N, pairNh = 0; const float* gk = nullptr;
        if (r < CI_1IN) { src = I.f1wi + (size_t)l * DM * 2 * DFF; dst = (bf16*)(wl + WO_1IN); K = DM; N = 2 * DFF; pairNh = DFF; gk = I.f1n + (size_t)l * DM; }
        else if ((r -= CI_1IN) < CI_1IN) { src = I.f2wi + (size_t)l * DM * 2 * DFF; dst = (bf16*)(wl + WO_2IN); K = DM; N = 2 * DFF; pairNh = DFF; gk = I.f2n + (size_t)l * DM; }
        else if ((r -= CI_1IN) < CI_1OUT) { src = I.f1wo + (size_t)l * DFF * DM; dst = (bf16*)(wl + WO_1OUT); K = DFF; N = DM; }
        else if ((r -= CI_1OUT) < CI_1OUT) { src = I.f2wo + (size_t)l * DFF * DM; dst = (bf16*)(wl + WO_2OUT); K = DFF; N = DM; }
        else if ((r -= CI_1OUT) < CI_IN) { src = I.win + (size_t)l * DM * INW; dst = (bf16*)(wl + WO_IN); K = DM; N = INW; gk = I.mixn + (size_t)l * DM; }
        else if ((r -= CI_IN) < CI_MKV) { src = I.wmkv + (size_t)l * DM * 2048; dst = (bf16*)(wl + WO_MKV); K = DM; N = 2048; }
        else if ((r -= CI_MKV) < CI_GLU) { src = I.wglu + (size_t)l * 1024 * 4096; dst = (bf16*)(wl + WO_GLU); K = 1024; N = 4096; pairNh = 2048; }
        else if ((r -= CI_GLU) < CI_SWA) { src = I.wswa + (size_t)l * 1024 * DM; dst = (bf16*)(wl + WO_SWA); K = 1024; N = DM; }
        else if ((r -= CI_SWA) < CI_MEM) { src = I.wmem + (size_t)l * 1024 * DM; dst = (bf16*)(wl + WO_MEM); K = 1024; N = DM; }
        else { r -= CI_MEM; src = I.wout + (size_t)l * DM * DM; dst = (bf16*)(wl + WO_OUT); K = DM; N = DM; }
        const int nblk = N / 64, r8 = r >> 3, wv = r & 7, kb = 8 * (r8 / nblk) + wv, nb = r8 % nblk, n0 = nb * 64, k0 = kb * 64;
        float sc = 1.f; if (N == INW) sc = n0 < COL_K ? 0.125f * LOG2E : ((n0 >= COL_MQ && n0 < COL_G) ? 0.0625f * LOG2E : 1.f);
        int row0 = n0; if (pairNh) { const int j = n0 < pairNh ? n0 : n0 - pairNh; row0 = (j >> 7) * 256 + (j & 127) + (n0 < pairNh ? 0 : 128); }
        c.src = src + (size_t)k0 * N + n0 + lane; c.gk = gk ? gk + k0 : nullptr; c.dst = dst + (size_t)(row0 + (lane >> 3)) * K + k0 + 8 * (lane & 7); c.K = K; c.N = N; c.scale = sc;
    };
    if (!tabwg) {
        LAS unsigned char* scr = F.lds + F.wave * 9216; constexpr int NIT = DEPTH * CI_LAYER;
        float va[64], vb[64]; ConvItem ca, cb; int it = gw;
        if (it < NIT) { item(it, ca); conv_load(ca, va); }
        while (it < NIT) {
            const int it1 = it + NGW; if (it1 < NIT) { item(it1, cb); conv_load(cb, vb); }
            conv_store(ca, va, lane, scr);
            if (it1 >= NIT) break;
            const int it2 = it1 + NGW; if (it2 < NIT) { item(it2, ca); conv_load(ca, va); }
            conv_store(cb, vb, lane, scr);
            it = it2;
        }
    }
    if (split) { if (!tabwg) return; gw = (int)blockIdx.x * NWAVES + F.wave; NGW = TAB_WGS * NWAVES; }
    for (int m = gw; m < T; m += NGW) {
        const f32x4* xr = (const f32x4*)(I.x + (size_t)m * DM) + lane; v2u* o8 = (v2u*)(wsb(F, WS_XN) + (size_t)m * DM) + lane; float s = 0.f;
#pragma unroll
        for (int j = 0; j < 8; ++j) { const f32x4 v = xr[64 * j]; s += (v.x * v.x + v.y * v.y) + (v.z * v.z + v.w * v.w); v2u o; o.x = cvt_pk_bf16(v.x, v.y); o.y = cvt_pk_bf16(v.z, v.w); o8[64 * j] = o; }
        s = wave_sum(s); if (lane < 32) ((float*)(F.ws + WS_SSQ))[(size_t)m * 32 + lane] = lane == 0 ? s : 0.f;
    }
    for (int it = gw; it < DEPTH * 512; it += NGW) {
        const int l = it / 512, row = it % 512;
        const f32x4* xr = (const f32x4*)(I.mem + (size_t)row * DM) + lane; const f32x4* gr = (const f32x4*)(I.memn + (size_t)l * DM) + lane;
        f32x4 v[8]; float s = 0.f;
#pragma unroll
        for (int j = 0; j < 8; ++j) { v[j] = xr[64 * j]; s += (v[j].x * v[j].x + v[j].y * v[j].y) + (v[j].z * v[j].z + v[j].w * v[j].w); }
        const float rstd = 1.0f / sqrtf(wave_sum(s) * (1.f / DM) + RMS_EPS);
        v2u* o8 = (v2u*)(wsb(F, WS_MEMN) + ((size_t)l * 512 + row) * DM) + lane;
#pragma unroll
        for (int j = 0; j < 8; ++j) { const f32x4 g = gr[64 * j]; v2u o; o.x = cvt_pk_bf16(v[j].x * rstd * g.x, v[j].y * rstd * g.y); o.y = cvt_pk_bf16(v[j].z * rstd * g.z, v[j].w * rstd * g.w); o8[64 * j] = o; }
    }
}
constexpr int RSTD_OFF = LDSCTL_OFF + 1024;
__device__ __forceinline__ void rstd_table(Frame& F, int pm) {
    LAS float* tab = (LAS float*)(F.lds + RSTD_OFF);
    if (F.tid < 256) { const f32x4* q = (const f32x4*)((const float*)(F.ws + WS_SSQ) + ((size_t)pm * 256 + F.tid) * 32); float s = 0.f;
#pragma unroll
        for (int j = 0; j < 8; ++j) { const f32x4 a = q[j]; s += (a[0] + a[1]) + (a[2] + a[3]); }
        tab[F.tid] = 1.0f / sqrtf(s * (1.0f / DM) + RMS_EPS); }
    __syncthreads();
}
template <bool OUTF32>
__device__ __forceinline__ void norm_phase(Frame& F, const float* hin, const float* gain, void* outp) {
    const int gw = blockIdx.x * NWAVES + F.wave, NGW = F.G * NWAVES, lane = F.lane;
    f32x4 g[8];
#pragma unroll
    for (int j = 0; j < 8; ++j) g[j] = ((const f32x4*)gain)[lane + 64 * j];
    for (int m = gw; m < T; m += NGW) {
        const f32x4* xr = (const f32x4*)(hin + (size_t)m * DM) + lane;
        f32x4 v[8]; float s = 0.f;
#pragma unroll
        for (int j = 0; j < 8; ++j) { v[j] = xr[64 * j]; s += (v[j].x * v[j].x + v[j].y * v[j].y) + (v[j].z * v[j].z + v[j].w * v[j].w); }
        const float rstd = 1.0f / sqrtf(wave_sum(s) * (1.f / DM) + RMS_EPS);
        if (OUTF32) { f32x4* o = (f32x4*)((float*)outp + (size_t)m * DM) + lane;
#pragma unroll
            for (int j = 0; j < 8; ++j) o[64 * j] = v[j] * rstd * g[j];
        } else { v2u* o8 = (v2u*)((bf16*)outp + (size_t)m * DM) + lane;
#pragma unroll
            for (int j = 0; j < 8; ++j) { v2u o; o.x = cvt_pk_bf16(v[j].x * rstd * g[j].x, v[j].y * rstd * g[j].y); o.y = cvt_pk_bf16(v[j].z * rstd * g[j].z, v[j].w * rstd * g[j].w); o8[64 * j] = o; } }
    }
}
__device__ __forceinline__ void final_norm(Frame& F, const bf16* hb, const float* gain, float* outp) {
    const int gw = blockIdx.x * NWAVES + F.wave, NGW = F.G * NWAVES, lane = F.lane;
    for (int m = gw; m < T; m += NGW) {
        const v4u* xr = (const v4u*)(hb + (size_t)m * DM) + lane; float v[4][8]; float s = 0.f;
#pragma unroll
        for (int j = 0; j < 4; ++j) { const v4u w = xr[64 * j]; v[j][0] = bf_lo(w.x); v[j][1] = bf_hi(w.x); v[j][2] = bf_lo(w.y); v[j][3] = bf_hi(w.y); v[j][4] = bf_lo(w.z); v[j][5] = bf_hi(w.z); v[j][6] = bf_lo(w.w); v[j][7] = bf_hi(w.w);
#pragma unroll
            for (int e = 0; e < 8; ++e) s += v[j][e] * v[j][e]; }
        const float rstd = 1.0f / sqrtf(wave_sum(s) * (1.f / DM) + RMS_EPS);
#pragma unroll
        for (int j = 0; j < 4; ++j) { const f32x4* g = (const f32x4*)(gain + (lane + 64 * j) * 8); f32x4* o = (f32x4*)(outp + (size_t)m * DM + (lane + 64 * j) * 8); const f32x4 g0 = g[0], g1 = g[1];
            o[0] = (f32x4){v[j][0] * rstd * g0[0], v[j][1] * rstd * g0[1], v[j][2] * rstd * g0[2], v[j][3] * rstd * g0[3]}; o[1] = (f32x4){v[j][4] * rstd * g1[0], v[j][5] * rstd * g1[1], v[j][6] * rstd * g1[2], v[j][7] * rstd * g1[3]}; }
    }
}
__device__ __forceinline__ void unpack8(const v4u w, float* f) { f[0] = bf_lo(w.x); f[1] = bf_hi(w.x); f[2] = bf_lo(w.y); f[3] = bf_hi(w.y); f[4] = bf_lo(w.z); f[5] = bf_hi(w.z); f[6] = bf_lo(w.w); f[7] = bf_hi(w.w); }

__device__ __forceinline__ void swa_naive(Frame& F, const float* sinks) {
    const bf16* P = wsb(F, WS_PROJ); bf16* O = wsb(F, WS_OSWA);
    for (int idx = blockIdx.x * 512 + F.tid; idx < T * 16; idx += F.G * 512) {
        const int hq = idx / T, m = idx % T, b = m / SEQ, t = m % SEQ, g = hq >> 2;
        float q[64];
        { const v4u* qp = (const v4u*)(P + (size_t)m * INW + COL_Q + hq * 64);
#pragma unroll
          for (int j = 0; j < 8; ++j) unpack8(qp[j], q + 8 * j); }
        float mrun = sinks[hq] * LOG2E, lrun = 1.f, o[64];
#pragma unroll
        for (int j = 0; j < 64; ++j) o[j] = 0.f;
        const int k0 = t >= 127 ? t - 127 : 0;
        for (int kp = k0; kp <= t; ++kp) {
            const bf16* kr = P + (size_t)(b * SEQ + kp) * INW + COL_K + g * 64; const bf16* vr = kr + (COL_V - COL_K);
            float s0 = 0.f, s1 = 0.f;
#pragma unroll
            for (int j = 0; j < 8; ++j) { float kf[8]; unpack8(((const v4u*)kr)[j], kf);
#pragma unroll
                for (int e = 0; e < 8; e += 2) { s0 += q[8 * j + e] * kf[e]; s1 += q[8 * j + e + 1] * kf[e + 1]; } }
            const float s = s0 + s1, mnew = fmaxf(mrun, s), corr = __builtin_amdgcn_exp2f(mrun - mnew), p = __builtin_amdgcn_exp2f(s - mnew);
            lrun = lrun * corr + p; mrun = mnew;
#pragma unroll
            for (int j = 0; j < 8; ++j) { float vf[8]; unpack8(((const v4u*)vr)[j], vf);
#pragma unroll
                for (int e = 0; e < 8; ++e) o[8 * j + e] = o[8 * j + e] * corr + p * vf[e]; }
        }
        const float inv = 1.0f / lrun; v4u* op = (v4u*)(O + (size_t)m * 1024 + hq * 64);
#pragma unroll
        for (int j = 0; j < 8; ++j) { v4u w; w.x = cvt_pk_bf16(o[8 * j] * inv, o[8 * j + 1] * inv); w.y = cvt_pk_bf16(o[8 * j + 2] * inv, o[8 * j + 3] * inv);
            w.z = cvt_pk_bf16(o[8 * j + 4] * inv, o[8 * j + 5] * inv); w.w = cvt_pk_bf16(o[8 * j + 6] * inv, o[8 * j + 7] * inv); op[j] = w; }
    }
}
__device__ __forceinline__ void memattn_naive(Frame& F) {
    const bf16* P = wsb(F, WS_PROJ); const bf16* KV = wsb(F, WS_MKV); bf16* O = wsb(F, WS_OMEM);
    LAS float* qs = (LAS float*)F.lds;
    LAS float* ss = qs + 32 * 260;
    const int tid = F.tid, ti = tid >> 4, kg = tid & 15;
    for (int unit = blockIdx.x; unit < 1024; unit += F.G) {
        const int b = unit >> 9, hd = (unit >> 7) & 3, tb = unit & 127, m0 = b * SEQ + tb * 32;
        { const v4u* src = (const v4u*)(P + (size_t)(m0 + ti) * INW + COL_MQ + hd * 256 + kg * 16); float f[16]; unpack8(src[0], f); unpack8(src[1], f + 8);
#pragma unroll
          for (int e = 0; e < 16; ++e) qs[ti * 260 + kg * 16 + e] = f[e]; }
        __syncthreads();
        float sc[16];
#pragma unroll 1
        for (int i = 0; i < 16; ++i) { const int key = kg + 16 * i; const v4u* kr = (const v4u*)(KV + (size_t)(b * NMEM + key) * 2048 + hd * 256);
            float a0 = 0.f, a1 = 0.f;
#pragma unroll 8
            for (int d8 = 0; d8 < 32; ++d8) { float kf[8]; unpack8(kr[d8], kf); const LAS f32x4* qp = (const LAS f32x4*)(qs + ti * 260 + d8 * 8); const f32x4 qa = qp[0], qb = qp[1];
                a0 += qa.x * kf[0] + qa.y * kf[1] + qa.z * kf[2] + qa.w * kf[3]; a1 += qb.x * kf[4] + qb.y * kf[5] + qb.z * kf[6] + qb.w * kf[7]; }
            ss[ti * 257 + key] = a0 + a1; }
        __syncthreads();
        float mx = -3.0e38f;
#pragma unroll
        for (int i = 0; i < 16; ++i) { sc[i] = ss[ti * 257 + kg + 16 * i]; mx = fmaxf(mx, sc[i]); }
#pragma unroll
        for (int o = 1; o < 16; o <<= 1) mx = fmaxf(mx, __shfl_xor(mx, o));
        float sum = 0.f;
#pragma unroll
        for (int i = 0; i < 16; ++i) { sc[i] = __builtin_amdgcn_exp2f(sc[i] - mx); sum += sc[i]; }
#pragma unroll
        for (int o = 1; o < 16; o <<= 1) sum += __shfl_xor(sum, o);
        const float inv = 1.0f / sum;
#pragma unroll
        for (int i = 0; i < 16; ++i) ss[ti * 257 + kg + 16 * i] = sc[i] * inv;
        __syncthreads();
        float o[16];
#pragma unroll
        for (int e = 0; e < 16; ++e) o[e] = 0.f;
#pragma unroll 4
        for (int key = 0; key < NMEM; ++key) { const float p = ss[ti * 257 + key]; const v4u* vr = (const v4u*)(KV + (size_t)(b * NMEM + key) * 2048 + 1024 + hd * 256 + kg * 16);
            float vf[16]; unpack8(vr[0], vf); unpack8(vr[1], vf + 8);
#pragma unroll
            for (int e = 0; e < 16; ++e) o[e] += p * vf[e]; }
        v4u* op = (v4u*)(O + (size_t)(m0 + ti) * 1024 + hd * 256 + kg * 16);
        v4u w; w.x = cvt_pk_bf16(o[0], o[1]); w.y = cvt_pk_bf16(o[2], o[3]); w.z = cvt_pk_bf16(o[4], o[5]); w.w = cvt_pk_bf16(o[6], o[7]); op[0] = w;
        w.x = cvt_pk_bf16(o[8], o[9]); w.y = cvt_pk_bf16(o[10], o[11]); w.z = cvt_pk_bf16(o[12], o[13]); w.w = cvt_pk_bf16(o[14], o[15]); op[1] = w;
        __syncthreads();
    }
}
__device__ __forceinline__ void sincos_red(double x, float& s, float& c) {
    const double k = __builtin_rint(x * 0.63661977236758134308); const double r = (x - k * 1.57079632679489655800) - k * 6.123233995736766036e-17; const double r2 = r * r;
    double sp = -7.6471637318198164759e-13; sp = sp * r2 + 1.6059043836821614599e-10; sp = sp * r2 - 2.5052108385441718775e-8; sp = sp * r2 + 2.7557319223985890653e-6; sp = sp * r2 - 1.9841269841269841270e-4; sp = sp * r2 + 8.3333333333333333333e-3; sp = sp * r2 - 1.6666666666666666667e-1;
    const double sr = r + r * r2 * sp;
    double cp = -1.1470745597729724714e-11; cp = cp * r2 + 2.0876756987868098979e-9; cp = cp * r2 - 2.7557319223985890653e-7; cp = cp * r2 + 2.4801587301587301587e-5; cp = cp * r2 - 1.3888888888888888889e-3; cp = cp * r2 + 4.1666666666666666667e-2; cp = cp * r2 - 0.5;
    const double cr = 1.0 + r2 * cp;
    const int q = ((int)k) & 3;
    const double ss = (q & 1) ? cr : sr, cc = (q & 1) ? sr : cr;
    s = (float)((q & 2) ? -ss : ss); c = (float)(((q == 1) || (q == 2)) ? -cc : cc);
}
struct SsmState { float ar, ai, a64r, a64i; float bbr[16], bbi[16]; };
struct SsmIn { const float *lre, *lim, *ldt, *bre, *bim, *cre, *cim, *dsk; };
__device__ __forceinline__ void ssm_params(const SsmIn& I, int g, int p, SsmState& S) {
    const int gp = g * 64 + p;
    const float lr = fminf(I.lre[gp], -1e-4f), li = I.lim[gp], dt = expf(I.ldt[g]);
    const float mag = expf(lr * dt); float sn, cs; const double th = (double)li * (double)dt; sincos_red(th, sn, cs);
    S.ar = mag * cs; S.ai = mag * sn;
    const float mag64 = expf(lr * dt * 64.f); sincos_red(th * 64.0, sn, cs); S.a64r = mag64 * cs; S.a64i = mag64 * sn;
    const float nr = S.ar - 1.f, ni = S.ai, den = lr * lr + li * li, kr = (nr * lr + ni * li) / den, ki = (ni * lr - nr * li) / den;
    const float* br = I.bre + (size_t)gp * 16; const float* bi = I.bim + (size_t)gp * 16;
#pragma unroll
    for (int c = 0; c < 16; ++c) { S.bbr[c] = kr * br[c] - ki * bi[c]; S.bbi[c] = kr * bi[c] + ki * br[c]; }
}
__device__ __forceinline__ void ssm_step(const SsmState& S, const bf16* up, float& sr, float& si) {
    const v4u* u4 = (const v4u*)up; float uf[16]; unpack8(u4[0], uf); unpack8(u4[1], uf + 8);
    float xr = 0.f, xi = 0.f;
#pragma unroll
    for (int c = 0; c < 16; ++c) { xr += S.bbr[c] * uf[c]; xi += S.bbi[c] * uf[c]; }
    const float nr = S.ar * sr - S.ai * si + xr, ni = S.ar * si + S.ai * sr + xi; sr = nr; si = ni;
}
__device__ __forceinline__ void ssm_local(Frame& F, const SsmIn& I) {
    const bf16* P = wsb(F, WS_PROJ); f32x2* SE = (f32x2*)(F.ws + WS_SEND);
    const int gw = blockIdx.x * NWAVES + F.wave, NGW = F.G * NWAVES, p = F.lane;
    for (int u = gw; u < 2 * 64 * 64; u += NGW) {
        const int g = u & 63, ch = (u >> 6) & 63, b = u >> 12;
        SsmState S; ssm_params(I, g, p, S);
        float sr = 0.f, si = 0.f; const bf16* up = P + (size_t)(b * SEQ + ch * 64) * INW + COL_S + g * 16;
#pragma unroll 4
        for (int j = 0; j < 64; ++j) ssm_step(S, up + (size_t)j * INW, sr, si);
        SE[((size_t)(b * 64 + ch) * 64 + g) * 64 + p] = (f32x2){sr, si};
    }
}
__device__ __forceinline__ void ssm_replay(Frame& F, const SsmIn& I) {
    const bf16* P = wsb(F, WS_PROJ); const f32x2* SE = (const f32x2*)(F.ws + WS_SEND); bf16* Y = wsb(F, WS_YS);
    LAS f32x2* Cs = (LAS f32x2*)F.lds;
    LAS float* Ds = (LAS float*)(F.lds + 16 * 65 * 8);
    LAS f32x2* Sw = (LAS f32x2*)(F.lds + 16384) + F.wave * (16 * 65);
    const int p = F.lane, jj = F.lane >> 2, cq = F.lane & 3;
    for (int unit = blockIdx.x; unit < 1024; unit += F.G) {
        const int oct = unit & 7, g = (unit >> 3) & 63, b = unit >> 9, ch = oct * 8 + F.wave;
        for (int e = F.tid; e < 1024; e += 512) { const int c = e >> 6, pp = e & 63; const size_t gi = ((size_t)g * 16 + c) * 64 + pp; Cs[c * 65 + pp] = (f32x2){I.cre[gi], I.cim[gi]}; }
        if (F.tid < 16) Ds[F.tid] = I.dsk[g * 16 + F.tid];
        __syncthreads();
        SsmState S; ssm_params(I, g, p, S);
        float sr = 0.f, si = 0.f;
        for (int j = 0; j < ch; ++j) { const f32x2 e = SE[((size_t)(b * 64 + j) * 64 + g) * 64 + p]; const float nr = S.a64r * sr - S.a64i * si + e.x, ni = S.a64r * si + S.a64i * sr + e.y; sr = nr; si = ni; }
        const size_t tok0 = (size_t)b * SEQ + ch * 64;
#pragma unroll 1
        for (int sub = 0; sub < 4; ++sub) {
#pragma unroll 4
            for (int j = 0; j < 16; ++j) { ssm_step(S, P + (tok0 + sub * 16 + j) * INW + COL_S + g * 16, sr, si); Sw[j * 65 + p] = (f32x2){sr, si}; }
            asm volatile("s_waitcnt lgkmcnt(0)" ::: "memory");
            float acc[4] = {0.f, 0.f, 0.f, 0.f};
#pragma unroll 4
            for (int pp = 0; pp < 64; ++pp) { const f32x2 sv = Sw[jj * 65 + pp];
#pragma unroll
                for (int ci = 0; ci < 4; ++ci) { const f32x2 cv = Cs[(cq * 4 + ci) * 65 + pp]; acc[ci] += cv.x * sv.x - cv.y * sv.y; } }
            const size_t tok = tok0 + sub * 16 + jj; const v2u uw = *(const v2u*)(P + tok * INW + COL_S + g * 16 + cq * 4);
            const float u0 = bf_lo(uw.x), u1 = bf_hi(uw.x), u2 = bf_lo(uw.y), u3 = bf_hi(uw.y);
            v2u o; o.x = cvt_pk_bf16(acc[0] + Ds[cq * 4] * u0, acc[1] + Ds[cq * 4 + 1] * u1); o.y = cvt_pk_bf16(acc[2] + Ds[cq * 4 + 2] * u2, acc[3] + Ds[cq * 4 + 3] * u3);
            *(v2u*)(Y + tok * 1024 + g * 16 + cq * 4) = o;
            asm volatile("s_waitcnt lgkmcnt(0)" ::: "memory");
        }
        __syncthreads();
    }
}

typedef short bf16x8 __attribute__((ext_vector_type(8)));
typedef short s16x4 __attribute__((ext_vector_type(4)));
typedef float f32x16 __attribute__((ext_vector_type(16)));
__device__ __forceinline__ s16x4 lds_tr16(const LAS unsigned char* p) { return __builtin_bit_cast(s16x4, __builtin_amdgcn_ds_read_tr16_b64_v4i16((LAS s16x4*)p)); }
__device__ __forceinline__ bf16x8 cat8(s16x4 lo, s16x4 hi) { return (bf16x8){lo[0], lo[1], lo[2], lo[3], hi[0], hi[1], hi[2], hi[3]}; }
__device__ __forceinline__ bf16x8 pack8(float a0, float a1, float a2, float a3, float a4, float a5, float a6, float a7) {
    v4u w; w.x = cvt_pk_bf16(a0, a1); w.y = cvt_pk_bf16(a2, a3); w.z = cvt_pk_bf16(a4, a5); w.w = cvt_pk_bf16(a6, a7); return __builtin_bit_cast(bf16x8, w); }

__device__ __forceinline__ void swa_mfma(Frame& F, const float* sinks) {
    const bf16* P = wsb(F, WS_PROJ); bf16* O = wsb(F, WS_OSWA);
    LAS unsigned char* Kl = F.lds;
    LAS unsigned char* Vl = F.lds + 36864;
    const int tid = F.tid, lane = F.lane, w = F.wave, r = w >> 1, qh = w & 1, l31 = lane & 31, h = lane >> 5;
    for (int ub_ = blockIdx.x; ub_ < 256; ub_ += F.G) { const int unit = (F.G == 256) ? ((ub_ & 7) * 32 + (ub_ >> 3)) : ub_;
        const int n = unit & 31, g = (unit >> 5) & 3, b = unit >> 7;
        const int hq = g * 4 + r; bf16x8 qfa[2][4];
#pragma unroll
        for (int qt = 0; qt < 2; ++qt)
#pragma unroll
            for (int ds = 0; ds < 4; ++ds) qfa[qt][ds] = *(const bf16x8*)(P + ((size_t)b * SEQ + n * 128 + (qh * 2 + qt) * 32 + l31) * INW + COL_Q + hq * 64 + ds * 16 + h * 8);
#pragma unroll
        for (int i = 0; i < 4; ++i) { const int c = tid + 512 * i, key = c >> 3, part = c & 7, pos = (n - 1) * 128 + key;
            v4u kv = {0u, 0u, 0u, 0u}, vv = {0u, 0u, 0u, 0u};
            if (pos >= 0) { const bf16* src = P + (size_t)(b * SEQ + pos) * INW + COL_K + g * 64 + part * 8; kv = *(const v4u*)src; vv = *(const v4u*)(src + (COL_V - COL_K)); }
            *(LAS v4u*)(Kl + key * 144 + part * 16) = kv;
            *(LAS v4u*)(Vl + (part >> 2) * 16384 + key * 64 + (part & 3) * 16) = vv; }
        __syncthreads();
        const float sink2 = sinks[hq] * LOG2E;
#pragma unroll 1
        for (int qt = 0; qt < 2; ++qt) {
            bf16x8 qf[4];
#pragma unroll
            for (int ds = 0; ds < 4; ++ds) qf[ds] = qt ? qfa[1][ds] : qfa[0][ds];
            const int a = qh * 2 + qt, qi = a * 32 + l31; const size_t m = (size_t)b * SEQ + n * 128 + qi;
            f32x16 s[5];
#pragma unroll
            for (int k5 = 0; k5 < 5; ++k5) { f32x16 acc;
#pragma unroll
                for (int e = 0; e < 16; ++e) acc[e] = 0.f;
                bf16x8 kf[4];
#pragma unroll
                for (int ds = 0; ds < 4; ++ds) kf[ds] = *(const LAS bf16x8*)(Kl + (32 * (a + k5) + l31) * 144 + ds * 32 + h * 16);
#pragma unroll
                for (int ds = 0; ds < 4; ++ds) acc = __builtin_amdgcn_mfma_f32_32x32x16_bf16(kf[ds], qf[ds], acc, 0, 0, 0);
                s[k5] = acc; }
            float mx = sink2;
#pragma unroll
            for (int k5 = 0; k5 < 5; ++k5)
#pragma unroll
                for (int e = 0; e < 16; ++e) { const int kl = 32 * (a + k5) + (e & 3) + 8 * (e >> 2) + 4 * h; const bool ok = (kl > qi) && (kl <= qi + 128) && (n > 0 || kl >= 128);
                    const float v = ok ? s[k5][e] : -1.0e30f; s[k5][e] = v; mx = fmaxf(mx, v); }
            mx = fmaxf(mx, __shfl_xor(mx, 32));
            float sum = 0.f;
#pragma unroll
            for (int k5 = 0; k5 < 5; ++k5)
#pragma unroll
                for (int e = 0; e < 16; ++e) { const float p = __builtin_amdgcn_exp2f(s[k5][e] - mx); s[k5][e] = p; sum += p; }
            sum += __shfl_xor(sum, 32); sum += __builtin_amdgcn_exp2f(sink2 - mx);
            f32x16 o[2];
#pragma unroll
            for (int e = 0; e < 16; ++e) { o[0][e] = 0.f; o[1][e] = 0.f; }
#pragma unroll
            for (int k5 = 0; k5 < 5; ++k5) { s16x4 vlo[2][2], vhi[2][2];
#pragma unroll
                for (int s2 = 0; s2 < 2; ++s2)
#pragma unroll
                    for (int db = 0; db < 2; ++db) { const LAS unsigned char* vp = Vl + db * 16384 + (32 * (a + k5) + 16 * s2 + 4 * h + ((lane & 15) >> 2)) * 64 + (16 * ((lane >> 4) & 1) + 4 * (lane & 3)) * 2;
                        vlo[s2][db] = lds_tr16(vp); vhi[s2][db] = lds_tr16(vp + 8 * 64); }
#pragma unroll
                for (int s2 = 0; s2 < 2; ++s2) { const bf16x8 pf = pack8(s[k5][8 * s2], s[k5][8 * s2 + 1], s[k5][8 * s2 + 2], s[k5][8 * s2 + 3], s[k5][8 * s2 + 4], s[k5][8 * s2 + 5], s[k5][8 * s2 + 6], s[k5][8 * s2 + 7]);
#pragma unroll
                    for (int db = 0; db < 2; ++db) o[db] = __builtin_amdgcn_mfma_f32_32x32x16_bf16(cat8(vlo[s2][db], vhi[s2][db]), pf, o[db], 0, 0, 0); } }
            const float inv = 1.0f / sum;
#pragma unroll
            for (int db = 0; db < 2; ++db)
#pragma unroll
                for (int g4 = 0; g4 < 4; ++g4) { v2u wv; wv.x = cvt_pk_bf16(o[db][4 * g4] * inv, o[db][4 * g4 + 1] * inv); wv.y = cvt_pk_bf16(o[db][4 * g4 + 2] * inv, o[db][4 * g4 + 3] * inv);
                    *(v2u*)(O + m * 1024 + hq * 64 + db * 32 + 8 * g4 + 4 * h) = wv; }
        }
        __syncthreads();
    }
}
__device__ __forceinline__ void memattn_mfma(Frame& F) {
    const bf16* P = wsb(F, WS_PROJ); const bf16* KV = wsb(F, WS_MKV); bf16* O = wsb(F, WS_OMEM);
    constexpr int RS = 544, SLOT = 64 * RS;
    const int tid = F.tid, lane = F.lane, w = F.wave, l15 = lane & 15, kq = lane >> 4;
    for (int ub_ = blockIdx.x; ub_ < 256; ub_ += F.G) { const int unit = (F.G == 256) ? ((ub_ & 7) * 32 + (ub_ >> 3)) : ub_;
        const int tb = unit & 31, hd = (unit >> 5) & 3, b = unit >> 7; const size_t m = (size_t)b * SEQ + tb * 128 + w * 16 + l15;
        bf16x8 qf[8];
#pragma unroll
        for (int ds = 0; ds < 8; ++ds) qf[ds] = *(const bf16x8*)(P + m * INW + COL_MQ + hd * 256 + ds * 32 + kq * 8);
        v4u st[2][4];
#define MA_LOAD(t) do { _Pragma("unroll") for (int i_ = 0; i_ < 4; ++i_) { const int c_ = tid + 512 * i_, row_ = c_ >> 5, part_ = c_ & 31; \
            st[(t) & 1][i_] = *(const v4u*)(KV + (size_t)(b * NMEM + 64 * ((t) & 3) + row_) * 2048 + ((t) >> 2) * 1024 + hd * 256 + part_ * 8); } } while (0)
#define MA_STORE(t) do { _Pragma("unroll") for (int i_ = 0; i_ < 4; ++i_) { const int c_ = tid + 512 * i_, row_ = c_ >> 5, part_ = c_ & 31; *(LAS v4u*)(F.lds + ((t) % 3) * SLOT + row_ * RS + part_ * 16) = st[(t) & 1][i_]; } } while (0)
        MA_LOAD(0); MA_LOAD(1); MA_STORE(0); __syncthreads();
        f32x4 s[16]; f32x4 o[16]; float inv = 0.f;
#pragma unroll
        for (int t = 0; t < 8; ++t) {
            if (t < 6) MA_LOAD(t + 2);
            const LAS unsigned char* cur = F.lds + (t % 3) * SLOT;
            if (t < 4) {
#pragma unroll
                for (int k4 = 0; k4 < 4; ++k4) { f32x4 acc = {0.f, 0.f, 0.f, 0.f}; bf16x8 kf[8];
#pragma unroll
                    for (int ds = 0; ds < 8; ++ds) kf[ds] = *(const LAS bf16x8*)(cur + (16 * k4 + l15) * RS + ds * 64 + kq * 16);
#pragma unroll
                    for (int ds = 0; ds < 8; ++ds) acc = __builtin_amdgcn_mfma_f32_16x16x32_bf16(kf[ds], qf[ds], acc, 0, 0, 0);
                    s[4 * t + k4] = acc; }
                if (t == 3) {
                    float mx = -3.0e38f;
#pragma unroll
                    for (int i = 0; i < 16; ++i) mx = fmaxf(mx, fmaxf(fmaxf(s[i][0], s[i][1]), fmaxf(s[i][2], s[i][3])));
                    mx = fmaxf(mx, __shfl_xor(mx, 16)); mx = fmaxf(mx, __shfl_xor(mx, 32));
                    float sum = 0.f;
#pragma unroll
                    for (int i = 0; i < 16; ++i)
#pragma unroll
                        for (int e = 0; e < 4; ++e) { const float p = __builtin_amdgcn_exp2f(s[i][e] - mx); s[i][e] = p; sum += p; }
                    sum += __shfl_xor(sum, 16); sum += __shfl_xor(sum, 32); inv = 1.0f / sum;
#pragma unroll
                    for (int i = 0; i < 16; ++i) o[i] = (f32x4){0.f, 0.f, 0.f, 0.f};
                }
            } else {
                const int tv = t - 4;
#pragma unroll
                for (int s2 = 0; s2 < 2; ++s2) { const f32x4 p0 = s[4 * tv + 2 * s2], p1 = s[4 * tv + 2 * s2 + 1]; const bf16x8 pf = pack8(p0[0], p0[1], p0[2], p0[3], p1[0], p1[1], p1[2], p1[3]);
#pragma unroll
                    for (int dh = 0; dh < 2; ++dh) { s16x4 vlo[8], vhi[8];
#pragma unroll
                        for (int d8 = 0; d8 < 8; ++d8) { const LAS unsigned char* vp = cur + (32 * s2 + 4 * kq + (l15 >> 2)) * RS + (16 * (8 * dh + d8) + 4 * (lane & 3)) * 2; vlo[d8] = lds_tr16(vp); vhi[d8] = lds_tr16(vp + 16 * RS); }
#pragma unroll
                        for (int d8 = 0; d8 < 8; ++d8) o[8 * dh + d8] = __builtin_amdgcn_mfma_f32_16x16x32_bf16(cat8(vlo[d8], vhi[d8]), pf, o[8 * dh + d8], 0, 0, 0); } }
            }
            if (t < 7) MA_STORE(t + 1);
            asm volatile("s_waitcnt lgkmcnt(0)" ::: "memory"); __builtin_amdgcn_s_barrier(); asm volatile("" ::: "memory");
        }
#undef MA_LOAD
#undef MA_STORE
#pragma unroll
        for (int db = 0; db < 16; ++db) { v2u wv; wv.x = cvt_pk_bf16(o[db][0] * inv, o[db][1] * inv); wv.y = cvt_pk_bf16(o[db][2] * inv, o[db][3] * inv); *(v2u*)(O + m * 1024 + hd * 256 + 16 * db + 4 * kq) = wv; }
    }
}

__device__ __forceinline__ void cmul(float ar, float ai, float br, float bi, float& cr, float& ci) { cr = ar * br - ai * bi; ci = ar * bi + ai * br; }
__device__ __forceinline__ void ssm_tables(Frame& F, const SsmIn& I0) {
    LAS f32x2* AP = (LAS f32x2*)F.lds;
    LAS f32x2* BB = (LAS f32x2*)(F.lds + 33280);
    LAS f32x2* CC = (LAS f32x2*)(F.lds + 33280 + 8192);
    LAS f32x2* KC = (LAS f32x2*)(F.lds + 33280 + 16384);
    const int t = F.tid;
    if ((int)blockIdx.x >= TAB_WGS && F.G > TAB_WGS) return;
    for (int unit = blockIdx.x; unit < DEPTH * 64; unit += (F.G > TAB_WGS ? TAB_WGS : F.G)) {
        const int l = unit >> 6, g = unit & 63, gp0 = unit * 64;
        const float dt = expf(I0.ldt[unit]);
        for (int e = t; e < 65 * 64; e += 512) { const int ee = e >> 6, p = e & 63; const float lr = fminf(I0.lre[gp0 + p], -1e-4f), li = I0.lim[gp0 + p];
            const float mag = expf(lr * dt * (float)ee); float sn, cs; sincos_red((double)li * (double)dt * (double)ee, sn, cs); AP[e] = (f32x2){mag * cs, mag * sn}; }
        __syncthreads();
        if (t < 64) { ((f32x2*)(F.ws + WS_A64))[gp0 + t] = AP[64 * 64 + t];
            const float lr = fminf(I0.lre[gp0 + t], -1e-4f), li = I0.lim[gp0 + t]; const f32x2 a = AP[64 + t]; const float nr = a.x - 1.f, ni = a.y, den = lr * lr + li * li;
            KC[t] = (f32x2){(nr * lr + ni * li) / den, (ni * lr - nr * li) / den}; }
        __syncthreads();
        for (int e = t; e < 1024; e += 512) { const int p = e >> 4; const f32x2 k = KC[p]; const float br = I0.bre[(size_t)gp0 * 16 + e], bi = I0.bim[(size_t)gp0 * 16 + e];
            BB[e] = (f32x2){k.x * br - k.y * bi, k.x * bi + k.y * br}; CC[e] = (f32x2){I0.cre[(size_t)gp0 * 16 + e], I0.cim[(size_t)gp0 * 16 + e]}; }
        __syncthreads();
        bf16* WinT = wsb(F, WS_WINT) + (size_t)unit * 131072; bf16* WoutT = wsb(F, WS_WOUTT) + (size_t)unit * 131072; bf16* LB = (bf16*)(F.ws + WS_LB + (size_t)unit * LB_BYTES);
        for (int q = t; q < 16384; q += 512) { const int n = q >> 7, ck = q & 127, j = ck >> 1, half = ck & 1, p = 16 * (n >> 5) + (n & 15), isim = (n >> 4) & 1; const f32x2 a = AP[(63 - j) * 64 + p]; float v[8];
#pragma unroll
            for (int e = 0; e < 8; ++e) { const f32x2 bb = BB[p * 16 + 8 * half + e]; float zr, zi; cmul(a.x, a.y, bb.x, bb.y, zr, zi); v[e] = isim ? zi : zr; }
            *(bf16x8*)(WinT + (size_t)n * 1024 + ck * 8) = pack8(v[0], v[1], v[2], v[3], v[4], v[5], v[6], v[7]); }
        for (int q = t; q < 16384; q += 512) { const int row = q >> 4, ck = q & 15, tau = row >> 4, c = row & 15, isim = ck >> 3, p0 = (8 * ck) & 63; float v[8];
#pragma unroll
            for (int e = 0; e < 8; ++e) { const f32x2 cc = CC[c * 64 + p0 + e], a = AP[(tau + 1) * 64 + p0 + e]; float zr, zi; cmul(cc.x, cc.y, a.x, a.y, zr, zi); v[e] = isim ? -zi : zr; }
            *(bf16x8*)(WoutT + (size_t)row * 128 + ck * 8) = pack8(v[0], v[1], v[2], v[3], v[4], v[5], v[6], v[7]); }
        { const int c = (t >> 4) & 15, c2 = t & 15, lh = t >> 8; float acc[32];
#pragma unroll
          for (int d = 0; d < 32; ++d) acc[d] = 0.f;
#pragma unroll 2
          for (int p = 0; p < 64; ++p) { const f32x2 cc = CC[c * 64 + p], bb = BB[p * 16 + c2]; float zr, zi; cmul(cc.x, cc.y, bb.x, bb.y, zr, zi);
#pragma unroll
              for (int d = 0; d < 32; ++d) { const f32x2 a = AP[(32 * lh + d) * 64 + p]; acc[d] += zr * a.x - zi * a.y; } }
          if (lh == 0 && c == c2) acc[0] += I0.dsk[l * 1024 + g * 16 + c];
#pragma unroll
          for (int d = 0; d < 32; ++d) LB[(((32 * lh + d + 1) * 2 + (c2 >> 3)) * 16 + c) * 8 + (c2 & 7)] = (bf16)(cvt_pk_bf16(acc[d], 0.f) & 0xffffu);
          if (t < 256) LB[t] = 0; }
        __syncthreads();
    }
}
__device__ __forceinline__ void ssm_s1(Frame& F, const SsmIn& I, int l) {
    const bf16* P = wsb(F, WS_PROJ); bf16* SST = wsb(F, WS_SST);
    LAS float* E = (LAS float*)F.lds;
    const int lane = F.lane, w = F.wave, l31 = lane & 31, h = lane >> 5, mi = w & 3, kh = w >> 2;
    for (int ub_ = blockIdx.x; ub_ < 256; ub_ += F.G) { const int unit = (F.G == 256) ? ((ub_ & 7) * 32 + (ub_ >> 3)) : ub_;
        const int g = unit >> 2, pq = unit & 3;
        const bf16* WinT = wsb(F, WS_WINT) + (size_t)(l * 64 + g) * 131072 + (size_t)(pq * 32 + l31) * 1024 + 8 * h;
        const int mrow = 32 * mi + l31, bb = mrow >> 6, kk = mrow & 63;
        const bf16* up = wsb(F, WS_SIN) + ((size_t)g * T + bb * SEQ + kk * 64) * 16 + 8 * h;
        f32x16 acc;
#pragma unroll
        for (int e = 0; e < 16; ++e) acc[e] = 0.f;
#pragma unroll 16
        for (int jj = 0; jj < 32; ++jj) { const int j = 32 * kh + jj; const bf16x8 af = *(const bf16x8*)(up + (size_t)j * 16), bf = *(const bf16x8*)(WinT + 16 * j);
            acc = __builtin_amdgcn_mfma_f32_32x32x16_bf16(af, bf, acc, 0, 0, 0); }
#pragma unroll
        for (int e = 0; e < 16; ++e) E[(kh * 128 + 32 * mi + (e & 3) + 8 * (e >> 2) + 4 * h) * 33 + l31] = acc[e];
        __syncthreads();
#pragma unroll 1
        for (int tk = 0; tk < 4; ++tk) { const int task = w * 4 + tk, b = task >> 4, st = task & 15, p = 16 * pq + st, k = lane;
            float xr = E[(b * 64 + k) * 33 + st] + E[(128 + b * 64 + k) * 33 + st], xi = E[(b * 64 + k) * 33 + 16 + st] + E[(128 + b * 64 + k) * 33 + 16 + st];
            float ar, ai; { const f32x2 a64 = ((const f32x2*)(F.ws + WS_A64))[(l * 64 + g) * 64 + p]; ar = a64.x; ai = a64.y; }
#pragma unroll
            for (int d = 1; d < 64; d <<= 1) { const float yr = __shfl_up(xr, d), yi = __shfl_up(xi, d); if (k >= d) { xr += ar * yr - ai * yi; xi += ar * yi + ai * yr; } const float nr = ar * ar - ai * ai, ni = 2.f * ar * ai; ar = nr; ai = ni; }
            float sr = __shfl_up(xr, 1), si = __shfl_up(xi, 1); if (k == 0) { sr = 0.f; si = 0.f; }
            bf16* dst = SST + ((size_t)(g * 128 + b * 64 + k)) * 128 + p; dst[0] = (bf16)(cvt_pk_bf16(sr, 0.f) & 0xffffu); dst[64] = (bf16)(cvt_pk_bf16(si, 0.f) & 0xffffu); }
        __syncthreads();
    }
}
__device__ __forceinline__ void ssm_s2(Frame& F, int l) {
    const bf16* P = wsb(F, WS_PROJ); const bf16* SST = wsb(F, WS_SST); bf16* Y = wsb(F, WS_YS);
    LAS unsigned char* Ul = F.lds;
    LAS unsigned char* Ll = F.lds + 66048;
    LAS unsigned char* Sl = F.lds + 66048 + 33280;
    const int t = F.tid, lane = F.lane, w = F.wave, l31 = lane & 31, h = lane >> 5;
    for (int ub_ = blockIdx.x; ub_ < 256; ub_ += F.G) { const int unit = (F.G == 256) ? ((ub_ & 7) * 32 + (ub_ >> 3)) : ub_;
        const int mt = unit & 1, b = (unit >> 1) & 1, g = unit >> 2;
        const bf16* WoutT = wsb(F, WS_WOUTT) + (size_t)(l * 64 + g) * 131072;
        bf16x8 wfr[4][8];
#pragma unroll
        for (int q = 0; q < 4; ++q) { const int n = (q == 0) ? w : (q == 1) ? 15 - w : (q == 2) ? 16 + w : 31 - w;
#pragma unroll
            for (int ks = 0; ks < 8; ++ks) wfr[q][ks] = *(const bf16x8*)(WoutT + (size_t)(32 * n + l31) * 128 + 16 * ks + 8 * h); }
#pragma unroll
        for (int i = 0; i < 8; ++i) { const int q = t + 512 * i, half = q & 1, ti = q >> 1, ir = ti >> 6, j = ti & 63;
            *(LAS v4u*)(Ul + ir * 2064 + j * 32 + half * 16) = *(const v4u*)(wsb(F, WS_SIN) + ((size_t)g * T + b * SEQ + (32 * mt) * 64) * 16 + (size_t)q * 8); }
        { const v4u* src = (const v4u*)(F.ws + WS_LB + (size_t)(l * 64 + g) * LB_BYTES);
          for (int q = t; q < (int)(LB_BYTES / 16); q += 512) *(LAS v4u*)(Ll + q * 16) = src[q]; }
        { const int row = t >> 4, part = t & 15; *(LAS v4u*)(Sl + row * 272 + part * 16) = *(const v4u*)(SST + ((size_t)(g * 128 + b * 64 + 32 * mt + row)) * 128 + part * 8); }
        __syncthreads();
#pragma unroll
        for (int q = 0; q < 4; ++q) { const int n = (q == 0) ? w : (q == 1) ? 15 - w : (q == 2) ? 16 + w : 31 - w;
            f32x16 acc;
#pragma unroll
            for (int e = 0; e < 16; ++e) acc[e] = 0.f;
#pragma unroll
            for (int ks = 0; ks < 8; ++ks) { const bf16x8 sf = *(const LAS bf16x8*)(Sl + l31 * 272 + ks * 32 + h * 16);
                acc = __builtin_amdgcn_mfma_f32_32x32x16_bf16(wfr[q][ks], sf, acc, 0, 0, 0); }
            const LAS unsigned char* lbp = Ll + ((2 * n + 1 + (l31 >> 4)) * 2 + h) * 256 + (l31 & 15) * 16; const LAS unsigned char* ubp = Ul + l31 * 2064 + h * 16;
#pragma unroll 4
            for (int j = 0; j < 2 * n + 2; ++j) { const bf16x8 kf = *(const LAS bf16x8*)(lbp - j * 512), uf = *(const LAS bf16x8*)(ubp + j * 32); acc = __builtin_amdgcn_mfma_f32_32x32x16_bf16(kf, uf, acc, 0, 0, 0); }
#pragma unroll
            for (int q4 = 0; q4 < 4; ++q4) { const int c0 = 8 * (q4 & 1) + 4 * h, tau = 2 * n + (q4 >> 1); const size_t tok = (size_t)b * SEQ + (32 * mt + l31) * 64 + tau;
                v2u wv; wv.x = cvt_pk_bf16(acc[4 * q4], acc[4 * q4 + 1]); wv.y = cvt_pk_bf16(acc[4 * q4 + 2], acc[4 * q4 + 3]); *(v2u*)(Y + tok * 1024 + g * 16 + c0) = wv; }
        }
        __syncthreads();
    }
}

constexpr int PH_PRO = 0, PH_SB0 = 1, PH_PER_SB = 6, N_SB = 3 * DEPTH, PH_FINAL = PH_SB0 + N_SB * PH_PER_SB, N_PH = PH_FINAL + 1;
struct Args { const float* in[N_IN]; float* out; unsigned char* ws; int ph_lo, ph_hi; };
static_assert(sizeof(Args) == N_IN * 8 + 8 + 8 + 8, "Args has no padding");

typedef __attribute__((address_space(4))) const Args* KArgs;
__device__ __forceinline__ KArgs kargs() { KArgs p = (KArgs)__builtin_amdgcn_kernarg_segment_ptr(); asm volatile("" : "+s"(p)); return p; }
#define AIN(i) (kargs()->in[i])
__global__ void __launch_bounds__(NWAVES * 64, 2) fwd(Args args_unused) {
    extern __shared__ __attribute__((aligned(16))) unsigned char lds[];
    Frame F;
    F.lds = (LAS unsigned char*)lds;
    F.tid = threadIdx.x; F.lane = F.tid & 63; F.wave = __builtin_amdgcn_readfirstlane(F.tid >> 6); F.G = gridDim.x;
    F.ws = kargs()->ws;
    volatile LAS unsigned* MISC = (volatile LAS unsigned*)(F.lds + MISC_OFF);
    for (int u = F.tid; u < (LDS_BYTES - LDSCTL_OFF) / 4; u += NWAVES * 64) ((LAS unsigned*)(F.lds + LDSCTL_OFF))[u] = 0u;
    __syncthreads();
    unsigned* barw = (unsigned*)(F.ws + WS_CTL) + CW_BAR;
    XcdBarrier bar; bar.bar = barw; bar.x = 0; bar.st = nullptr;
    if (kargs()->ph_hi - kargs()->ph_lo > 1) (void)xcd_barrier_post(barw, MISC + 8);
#define IN(p) (kargs()->ph_lo <= (p) && (p) < kargs()->ph_hi)
#define hi (kargs()->ph_hi)
#define BARNOW() XcdBarrier{(unsigned*)(kargs()->ws + WS_CTL) + CW_BAR, xb_xcc_id(), (volatile LAS unsigned*)((LAS unsigned char*)lds + MISC_OFF) + 8}
#define FRESH() do { int t_ = threadIdx.x; asm volatile("" : "+v"(t_)); F.tid = t_; F.lane = t_ & 63; F.wave = __builtin_amdgcn_readfirstlane(t_ >> 6); unsigned char* w_ = kargs()->ws; F.ws = w_; } while (0)
#if DIAG
#define SEAM(p, q) do { if (IN(p) && (q) < hi) { xcd_barrier(BARNOW()); if ((q) == PH_FINAL && threadIdx.x == 0) { const unsigned dwt = MISC[16]; unsigned* dw = (unsigned*)(kargs()->ws + WS_CTL) + 2048; atomicMax(dw, dwt); atomicAdd(dw + 128, dwt >> 8); } } } while (0)
#else
#define SEAM(p, q) do { if (IN(p) && (q) < hi) xcd_barrier(BARNOW()); } while (0)
#endif

    if (IN(PH_PRO) && EN_PRO) for (int rep_ = 0; rep_ < REP_PRO; ++rep_) { FRESH(); const ProIn I{AIN(I_F1WI), AIN(I_F2WI), AIN(I_F1WO), AIN(I_F2WO), AIN(I_WIN), AIN(I_WMKV), AIN(I_WGLU), AIN(I_WSWA), AIN(I_WMEMUP), AIN(I_WOUT), AIN(I_MEM), AIN(I_MEMN), AIN(I_F1N), AIN(I_F2N), AIN(I_MIXN), AIN(I_X)}; prologue(F, I);
        const SsmIn I0{AIN(I_LRE), AIN(I_LIM), AIN(I_LDT), AIN(I_BRE), AIN(I_BIM), AIN(I_CRE), AIN(I_CIM), AIN(I_DSK)}; ssm_tables(F, I0); }
    SEAM(PH_PRO, PH_SB0);

    for (int sb = 0; sb < N_SB; ++sb) {
        const int l = sb / 3, ty = sb % 3, pb = PH_SB0 + sb * PH_PER_SB;
        if (pb + PH_PER_SB <= kargs()->ph_lo || pb >= hi) continue;
#define HIN() ((sb == 0) ? AIN(I_X) : (const float*)(F.ws + WS_H))
#define WL() (F.ws + WS_W + (size_t)l * W_LAYER)
        if (ty != 1) {
            if (IN(pb + 1) && EN_G1) for (int rep_ = 0; rep_ < REP_G1; ++rep_) { FRESH();
                pg8::SchedG1 S{(const char*)(F.ws + WS_XN), (const char*)(WL() + (ty == 0 ? WO_1IN : WO_2IN)), (size_t)256 * DM * 2, T / 256, 2 * DFF / 256, F.G, (int)blockIdx.x};
                pg8::Unit u0; int pm0 = -1; if (S.next(0, u0)) { pm0 = u0.pm; rstd_table(F, pm0); }
                pg8::EpiSwiGLU E{wsb(F, WS_HID), DFF, pg8::RstdTab{(const LAS float*)(F.lds + RSTD_OFF), pm0, (const float*)(F.ws + WS_SSQ)}};
                pg8::gemm_phase<pg8::EpiSwiGLU, pg8::SchedG1, true, true>(F.lds + RING_OFF, DM, S, E);
            }
            SEAM(pb + 1, pb + 5);
        } else {
            if (IN(pb + 1) && EN_G3) for (int rep_ = 0; rep_ < REP_G3; ++rep_) { FRESH();
                pg8::SchedProj S{(const char*)(F.ws + WS_XN), (const char*)(WL() + WO_IN), (const char*)(F.ws + WS_MEMN + (size_t)l * 512 * DM * 2), (const char*)(WL() + WO_MKV), (size_t)256 * DM * 2, T / 256, INW / 256, F.G, (int)blockIdx.x};
                pg8::Unit u0; int pm0 = -1; if (S.next(0, u0)) { pm0 = u0.pm; rstd_table(F, pm0); }
                pg8::EpiProj E{wsb(F, WS_PROJ), INW, COL_G / 256, wsb(F, WS_MKV), 2048, pg8::RstdTab{(const LAS float*)(F.lds + RSTD_OFF), pm0, (const float*)(F.ws + WS_SSQ)}, wsb(F, WS_SIN)};
                pg8::gemm_phase<pg8::EpiProj, pg8::SchedProj, true, true>(F.lds + RING_OFF, DM, S, E);
            }
            SEAM(pb + 1, pb + 2);
            if (IN(pb + 2) && EN_M1) for (int rep_ = 0; rep_ < REP_M; ++rep_) { FRESH(); for (int r2_ = 0; r2_ < REP_SWA; ++r2_) swa_mfma(F, AIN(I_SINK) + l * 16); for (int r2_ = 0; r2_ < REP_MA; ++r2_) memattn_mfma(F);
                const SsmIn I{AIN(I_LRE) + l * 4096, AIN(I_LIM) + l * 4096, AIN(I_LDT) + l * 64, AIN(I_BRE) + l * 65536, AIN(I_BIM) + l * 65536, AIN(I_CRE) + l * 65536, AIN(I_CIM) + l * 65536, AIN(I_DSK) + l * 1024}; for (int r2_ = 0; r2_ < REP_S1; ++r2_) ssm_s1(F, I, l); }
            SEAM(pb + 2, pb + 3);
            if (IN(pb + 3) && EN_M2) for (int rep_ = 0; rep_ < REP_M; ++rep_) { FRESH(); const SsmIn I{AIN(I_LRE) + l * 4096, AIN(I_LIM) + l * 4096, AIN(I_LDT) + l * 64, AIN(I_BRE) + l * 65536, AIN(I_BIM) + l * 65536, AIN(I_CRE) + l * 65536, AIN(I_CIM) + l * 65536, AIN(I_DSK) + l * 1024}; (void)I; for (int r2_ = 0; r2_ < REP_S2; ++r2_) ssm_s2(F, l); }
            SEAM(pb + 3, pb + 4);
            if (IN(pb + 4) && EN_G4) for (int rep_ = 0; rep_ < REP_G4; ++rep_) { FRESH();
                pg8::SchedMix S{(const char*)(F.ws + WS_OSWA), (const char*)(F.ws + WS_OMEM), (const char*)(F.ws + WS_YS), (const char*)(WL() + WO_SWA), (const char*)(WL() + WO_MEM), (const char*)(WL() + WO_GLU), (size_t)256 * 1024 * 2, T / 256, DM / 256, F.G, (int)blockIdx.x};
                pg8::EpiMix E{wsb(F, WS_MG), wsb(F, WS_PROJ) + COL_G, INW};
                pg8::gemm_phase<pg8::EpiMix, pg8::SchedMix, true, true>(F.lds + RING_OFF, 1024, S, E);
            }
            SEAM(pb + 4, pb + 5);
        }
        if (IN(pb + 5) && EN_GR) for (int rep_ = 0; rep_ < REP_GR; ++rep_) { FRESH();
            const int K = (ty == 1) ? DM : DFF;
            pg8::SchedTiles S{(const char*)(F.ws + (ty == 1 ? WS_MG : WS_HID)), (const char*)(WL() + (ty == 0 ? WO_1OUT : ty == 1 ? WO_OUT : WO_2OUT)), (size_t)256 * K * 2, T / 256, DM / 256, F.G, (int)blockIdx.x};
            pg8::EpiResid E{(sb == 0) ? AIN(I_X) : nullptr, ty == 1 ? 1.0f : 0.5f, DM, wsb(F, WS_XN), (float*)(F.ws + (rep_ ? WS_T32 : WS_SSQ)), wsb(F, rep_ ? WS_H : WS_XN)};
            pg8::gemm_phase<pg8::EpiResid, pg8::SchedTiles, true, true>(F.lds + RING_OFF, K, S, E);
        }
        SEAM(pb + 5, pb + 6);
    }
    if (IN(PH_FINAL)) { FRESH(); final_norm(F, wsb(F, WS_XN), AIN(I_FINN), kargs()->out);
#if DIAG
        xcd_barrier(BARNOW());
        if (blockIdx.x == 0) { const unsigned* dw = (const unsigned*)(F.ws + WS_CTL) + 2048; const float vmax = (float)__hip_atomic_load(dw, __ATOMIC_RELAXED, __HIP_MEMORY_SCOPE_AGENT) * 0.01f, vmean = (float)__hip_atomic_load(dw + 128, __ATOMIC_RELAXED, __HIP_MEMORY_SCOPE_AGENT) * 2.56f / 256.f;
            float* o = kargs()->out; if (F.tid == 0) o[0] = vmax * DIAG_SCALE0; for (int i = 1 + F.tid; i < 1 + (1 << 20); i += 512) o[i] += vmean * DIAG_SCALE1; }
#endif
    }
#undef IN
#undef hi
#undef SEAM
}

static bool phase_valid(int p) {
    if (p == PH_PRO || p == PH_FINAL) return true;
    const int sb = (p - PH_SB0) / PH_PER_SB, k = (p - PH_SB0) % PH_PER_SB;
    return k != 0 && ((sb % 3 == 1) || k == 1 || k == 5);
}
extern "C" void kernel_launch(void* const* d_in, const int* in_sizes, int n_in, void* d_out, int out_size, void* d_ws, size_t ws_size, hipStream_t stream) {
    static int grid = 0;
    if (grid == 0) {
        if (n_in != N_IN || in_sizes[0] != T * DM || out_size != T * DM || ws_size < WS_END) { fprintf(stderr, "kernel_launch: unexpected shapes: n_in %d in0 %d out %d ws %zu (need %zu); nothing launched\n", n_in, n_in > 0 ? in_sizes[0] : -1, out_size, ws_size, (size_t)WS_END); grid = -1; return; }
        int dev = 0, cus = 0, per_cu = 0;
        if (hipGetDevice(&dev) != hipSuccess || hipDeviceGetAttribute(&cus, hipDeviceAttributeMultiprocessorCount, dev) != hipSuccess) { fprintf(stderr, "kernel_launch: device query failed\n"); grid = -1; return; }
        if (hipFuncSetAttribute((const void*)fwd, hipFuncAttributeMaxDynamicSharedMemorySize, LDS_BYTES) != hipSuccess) { fprintf(stderr, "kernel_launch: hipFuncSetAttribute failed\n"); grid = -1; return; }
        if (hipOccupancyMaxActiveBlocksPerMultiprocessor(&per_cu, (const void*)fwd, NWAVES * 64, LDS_BYTES) != hipSuccess || per_cu < 1) fprintf(stderr, "kernel_launch: note: occupancy query reports %d workgroups per CU\n", per_cu);
        (void)hipGetLastError();
        if (cus != 256) { fprintf(stderr, "kernel_launch: built for a 256-CU device (got %d); nothing launched\n", cus); grid = -1; return; }
        grid = cus;
    }
    if (grid < 0) return;
    if (hipMemsetAsync((char*)d_ws + WS_CTL, 0, CTL_ZERO_BYTES, stream) != hipSuccess) { fprintf(stderr, "kernel_launch: memset failed\n"); return; }
    Args a{};
    for (int i = 0; i < N_IN; ++i) a.in[i] = (const float*)d_in[i];
    a.out = (float*)d_out; a.ws = (unsigned char*)d_ws;
#if ONE_LAUNCH
    a.ph_lo = 0; a.ph_hi = N_PH;
    hipLaunchKernelGGL(fwd, dim3(grid), dim3(NWAVES * 64), LDS_BYTES, stream, a);
#else
    for (int p = 0; p < N_PH; ++p) { if (!phase_valid(p)) continue; a.ph_lo = p; a.ph_hi = p + 1; hipLaunchKernelGGL(fwd, dim3(grid), dim3(NWAVES * 64), LDS_BYTES, stream, a); }
#endif
    const hipError_t le = hipPeekAtLastError();
    if (le != hipSuccess) fprintf(stderr, "kernel_launch: launch failed: %s\n", hipGetErrorName(le));
}
```

```cpp
#include <hip/hip_runtime.h>
#include <cstdio>
#include <cstdint>

#ifndef EN_PRO
#define EN_PRO 1
#endif
#ifndef EN_NORM
#define EN_NORM 1
#endif
#ifndef EN_G1
#define EN_G1 1
#endif
#ifndef EN_G3
#define EN_G3 1
#endif
#ifndef EN_M1
#define EN_M1 1
#endif
#ifndef EN_M2
#define EN_M2 1
#endif
#ifndef EN_G4
#define EN_G4 1
#endif
#ifndef EN_GR
#define EN_GR 1
#endif
#ifndef REP_SWA
#define REP_SWA 1
#endif
#ifndef REP_MA
#define REP_MA 1
#endif
#ifndef REP_S1
#define REP_S1 1
#endif
#ifndef REP_S2
#define REP_S2 1
#endif
#ifndef REP_M
#define REP_M 1
#endif
#ifndef REP_PRO
#define REP_PRO 1
#endif
#ifndef REP_NORM
#define REP_NORM 1
#endif
#ifndef REP_G1
#define REP_G1 1
#endif
#ifndef REP_G3
#define REP_G3 1
#endif
#ifndef REP_G4
#define REP_G4 1
#endif
#ifndef REP_GR
#define REP_GR 1
#endif
#ifndef DIAG
#define DIAG 0
#endif
#ifndef DIAG_SCALE0
#define DIAG_SCALE0 1.0f
#endif
#ifndef DIAG_SCALE1
#define DIAG_SCALE1 0.01f
#endif
#ifndef ONE_LAUNCH
#define ONE_LAUNCH 1
#endif

namespace pg8 {
#define PG8_LAS __attribute__((address_space(3)))
typedef unsigned short bf16_t;
typedef short bf16x8 __attribute__((ext_vector_type(8)));
typedef float f32x4 __attribute__((ext_vector_type(4)));
typedef unsigned u32x4 __attribute__((ext_vector_type(4)));
constexpr int BM = 256, BK = 64, HALF = 128, HTB = HALF * BK * 2  , STAGE_BYTES = 8 * HTB, NXCD = 8, WGM = 8;

__host__ __device__ __forceinline__ int lds_byte(int r, int c) { const int st = (r >> 4) * 2 + (c >> 5), rr = r & 15, cc = c & 31, ob = rr * 64 + cc * 2; return st * 1024 + (ob ^ (((ob >> 9) & 1) << 5)); }
__host__ __device__ __forceinline__ void stage_rc(int b, int& R, int& C) { const int st = b / 1024, sb = b % 1024, swz = sb ^ (((sb >> 9) & 1) << 5); R = (st >> 1) * 16 + swz / 64; C = (st & 1) * 32 + (swz % 64) / 2; }
__host__ __device__ __forceinline__ int perm32(int rho) { const int n = rho >> 4, i = rho & 15; return 8 * (i >> 2) + 4 * n + (i & 3); }


struct Unit { int pm, pn, kind; };

typedef float f32x2_cv __attribute__((ext_vector_type(2))); typedef __bf16 bf16x2_cv __attribute__((ext_vector_type(2)));
__device__ __forceinline__ unsigned cvt_pk_bf16(float lo, float hi) { const f32x2_cv v = {lo, hi}; const bf16x2_cv b = __builtin_convertvector(v, bf16x2_cv); return __builtin_bit_cast(unsigned, b); }
__device__ __forceinline__ float bf_lo(unsigned u) { return __uint_as_float(u << 16); }
__device__ __forceinline__ float bf_hi(unsigned u) { return __uint_as_float(u & 0xffff0000u); }
__device__ __forceinline__ float sigmoidf_fast(float x) { return __builtin_amdgcn_rcpf(1.0f + __builtin_amdgcn_exp2f(-1.4426950408889634f * x)); }

__device__ __forceinline__ void tile_of(int L, int nM, int nN, int& pm, int& pn) {
    const int nwg = nM * nN; int wgid = L; { const int q = nwg / NXCD, r = nwg % NXCD, xcd = wgid % NXCD, off = wgid / NXCD; wgid = (xcd < r ? xcd * (q + 1) : r * (q + 1) + (xcd - r) * q) + off; }
    const int nig = WGM * nN, gid = wgid / nig, fm = gid * WGM, gsz = (nM - fm) < WGM ? (nM - fm) : WGM;
    pm = fm + ((wgid % nig) % gsz); pn = (wgid % nig) / gsz;
}

struct SchedTiles {
    static constexpr bool HAS_HALF = false;
    const char* A; const char* Bt; size_t tstep; int nM, nN, G, c;
    __device__ __forceinline__ bool next(int i, Unit& u) const { const int L = i * G + c; if (L >= nM * nN) return false; tile_of(L, nM, nN, u.pm, u.pn); u.kind = 0; return true; }
    __device__ __forceinline__ void operands(const Unit& u, const char*& a, const char*& b) const { a = A + (size_t)u.pm * tstep; b = Bt + (size_t)u.pn * tstep; }
    __device__ __forceinline__ void a_ready(const Unit&) const {}
    __device__ __forceinline__ void done(const Unit&) const {}
};
struct SchedG1 {
    static constexpr bool HAS_HALF = true;
    const char* A; const char* Bt; size_t tstep; int nM, nN, G, c;
    __device__ __forceinline__ bool next(int i, Unit& u) const {
        if (i < 5) { tile_of(i * 256 + c, 32, 44, u.pm, u.pn); u.kind = 0; return true; }
        if (i > 5) return false; const int x = c & 7, j = c >> 3, r = j & 7, q = j >> 3; u.pm = 8 * (x >> 1) + r; u.pn = ((x & 1) ? 42 : 20) + (q >> 1); u.kind = 2 + (q & 1); return true; }
    __device__ __forceinline__ bool is_half(const Unit& u) const { return u.kind >= 2; }
    __device__ __forceinline__ void operands(const Unit& u, const char*& a, const char*& b) const { a = A + (size_t)u.pm * tstep + (u.kind == 3 ? (tstep >> 1) : 0); b = Bt + (size_t)u.pn * tstep; }
    __device__ __forceinline__ void a_ready(const Unit&) const {}
    __device__ __forceinline__ void done(const Unit&) const {}
};
struct SchedProj {
    static constexpr bool HAS_HALF = false;
    const char* A; const char* Bt; const char* A2; const char* Bt2; size_t tstep; int nM, nN, G, c;
    __device__ __forceinline__ bool next(int i, Unit& u) const { const int L = i * G + c, nwg = nM * nN; if (L < nwg) { tile_of(L, nM, nN, u.pm, u.pn); u.kind = 0; return true; }
        if (L < nwg + 16) { const int j = L - nwg; u.pm = j & 1; u.pn = j >> 1; u.kind = 1; return true; } return false; }
    __device__ __forceinline__ void operands(const Unit& u, const char*& a, const char*& b) const { a = (u.kind ? A2 : A) + (size_t)u.pm * tstep; b = (u.kind ? Bt2 : Bt) + (size_t)u.pn * tstep; }
    __device__ __forceinline__ void a_ready(const Unit&) const {}
    __device__ __forceinline__ void done(const Unit&) const {}
};
struct SchedMix {
    static constexpr bool HAS_HALF = false;
    const char* Aswa; const char* Amem; const char* Ays; const char* Bswa; const char* Bmem; const char* Bglu; size_t tstep; int nM, nN, G, c;
    __device__ __forceinline__ bool next(int i, Unit& u) const { const int L = (i >> 2) * G + c; if (L >= nM * nN) return false; tile_of(L, nM, nN, u.pm, u.pn); u.kind = i & 3; return true; }
    __device__ __forceinline__ void operands(const Unit& u, const char*& a, const char*& b) const {
        if (u.kind == 0) { a = Aswa + (size_t)u.pm * tstep; b = Bswa + (size_t)u.pn * tstep; }
        else if (u.kind == 1) { a = Amem + (size_t)u.pm * tstep; b = Bmem + (size_t)u.pn * tstep; }
        else { a = Ays + (size_t)u.pm * tstep; b = Bglu + (size_t)(2 * u.pn + (u.kind - 2)) * tstep; } }
    __device__ __forceinline__ void a_ready(const Unit&) const {}
    __device__ __forceinline__ void done(const Unit&) const {}
};

__device__ __forceinline__ float row_rstd(const float* SSQ, size_t row, int fq) {
    const f32x4* q = (const f32x4*)(SSQ + row * 32 + 8 * fq); const f32x4 a = q[0], b = q[1];
    float s = ((a[0] + a[1]) + (a[2] + a[3])) + ((b[0] + b[1]) + (b[2] + b[3])); s += __shfl_xor(s, 16); s += __shfl_xor(s, 32);
    return 1.0f / sqrtf(s * (1.0f / 2048.0f) + 1e-5f);
}
struct RstdTab { const PG8_LAS float* tab; int pm0; const float* SSQ; float inv_n, eps;
    __device__ __forceinline__ void prep(int tid) const { if (tid < 256 && pm0 >= 0) { const f32x4* q = (const f32x4*)(SSQ + ((size_t)pm0 * 256 + tid) * 32); float s = 0.f;
#pragma unroll
            for (int j = 0; j < 8; ++j) { const f32x4 a = q[j]; s += (a[0] + a[1]) + (a[2] + a[3]); }
            ((PG8_LAS float*)tab)[tid] = 1.0f / sqrtf(s * inv_n + eps); } }
    __device__ __forceinline__ float get(const Unit& u, int rowin, int fq) const { const float r = tab[rowin]; return (u.pm == pm0) ? r : __builtin_nanf(""); } };
struct EpiSwiGLU {
    static constexpr bool PERM = true, AFTER_DRAIN = false, HAS_PREP = true;
    bf16_t* O; int ldo; RstdTab R;
    __device__ __forceinline__ void prep(int tid) const { R.prep(tid); }
    __device__ __forceinline__ void operator()(const f32x4 (&acc)[2][2][4][2], const Unit& u, int wr, int wc, int fr, int fq) const {
        const int hoff = (u.kind == 3) ? HALF : 0, row0 = u.pm * BM + hoff + wr * 64 + fr, col0 = u.pn * HALF + wc * 32 + 8 * fq;
#pragma unroll
        for (int ai = 0; ai < 2; ++ai) { if (ai == 1 && u.kind >= 2) break;
#pragma unroll
            for (int m = 0; m < 4; ++m) { bf16_t* rowp = O + (size_t)(row0 + ai * HALF + m * 16) * ldo + col0; float o[8]; const float rs = R.get(u, hoff + wr * 64 + fr + ai * HALF + m * 16, fq);
#pragma unroll
                for (int n = 0; n < 2; ++n)
#pragma unroll
                    for (int e = 0; e < 4; ++e) { const float g = acc[ai][0][m][n][e] * rs, uu = acc[ai][1][m][n][e] * rs; o[4 * n + e] = g * sigmoidf_fast(g) * uu; }
                u32x4 w; w.x = cvt_pk_bf16(o[0], o[1]); w.y = cvt_pk_bf16(o[2], o[3]); w.z = cvt_pk_bf16(o[4], o[5]); w.w = cvt_pk_bf16(o[6], o[7]);
                *(u32x4*)rowp = w; } }
    }
};
struct EpiResid {
    static constexpr bool PERM = true, AFTER_DRAIN = false, HAS_PREP = false;
    const float* X0; float alpha; int ldc; bf16_t* HB; float* SSQ; bf16_t* HBout;
    static __device__ __forceinline__ void finish(const f32x4 (&v)[2][2], int ai, int m, int pn, int row0, int col0, int wc, int fq, int ldc, bf16_t* HBout, float* SSQ) {
        const size_t off = (size_t)(row0 + ai * HALF + m * 16) * ldc + col0; float ss = 0.f;
#pragma unroll
        for (int bj = 0; bj < 2; ++bj) { const f32x4 x0 = v[bj][0], x1 = v[bj][1];
            ss += ((x0[0] * x0[0] + x0[1] * x0[1]) + (x0[2] * x0[2] + x0[3] * x0[3])) + ((x1[0] * x1[0] + x1[1] * x1[1]) + (x1[2] * x1[2] + x1[3] * x1[3]));
            u32x4 w; w.x = cvt_pk_bf16(x0[0], x0[1]); w.y = cvt_pk_bf16(x0[2], x0[3]); w.z = cvt_pk_bf16(x1[0], x1[1]); w.w = cvt_pk_bf16(x1[2], x1[3]); *(u32x4*)(HBout + off + bj * HALF) = w; }
        ss += __shfl_xor(ss, 16); ss += __shfl_xor(ss, 32);
        if (fq == 0) SSQ[(size_t)(row0 + ai * HALF + m * 16) * 32 + pn * 4 + wc] = ss;
    }
    __device__ __forceinline__ void operator()(const f32x4 (&acc)[2][2][4][2], const Unit& u, int wr, int wc, int fr, int fq) const {
        int row0 = u.pm * BM + wr * 64 + fr, col0 = u.pn * BM + wc * 32 + 8 * fq;
        asm volatile("" : "+v"(row0), "+v"(col0));
        const int pn_ = u.pn, ldc_ = ldc; bf16_t* const hbo_ = HBout; float* const ssq_ = SSQ; const float alpha_ = alpha; const float* const x0_ = X0; const bf16_t* const hb_ = HB;
        if (x0_) {
#pragma unroll
            for (int ai = 0; ai < 2; ++ai)
#pragma unroll
                for (int mp = 0; mp < 2; ++mp) { f32x4 b[2][2][2];
#pragma unroll
                    for (int mm = 0; mm < 2; ++mm)
#pragma unroll
                        for (int bj = 0; bj < 2; ++bj)
#pragma unroll
                            for (int n = 0; n < 2; ++n) b[mm][bj][n] = *(const f32x4*)(x0_ + (size_t)(row0 + ai * HALF + (2 * mp + mm) * 16) * ldc_ + col0 + bj * HALF + n * 4);
#pragma unroll
                    for (int mm = 0; mm < 2; ++mm) { f32x4 v[2][2];
#pragma unroll
                        for (int bj = 0; bj < 2; ++bj)
#pragma unroll
                            for (int n = 0; n < 2; ++n) v[bj][n] = b[mm][bj][n] + acc[ai][bj][2 * mp + mm][n] * alpha_;
                        finish(v, ai, 2 * mp + mm, pn_, row0, col0, wc, fq, ldc_, hbo_, ssq_); }
                }
        } else {
#pragma unroll
            for (int ai = 0; ai < 2; ++ai) { u32x4 hw[4][2];
#pragma unroll
                for (int m = 0; m < 4; ++m)
#pragma unroll
                    for (int bj = 0; bj < 2; ++bj) hw[m][bj] = *(const u32x4*)(hb_ + (size_t)(row0 + ai * HALF + m * 16) * ldc_ + col0 + bj * HALF);
#pragma unroll
                for (int m = 0; m < 4; ++m) { f32x4 v[2][2];
#pragma unroll
                    for (int bj = 0; bj < 2; ++bj) { const u32x4 h4 = hw[m][bj];
                        v[bj][0] = (f32x4){bf_lo(h4.x), bf_hi(h4.x), bf_lo(h4.y), bf_hi(h4.y)} + acc[ai][bj][m][0] * alpha_; v[bj][1] = (f32x4){bf_lo(h4.z), bf_hi(h4.z), bf_lo(h4.w), bf_hi(h4.w)} + acc[ai][bj][m][1] * alpha_; }
                    finish(v, ai, m, pn_, row0, col0, wc, fq, ldc_, hbo_, ssq_); }
            }
        }
    }
};
struct EpiProj {
    static constexpr bool PERM = true, AFTER_DRAIN = false, HAS_PREP = true;
    __device__ __forceinline__ void prep(int tid) const { R.prep(tid); }
    bf16_t* P; int ldp; int sig_from; bf16_t* KV; int ldk; RstdTab R; bf16_t* SIN;
    __device__ __forceinline__ void operator()(const f32x4 (&acc)[2][2][4][2], const Unit& u, int wr, int wc, int fr, int fq) const {
        const int row0 = u.pm * BM + wr * 64 + fr, col0 = u.pn * BM + wc * 32 + 8 * fq;
        bf16_t* base = u.kind ? KV : P; const int ld = u.kind ? ldk : ldp; const bool sig = (u.kind == 0) && (u.pn >= sig_from);
#pragma unroll
        for (int ai = 0; ai < 2; ++ai)
#pragma unroll
            for (int m = 0; m < 4; ++m) { bf16_t* rowp = base + (size_t)(row0 + ai * HALF + m * 16) * ld + col0; const float rs = u.kind ? 1.0f : R.get(u, wr * 64 + fr + ai * HALF + m * 16, fq);
#pragma unroll
                for (int bj = 0; bj < 2; ++bj) { f32x4 v0 = acc[ai][bj][m][0] * rs, v1 = acc[ai][bj][m][1] * rs;
                    if (sig) {
#pragma unroll
                        for (int e = 0; e < 4; ++e) { v0[e] = sigmoidf_fast(v0[e]); v1[e] = sigmoidf_fast(v1[e]); } }
                    u32x4 w; w.x = cvt_pk_bf16(v0[0], v0[1]); w.y = cvt_pk_bf16(v0[2], v0[3]); w.z = cvt_pk_bf16(v1[0], v1[1]); w.w = cvt_pk_bf16(v1[2], v1[3]);
                    if (u.kind == 0 && u.pn >= 6 && u.pn < 10) { const int cs = (u.pn - 6) * BM + bj * HALF + wc * 32 + 8 * fq; *(u32x4*)(SIN + ((size_t)(cs >> 4) * 8192 + (size_t)(row0 + ai * HALF + m * 16)) * 16 + (cs & 15)) = w; }
                    else *(u32x4*)(rowp + bj * HALF) = w; } }
    }
};
struct EpiMix {
    static constexpr bool PERM = true, AFTER_DRAIN = false, HAS_PREP = false;
    bf16_t* MG; const bf16_t* Gt; int ldg;
    __device__ __forceinline__ void operator()(const f32x4 (&acc)[2][2][4][2], const Unit& u, int wr, int wc, int fr, int fq) const {
        int row0 = u.pm * BM + wr * 64 + fr, cw = wc * 32 + 8 * fq;
        asm volatile("" : "+v"(row0), "+v"(cw));
        if (u.kind < 2) {
            const int gsel = u.kind == 0 ? 0 : 4096;
#pragma unroll
            for (int ai = 0; ai < 2; ++ai)
#pragma unroll
                for (int mp = 0; mp < 2; ++mp) { u32x4 gw[2][2], tw[2][2];
#pragma unroll
                    for (int mm = 0; mm < 2; ++mm)
#pragma unroll
                        for (int bj = 0; bj < 2; ++bj) { const size_t row = (size_t)(row0 + ai * HALF + (2 * mp + mm) * 16); const int col = u.pn * BM + bj * HALF + cw;
                            gw[mm][bj] = *(const u32x4*)(Gt + row * ldg + gsel + col); if (u.kind == 1) tw[mm][bj] = *(const u32x4*)(MG + row * 2048 + col); else tw[mm][bj] = (u32x4){0u, 0u, 0u, 0u}; }
#pragma unroll
                    for (int mm = 0; mm < 2; ++mm)
#pragma unroll
                        for (int bj = 0; bj < 2; ++bj) { const int m = 2 * mp + mm; const size_t row = (size_t)(row0 + ai * HALF + m * 16); const int col = u.pn * BM + bj * HALF + cw; const u32x4 g = gw[mm][bj], t = tw[mm][bj];
                            const f32x4 g0 = {bf_lo(g.x), bf_hi(g.x), bf_lo(g.y), bf_hi(g.y)}, g1 = {bf_lo(g.z), bf_hi(g.z), bf_lo(g.w), bf_hi(g.w)};
                            const f32x4 t0 = acc[ai][bj][m][0] * g0 + (f32x4){bf_lo(t.x), bf_hi(t.x), bf_lo(t.y), bf_hi(t.y)}, t1 = acc[ai][bj][m][1] * g1 + (f32x4){bf_lo(t.z), bf_hi(t.z), bf_lo(t.w), bf_hi(t.w)};
                            u32x4 w; w.x = cvt_pk_bf16(t0[0], t0[1]); w.y = cvt_pk_bf16(t0[2], t0[3]); w.z = cvt_pk_bf16(t1[0], t1[1]); w.w = cvt_pk_bf16(t1[2], t1[3]); *(u32x4*)(MG + row * 2048 + col) = w; }
                    }
        } else {
            const int col = u.pn * BM + (u.kind - 2) * HALF + cw;
#pragma unroll
            for (int ai = 0; ai < 2; ++ai) { u32x4 gw[4], tw[4];
#pragma unroll
                for (int m = 0; m < 4; ++m) { const size_t row = (size_t)(row0 + ai * HALF + m * 16); gw[m] = *(const u32x4*)(Gt + row * ldg + 2048 + col); tw[m] = *(const u32x4*)(MG + row * 2048 + col); }
#pragma unroll
                for (int m = 0; m < 4; ++m) { const size_t row = (size_t)(row0 + ai * HALF + m * 16); const u32x4 g = gw[m], t = tw[m];
                    const float gg[8] = {bf_lo(g.x), bf_hi(g.x), bf_lo(g.y), bf_hi(g.y), bf_lo(g.z), bf_hi(g.z), bf_lo(g.w), bf_hi(g.w)};
                    const float tt[8] = {bf_lo(t.x), bf_hi(t.x), bf_lo(t.y), bf_hi(t.y), bf_lo(t.z), bf_hi(t.z), bf_lo(t.w), bf_hi(t.w)}; float o[8];
#pragma unroll
                    for (int n = 0; n < 2; ++n)
#pragma unroll
                        for (int e = 0; e < 4; ++e) { const float ga = acc[ai][0][m][n][e], gb = acc[ai][1][m][n][e]; o[4 * n + e] = tt[4 * n + e] + gg[4 * n + e] * ga * sigmoidf_fast(gb); }
                    u32x4 w; w.x = cvt_pk_bf16(o[0], o[1]); w.y = cvt_pk_bf16(o[2], o[3]); w.z = cvt_pk_bf16(o[4], o[5]); w.w = cvt_pk_bf16(o[6], o[7]);
                    *(u32x4*)(MG + row * 2048 + col) = w; }
                }
        }
    }
};

template <class Epi, class Sched, bool ALIGN_EPI = false, bool SP2 = false>
__device__ __forceinline__ void gemm_phase(PG8_LAS unsigned char* lds, const int K, const Sched& S, const Epi& E) {
    int tid_ = threadIdx.x; asm volatile("" : "+v"(tid_));
    const int tid = tid_, wid = __builtin_amdgcn_readfirstlane(tid >> 6), lane = tid & 63, wr = wid >> 2, wc = wid & 3, fr = lane & 15, fq = lane >> 4;
    static_assert(SP2, "this copy of the body keeps only the two-super-phase K-loop");
    const int nt = K / BK;
    unsigned voffA[2], voffB[2];
#pragma unroll
    for (int i = 0; i < 2; ++i) { int R, C; stage_rc(tid * 16 + i * 8192, R, C); const int Rb = Epi::PERM ? ((R & ~31) + perm32(R & 31)) : R;
        voffA[i] = (unsigned)(R * K + C) * 2u; voffB[i] = (unsigned)(Rb * K + C) * 2u; }
    const size_t kstep = (size_t)(BK * 2);
    const size_t hstep = (size_t)HALF * K * 2;
    const unsigned ldsw = (unsigned)wid * 1024u;
    const int aoff = lds_byte(wr * 64 + fr, fq * 8), boff = lds_byte(wc * 32 + fr, fq * 8);
#define PG8_SA(b, h) (((b) * 2 + (h)) * HTB)
#define PG8_SB(b, h) ((4 + (b) * 2 + (h)) * HTB)
#define PG8_STAGE(bufoff, gbase, voff) do { _Pragma("unroll") for (int _i = 0; _i < 2; ++_i) \
        __builtin_amdgcn_global_load_lds((const unsigned*)((const char*)(gbase) + (voff)[_i]), (PG8_LAS unsigned*)(lds + (bufoff) + ldsw + _i * 8192), 16, 0, 0); } while (0)
#define PG8_LDA(dst, b, h) do { _Pragma("unroll") for (int m = 0; m < 4; ++m) _Pragma("unroll") for (int k = 0; k < 2; ++k) dst[m][k] = *(const PG8_LAS bf16x8*)(lds + PG8_SA(b, h) + aoff + m * 2048 + k * 1024); } while (0)
#define PG8_LDB(dst, b, h) do { _Pragma("unroll") for (int n = 0; n < 2; ++n) _Pragma("unroll") for (int k = 0; k < 2; ++k) dst[n][k] = *(const PG8_LAS bf16x8*)(lds + PG8_SB(b, h) + boff + n * 2048 + k * 1024); } while (0)
#define PG8_MMA(ai, bj, At, Bt) do { __builtin_amdgcn_s_setprio(1); _Pragma("unroll") for (int m = 0; m < 4; ++m) _Pragma("unroll") for (int n = 0; n < 2; ++n) _Pragma("unroll") for (int k = 0; k < 2; ++k) \
        acc[ai][bj][m][n] = __builtin_amdgcn_mfma_f32_16x16x32_bf16(Bt[n][k], At[m][k], acc[ai][bj][m][n], 0, 0, 0); __builtin_amdgcn_s_setprio(0); } while (0)
#define PG8_WAIT_V(n) asm volatile("s_waitcnt vmcnt(" #n ")" ::: "memory")
#define PG8_WAIT_L(n) asm volatile("s_waitcnt lgkmcnt(" #n ")" ::: "memory")
#define PG8_BAR __builtin_amdgcn_s_barrier()
#define PG8_SCHED __builtin_amdgcn_sched_barrier(0)
    Unit cur, nxt; int ui = 0;
    if (!S.next(0, cur)) return;
    f32x4 acc[2][2][4][2];
#pragma unroll
    for (int a = 0; a < 2; ++a)
#pragma unroll
        for (int b = 0; b < 2; ++b)
#pragma unroll
            for (int m = 0; m < 4; ++m)
#pragma unroll
                for (int n = 0; n < 2; ++n) acc[a][b][m][n] = (f32x4){0.f, 0.f, 0.f, 0.f};
    bf16x8 At[4][2], B0[2][2], B1[2][2];
    const char* cA; const char* cB; S.operands(cur, cA, cB);
    S.a_ready(cur);
    if constexpr (SP2 && Epi::HAS_PREP) {
        PG8_STAGE(PG8_SB(0, 0), cB, voffB); PG8_STAGE(PG8_SB(0, 1), cB + hstep, voffB); PG8_STAGE(PG8_SA(0, 0), cA, voffA); PG8_STAGE(PG8_SA(0, 1), cA + hstep, voffA);
        PG8_STAGE(PG8_SB(1, 0), cB + kstep, voffB); PG8_STAGE(PG8_SA(1, 0), cA + kstep, voffA); PG8_STAGE(PG8_SB(1, 1), cB + hstep + kstep, voffB);
        E.prep(tid);
        PG8_WAIT_V(0); PG8_WAIT_L(0); PG8_BAR;
        if (wr == 1) PG8_BAR;
        PG8_BAR; PG8_BAR;
    } else if constexpr (SP2) {
        PG8_STAGE(PG8_SB(0, 0), cB, voffB); PG8_STAGE(PG8_SB(0, 1), cB + hstep, voffB); PG8_STAGE(PG8_SA(0, 0), cA, voffA); PG8_STAGE(PG8_SA(0, 1), cA + hstep, voffA);
        if (wr == 1) PG8_BAR;
        PG8_WAIT_V(2); PG8_BAR;
        PG8_STAGE(PG8_SB(1, 0), cB + kstep, voffB); PG8_STAGE(PG8_SA(1, 0), cA + kstep, voffA); PG8_STAGE(PG8_SB(1, 1), cB + hstep + kstep, voffB);
        PG8_WAIT_V(6); PG8_BAR;
    } else {
        PG8_STAGE(PG8_SB(0, 0), cB, voffB); PG8_STAGE(PG8_SA(0, 0), cA, voffA); PG8_STAGE(PG8_SB(0, 1), cB + hstep, voffB); PG8_STAGE(PG8_SA(0, 1), cA + hstep, voffA);
        if (wr == 1) PG8_BAR;
        PG8_WAIT_V(4); PG8_BAR;
        PG8_STAGE(PG8_SB(1, 0), cB + kstep, voffB); PG8_STAGE(PG8_SA(1, 0), cA + kstep, voffA); PG8_STAGE(PG8_SB(1, 1), cB + hstep + kstep, voffB);
        PG8_WAIT_V(6); PG8_BAR;
    }
    for (;;) {
        const bool has_next = S.next(ui + 1, nxt);
        const char* nA = cA; const char* nB = cB; if (has_next) S.operands(nxt, nA, nB);
#define PG8_KLOOP(HF)         for (int t = 0; t < nt; t += 2) { \
            const bool last = (t == nt - 2); \
            const char* a1 = cA + (size_t)(t + 1) * kstep; \
            const char* a2 = last ? nA : cA + (size_t)(t + 2) * kstep; const char* b2 = last ? nB : cB + (size_t)(t + 2) * kstep; \
            const char* a3 = a2 + kstep; const char* b3 = b2 + kstep; \
            if (last && has_next) S.a_ready(nxt); \
            PG8_LDB(B0, 0, 0); PG8_LDB(B1, 0, 1); PG8_SCHED; PG8_LDA(At, 0, 0); if (!(HF)) PG8_STAGE(PG8_SA(1, 1), a1 + hstep, voffA); \
            if (HF) PG8_WAIT_V(6); else PG8_WAIT_V(8); PG8_WAIT_L(0); PG8_BAR; PG8_MMA(0, 0, At, B0); PG8_MMA(0, 1, At, B1); PG8_BAR; PG8_SCHED; \
            if (!(HF)) PG8_LDA(At, 0, 1); PG8_STAGE(PG8_SB(0, 0), b2, voffB); PG8_STAGE(PG8_SB(0, 1), b2 + hstep, voffB); PG8_STAGE(PG8_SA(0, 0), a2, voffA); \
            if (HF) PG8_WAIT_V(6); else PG8_WAIT_V(8); PG8_WAIT_L(0); PG8_BAR; if (!(HF)) { PG8_MMA(1, 0, At, B0); PG8_MMA(1, 1, At, B1); } PG8_BAR; PG8_SCHED; \
            PG8_LDB(B0, 1, 0); PG8_LDB(B1, 1, 1); PG8_SCHED; PG8_LDA(At, 1, 0); if (!(HF)) PG8_STAGE(PG8_SA(0, 1), a2 + hstep, voffA); \
            if (HF) PG8_WAIT_V(6); else PG8_WAIT_V(8); PG8_WAIT_L(0); PG8_BAR; PG8_MMA(0, 0, At, B0); PG8_MMA(0, 1, At, B1); PG8_BAR; PG8_SCHED; \
            if (!(HF)) PG8_LDA(At, 1, 1); PG8_STAGE(PG8_SB(1, 0), b3, voffB); PG8_STAGE(PG8_SB(1, 1), b3 + hstep, voffB); PG8_STAGE(PG8_SA(1, 0), a3, voffA); \
            if (HF) PG8_WAIT_V(6); else PG8_WAIT_V(8); PG8_WAIT_L(0); PG8_BAR; if (!(HF)) { PG8_MMA(1, 0, At, B0); PG8_MMA(1, 1, At, B1); } PG8_BAR; PG8_SCHED; \
        }
        if constexpr (Sched::HAS_HALF) { if (S.is_half(cur)) { PG8_KLOOP(true) } else { PG8_KLOOP(false) } } else { PG8_KLOOP(false) }
#undef PG8_KLOOP
        if constexpr (ALIGN_EPI) { if (wr == 0) PG8_BAR; }
        if constexpr (!Epi::AFTER_DRAIN) { E(acc, cur, wr, wc, fr, fq); S.done(cur); }
        if (!has_next) break;
#pragma unroll
        for (int a = 0; a < 2; ++a)
#pragma unroll
            for (int b = 0; b < 2; ++b)
#pragma unroll
                for (int m = 0; m < 4; ++m)
#pragma unroll
                    for (int n = 0; n < 2; ++n) acc[a][b][m][n] = (f32x4){0.f, 0.f, 0.f, 0.f};
        cur = nxt; cA = nA; cB = nB; ++ui;
        if constexpr (ALIGN_EPI) { if (wr == 1) PG8_BAR; }
    }
    PG8_WAIT_V(0);
    if constexpr (!ALIGN_EPI) { if (wr == 0) PG8_BAR; }
    PG8_BAR;
    if constexpr (Epi::AFTER_DRAIN) { E.fused(acc, cur, wr, wc, fr, fq, lds, wid, lane); S.done(cur); }
#undef PG8_SA
#undef PG8_SB
#undef PG8_STAGE
#undef PG8_LDA
#undef PG8_LDB
#undef PG8_MMA
#undef PG8_WAIT_V
#undef PG8_WAIT_L
#undef PG8_BAR
#undef PG8_SCHED
}
}

constexpr int BATCH = 2, SEQ = 4096, DM = 2048, DEPTH = 4, NMEM = 256, DFF = 5632;
constexpr int T = BATCH * SEQ;
constexpr int INW = 9728, COL_Q = 0, COL_K = 1024, COL_V = 1280, COL_S = 1536, COL_MQ = 2560, COL_G = 3584;
constexpr float RMS_EPS = 1e-5f, LOG2E = 1.4426950408889634f;
constexpr int NWAVES = 8;
enum { I_X = 0, I_MEM, I_F1N, I_F1WI, I_F1WO, I_MIXN, I_MEMN, I_WIN, I_SINK, I_WMKV, I_LRE, I_LIM, I_LDT, I_BRE, I_BIM, I_CRE, I_CIM, I_DSK, I_WGLU, I_WSWA, I_WMEMUP, I_WOUT, I_F2N, I_F2WI, I_F2WO, I_FINN, N_IN };

constexpr size_t MiB = 1u << 20;
constexpr size_t WS_CTL = 0, CTL_ZERO_BYTES = 32 * 1024;
constexpr size_t WS_W = 2 * MiB, W_LAYER = 202 * MiB;
constexpr size_t WO_1IN = 0, WO_1OUT = 44 * MiB, WO_IN = 66 * MiB, WO_MKV = 104 * MiB, WO_SWA = 112 * MiB, WO_MEM = 116 * MiB, WO_GLU = 120 * MiB, WO_OUT = 128 * MiB, WO_2IN = 136 * MiB, WO_2OUT = 180 * MiB;
constexpr size_t WS_MEMN = WS_W + DEPTH * W_LAYER;
constexpr size_t WS_H = WS_MEMN + 8 * MiB;
constexpr size_t WS_XN = WS_H + 64 * MiB;
constexpr size_t WS_HID = WS_XN + 32 * MiB;
constexpr size_t WS_PROJ = WS_HID + 88 * MiB;
constexpr size_t WS_MKV = WS_PROJ + 152 * MiB;
constexpr size_t WS_OSWA = WS_MKV + 2 * MiB, WS_YS = WS_OSWA + 16 * MiB, WS_OMEM = WS_YS + 16 * MiB;
constexpr size_t WS_T32 = WS_OMEM + 16 * MiB;
constexpr size_t WS_MG = WS_T32 + 64 * MiB;
constexpr size_t WS_SEND = WS_MG + 32 * MiB;
constexpr size_t LB_BYTES = 65 * 512;
constexpr size_t WS_LB = WS_SEND + 4 * MiB;
constexpr size_t WS_WINT = WS_LB + 9 * MiB;
constexpr size_t WS_WOUTT = WS_WINT + 64 * MiB;
constexpr size_t WS_SST = WS_WOUTT + 64 * MiB;
constexpr size_t WS_A64 = WS_SST + 2 * MiB;
constexpr size_t WS_SSQ = WS_A64 + 1 * MiB;
constexpr size_t WS_SIN = WS_SSQ + 1 * MiB;
constexpr size_t WS_END = WS_SIN + 16 * MiB;
static_assert(DEPTH * 64 * LB_BYTES <= 9 * MiB, "lag tables fit");
constexpr int CW_BAR = 4096;
static_assert((CW_BAR + 3456) * 4 <= (int)CTL_ZERO_BYTES, "barrier words inside the per-call memset");

constexpr int RING_OFF = 0, RING_BYTES = 131072;
constexpr int LDSCTL_OFF = RING_BYTES, MISC_OFF = LDSCTL_OFF + 320;
constexpr int LDS_BYTES = 147456;

#define GAS __attribute__((address_space(1)))
#define LAS __attribute__((address_space(3)))
typedef unsigned short bf16;
typedef unsigned v4u __attribute__((ext_vector_type(4)));
typedef unsigned v2u __attribute__((ext_vector_type(2)));
typedef float f32x4 __attribute__((ext_vector_type(4)));
typedef float f32x2 __attribute__((ext_vector_type(2)));
typedef GAS unsigned gu32;
using pg8::cvt_pk_bf16; using pg8::bf_lo; using pg8::bf_hi;

#define XB_TMO      128
#define XB_XCNT(j)  (256  + 64 * (j))
#define XB_XSUB(j)  (1280 + 64 * (j))
#define XB_XGEN(j)  (2304 + 64 * (j))
#define XB_TOP      3328
#define XB_TOPGEN   3392
#define XCD_BAR_WORDS 3456
#define XB_SPIN_CAP (1u << 18)

__device__ __forceinline__ unsigned xb_ld(unsigned* p)              { return __hip_atomic_load(p, __ATOMIC_RELAXED, __HIP_MEMORY_SCOPE_AGENT); }
__device__ __forceinline__ unsigned xb_add(unsigned* p, unsigned v) { return __hip_atomic_fetch_add(p, v, __ATOMIC_RELAXED, __HIP_MEMORY_SCOPE_AGENT); }
__device__ __forceinline__ unsigned xb_xcc_id() { return (unsigned)__builtin_amdgcn_s_getreg((3 << 11) | 20) & 0xFu; }
#define XB_SPIN(cond, bar) do { unsigned _sp = 0; while (cond) { __builtin_amdgcn_s_sleep(1); \
    if ((++_sp & 255u) == 0u) { if (xb_ld(&(bar)[XB_TMO])) break; if (_sp > XB_SPIN_CAP) { atomicAdd(&(bar)[XB_TMO], 1u); break; } } } } while (0)

struct XcdBarrier {
    unsigned* bar; unsigned x;
    volatile LAS unsigned* st;
};

__device__ __forceinline__ XcdBarrier xcd_barrier_post(unsigned* bar, volatile LAS unsigned* st) {
    XcdBarrier b; b.bar = bar; b.x = xb_xcc_id(); b.st = st;
    if (threadIdx.x == 0) (void)xb_add(&bar[XB_XCNT(b.x)], 1u);
    return b;
}
__device__ __forceinline__ void xcd_barrier_complete(unsigned* bar, unsigned x, unsigned& nloc, unsigned& nx) {
    const unsigned G = gridDim.x * gridDim.y * gridDim.z;
    unsigned sum, cnt, mine, sp = 0u;
    for (;;) {
        sum = 0u; cnt = 0u; mine = 0u;
#pragma unroll
        for (unsigned j = 0; j < 16; ++j) { const unsigned c = xb_ld(&bar[XB_XCNT(j)]); sum += c; cnt += (c > 0u) ? 1u : 0u; mine = (j == x) ? c : mine; }
        if (sum == G) break;
        __builtin_amdgcn_s_sleep(1);
        if ((++sp & 255u) == 0u) { if (xb_ld(&bar[XB_TMO])) break; if (sp > XB_SPIN_CAP) { atomicAdd(&bar[XB_TMO], 1u); break; } }
    }
    nloc = mine > 0u ? mine : 1u; nx = cnt > 0u ? cnt : 1u;
}

__device__ __forceinline__ void xcd_barrier(const XcdBarrier& b) {
    asm volatile("s_waitcnt vmcnt(0)" ::: "memory");
    __syncthreads();
    if (threadIdx.x == 0) {
#if DIAG
        const unsigned long long dt0_ = __builtin_amdgcn_s_memrealtime();
#endif
        unsigned* bar = b.bar;
        __builtin_amdgcn_s_waitcnt(0);
        unsigned nloc = b.st[0], nx = b.st[1];
        if (nloc == 0u) { xcd_barrier_complete(bar, b.x, nloc, nx); b.st[0] = nloc; b.st[1] = nx; }
        const unsigned old = xb_add(&bar[XB_XSUB(b.x)], 1u);
        const unsigned gen = old / nloc;
        if (old + 1u == (gen + 1u) * nloc) {
            __builtin_amdgcn_fence(__ATOMIC_RELEASE, "agent");
            asm volatile("s_waitcnt vmcnt(0)" ::: "memory");
            const unsigned og = xb_add(&bar[XB_TOP], 1u);
            const unsigned tg = og / nx;
            if (og + 1u == (tg + 1u) * nx) xb_add(&bar[XB_TOPGEN], 1u);
            else XB_SPIN(xb_ld(&bar[XB_TOPGEN]) == tg, bar);
            __builtin_amdgcn_fence(__ATOMIC_ACQUIRE, "agent");
            xb_add(&bar[XB_XGEN(b.x)], 1u);
            asm volatile("s_waitcnt vmcnt(0)" ::: "memory");
        } else {
            XB_SPIN(xb_ld(&bar[XB_XGEN(b.x)]) == gen, bar);
            __builtin_amdgcn_fence(__ATOMIC_ACQUIRE, "agent");
            asm volatile("s_waitcnt vmcnt(0)" ::: "memory");
        }
#if DIAG
        b.st[8] += (unsigned)(__builtin_amdgcn_s_memrealtime() - dt0_);
#endif
    }
    __syncthreads();
}

struct Frame {
    LAS unsigned char* lds;
    int tid, lane, wave, G;
    unsigned char* ws;
};
__device__ __forceinline__ float wave_sum(float v) {
#pragma unroll
    for (int o = 1; o < 64; o <<= 1) v += __shfl_xor(v, o);
    return v;
}
__device__ __forceinline__ bf16* wsb(const Frame& F, size_t off) { return (bf16*)(F.ws + off); }

struct ConvItem { const float* src; const float* gk; bf16* dst; int K, N; float scale; };
__device__ __forceinline__ void conv_load(const ConvItem& c, float (&v)[64]) {
#pragma unroll
    for (int i = 0; i < 64; ++i) v[i] = c.src[(size_t)i * c.N];
}
__device__ __forceinline__ void conv_store(const ConvItem& c, float (&v)[64], int lane, LAS unsigned char* scr) {
    if (c.gk) {
#pragma unroll
        for (int i = 0; i < 64; ++i) v[i] *= c.gk[i]; }
    const float scale = c.scale;
#pragma unroll
    for (int q = 0; q < 8; ++q) { v4u o; o.x = cvt_pk_bf16(v[8 * q] * scale, v[8 * q + 1] * scale); o.y = cvt_pk_bf16(v[8 * q + 2] * scale, v[8 * q + 3] * scale);
        o.z = cvt_pk_bf16(v[8 * q + 4] * scale, v[8 * q + 5] * scale); o.w = cvt_pk_bf16(v[8 * q + 6] * scale, v[8 * q + 7] * scale); *(LAS v4u*)(scr + lane * 144 + q * 16) = o; }
    asm volatile("s_waitcnt lgkmcnt(0)" ::: "memory");
#pragma unroll
    for (int i = 0; i < 8; ++i) { const v4u o = *(const LAS v4u*)(scr + (8 * i + (lane >> 3)) * 144 + (lane & 7) * 16); *(v4u*)(c.dst + (size_t)(8 * i) * c.K) = o; }
    asm volatile("s_waitcnt lgkmcnt(0)" ::: "memory");
}
constexpr int CI_1IN = (DM / 64) * (2 * DFF / 64), CI_1OUT = (DFF / 64) * (DM / 64), CI_IN = (DM / 64) * (INW / 64), CI_MKV = (DM / 64) * (2048 / 64), CI_GLU = (1024 / 64) * (4096 / 64),
              CI_SWA = (1024 / 64) * (DM / 64), CI_MEM = CI_SWA, CI_OUT = (DM / 64) * (DM / 64), CI_LAYER = 2 * CI_1IN + 2 * CI_1OUT + CI_IN + CI_MKV + CI_GLU + CI_SWA + CI_MEM + CI_OUT;
struct ProIn { const float *f1wi, *f2wi, *f1wo, *f2wo, *win, *wmkv, *wglu, *wswa, *wmem, *wout, *mem, *memn, *f1n, *f2n, *mixn, *x; };
constexpr int TAB_WGS = 64;
__device__ __forceinline__ void prologue(Frame& F, const ProIn& I) {
    const bool split = F.G > TAB_WGS, tabwg = split && (int)blockIdx.x < TAB_WGS;
    const int nconv = split ? F.G - TAB_WGS : F.G, bconv = split ? (int)blockIdx.x - TAB_WGS : (int)blockIdx.x;
    int gw = bconv * NWAVES + F.wave, NGW = nconv * NWAVES; const int lane = F.lane;
    auto item = [&](int it, ConvItem& c) {
        const int l = it / CI_LAYER; int r = it % CI_LAYER; unsigned char* wl = F.ws + WS_W + (size_t)l * W_LAYER;
        const float* src; bf16* dst; int K, N, pairNh = 0; const float* gk = nullptr;
        if (r < CI_1IN) { src = I.f1wi + (size_t)l * DM * 2 * DFF; dst = (bf16*)(wl + WO_1IN); K = DM; N = 2 * DFF; pairNh = DFF; gk = I.f1n + (size_t)l * DM; }
        else if ((r -= CI_1IN) < CI_1IN) { src = I.f2wi + (size_t)l * DM * 2 * DFF; dst = (bf16*)(wl + WO_2IN); K = DM; N = 2 * DFF; pairNh = DFF; gk = I.f2n + (size_t)l * DM; }
        else if ((r -= CI_1IN) < CI_1OUT) { src = I.f1wo + (size_t)l * DFF * DM; dst = (bf16*)(wl + WO_1OUT); K = DFF; N = DM; }
        else if ((r -= CI_1OUT) < CI_1OUT) { src = I.f2wo + (size_t)l * DFF * DM; dst = (bf16*)(wl + WO_2OUT); K = DFF; N = DM; }
        else if ((r -= CI_1OUT) < CI_IN) { src = I.win + (size_t)l * DM * INW; dst = (bf16*)(wl + WO_IN); K = DM; N = INW; gk = I.mixn + (size_t)l * DM; }
        else if ((r -= CI_IN) < CI_MKV) { src = I.wmkv + (size_t)l * DM * 2048; dst = (bf16*)(wl + WO_MKV); K = DM; N = 2048; }
        else if ((r -= CI_MKV) < CI_GLU) { src = I.wglu + (size_t)l * 1024 * 4096; dst = (bf16*)(wl + WO_GLU); K = 1024; N = 4096; pairNh = 2048; }
        else if ((r -= CI_GLU) < CI_SWA) { src = I.wswa + (size_t)l * 1024 * DM; dst = (bf16*)(wl + WO_SWA); K = 1024; N = DM; }
        else if ((r -= CI_SWA) < CI_MEM) { src = I.wmem + (size_t)l * 1024 * DM; dst = (bf16*)(wl + WO_MEM); K = 1024; N = DM; }
        else { r -= CI_MEM; src = I.wout + (size_t)l * DM * DM; dst = (bf16*)(wl + WO_OUT); K = DM; N = DM; }
        const int nblk = N / 64, nb8 = nblk >> 3, r8 = r >> 3, wv = r & 7, kb = r8 / nb8, nb = 8 * (r8 % nb8) + wv, n0 = nb * 64, k0 = kb * 64;
        float sc = 1.f; if (N == INW) sc = n0 < COL_K ? 0.125f * LOG2E : ((n0 >= COL_MQ && n0 < COL_G) ? 0.0625f * LOG2E : 1.f);
        int row0 = n0; if (pairNh) { const int j = n0 < pairNh ? n0 : n0 - pairNh; row0 = (j >> 7) * 256 + (j & 127) + (n0 < pairNh ? 0 : 128); }
        c.src = src + (size_t)k0 * N + n0 + lane; c.gk = gk ? gk + k0 : nullptr; c.dst = dst + (size_t)(row0 + (lane >> 3)) * K + k0 + 8 * (lane & 7); c.K = K; c.N = N; c.scale = sc;
    };
    if (!tabwg) {
        LAS unsigned char* scr = F.lds + F.wave * 9216; constexpr int NIT = DEPTH * CI_LAYER;
        float va[64], vb[64]; ConvItem ca, cb; int it = gw;
        if (it < NIT) { item(it, ca); conv_load(ca, va); }
        while (it < NIT) {
            const int it1 = it + NGW; if (it1 < NIT) { item(it1, cb); conv_load(cb, vb); }
            conv_store(ca, va, lane, scr);
            if (it1 >= NIT) break;
            const int it2 = it1 + NGW; if (it2 < NIT) { item(it2, ca); conv_load(ca, va); }
            conv_store(cb, vb, lane, scr);
            it = it2;
        }
    }
    if (split) { if (!tabwg) return; gw = (int)blockIdx.x * NWAVES + F.wave; NGW = TAB_WGS * NWAVES; }
    for (int m = gw; m < T; m += NGW) {
        const f32x4* xr = (const f32x4*)(I.x + (size_t)m * DM) + lane; v2u* o8 = (v2u*)(wsb(F, WS_XN) + (size_t)m * DM) + lane; float s = 0.f;
#pragma unroll
        for (int j = 0; j < 8; ++j) { const f32x4 v = xr[64 * j]; s += (v.x * v.x + v.y * v.y) + (v.z * v.z + v.w * v.w); v2u o; o.x = cvt_pk_bf16(v.x, v.y); o.y = cvt_pk_bf16(v.z, v.w); o8[64 * j] = o; }
        s = wave_sum(s); if (lane < 32) ((float*)(F.ws + WS_SSQ))[(size_t)m * 32 + lane] = lane == 0 ? s : 0.f;
    }
    for (int it = gw; it < DEPTH * 512; it += NGW) {
        const int l = it / 512, row = it % 512;
        const f32x4* xr = (const f32x4*)(I.mem + (size_t)row * DM) + lane; const f32x4* gr = (const f32x4*)(I.memn + (size_t)l * DM) + lane;
        f32x4 v[8]; float s = 0.f;
#pragma unroll
        for (int j = 0; j < 8; ++j) { v[j] = xr[64 * j]; s += (v[j].x * v[j].x + v[j].y * v[j].y) + (v[j].z * v[j].z + v[j].w * v[j].w); }
        const float rstd = 1.0f / sqrtf(wave_sum(s) * (1.f / DM) + RMS_EPS);
        v2u* o8 = (v2u*)(wsb(F, WS_MEMN) + ((size_t)l * 512 + row) * DM) + lane;
#pragma unroll
        for (int j = 0; j < 8; ++j) { const f32x4 g = gr[64 * j]; v2u o; o.x = cvt_pk_bf16(v[j].x * rstd * g.x, v[j].y * rstd * g.y); o.y = cvt_pk_bf16(v[j].z * rstd * g.z, v[j].w * rstd * g.w); o8[64 * j] = o; }
    }
}
constexpr int RSTD_OFF = LDSCTL_OFF + 1024;
__device__ __forceinline__ void rstd_table(Frame& F, int pm) {
    LAS float* tab = (LAS float*)(F.lds + RSTD_OFF);
    if (F.tid < 256) { const f32x4* q = (const f32x4*)((const float*)(F.ws + WS_SSQ) + ((size_t)pm * 256 + F.tid) * 32); float s = 0.f;
#pragma unroll
        for (int j = 0; j < 8; ++j) { const f32x4 a = q[j]; s += (a[0] + a[1]) + (a[2] + a[3]); }
        tab[F.tid] = 1.0f / sqrtf(s * (1.0f / DM) + RMS_EPS); }
    __syncthreads();
}
template <bool OUTF32>
__device__ __forceinline__ void norm_phase(Frame& F, const float* hin, const float* gain, void* outp) {
    const int gw = blockIdx.x * NWAVES + F.wave, NGW = F.G * NWAVES, lane = F.lane;
    f32x4 g[8];
#pragma unroll
    for (int j = 0; j < 8; ++j) g[j] = ((const f32x4*)gain)[lane + 64 * j];
    for (int m = gw; m < T; m += NGW) {
        const f32x4* xr = (const f32x4*)(hin + (size_t)m * DM) + lane;
        f32x4 v[8]; float s = 0.f;
#pragma unroll
        for (int j = 0; j < 8; ++j) { v[j] = xr[64 * j]; s += (v[j].x * v[j].x + v[j].y * v[j].y) + (v[j].z * v[j].z + v[j].w * v[j].w); }
        const float rstd = 1.0f / sqrtf(wave_sum(s) * (1.f / DM) + RMS_EPS);
        if (OUTF32) { f32x4* o = (f32x4*)((float*)outp + (size_t)m * DM) + lane;
#pragma unroll
            for (int j = 0; j < 8; ++j) o[64 * j] = v[j] * rstd * g[j];
        } else { v2u* o8 = (v2u*)((bf16*)outp + (size_t)m * DM) + lane;
#pragma unroll
            for (int j = 0; j < 8; ++j) { v2u o; o.x = cvt_pk_bf16(v[j].x * rstd * g[j].x, v[j].y * rstd * g[j].y); o.y = cvt_pk_bf16(v[j].z * rstd * g[j].z, v[j].w * rstd * g[j].w); o8[64 * j] = o; } }
    }
}
__device__ __forceinline__ void final_norm(Frame& F, const bf16* hb, const float* gain, float* outp) {
    const int gw = blockIdx.x * NWAVES + F.wave, NGW = F.G * NWAVES, lane = F.lane;
    for (int m = gw; m < T; m += NGW) {
        const v4u* xr = (const v4u*)(hb + (size_t)m * DM) + lane; float v[4][8]; float s = 0.f;
#pragma unroll
        for (int j = 0; j < 4; ++j) { const v4u w = xr[64 * j]; v[j][0] = bf_lo(w.x); v[j][1] = bf_hi(w.x); v[j][2] = bf_lo(w.y); v[j][3] = bf_hi(w.y); v[j][4] = bf_lo(w.z); v[j][5] = bf_hi(w.z); v[j][6] = bf_lo(w.w); v[j][7] = bf_hi(w.w);
#pragma unroll
            for (int e = 0; e < 8; ++e) s += v[j][e] * v[j][e]; }
        const float rstd = 1.0f / sqrtf(wave_sum(s) * (1.f / DM) + RMS_EPS);
#pragma unroll
        for (int j = 0; j < 4; ++j) { const f32x4* g = (const f32x4*)(gain + (lane + 64 * j) * 8); f32x4* o = (f32x4*)(outp + (size_t)m * DM + (lane + 64 * j) * 8); const f32x4 g0 = g[0], g1 = g[1];
            o[0] = (f32x4){v[j][0] * rstd * g0[0], v[j][1] * rstd * g0[1], v[j][2] * rstd * g0[2], v[j][3] * rstd * g0[3]}; o[1] = (f32x4){v[j][4] * rstd * g1[0], v[j][5] * rstd * g1[1], v[j][6] * rstd * g1[2], v[j][7] * rstd * g1[3]}; }
    }
}
__device__ __forceinline__ void unpack8(const v4u w, float* f) { f[0] = bf_lo(w.x); f[1] = bf_hi(w.x); f[2] = bf_lo(w.y); f[3] = bf_hi(w.y); f[4] = bf_lo(w.z); f[5] = bf_hi(w.z); f[6] = bf_lo(w.w); f[7] = bf_hi(w.w); }

__device__ __forceinline__ void swa_naive(Frame& F, const float* sinks) {
    const bf16* P = wsb(F, WS_PROJ); bf16* O = wsb(F, WS_OSWA);
    for (int idx = blockIdx.x * 512 + F.tid; idx < T * 16; idx += F.G * 512) {
        const int hq = idx / T, m = idx % T, b = m / SEQ, t = m % SEQ, g = hq >> 2;
        float q[64];
        { const v4u* qp = (const v4u*)(P + (size_t)m * INW + COL_Q + hq * 64);
#pragma unroll
          for (int j = 0; j < 8; ++j) unpack8(qp[j], q + 8 * j); }
        float mrun = sinks[hq] * LOG2E, lrun = 1.f, o[64];
#pragma unroll
        for (int j = 0; j < 64; ++j) o[j] = 0.f;
        const int k0 = t >= 127 ? t - 127 : 0;
        for (int kp = k0; kp <= t; ++kp) {
            const bf16* kr = P + (size_t)(b * SEQ + kp) * INW + COL_K + g * 64; const bf16* vr = kr + (COL_V - COL_K);
            float s0 = 0.f, s1 = 0.f;
#pragma unroll
            for (int j = 0; j < 8; ++j) { float kf[8]; unpack8(((const v4u*)kr)[j], kf);
#pragma unroll
                for (int e = 0; e < 8; e += 2) { s0 += q[8 * j + e] * kf[e]; s1 += q[8 * j + e + 1] * kf[e + 1]; } }
            const float s = s0 + s1, mnew = fmaxf(mrun, s), corr = __builtin_amdgcn_exp2f(mrun - mnew), p = __builtin_amdgcn_exp2f(s - mnew);
            lrun = lrun * corr + p; mrun = mnew;
#pragma unroll
            for (int j = 0; j < 8; ++j) { float vf[8]; unpack8(((const v4u*)vr)[j], vf);
#pragma unroll
                for (int e = 0; e < 8; ++e) o[8 * j + e] = o[8 * j + e] * corr + p * vf[e]; }
        }
        const float inv = 1.0f / lrun; v4u* op = (v4u*)(O + (size_t)m * 1024 + hq * 64);
#pragma unroll
        for (int j = 0; j < 8; ++j) { v4u w; w.x = cvt_pk_bf16(o[8 * j] * inv, o[8 * j + 1] * inv); w.y = cvt_pk_bf16(o[8 * j + 2] * inv, o[8 * j + 3] * inv);
            w.z = cvt_pk_bf16(o[8 * j + 4] * inv, o[8 * j + 5] * inv); w.w = cvt_pk_bf16(o[8 * j + 6] * inv, o[8 * j + 7] * inv); op[j] = w; }
    }
}
__device__ __forceinline__ void memattn_naive(Frame& F) {
    const bf16* P = wsb(F, WS_PROJ); const bf16* KV = wsb(F, WS_MKV); bf16* O = wsb(F, WS_OMEM);
    LAS float* qs = (LAS float*)F.lds;
    LAS float* ss = qs + 32 * 260;
    const int tid = F.tid, ti = tid >> 4, kg = tid & 15;
    for (int unit = blockIdx.x; unit < 1024; unit += F.G) {
        const int b = unit >> 9, hd = (unit >> 7) & 3, tb = unit & 127, m0 = b * SEQ + tb * 32;
        { const v4u* src = (const v4u*)(P + (size_t)(m0 + ti) * INW + COL_MQ + hd * 256 + kg * 16); float f[16]; unpack8(src[0], f); unpack8(src[1], f + 8);
#pragma unroll
          for (int e = 0; e < 16; ++e) qs[ti * 260 + kg * 16 + e] = f[e]; }
        __syncthreads();
        float sc[16];
#pragma unroll 1
        for (int i = 0; i < 16; ++i) { const int key = kg + 16 * i; const v4u* kr = (const v4u*)(KV + (size_t)(b * NMEM + key) * 2048 + hd * 256);
            float a0 = 0.f, a1 = 0.f;
#pragma unroll 8
            for (int d8 = 0; d8 < 32; ++d8) { float kf[8]; unpack8(kr[d8], kf); const LAS f32x4* qp = (const LAS f32x4*)(qs + ti * 260 + d8 * 8); const f32x4 qa = qp[0], qb = qp[1];
                a0 += qa.x * kf[0] + qa.y * kf[1] + qa.z * kf[2] + qa.w * kf[3]; a1 += qb.x * kf[4] + qb.y * kf[5] + qb.z * kf[6] + qb.w * kf[7]; }
            ss[ti * 257 + key] = a0 + a1; }
        __syncthreads();
        float mx = -3.0e38f;
#pragma unroll
        for (int i = 0; i < 16; ++i) { sc[i] = ss[ti * 257 + kg + 16 * i]; mx = fmaxf(mx, sc[i]); }
#pragma unroll
        for (int o = 1; o < 16; o <<= 1) mx = fmaxf(mx, __shfl_xor(mx, o));
        float sum = 0.f;
#pragma unroll
        for (int i = 0; i < 16; ++i) { sc[i] = __builtin_amdgcn_exp2f(sc[i] - mx); sum += sc[i]; }
#pragma unroll
        for (int o = 1; o < 16; o <<= 1) sum += __shfl_xor(sum, o);
        const float inv = 1.0f / sum;
#pragma unroll
        for (int i = 0; i < 16; ++i) ss[ti * 257 + kg + 16 * i] = sc[i] * inv;
        __syncthreads();
        float o[16];
#pragma unroll
        for (int e = 0; e < 16; ++e) o[e] = 0.f;
#pragma unroll 4
        for (int key = 0; key < NMEM; ++key) { const float p = ss[ti * 257 + key]; const v4u* vr = (const v4u*)(KV + (size_t)(b * NMEM + key) * 2048 + 1024 + hd * 256 + kg * 16);
            float vf[16]; unpack8(vr[0], vf); unpack8(vr[1], vf + 8);
#pragma unroll
            for (int e = 0; e < 16; ++e) o[e] += p * vf[e]; }
        v4u* op = (v4u*)(O + (size_t)(m0 + ti) * 1024 + hd * 256 + kg * 16);
        v4u w; w.x = cvt_pk_bf16(o[0], o[1]); w.y = cvt_pk_bf16(o[2], o[3]); w.z = cvt_pk_bf16(o[4], o[5]); w.w = cvt_pk_bf16(o[6], o[7]); op[0] = w;
        w.x = cvt_pk_bf16(o[8], o[9]); w.y = cvt_pk_bf16(o[10], o[11]); w.z = cvt_pk_bf16(o[12], o[13]); w.w = cvt_pk_bf16(o[14], o[15]); op[1] = w;
        __syncthreads();
    }
}
__device__ __forceinline__ void sincos_red(double x, float& s, float& c) {
    const double k = __builtin_rint(x * 0.63661977236758134308); const double r = (x - k * 1.57079632679489655800) - k * 6.123233995736766036e-17; const double r2 = r * r;
    double sp = -7.6471637318198164759e-13; sp = sp * r2 + 1.6059043836821614599e-10; sp = sp * r2 - 2.5052108385441718775e-8; sp = sp * r2 + 2.7557319223985890653e-6; sp = sp * r2 - 1.9841269841269841270e-4; sp = sp * r2 + 8.3333333333333333333e-3; sp = sp * r2 - 1.6666666666666666667e-1;
    const double sr = r + r * r2 * sp;
    double cp = -1.1470745597729724714e-11; cp = cp * r2 + 2.0876756987868098979e-9; cp = cp * r2 - 2.7557319223985890653e-7; cp = cp * r2 + 2.4801587301587301587e-5; cp = cp * r2 - 1.3888888888888888889e-3; cp = cp * r2 + 4.1666666666666666667e-2; cp = cp * r2 - 0.5;
    const double cr = 1.0 + r2 * cp;
    const int q = ((int)k) & 3;
    const double ss = (q & 1) ? cr : sr, cc = (q & 1) ? sr : cr;
    s = (float)((q & 2) ? -ss : ss); c = (float)(((q == 1) || (q == 2)) ? -cc : cc);
}
struct SsmState { float ar, ai, a64r, a64i; float bbr[16], bbi[16]; };
struct SsmIn { const float *lre, *lim, *ldt, *bre, *bim, *cre, *cim, *dsk; };
__device__ __forceinline__ void ssm_params(const SsmIn& I, int g, int p, SsmState& S) {
    const int gp = g * 64 + p;
    const float lr = fminf(I.lre[gp], -1e-4f), li = I.lim[gp], dt = expf(I.ldt[g]);
    const float mag = expf(lr * dt); float sn, cs; const double th = (double)li * (double)dt; sincos_red(th, sn, cs);
    S.ar = mag * cs; S.ai = mag * sn;
    const float mag64 = expf(lr * dt * 64.f); sincos_red(th * 64.0, sn, cs); S.a64r = mag64 * cs; S.a64i = mag64 * sn;
    const float nr = S.ar - 1.f, ni = S.ai, den = lr * lr + li * li, kr = (nr * lr + ni * li) / den, ki = (ni * lr - nr * li) / den;
    const float* br = I.bre + (size_t)gp * 16; const float* bi = I.bim + (size_t)gp * 16;
#pragma unroll
    for (int c = 0; c < 16; ++c) { S.bbr[c] = kr * br[c] - ki * bi[c]; S.bbi[c] = kr * bi[c] + ki * br[c]; }
}
__device__ __forceinline__ void ssm_step(const SsmState& S, const bf16* up, float& sr, float& si) {
    const v4u* u4 = (const v4u*)up; float uf[16]; unpack8(u4[0], uf); unpack8(u4[1], uf + 8);
    float xr = 0.f, xi = 0.f;
#pragma unroll
    for (int c = 0; c < 16; ++c) { xr += S.bbr[c] * uf[c]; xi += S.bbi[c] * uf[c]; }
    const float nr = S.ar * sr - S.ai * si + xr, ni = S.ar * si + S.ai * sr + xi; sr = nr; si = ni;
}
__device__ __forceinline__ void ssm_local(Frame& F, const SsmIn& I) {
    const bf16* P = wsb(F, WS_PROJ); f32x2* SE = (f32x2*)(F.ws + WS_SEND);
    const int gw = blockIdx.x * NWAVES + F.wave, NGW = F.G * NWAVES, p = F.lane;
    for (int u = gw; u < 2 * 64 * 64; u += NGW) {
        const int g = u & 63, ch = (u >> 6) & 63, b = u >> 12;
        SsmState S; ssm_params(I, g, p, S);
        float sr = 0.f, si = 0.f; const bf16* up = P + (size_t)(b * SEQ + ch * 64) * INW + COL_S + g * 16;
#pragma unroll 4
        for (int j = 0; j < 64; ++j) ssm_step(S, up + (size_t)j * INW, sr, si);
        SE[((size_t)(b * 64 + ch) * 64 + g) * 64 + p] = (f32x2){sr, si};
    }
}
__device__ __forceinline__ void ssm_replay(Frame& F, const SsmIn& I) {
    const bf16* P = wsb(F, WS_PROJ); const f32x2* SE = (const f32x2*)(F.ws + WS_SEND); bf16* Y = wsb(F, WS_YS);
    LAS f32x2* Cs = (LAS f32x2*)F.lds;
    LAS float* Ds = (LAS float*)(F.lds + 16 * 65 * 8);
    LAS f32x2* Sw = (LAS f32x2*)(F.lds + 16384) + F.wave * (16 * 65);
    const int p = F.lane, jj = F.lane >> 2, cq = F.lane & 3;
    for (int unit = blockIdx.x; unit < 1024; unit += F.G) {
        const int oct = unit & 7, g = (unit >> 3) & 63, b = unit >> 9, ch = oct * 8 + F.wave;
        for (int e = F.tid; e < 1024; e += 512) { const int c = e >> 6, pp = e & 63; const size_t gi = ((size_t)g * 16 + c) * 64 + pp; Cs[c * 65 + pp] = (f32x2){I.cre[gi], I.cim[gi]}; }
        if (F.tid < 16) Ds[F.tid] = I.dsk[g * 16 + F.tid];
        __syncthreads();
        SsmState S; ssm_params(I, g, p, S);
        float sr = 0.f, si = 0.f;
        for (int j = 0; j < ch; ++j) { const f32x2 e = SE[((size_t)(b * 64 + j) * 64 + g) * 64 + p]; const float nr = S.a64r * sr - S.a64i * si + e.x, ni = S.a64r * si + S.a64i * sr + e.y; sr = nr; si = ni; }
        const size_t tok0 = (size_t)b * SEQ + ch * 64;
#pragma unroll 1
        for (int sub = 0; sub < 4; ++sub) {
#pragma unroll 4
            for (int j = 0; j < 16; ++j) { ssm_step(S, P + (tok0 + sub * 16 + j) * INW + COL_S + g * 16, sr, si); Sw[j * 65 + p] = (f32x2){sr, si}; }
            asm volatile("s_waitcnt lgkmcnt(0)" ::: "memory");
            float acc[4] = {0.f, 0.f, 0.f, 0.f};
#pragma unroll 4
            for (int pp = 0; pp < 64; ++pp) { const f32x2 sv = Sw[jj * 65 + pp];
#pragma unroll
                for (int ci = 0; ci < 4; ++ci) { const f32x2 cv = Cs[(cq * 4 + ci) * 65 + pp]; acc[ci] += cv.x * sv.x - cv.y * sv.y; } }
            const size_t tok = tok0 + sub * 16 + jj; const v2u uw = *(const v2u*)(P + tok * INW + COL_S + g * 16 + cq * 4);
            const float u0 = bf_lo(uw.x), u1 = bf_hi(uw.x), u2 = bf_lo(uw.y), u3 = bf_hi(uw.y);
            v2u o; o.x = cvt_pk_bf16(acc[0] + Ds[cq * 4] * u0, acc[1] + Ds[cq * 4 + 1] * u1); o.y = cvt_pk_bf16(acc[2] + Ds[cq * 4 + 2] * u2, acc[3] + Ds[cq * 4 + 3] * u3);
            *(v2u*)(Y + tok * 1024 + g * 16 + cq * 4) = o;
            asm volatile("s_waitcnt lgkmcnt(0)" ::: "memory");
        }
        __syncthreads();
    }
}

typedef short bf16x8 __attribute__((ext_vector_type(8)));
typedef short s16x4 __attribute__((ext_vector_type(4)));
typedef float f32x16 __attribute__((ext_vector_type(16)));
__device__ __forceinline__ s16x4 lds_tr16(const LAS unsigned char* p) { return __builtin_bit_cast(s16x4, __builtin_amdgcn_ds_read_tr16_b64_v4i16((LAS s16x4*)p)); }
__device__ __forceinline__ bf16x8 cat8(s16x4 lo, s16x4 hi) { return (bf16x8){lo[0], lo[1], lo[2], lo[3], hi[0], hi[1], hi[2], hi[3]}; }
__device__ __forceinline__ bf16x8 pack8(float a0, float a1, float a2, float a3, float a4, float a5, float a6, float a7) {
    v4u w; w.x = cvt_pk_bf16(a0, a1); w.y = cvt_pk_bf16(a2, a3); w.z = cvt_pk_bf16(a4, a5); w.w = cvt_pk_bf16(a6, a7); return __builtin_bit_cast(bf16x8, w); }

__device__ __forceinline__ void swa_mfma(Frame& F, const float* sinks) {
    const bf16* P = wsb(F, WS_PROJ); bf16* O = wsb(F, WS_OSWA);
    LAS unsigned char* Kl = F.lds;
    LAS unsigned char* Vl = F.lds + 36864;
    const int tid = F.tid, lane = F.lane, w = F.wave, r = w >> 1, qh = w & 1, l31 = lane & 31, h = lane >> 5;
    for (int ub_ = blockIdx.x; ub_ < 256; ub_ += F.G) { const int unit = (F.G == 256) ? ((ub_ & 7) * 32 + (ub_ >> 3)) : ub_;
        const int n = unit & 31, g = (unit >> 5) & 3, b = unit >> 7;
        const int hq = g * 4 + r; bf16x8 qfa[2][4];
#pragma unroll
        for (int qt = 0; qt < 2; ++qt)
#pragma unroll
            for (int ds = 0; ds < 4; ++ds) qfa[qt][ds] = *(const bf16x8*)(P + ((size_t)b * SEQ + n * 128 + (qh * 2 + qt) * 32 + l31) * INW + COL_Q + hq * 64 + ds * 16 + h * 8);
        const float sinkv = sinks[hq];
        {
            v4u kv[4], vv[4];
#pragma unroll
            for (int i = 0; i < 4; ++i) { const int c = tid + 512 * i, key = c >> 3, part = c & 7, pos = (n - 1) * 128 + key, pc = pos < 0 ? 0 : pos;
                const bf16* src = P + (size_t)(b * SEQ + pc) * INW + COL_K + g * 64 + part * 8; kv[i] = *(const v4u*)src; vv[i] = *(const v4u*)(src + (COL_V - COL_K)); }
#pragma unroll
            for (int i = 0; i < 4; ++i) { const int c = tid + 512 * i, key = c >> 3, part = c & 7, pos = (n - 1) * 128 + key;
                const v4u z = {0u, 0u, 0u, 0u};
                *(LAS v4u*)(Kl + key * 144 + part * 16) = pos >= 0 ? kv[i] : z;
                *(LAS v4u*)(Vl + (part >> 2) * 16384 + key * 64 + (part & 3) * 16) = pos >= 0 ? vv[i] : z; }
        }
        __syncthreads();
        const float sink2 = sinkv * LOG2E;
#pragma unroll 1
        for (int qt = 0; qt < 2; ++qt) {
            bf16x8 qf[4];
#pragma unroll
            for (int ds = 0; ds < 4; ++ds) qf[ds] = qt ? qfa[1][ds] : qfa[0][ds];
            const int a = qh * 2 + qt, qi = a * 32 + l31; const size_t m = (size_t)b * SEQ + n * 128 + qi;
            f32x16 s[5];
#pragma unroll
            for (int k5 = 0; k5 < 5; ++k5) { f32x16 acc;
#pragma unroll
                for (int e = 0; e < 16; ++e) acc[e] = 0.f;
                bf16x8 kf[4];
#pragma unroll
                for (int ds = 0; ds < 4; ++ds) kf[ds] = *(const LAS bf16x8*)(Kl + (32 * (a + k5) + l31) * 144 + ds * 32 + h * 16);
#pragma unroll
                for (int ds = 0; ds < 4; ++ds) acc = __builtin_amdgcn_mfma_f32_32x32x16_bf16(kf[ds], qf[ds], acc, 0, 0, 0);
                s[k5] = acc; }
            float mx = sink2;
            const int dlo = (n == 0) ? 127 - qi : 0; const unsigned lim = 128u - (unsigned)dlo; const int dbase = 4 * h - l31 - 1 - dlo;
#pragma unroll
            for (int k5 = 0; k5 < 5; ++k5) { int bk = dbase + 32 * k5; asm volatile("" : "+v"(bk));
#pragma unroll
                for (int e = 0; e < 16; ++e) { const unsigned ud = (unsigned)(bk + (e & 3) + 8 * (e >> 2));
                    const float v = (ud < lim) ? s[k5][e] : -1.0e30f; s[k5][e] = v; mx = fmaxf(mx, v); } }
            mx = fmaxf(mx, __shfl_xor(mx, 32));
            float sum = 0.f;
#pragma unroll
            for (int k5 = 0; k5 < 5; ++k5)
#pragma unroll
                for (int e = 0; e < 16; ++e) { const float p = __builtin_amdgcn_exp2f(s[k5][e] - mx); s[k5][e] = p; sum += p; }
            sum += __shfl_xor(sum, 32); sum += __builtin_amdgcn_exp2f(sink2 - mx);
            f32x16 o[2];
#pragma unroll
            for (int e = 0; e < 16; ++e) { o[0][e] = 0.f; o[1][e] = 0.f; }
#pragma unroll
            for (int k5 = 0; k5 < 5; ++k5) { s16x4 vlo[2][2], vhi[2][2];
#pragma unroll
                for (int s2 = 0; s2 < 2; ++s2)
#pragma unroll
                    for (int db = 0; db < 2; ++db) { const LAS unsigned char* vp = Vl + db * 16384 + (32 * (a + k5) + 16 * s2 + 4 * h + ((lane & 15) >> 2)) * 64 + (16 * ((lane >> 4) & 1) + 4 * (lane & 3)) * 2;
                        vlo[s2][db] = lds_tr16(vp); vhi[s2][db] = lds_tr16(vp + 8 * 64); }
#pragma unroll
                for (int s2 = 0; s2 < 2; ++s2) { const bf16x8 pf = pack8(s[k5][8 * s2], s[k5][8 * s2 + 1], s[k5][8 * s2 + 2], s[k5][8 * s2 + 3], s[k5][8 * s2 + 4], s[k5][8 * s2 + 5], s[k5][8 * s2 + 6], s[k5][8 * s2 + 7]);
#pragma unroll
                    for (int db = 0; db < 2; ++db) o[db] = __builtin_amdgcn_mfma_f32_32x32x16_bf16(cat8(vlo[s2][db], vhi[s2][db]), pf, o[db], 0, 0, 0); } }
            const float inv = 1.0f / sum;
#pragma unroll
            for (int db = 0; db < 2; ++db)
#pragma unroll
                for (int g4 = 0; g4 < 4; ++g4) { v2u wv; wv.x = cvt_pk_bf16(o[db][4 * g4] * inv, o[db][4 * g4 + 1] * inv); wv.y = cvt_pk_bf16(o[db][4 * g4 + 2] * inv, o[db][4 * g4 + 3] * inv);
                    *(v2u*)(O + m * 1024 + hq * 64 + db * 32 + 8 * g4 + 4 * h) = wv; }
        }
        __syncthreads();
    }
}
__device__ __forceinline__ void memattn_mfma(Frame& F) {
    const bf16* P = wsb(F, WS_PROJ); const bf16* KV = wsb(F, WS_MKV); bf16* O = wsb(F, WS_OMEM);
    constexpr int RS = 544, SLOT = 64 * RS;
    const int tid = F.tid, lane = F.lane, w = F.wave, l15 = lane & 15, kq = lane >> 4;
    for (int ub_ = blockIdx.x; ub_ < 256; ub_ += F.G) { const int unit = (F.G == 256) ? ((ub_ & 7) * 32 + (ub_ >> 3)) : ub_;
        const int tb = unit & 31, hd = (unit >> 5) & 3, b = unit >> 7; const size_t m = (size_t)b * SEQ + tb * 128 + w * 16 + l15;
        bf16x8 qf[8];
#pragma unroll
        for (int ds = 0; ds < 8; ++ds) qf[ds] = *(const bf16x8*)(P + m * INW + COL_MQ + hd * 256 + ds * 32 + kq * 8);
        v4u st[2][4];
#define MA_LOAD(t) do { _Pragma("unroll") for (int i_ = 0; i_ < 4; ++i_) { const int c_ = tid + 512 * i_, row_ = c_ >> 5, part_ = c_ & 31; \
            st[(t) & 1][i_] = *(const v4u*)(KV + (size_t)(b * NMEM + 64 * ((t) & 3) + row_) * 2048 + ((t) >> 2) * 1024 + hd * 256 + part_ * 8); } } while (0)
#define MA_STORE(t) do { _Pragma("unroll") for (int i_ = 0; i_ < 4; ++i_) { const int c_ = tid + 512 * i_, row_ = c_ >> 5, part_ = c_ & 31; *(LAS v4u*)(F.lds + ((t) % 3) * SLOT + row_ * RS + part_ * 16) = st[(t) & 1][i_]; } } while (0)
        MA_LOAD(0); MA_LOAD(1); MA_STORE(0); __syncthreads();
        f32x4 s[16]; f32x4 o[16]; float inv = 0.f;
#pragma unroll
        for (int t = 0; t < 8; ++t) {
            if (t < 6) MA_LOAD(t + 2);
            const LAS unsigned char* cur = F.lds + (t % 3) * SLOT;
            if (t < 4) {
#pragma unroll
                for (int k4 = 0; k4 < 4; ++k4) { f32x4 acc = {0.f, 0.f, 0.f, 0.f}; bf16x8 kf[8];
#pragma unroll
                    for (int ds = 0; ds < 8; ++ds) kf[ds] = *(const LAS bf16x8*)(cur + (16 * k4 + l15) * RS + ds * 64 + kq * 16);
#pragma unroll
                    for (int ds = 0; ds < 8; ++ds) acc = __builtin_amdgcn_mfma_f32_16x16x32_bf16(kf[ds], qf[ds], acc, 0, 0, 0);
                    s[4 * t + k4] = acc; }
                if (t == 3) {
                    float mx = -3.0e38f;
#pragma unroll
                    for (int i = 0; i < 16; ++i) mx = fmaxf(mx, fmaxf(fmaxf(s[i][0], s[i][1]), fmaxf(s[i][2], s[i][3])));
                    mx = fmaxf(mx, __shfl_xor(mx, 16)); mx = fmaxf(mx, __shfl_xor(mx, 32));
                    float sum = 0.f;
#pragma unroll
                    for (int i = 0; i < 16; ++i)
#pragma unroll
                        for (int e = 0; e < 4; ++e) { const float p = __builtin_amdgcn_exp2f(s[i][e] - mx); s[i][e] = p; sum += p; }
                    sum += __shfl_xor(sum, 16); sum += __shfl_xor(sum, 32); inv = 1.0f / sum;
#pragma unroll
                    for (int i = 0; i < 16; ++i) o[i] = (f32x4){0.f, 0.f, 0.f, 0.f};
                }
            } else {
                const int tv = t - 4;
#pragma unroll
                for (int s2 = 0; s2 < 2; ++s2) { const f32x4 p0 = s[4 * tv + 2 * s2], p1 = s[4 * tv + 2 * s2 + 1]; const bf16x8 pf = pack8(p0[0], p0[1], p0[2], p0[3], p1[0], p1[1], p1[2], p1[3]);
#pragma unroll
                    for (int dh = 0; dh < 2; ++dh) { s16x4 vlo[8], vhi[8];
#pragma unroll
                        for (int d8 = 0; d8 < 8; ++d8) { const LAS unsigned char* vp = cur + (32 * s2 + 4 * kq + (l15 >> 2)) * RS + (16 * (8 * dh + d8) + 4 * (lane & 3)) * 2; vlo[d8] = lds_tr16(vp); vhi[d8] = lds_tr16(vp + 16 * RS); }
#pragma unroll
                        for (int d8 = 0; d8 < 8; ++d8) o[8 * dh + d8] = __builtin_amdgcn_mfma_f32_16x16x32_bf16(cat8(vlo[d8], vhi[d8]), pf, o[8 * dh + d8], 0, 0, 0); } }
            }
            if (t < 7) MA_STORE(t + 1);
            asm volatile("s_waitcnt lgkmcnt(0)" ::: "memory"); __builtin_amdgcn_s_barrier(); asm volatile("" ::: "memory");
        }
#undef MA_LOAD
#undef MA_STORE
#pragma unroll
        for (int db = 0; db < 16; ++db) { v2u wv; wv.x = cvt_pk_bf16(o[db][0] * inv, o[db][1] * inv); wv.y = cvt_pk_bf16(o[db][2] * inv, o[db][3] * inv); *(v2u*)(O + m * 1024 + hd * 256 + 16 * db + 4 * kq) = wv; }
    }
}

__device__ __forceinline__ void cmul(float ar, float ai, float br, float bi, float& cr, float& ci) { cr = ar * br - ai * bi; ci = ar * bi + ai * br; }
__device__ __forceinline__ void ssm_tables(Frame& F, const SsmIn& I0) {
    LAS f32x2* AP = (LAS f32x2*)F.lds;
    LAS f32x2* BB = (LAS f32x2*)(F.lds + 33280);
    LAS f32x2* CC = (LAS f32x2*)(F.lds + 33280 + 8192);
    LAS f32x2* KC = (LAS f32x2*)(F.lds + 33280 + 16384);
    const int t = F.tid;
    if ((int)blockIdx.x >= TAB_WGS && F.G > TAB_WGS) return;
    for (int unit = blockIdx.x; unit < DEPTH * 64; unit += (F.G > TAB_WGS ? TAB_WGS : F.G)) {
        const int l = unit >> 6, g = unit & 63, gp0 = unit * 64;
        const float dt = expf(I0.ldt[unit]);
        for (int e = t; e < 65 * 64; e += 512) { const int ee = e >> 6, p = e & 63; const float lr = fminf(I0.lre[gp0 + p], -1e-4f), li = I0.lim[gp0 + p];
            const float mag = expf(lr * dt * (float)ee); float sn, cs; sincos_red((double)li * (double)dt * (double)ee, sn, cs); AP[e] = (f32x2){mag * cs, mag * sn}; }
        __syncthreads();
        if (t < 64) { ((f32x2*)(F.ws + WS_A64))[gp0 + t] = AP[64 * 64 + t];
            const float lr = fminf(I0.lre[gp0 + t], -1e-4f), li = I0.lim[gp0 + t]; const f32x2 a = AP[64 + t]; const float nr = a.x - 1.f, ni = a.y, den = lr * lr + li * li;
            KC[t] = (f32x2){(nr * lr + ni * li) / den, (ni * lr - nr * li) / den}; }
        __syncthreads();
        for (int e = t; e < 1024; e += 512) { const int p = e >> 4; const f32x2 k = KC[p]; const float br = I0.bre[(size_t)gp0 * 16 + e], bi = I0.bim[(size_t)gp0 * 16 + e];
            BB[e] = (f32x2){k.x * br - k.y * bi, k.x * bi + k.y * br}; CC[e] = (f32x2){I0.cre[(size_t)gp0 * 16 + e], I0.cim[(size_t)gp0 * 16 + e]}; }
        __syncthreads();
        bf16* WinT = wsb(F, WS_WINT) + (size_t)unit * 131072; bf16* WoutT = wsb(F, WS_WOUTT) + (size_t)unit * 131072; bf16* LB = (bf16*)(F.ws + WS_LB + (size_t)unit * LB_BYTES);
        for (int q = t; q < 16384; q += 512) { const int n = q >> 7, ck = q & 127, j = ck >> 1, half = ck & 1, p = 16 * (n >> 5) + (n & 15), isim = (n >> 4) & 1; const f32x2 a = AP[(63 - j) * 64 + p]; float v[8];
#pragma unroll
            for (int e = 0; e < 8; ++e) { const f32x2 bb = BB[p * 16 + 8 * half + e]; float zr, zi; cmul(a.x, a.y, bb.x, bb.y, zr, zi); v[e] = isim ? zi : zr; }
            *(bf16x8*)(WinT + (size_t)n * 1024 + ck * 8) = pack8(v[0], v[1], v[2], v[3], v[4], v[5], v[6], v[7]); }
        for (int q = t; q < 16384; q += 512) { const int row = q >> 4, ck = q & 15, tau = row >> 4, c = row & 15, isim = ck >> 3, p0 = (8 * ck) & 63; float v[8];
#pragma unroll
            for (int e = 0; e < 8; ++e) { const f32x2 cc = CC[c * 64 + p0 + e], a = AP[(tau + 1) * 64 + p0 + e]; float zr, zi; cmul(cc.x, cc.y, a.x, a.y, zr, zi); v[e] = isim ? -zi : zr; }
            *(bf16x8*)(WoutT + (size_t)row * 128 + ck * 8) = pack8(v[0], v[1], v[2], v[3], v[4], v[5], v[6], v[7]); }
        { const int c = (t >> 4) & 15, c2 = t & 15, lh = t >> 8; float acc[32];
#pragma unroll
          for (int d = 0; d < 32; ++d) acc[d] = 0.f;
#pragma unroll 2
          for (int p = 0; p < 64; ++p) { const f32x2 cc = CC[c * 64 + p], bb = BB[p * 16 + c2]; float zr, zi; cmul(cc.x, cc.y, bb.x, bb.y, zr, zi);
#pragma unroll
              for (int d = 0; d < 32; ++d) { const f32x2 a = AP[(32 * lh + d) * 64 + p]; acc[d] += zr * a.x - zi * a.y; } }
          if (lh == 0 && c == c2) acc[0] += I0.dsk[l * 1024 + g * 16 + c];
#pragma unroll
          for (int d = 0; d < 32; ++d) LB[(((32 * lh + d + 1) * 2 + (c2 >> 3)) * 16 + c) * 8 + (c2 & 7)] = (bf16)(cvt_pk_bf16(acc[d], 0.f) & 0xffffu);
          if (t < 256) LB[t] = 0; }
        __syncthreads();
    }
}
__device__ __forceinline__ void ssm_s1(Frame& F, const SsmIn& I, int l) {
    const bf16* P = wsb(F, WS_PROJ); bf16* SST = wsb(F, WS_SST);
    LAS float* E = (LAS float*)F.lds;
    const int lane = F.lane, w = F.wave, l31 = lane & 31, h = lane >> 5, mi = w & 3, kh = w >> 2;
    for (int ub_ = blockIdx.x; ub_ < 256; ub_ += F.G) { const int unit = (F.G == 256) ? ((ub_ & 7) * 32 + (ub_ >> 3)) : ub_;
        const int g = unit >> 2, pq = unit & 3;
        const bf16* WinT = wsb(F, WS_WINT) + (size_t)(l * 64 + g) * 131072 + (size_t)(pq * 32 + l31) * 1024 + 8 * h;
        const int mrow = 32 * mi + l31, bb = mrow >> 6, kk = mrow & 63;
        const bf16* up = wsb(F, WS_SIN) + ((size_t)g * T + bb * SEQ + kk * 64) * 16 + 8 * h;
        f32x2 a64v[4];
#pragma unroll
        for (int tk = 0; tk < 4; ++tk) a64v[tk] = ((const f32x2*)(F.ws + WS_A64))[(l * 64 + g) * 64 + 16 * pq + ((w * 4 + tk) & 15)];
        f32x16 acc;
#pragma unroll
        for (int e = 0; e < 16; ++e) acc[e] = 0.f;
#pragma unroll
        for (int jb = 0; jb < 2; ++jb) { bf16x8 af[16], bf[16];
#pragma unroll
            for (int jj = 0; jj < 16; ++jj) { const int j = 32 * kh + 16 * jb + jj; af[jj] = *(const bf16x8*)(up + (size_t)j * 16); bf[jj] = *(const bf16x8*)(WinT + 16 * j); }
            __builtin_amdgcn_sched_barrier(0);
#pragma unroll
            for (int jj = 0; jj < 16; ++jj) acc = __builtin_amdgcn_mfma_f32_32x32x16_bf16(af[jj], bf[jj], acc, 0, 0, 0);
            __builtin_amdgcn_sched_barrier(0); }
#pragma unroll
        for (int e = 0; e < 16; ++e) E[(kh * 128 + 32 * mi + (e & 3) + 8 * (e >> 2) + 4 * h) * 33 + l31] = acc[e];
        __syncthreads();
        {
            const int k = lane; float xr[4], xi[4], ar[4], ai[4];
#pragma unroll
            for (int tk = 0; tk < 4; ++tk) { const int task = w * 4 + tk, b = task >> 4, st = task & 15, p = 16 * pq + st;
                (void)p; ar[tk] = a64v[tk].x; ai[tk] = a64v[tk].y;
                xr[tk] = E[(b * 64 + k) * 33 + st] + E[(128 + b * 64 + k) * 33 + st]; xi[tk] = E[(b * 64 + k) * 33 + 16 + st] + E[(128 + b * 64 + k) * 33 + 16 + st]; }
#pragma unroll
            for (int d = 1; d < 64; d <<= 1)
#pragma unroll
                for (int tk = 0; tk < 4; ++tk) { const float yr = __shfl_up(xr[tk], d), yi = __shfl_up(xi[tk], d); if (k >= d) { xr[tk] += ar[tk] * yr - ai[tk] * yi; xi[tk] += ar[tk] * yi + ai[tk] * yr; }
                    const float nr = ar[tk] * ar[tk] - ai[tk] * ai[tk], ni = 2.f * ar[tk] * ai[tk]; ar[tk] = nr; ai[tk] = ni; }
#pragma unroll
            for (int tk = 0; tk < 4; ++tk) { const int task = w * 4 + tk, b = task >> 4, st = task & 15, p = 16 * pq + st;
                float sr = __shfl_up(xr[tk], 1), si = __shfl_up(xi[tk], 1); if (k == 0) { sr = 0.f; si = 0.f; }
                bf16* dst = SST + ((size_t)(g * 128 + b * 64 + k)) * 128 + p; dst[0] = (bf16)(cvt_pk_bf16(sr, 0.f) & 0xffffu); dst[64] = (bf16)(cvt_pk_bf16(si, 0.f) & 0xffffu); }
        }
        __syncthreads();
    }
}
__device__ __forceinline__ void ssm_s2(Frame& F, int l) {
    const bf16* P = wsb(F, WS_PROJ); const bf16* SST = wsb(F, WS_SST); bf16* Y = wsb(F, WS_YS);
    LAS unsigned char* Ul = F.lds;
    LAS unsigned char* Ll = F.lds + 66048;
    LAS unsigned char* Sl = F.lds + 66048 + 40960;
    const int t = F.tid, lane = F.lane, w = F.wave, l31 = lane & 31, h = lane >> 5;
    for (int ub_ = blockIdx.x; ub_ < 256; ub_ += F.G) { const int unit = (F.G == 256) ? ((ub_ & 7) * 32 + (ub_ >> 3)) : ub_;
        const int mt = unit & 1, b = (unit >> 1) & 1, g = unit >> 2;
        const bf16* WoutT = wsb(F, WS_WOUTT) + (size_t)(l * 64 + g) * 131072;
        bf16x8 wfr[4][8];
#pragma unroll
        for (int q = 0; q < 4; ++q) { const int n = (q == 0) ? w : (q == 1) ? 15 - w : (q == 2) ? 16 + w : 31 - w;
#pragma unroll
            for (int ks = 0; ks < 8; ++ks) wfr[q][ks] = *(const bf16x8*)(WoutT + (size_t)(32 * n + l31) * 128 + 16 * ks + 8 * h); }
        {
            v4u ur[8], lr[5], sr;
            const v4u* usrc = (const v4u*)(wsb(F, WS_SIN) + ((size_t)g * T + b * SEQ + (32 * mt) * 64) * 16); const v4u* lsrc = (const v4u*)(F.ws + WS_LB + (size_t)(l * 64 + g) * LB_BYTES);
#pragma unroll
            for (int i = 0; i < 8; ++i) ur[i] = usrc[t + 512 * i];
#pragma unroll
            for (int i = 0; i < 5; ++i) { const int q = t + 512 * i; lr[i] = lsrc[q < (int)(LB_BYTES / 16) ? q : 0]; }
            sr = *(const v4u*)(SST + ((size_t)(g * 128 + b * 64 + 32 * mt + (t >> 4))) * 128 + (t & 15) * 8);
#pragma unroll
            for (int i = 0; i < 8; ++i) { const int q = t + 512 * i, half = q & 1, ti = q >> 1, ir = ti >> 6, j = ti & 63; *(LAS v4u*)(Ul + ir * 2064 + j * 32 + half * 16) = ur[i]; }
#pragma unroll
            for (int i = 0; i < 5; ++i) { const int q = t + 512 * i; *(LAS v4u*)(Ll + q * 16) = lr[i]; }
            *(LAS v4u*)(Sl + (t >> 4) * 272 + (t & 15) * 16) = sr;
        }
        __syncthreads();
#pragma unroll
        for (int q = 0; q < 4; ++q) { const int n = (q == 0) ? w : (q == 1) ? 15 - w : (q == 2) ? 16 + w : 31 - w;
            f32x16 acc;
#pragma unroll
            for (int e = 0; e < 16; ++e) acc[e] = 0.f;
            { bf16x8 sf[8];
#pragma unroll
              for (int ks = 0; ks < 8; ++ks) sf[ks] = *(const LAS bf16x8*)(Sl + l31 * 272 + ks * 32 + h * 16);
              __builtin_amdgcn_sched_barrier(0);
#pragma unroll
              for (int ks = 0; ks < 8; ++ks) acc = __builtin_amdgcn_mfma_f32_32x32x16_bf16(wfr[q][ks], sf[ks], acc, 0, 0, 0);
              __builtin_amdgcn_sched_barrier(0); }
            const LAS unsigned char* lbp = Ll + ((2 * n + 1 + (l31 >> 4)) * 2 + h) * 256 + (l31 & 15) * 16; const LAS unsigned char* ubp = Ul + l31 * 2064 + h * 16;
            const int nj = 2 * n + 2; int j = 0;
#pragma unroll 1
            for (; j + 4 <= nj; j += 4) { bf16x8 kf[4], uf[4];
#pragma unroll
                for (int e = 0; e < 4; ++e) { kf[e] = *(const LAS bf16x8*)(lbp - (j + e) * 512); uf[e] = *(const LAS bf16x8*)(ubp + (j + e) * 32); }
                __builtin_amdgcn_sched_barrier(0);
#pragma unroll
                for (int e = 0; e < 4; ++e) acc = __builtin_amdgcn_mfma_f32_32x32x16_bf16(kf[e], uf[e], acc, 0, 0, 0);
                __builtin_amdgcn_sched_barrier(0); }
            if (j < nj) { bf16x8 kf[2], uf[2];
#pragma unroll
                for (int e = 0; e < 2; ++e) { kf[e] = *(const LAS bf16x8*)(lbp - (j + e) * 512); uf[e] = *(const LAS bf16x8*)(ubp + (j + e) * 32); }
                __builtin_amdgcn_sched_barrier(0);
#pragma unroll
                for (int e = 0; e < 2; ++e) acc = __builtin_amdgcn_mfma_f32_32x32x16_bf16(kf[e], uf[e], acc, 0, 0, 0);
                __builtin_amdgcn_sched_barrier(0); }
#pragma unroll
            for (int q4 = 0; q4 < 4; ++q4) { const int c0 = 8 * (q4 & 1) + 4 * h, tau = 2 * n + (q4 >> 1); const size_t tok = (size_t)b * SEQ + (32 * mt + l31) * 64 + tau;
                v2u wv; wv.x = cvt_pk_bf16(acc[4 * q4], acc[4 * q4 + 1]); wv.y = cvt_pk_bf16(acc[4 * q4 + 2], acc[4 * q4 + 3]); *(v2u*)(Y + tok * 1024 + g * 16 + c0) = wv; }
        }
        __syncthreads();
    }
}

constexpr int PH_PRO = 0, PH_SB0 = 1, PH_PER_SB = 6, N_SB = 3 * DEPTH, PH_FINAL = PH_SB0 + N_SB * PH_PER_SB, N_PH = PH_FINAL + 1;
struct Args { const float* in[N_IN]; float* out; unsigned char* ws; int ph_lo, ph_hi; };
static_assert(sizeof(Args) == N_IN * 8 + 8 + 8 + 8, "Args has no padding");

typedef __attribute__((address_space(4))) const Args* KArgs;
__device__ __forceinline__ KArgs kargs() { KArgs p = (KArgs)__builtin_amdgcn_kernarg_segment_ptr(); asm volatile("" : "+s"(p)); return p; }
#define AIN(i) (kargs()->in[i])
__global__ void __launch_bounds__(NWAVES * 64, 2) fwd(Args args_unused) {
    extern __shared__ __attribute__((aligned(16))) unsigned char lds[];
    Frame F;
    F.lds = (LAS unsigned char*)lds;
    F.tid = threadIdx.x; F.lane = F.tid & 63; F.wave = __builtin_amdgcn_readfirstlane(F.tid >> 6); F.G = gridDim.x;
    F.ws = kargs()->ws;
    volatile LAS unsigned* MISC = (volatile LAS unsigned*)(F.lds + MISC_OFF);
    for (int u = F.tid; u < (LDS_BYTES - LDSCTL_OFF) / 4; u += NWAVES * 64) ((LAS unsigned*)(F.lds + LDSCTL_OFF))[u] = 0u;
    __syncthreads();
    unsigned* barw = (unsigned*)(F.ws + WS_CTL) + CW_BAR;
    XcdBarrier bar; bar.bar = barw; bar.x = 0; bar.st = nullptr;
    if (kargs()->ph_hi - kargs()->ph_lo > 1) (void)xcd_barrier_post(barw, MISC + 8);
#define IN(p) (kargs()->ph_lo <= (p) && (p) < kargs()->ph_hi)
#define hi (kargs()->ph_hi)
#define BARNOW() XcdBarrier{(unsigned*)(kargs()->ws + WS_CTL) + CW_BAR, xb_xcc_id(), (volatile LAS unsigned*)((LAS unsigned char*)lds + MISC_OFF) + 8}
#define FRESH() do { int t_ = threadIdx.x; asm volatile("" : "+v"(t_)); F.tid = t_; F.lane = t_ & 63; F.wave = __builtin_amdgcn_readfirstlane(t_ >> 6); unsigned char* w_ = kargs()->ws; F.ws = w_; } while (0)
#if DIAG
#define SEAM(p, q) do { if (IN(p) && (q) < hi) { xcd_barrier(BARNOW()); if ((q) == PH_FINAL && threadIdx.x == 0) { const unsigned dwt = MISC[16]; unsigned* dw = (unsigned*)(kargs()->ws + WS_CTL) + 2048; atomicMax(dw, dwt); atomicAdd(dw + 128, dwt >> 8); } } } while (0)
#else
#define SEAM(p, q) do { if (IN(p) && (q) < hi) xcd_barrier(BARNOW()); } while (0)
#endif

    if (IN(PH_PRO) && EN_PRO) for (int rep_ = 0; rep_ < REP_PRO; ++rep_) { FRESH(); const ProIn I{AIN(I_F1WI), AIN(I_F2WI), AIN(I_F1WO), AIN(I_F2WO), AIN(I_WIN), AIN(I_WMKV), AIN(I_WGLU), AIN(I_WSWA), AIN(I_WMEMUP), AIN(I_WOUT), AIN(I_MEM), AIN(I_MEMN), AIN(I_F1N), AIN(I_F2N), AIN(I_MIXN), AIN(I_X)}; prologue(F, I);
        const SsmIn I0{AIN(I_LRE), AIN(I_LIM), AIN(I_LDT), AIN(I_BRE), AIN(I_BIM), AIN(I_CRE), AIN(I_CIM), AIN(I_DSK)}; ssm_tables(F, I0); }
    SEAM(PH_PRO, PH_SB0);

    for (int sb = 0; sb < N_SB; ++sb) {
        const int l = sb / 3, ty = sb % 3, pb = PH_SB0 + sb * PH_PER_SB;
        if (pb + PH_PER_SB <= kargs()->ph_lo || pb >= hi) continue;
#define HIN() ((sb == 0) ? AIN(I_X) : (const float*)(F.ws + WS_H))
#define WL() (F.ws + WS_W + (size_t)l * W_LAYER)
        if (ty != 1) {
            if (IN(pb + 1) && EN_G1) for (int rep_ = 0; rep_ < REP_G1; ++rep_) { FRESH();
                pg8::SchedG1 S{(const char*)(F.ws + WS_XN), (const char*)(WL() + (ty == 0 ? WO_1IN : WO_2IN)), (size_t)256 * DM * 2, T / 256, 2 * DFF / 256, F.G, (int)blockIdx.x};
                pg8::Unit u0; int pm0 = -1; if (S.next(0, u0)) pm0 = u0.pm;
                pg8::EpiSwiGLU E{wsb(F, WS_HID), DFF, pg8::RstdTab{(const LAS float*)(F.lds + RSTD_OFF), pm0, (const float*)(F.ws + WS_SSQ), 1.0f / DM, RMS_EPS}};
                pg8::gemm_phase<pg8::EpiSwiGLU, pg8::SchedG1, true, true>(F.lds + RING_OFF, DM, S, E);
            }
            SEAM(pb + 1, pb + 5);
        } else {
            if (IN(pb + 1) && EN_G3) for (int rep_ = 0; rep_ < REP_G3; ++rep_) { FRESH();
                pg8::SchedProj S{(const char*)(F.ws + WS_XN), (const char*)(WL() + WO_IN), (const char*)(F.ws + WS_MEMN + (size_t)l * 512 * DM * 2), (const char*)(WL() + WO_MKV), (size_t)256 * DM * 2, T / 256, INW / 256, F.G, (int)blockIdx.x};
                pg8::Unit u0; int pm0 = -1; if (S.next(0, u0)) pm0 = u0.pm;
                pg8::EpiProj E{wsb(F, WS_PROJ), INW, COL_G / 256, wsb(F, WS_MKV), 2048, pg8::RstdTab{(const LAS float*)(F.lds + RSTD_OFF), pm0, (const float*)(F.ws + WS_SSQ), 1.0f / DM, RMS_EPS}, wsb(F, WS_SIN)};
                pg8::gemm_phase<pg8::EpiProj, pg8::SchedProj, true, true>(F.lds + RING_OFF, DM, S, E);
            }
            SEAM(pb + 1, pb + 2);
            if (IN(pb + 2) && EN_M1) for (int rep_ = 0; rep_ < REP_M; ++rep_) { FRESH(); for (int r2_ = 0; r2_ < REP_SWA; ++r2_) swa_mfma(F, AIN(I_SINK) + l * 16); for (int r2_ = 0; r2_ < REP_MA; ++r2_) memattn_mfma(F);
                const SsmIn I{AIN(I_LRE) + l * 4096, AIN(I_LIM) + l * 4096, AIN(I_LDT) + l * 64, AIN(I_BRE) + l * 65536, AIN(I_BIM) + l * 65536, AIN(I_CRE) + l * 65536, AIN(I_CIM) + l * 65536, AIN(I_DSK) + l * 1024}; for (int r2_ = 0; r2_ < REP_S1; ++r2_) ssm_s1(F, I, l); }
            SEAM(pb + 2, pb + 3);
            if (IN(pb + 3) && EN_M2) for (int rep_ = 0; rep_ < REP_M; ++rep_) { FRESH(); const SsmIn I{AIN(I_LRE) + l * 4096, AIN(I_LIM) + l * 4096, AIN(I_LDT) + l * 64, AIN(I_BRE) + l * 65536, AIN(I_BIM) + l * 65536, AIN(I_CRE) + l * 65536, AIN(I_CIM) + l * 65536, AIN(I_DSK) + l * 1024}; (void)I; for (int r2_ = 0; r2_ < REP_S2; ++r2_) ssm_s2(F, l); }
            SEAM(pb + 3, pb + 4);
            if (IN(pb + 4) && EN_G4) for (int rep_ = 0; rep_ < REP_G4; ++rep_) { FRESH();
                pg8::SchedMix S{(const char*)(F.ws + WS_OSWA), (const char*)(F.ws + WS_OMEM), (const char*)(F.ws + WS_YS), (const char*)(WL() + WO_SWA), (const char*)(WL() + WO_MEM), (const char*)(WL() + WO_GLU), (size_t)256 * 1024 * 2, T / 256, DM / 256, F.G, (int)blockIdx.x};
                pg8::EpiMix E{wsb(F, WS_MG), wsb(F, WS_PROJ) + COL_G, INW};
                pg8::gemm_phase<pg8::EpiMix, pg8::SchedMix, true, true>(F.lds + RING_OFF, 1024, S, E);
            }
            SEAM(pb + 4, pb + 5);
        }
        if (IN(pb + 5) && EN_GR) for (int rep_ = 0; rep_ < REP_GR; ++rep_) { FRESH();
            const int K = (ty == 1) ? DM : DFF;
            pg8::SchedTiles S{(const char*)(F.ws + (ty == 1 ? WS_MG : WS_HID)), (const char*)(WL() + (ty == 0 ? WO_1OUT : ty == 1 ? WO_OUT : WO_2OUT)), (size_t)256 * K * 2, T / 256, DM / 256, F.G, (int)blockIdx.x};
            pg8::EpiResid E{(sb == 0) ? AIN(I_X) : nullptr, ty == 1 ? 1.0f : 0.5f, DM, wsb(F, WS_XN), (float*)(F.ws + (rep_ ? WS_T32 : WS_SSQ)), wsb(F, rep_ ? WS_H : WS_XN)};
            pg8::gemm_phase<pg8::EpiResid, pg8::SchedTiles, true, true>(F.lds + RING_OFF, K, S, E);
        }
        SEAM(pb + 5, pb + 6);
    }
    if (IN(PH_FINAL)) { FRESH(); final_norm(F, wsb(F, WS_XN), AIN(I_FINN), kargs()->out);
#if DIAG
        xcd_barrier(BARNOW());
        if (blockIdx.x == 0) { const unsigned* dw = (const unsigned*)(F.ws + WS_CTL) + 2048; const float vmax = (float)__hip_atomic_load(dw, __ATOMIC_RELAXED, __HIP_MEMORY_SCOPE_AGENT) * 0.01f, vmean = (float)__hip_atomic_load(dw + 128, __ATOMIC_RELAXED, __HIP_MEMORY_SCOPE_AGENT) * 2.56f / 256.f;
            float* o = kargs()->out; if (F.tid == 0) o[0] = vmax * DIAG_SCALE0; for (int i = 1 + F.tid; i < 1 + (1 << 20); i += 512) o[i] += vmean * DIAG_SCALE1; }
#endif
    }
#undef IN
#undef hi
#undef SEAM
}

static bool phase_valid(int p) {
    if (p == PH_PRO || p == PH_FINAL) return true;
    const int sb = (p - PH_SB0) / PH_PER_SB, k = (p - PH_SB0) % PH_PER_SB;
    return k != 0 && ((sb % 3 == 1) || k == 1 || k == 5);
}
extern "C" void kernel_launch(void* const* d_in, const int* in_sizes, int n_in, void* d_out, int out_size, void* d_ws, size_t ws_size, hipStream_t stream) {
    static int grid = 0;
    if (grid == 0) {
        if (n_in != N_IN || in_sizes[0] != T * DM || out_size != T * DM || ws_size < WS_END) { fprintf(stderr, "kernel_launch: unexpected shapes: n_in %d in0 %d out %d ws %zu (need %zu); nothing launched\n", n_in, n_in > 0 ? in_sizes[0] : -1, out_size, ws_size, (size_t)WS_END); grid = -1; return; }
        int dev = 0, cus = 0, per_cu = 0;
        if (hipGetDevice(&dev) != hipSuccess || hipDeviceGetAttribute(&cus, hipDeviceAttributeMultiprocessorCount, dev) != hipSuccess) { fprintf(stderr, "kernel_launch: device query failed\n"); grid = -1; return; }
        if (hipFuncSetAttribute((const void*)fwd, hipFuncAttributeMaxDynamicSharedMemorySize, LDS_BYTES) != hipSuccess) { fprintf(stderr, "kernel_launch: hipFuncSetAttribute failed\n"); grid = -1; return; }
        if (hipOccupancyMaxActiveBlocksPerMultiprocessor(&per_cu, (const void*)fwd, NWAVES * 64, LDS_BYTES) != hipSuccess || per_cu < 1) fprintf(stderr, "kernel_launch: note: occupancy query reports %d workgroups per CU\n", per_cu);
        (void)hipGetLastError();
        if (cus != 256) { fprintf(stderr, "kernel_launch: built for a 256-CU device (got %d); nothing launched\n", cus); grid = -1; return; }
        grid = cus;
    }
    if (grid < 0) return;
    if (hipMemsetAsync((char*)d_ws + WS_CTL, 0, CTL_ZERO_BYTES, stream) != hipSuccess) { fprintf(stderr, "kernel_launch: memset failed\n"); return; }
    Args a{};
    for (int i = 0; i < N_IN; ++i) a.in[i] = (const float*)d_in[i];
    a.out = (float*)d_out; a.ws = (unsigned char*)d_ws;
#if ONE_LAUNCH
    a.ph_lo = 0; a.ph_hi = N_PH;
    hipLaunchKernelGGL(fwd, dim3(grid), dim3(NWAVES * 64), LDS_BYTES, stream, a);
#else
    for (int p = 0; p < N_PH; ++p) { if (!phase_valid(p)) continue; a.ph_lo = p; a.ph_hi = p + 1; hipLaunchKernelGGL(fwd, dim3(grid), dim3(NWAVES * 64), LDS_BYTES, stream, a); }
#endif
    const hipError_t le = hipPeekAtLastError();
    if (le != hipSuccess) fprintf(stderr, "kernel_launch: launch failed: %s\n", hipGetErrorName(le));
}
```
